# Optimizing an MI355X kernel written in HIP

```python
import jax
import jax.numpy as jnp
from jax import lax
import numpy as np

D_MODEL = 1024
BATCH = 4
SEQ = 4096
DEPTH = 2

GRID_W = 64
CTX_LEN = 256
N_MIXERS = 4
MIX_W = D_MODEL
GROUP_W = MIX_W // N_MIXERS
HEAD_DIM = 64
GROUP_HEADS = GROUP_W // HEAD_DIM
RMS_EPS = 1e-6
ROPE_BASE = 10000.0

RWKV_W_LORA = 32
RWKV_A_LORA = 32
RWKV_V_LORA = 32
RWKV_G_LORA = 64
RWKV_GN_EPS = 64e-5

RET_CHUNK = 128
GDN_CHUNK = 64
SHORT_CONV = 4
LRU_CONV = 4
LRU_C = 8.0

N_EXPERTS = 64
TOP_K = 8
EXPERT_FF = 256
SHARED_FF = 256
ROUTED_SCALE = 2.5
MOE_BLOCK = 128

RWKV_COLS = (GROUP_W, GROUP_W, GROUP_W, 2 * RWKV_W_LORA, 2 * RWKV_A_LORA, RWKV_G_LORA)
RET_COLS = (GROUP_W, GROUP_W, GROUP_W, GROUP_W)
GDN_COLS = (3 * GROUP_W, 2 * GROUP_HEADS, 2 * GROUP_HEADS, GROUP_W)
LRU_COLS = (GROUP_W, GROUP_W)
N_RWKV = sum(RWKV_COLS)
N_RET = sum(RET_COLS)
N_GDN = sum(GDN_COLS)
N_LRU = sum(LRU_COLS)
N_IN = N_RWKV + N_RET + N_GDN + N_LRU

kernel_name = 'hybrid_parallel_mixer_moe_dit'


def split_cols(t, sizes):
    return jnp.split(t, np.cumsum(sizes)[:-1].tolist(), axis=-1)


def to_heads(t):
    return t.reshape(t.shape[0], t.shape[1], -1, HEAD_DIM)


def flip_if(t, rev):
    return jnp.flip(t, 1) if rev else t


def rmsnorm(x, g):
    xf = x.astype(jnp.float32)
    y = xf * lax.rsqrt(jnp.mean(xf * xf, -1, keepdims=True) + RMS_EPS)
    return (y * g.astype(jnp.float32)).astype(x.dtype)


def head_rmsnorm(y):
    y = y.astype(jnp.float32)
    return y * lax.rsqrt(jnp.mean(y * y, -1, keepdims=True) + RMS_EPS)


def l2norm(t):
    tf = t.astype(jnp.float32)
    return tf * lax.rsqrt(jnp.sum(tf * tf, -1, keepdims=True) + 1e-6)


def group_norm_heads(y, w, b):
    mu = jnp.mean(y, -1, keepdims=True)
    var = jnp.mean(jnp.square(y - mu), -1, keepdims=True)
    yn = ((y - mu) * lax.rsqrt(var + RWKV_GN_EPS)).reshape(y.shape[0], y.shape[1], -1)
    return yn * w + b


def modulate(xn, shift, scale):
    return xn * (1 + scale) + shift


def conv_centred(x, w):
    K = w.shape[0]
    left = K // 2
    L = x.shape[1]
    xp = jnp.pad(x, ((0, 0), (left, K - 1 - left), (0, 0)))
    return sum(xp[:, j:j + L] * w[j] for j in range(K))


def token_shift_centred(x):
    xp = jnp.pad(x, ((0, 0), (1, 1), (0, 0)))
    return 0.5 * (xp[:, :-2] + xp[:, 2:])


def axial_rope(t):
    L = t.shape[1]
    rows_n = L // GRID_W
    rows = jnp.repeat(jnp.arange(rows_n), GRID_W).astype(jnp.float32)
    cols = jnp.tile(jnp.arange(GRID_W), rows_n).astype(jnp.float32)
    nf = HEAD_DIM // 4
    inv = ROPE_BASE ** (-jnp.arange(nf, dtype=jnp.float32) / nf)
    ang = jnp.concatenate([rows[:, None] * inv, cols[:, None] * inv], -1)[None, :, None, :]
    cos, sin = jnp.cos(ang), jnp.sin(ang)
    tf = t.astype(jnp.float32)
    t1, t2 = tf[..., :HEAD_DIM // 2], tf[..., HEAD_DIM // 2:]
    return jnp.concatenate([t1 * cos - t2 * sin, t1 * sin + t2 * cos], -1).astype(t.dtype)


def rwkv7_prepare(p, mu, w0, w2, a0, a2, g2, k_k, k_a):
    B_, L, _ = p.shape
    p = p + (token_shift_centred(p) - p) * mu
    r, k, v, wd, ad, gd = split_cols(p, RWKV_COLS)
    z = w0 + jnp.einsum('bldr,drc->bldc', jnp.tanh(wd.reshape(B_, L, 2, RWKV_W_LORA)), w2)
    log_w = -jnp.exp(-jax.nn.softplus(-z.astype(jnp.float32)) - 0.5)
    a = jax.nn.sigmoid(a0 + jnp.einsum('bldr,drc->bldc', ad.reshape(B_, L, 2, RWKV_A_LORA), a2))
    g = jax.nn.sigmoid(gd) @ g2
    kk = l2norm(to_heads(k * k_k))
    k_dir = k[:, :, None, :] * (1 + (a - 1) * k_a)
    return r, k_dir, v, log_w, a, kk, g


def rwkv7_scan(r, log_w, k, v, kk, a, S0, reverse):
    f = lambda t: jnp.moveaxis(t.astype(jnp.float32), 1, 0)

    def step(S, inp):
        r_t, lw_t, k_t, v_t, kk_t, a_t = inp
        sa = jnp.einsum('bhvk,bhk->bhv', S, kk_t)
        S = (S * jnp.exp(lw_t)[:, :, None, :] - sa[..., None] * (kk_t * a_t)[:, :, None, :]
             + v_t[..., None] * k_t[:, :, None, :])
        return S, jnp.einsum('bhvk,bhk->bhv', S, r_t)

    S, y = lax.scan(step, S0, (f(r), f(log_w), f(k), f(v), f(kk), f(a)), reverse=reverse)
    return jnp.moveaxis(y, 0, 1), S


def rwkv7_bonus(r, k, v, r_k):
    rf, kf, vf = (to_heads(t).astype(jnp.float32) for t in (r, k, v))
    b = jnp.sum(rf * kf * r_k, -1, keepdims=True) * vf
    return b.reshape(b.shape[0], b.shape[1], GROUP_W)


def rwkv7_mixer(pc, px, vres, mu, w0, w2, a0, a2, g2, k_k, k_a, r_k, ln_w, ln_b, ctx_out):
    prm = (mu, w0, w2, a0, a2, g2, k_k, k_a)
    rc, kc, vc, lwc, ac, kkc, gc = rwkv7_prepare(pc, *prm)
    rx, kx, vx, lwx, ax, kkx, gx = rwkv7_prepare(px, *prm)
    if vres is not None:
        vf_c, vf_x, vd_c, vd_x, v0, v2 = vres
        vc = vc + (vf_c - vc) * jax.nn.sigmoid(v0 + vd_c @ v2)
        vx = vx + (vf_x - vx) * jax.nn.sigmoid(v0 + vd_x @ v2)
    S0 = jnp.zeros((pc.shape[0], GROUP_HEADS, HEAD_DIM, HEAD_DIM), jnp.float32)
    yc = yx = bc = bx = 0.0
    for d, rev in enumerate((False, True)):
        zc, Sc = rwkv7_scan(to_heads(rc), to_heads(lwc[:, :, d]), to_heads(kc[:, :, d]), to_heads(vc),
                            kkc, to_heads(ac[:, :, d]), S0, rev)
        zx, _ = rwkv7_scan(to_heads(rx), to_heads(lwx[:, :, d]), to_heads(kx[:, :, d]), to_heads(vx),
                           kkx, to_heads(ax[:, :, d]), Sc, rev)
        yx = yx + zx
        bx = bx + rwkv7_bonus(rx, kx[:, :, d], vx, r_k)
        if ctx_out:
            yc = yc + zc
            bc = bc + rwkv7_bonus(rc, kc[:, :, d], vc, r_k)
    out_x = (group_norm_heads(yx, ln_w, ln_b) + bx) * gx
    out_c = (group_norm_heads(yc, ln_w, ln_b) + bc) * gc if ctx_out else None
    return out_c, out_x, vc, vx


def retention_chunked(q, k, v, log_gamma, R0):
    B_, L, H, dk = q.shape
    dv = v.shape[-1]
    C = RET_CHUNK
    n = L // C
    q, k, v = (t.astype(jnp.float32).reshape(B_, n, C, H, t.shape[-1]) for t in (q, k, v))
    i = jnp.arange(C, dtype=jnp.float32)
    diff = i[:, None] - i[None, :]
    decay = jnp.where(diff >= 0, jnp.exp(jnp.maximum(diff, 0.0)[None] * log_gamma[:, None, None]), 0.0)
    s = jnp.einsum('bnihd,bnjhd->bnhij', q, k) * decay
    o = jnp.einsum('bnhij,bnjhe->bnihe', s, v)
    zeta = jnp.exp((C - 1 - i)[None] * log_gamma[:, None])
    kv = jnp.einsum('bnjhd,bnjhe,hj->nbhde', k, v, zeta)
    gC = jnp.exp(C * log_gamma)[:, None, None]

    def step(R, kv_i):
        return R * gC + kv_i, R

    R, R_prev = lax.scan(step, R0, kv)
    xi = jnp.exp((i + 1)[None] * log_gamma[:, None])
    o = o + jnp.einsum('bnihd,nbhde,hi->bnihe', q, R_prev, xi)
    return o.reshape(B_, L, H, dv), R


def retention_mixer(pc, px, ret_lambda, ctx_out):
    def prep(p, rope):
        q, k, v, g = (to_heads(t) for t in split_cols(p, RET_COLS))
        if rope:
            q, k = axial_rope(q), axial_rope(k)
        return q, k * HEAD_DIM ** -0.5, v, g

    qc, kc, vc, gc = prep(pc, False)
    qx, kx, vx, gx = prep(px, True)
    R0 = jnp.zeros((pc.shape[0], GROUP_HEADS, HEAD_DIM, HEAD_DIM), jnp.float32)
    oc = ox = 0.0
    for d, rev in enumerate((False, True)):
        lg = -ret_lambda[d].astype(jnp.float32)
        o1, R = retention_chunked(flip_if(qc, rev), flip_if(kc, rev), flip_if(vc, rev), lg, R0)
        o2, _ = retention_chunked(flip_if(qx, rev), flip_if(kx, rev), flip_if(vx, rev), lg, R)
        ox = ox + flip_if(o2, rev)
        if ctx_out:
            oc = oc + flip_if(o1, rev)

    def post(o, g):
        y = head_rmsnorm(o) * jax.nn.silu(g.astype(jnp.float32))
        return y.reshape(y.shape[0], y.shape[1], GROUP_W)

    return (post(oc, gc) if ctx_out else None), post(ox, gx)


def gated_delta_chunked(q, k, v, g, beta, S0):
    B_, L, H, dk = q.shape
    dv = v.shape[-1]
    C = GDN_CHUNK
    n = L // C

    def chunk(t):
        t = t.astype(jnp.float32).reshape((B_, n, C, H) + t.shape[3:])
        return jnp.moveaxis(t, 3, 1)

    q, k, v, g, beta = chunk(q), chunk(k), chunk(v), chunk(g), chunk(beta)
    gc = jnp.cumsum(g, -1)
    i = jnp.arange(C)
    lower = i[:, None] >= i[None, :]
    strict = i[:, None] > i[None, :]
    gam = jnp.exp(jnp.where(lower, gc[..., :, None] - gc[..., None, :], -jnp.inf))
    kb = k * beta[..., None]
    A = jnp.where(strict, jnp.einsum('bhnid,bhnjd->bhnij', kb, k) * gam, 0.0)
    M = A + jnp.eye(C, dtype=jnp.float32)
    rhs = jnp.concatenate([v * beta[..., None], kb * jnp.exp(gc)[..., None]], -1)
    sol = lax.linalg.triangular_solve(M, rhs, left_side=True, lower=True, unit_diagonal=True)
    u, w = sol[..., :dv], sol[..., dv:]
    attn = jnp.einsum('bhnid,bhnjd->bhnij', q, k) * gam
    qg = q * jnp.exp(gc)[..., None]
    kg = k * jnp.exp(gc[..., -1:] - gc)[..., None]
    glast = jnp.exp(gc[..., -1])[..., None, None]

    def step(S, inp):
        u_i, w_i, a_i, qg_i, kg_i, gl_i = inp
        v_new = u_i - jnp.einsum('bhck,bhkv->bhcv', w_i, S)
        o_i = jnp.einsum('bhck,bhkv->bhcv', qg_i, S) + jnp.einsum('bhij,bhjv->bhiv', a_i, v_new)
        S = S * gl_i + jnp.einsum('bhck,bhcv->bhkv', kg_i, v_new)
        return S, o_i

    xs = tuple(jnp.moveaxis(t, 2, 0) for t in (u, w, attn, qg, kg, glast))
    S, o = lax.scan(step, S0, xs)
    o = jnp.transpose(o, (1, 0, 3, 2, 4)).reshape(B_, L, H, dv)
    return o, S


def gdn_mixer(pc, px, conv_w, a_log, dt_bias, norm_w, ctx_out):
    def prep(p):
        B_, L, _ = p.shape
        qkv, a, b, g = split_cols(p, GDN_COLS)
        q, k, v = jnp.split(jax.nn.silu(conv_centred(qkv, conv_w)), 3, -1)
        q = l2norm(to_heads(q)) * HEAD_DIM ** -0.5
        k = l2norm(to_heads(k))
        a = a.reshape(B_, L, 2, GROUP_HEADS).astype(jnp.float32)
        log_decay = -jnp.exp(a_log.astype(jnp.float32)) * jax.nn.softplus(a + dt_bias)
        beta = jax.nn.sigmoid(b.reshape(B_, L, 2, GROUP_HEADS).astype(jnp.float32))
        return q, k, to_heads(v), log_decay, beta, to_heads(g)

    qc, kc, vc, ldc, btc, gc = prep(pc)
    qx, kx, vx, ldx, btx, gx = prep(px)
    S0 = jnp.zeros((pc.shape[0], GROUP_HEADS, HEAD_DIM, HEAD_DIM), jnp.float32)
    oc = ox = 0.0
    for d, rev in enumerate((False, True)):
        o1, S = gated_delta_chunked(flip_if(qc, rev), flip_if(kc, rev), flip_if(vc, rev),
                                    flip_if(ldc[:, :, d], rev), flip_if(btc[:, :, d], rev), S0)
        o2, _ = gated_delta_chunked(flip_if(qx, rev), flip_if(kx, rev), flip_if(vx, rev),
                                    flip_if(ldx[:, :, d], rev), flip_if(btx[:, :, d], rev), S)
        ox = ox + flip_if(o2, rev)
        if ctx_out:
            oc = oc + flip_if(o1, rev)

    def post(o, g):
        y = head_rmsnorm(o) * norm_w * jax.nn.silu(g.astype(jnp.float32))
        return y.reshape(y.shape[0], y.shape[1], GROUP_W)

    return (post(oc, gc) if ctx_out else None), post(ox, gx)


def linear_scan(a, b, h0, reverse):
    if h0 is not None:
        end = -1 if reverse else 0
        b = b.at[:, end].add(a[:, end] * h0)

    def combine(l, r):
        return l[0] * r[0], r[0] * l[1] + r[1]

    return lax.associative_scan(combine, (a, b), reverse=reverse, axis=1)[1]


def rglru_mixer(pc, px, conv_w, conv_b, w_a, b_a, w_x, b_x, lam, ctx_out):
    def prep(p):
        xm, gate = split_cols(p, LRU_COLS)
        return conv_centred(xm, conv_w) + conv_b, gate

    def gates(xm, d):
        xb = to_heads(xm)
        r = jax.nn.sigmoid(jnp.einsum('blhi,hij->blhj', xb, w_a[d]).reshape(xm.shape) + b_a[d]).astype(jnp.float32)
        i = jax.nn.sigmoid(jnp.einsum('blhi,hij->blhj', xb, w_x[d]).reshape(xm.shape) + b_x[d]).astype(jnp.float32)
        log_a = -LRU_C * jax.nn.softplus(-lam[d].astype(jnp.float32)) * r
        return jnp.exp(log_a), jnp.sqrt(-jnp.expm1(2 * log_a)) * i * xm.astype(jnp.float32)

    xc, gc = prep(pc)
    xx, gx = prep(px)
    hc_sum = hx_sum = 0.0
    for d, rev in enumerate((False, True)):
        a_c, bb_c = gates(xc, d)
        h_c = linear_scan(a_c, bb_c, None, rev)
        a_x, bb_x = gates(xx, d)
        h_x = linear_scan(a_x, bb_x, h_c[:, 0] if rev else h_c[:, -1], rev)
        hx_sum = hx_sum + h_x
        if ctx_out:
            hc_sum = hc_sum + h_c
    out_x = hx_sum * jax.nn.gelu(gx.astype(jnp.float32))
    out_c = hc_sum * jax.nn.gelu(gc.astype(jnp.float32)) if ctx_out else None
    return out_c, out_x


def moe_ffn(h, router_w, router_bias, w_gate, w_up, w_down, s_gate, s_up, s_down):
    T, D = h.shape
    E = w_gate.shape[0]
    scores = jax.nn.sigmoid((h @ router_w).astype(jnp.float32))
    _, idx = lax.top_k(scores + router_bias.astype(jnp.float32), TOP_K)
    gate = jnp.take_along_axis(scores, idx, -1)
    gate = ROUTED_SCALE * gate / jnp.sum(gate, -1, keepdims=True)
    TK = T * TOP_K
    flat_e = idx.reshape(TK)
    order = jnp.argsort(flat_e)
    se = flat_e[order]
    counts = jnp.bincount(flat_e, length=E)
    nblk = (counts + MOE_BLOCK - 1) // MOE_BLOCK
    blk_end = jnp.cumsum(nblk)
    pad_start = (blk_end - nblk) * MOE_BLOCK
    grp_start = jnp.cumsum(counts) - counts
    dest = pad_start[se] + jnp.arange(TK) - grp_start[se]
    NB = -(-TK // MOE_BLOCK) + E
    slot_tok = jnp.full((NB * MOE_BLOCK,), T, jnp.int32).at[dest].set((order // TOP_K).astype(jnp.int32))
    slot_w = jnp.zeros((NB * MOE_BLOCK,), h.dtype).at[dest].set(gate.reshape(TK)[order].astype(h.dtype))
    blk_e = jnp.minimum(jnp.searchsorted(blk_end, jnp.arange(NB), side='right'), E - 1)
    h_pad = jnp.concatenate([h, jnp.zeros((1, D), h.dtype)], 0)

    def expert_block(acc, inp):
        tok, wt, e = inp
        hb = h_pad[tok]
        yb = (jax.nn.silu(hb @ w_gate[e]) * (hb @ w_up[e])) @ w_down[e]
        return acc.at[tok].add(yb * wt[:, None]), None

    routed, _ = lax.scan(expert_block, jnp.zeros((T + 1, D), h.dtype),
                         (slot_tok.reshape(NB, MOE_BLOCK), slot_w.reshape(NB, MOE_BLOCK), blk_e))
    shared = (jax.nn.silu(h @ s_gate) * (h @ s_up)) @ s_down
    return routed[:T] + shared


def setup_inputs(seed: int = 0) -> dict:
    key = jax.random.key(seed)
    keys = jax.random.split(key, 64)
    cnt = [0]
    f32 = jnp.float32

    def nxt():
        k = keys[cnt[0]]
        cnt[0] += 1
        return k

    def nrm(shape, scale=1.0):
        return scale * jax.random.normal(nxt(), shape, f32)

    def unif(shape, lo, hi):
        return jax.random.uniform(nxt(), shape, f32, lo, hi)

    L, H, D = DEPTH, GROUP_HEADS, D_MODEL
    ratio = jnp.arange(GROUP_W, dtype=f32) / (GROUP_W - 1)
    ret_base = -jnp.log(1.0 - 2.0 ** (-5.0 - jnp.arange(H, dtype=f32)))
    dt = jnp.exp(unif((L, 2, H), float(np.log(1e-3)), float(np.log(1e-1))))
    lru_a = unif((L, 2, GROUP_W), 0.9, 0.999) ** (1.0 / LRU_C)
    return {
        'x': nrm((BATCH, SEQ, D)),
        'c': nrm((BATCH, D)),
        'ctx': nrm((BATCH, CTX_LEN, D)),
        'c_ctx': nrm((D,)),
        'ada_w': nrm((L, D, 6 * D), 0.5 * D ** -0.5),
        'ada_b': nrm((L, 6 * D), 0.02),
        'norm_mix': 1.0 + nrm((L, D), 0.02),
        'norm_ffn': 1.0 + nrm((L, D), 0.02),
        'norm_final': 1.0 + nrm((D,), 0.02),
        'w_in': nrm((L, D, N_IN), D ** -0.5),
        'w_vres': nrm((L - 1, D, RWKV_V_LORA), D ** -0.5),
        'w_out': nrm((L, MIX_W, D), MIX_W ** -0.5),
        'rw_mu': unif((L, N_RWKV), 0.0, 1.0),
        'rw_w0': -6.0 + 5.0 * ratio ** 0.9 + nrm((L, 2, GROUP_W), 0.1),
        'rw_w2': nrm((L, 2, RWKV_W_LORA, GROUP_W), 0.1),
        'rw_a0': nrm((L, 2, GROUP_W), 0.1),
        'rw_a2': nrm((L, 2, RWKV_A_LORA, GROUP_W), 0.1),
        'rw_g2': nrm((L, RWKV_G_LORA, GROUP_W), RWKV_G_LORA ** -0.5),
        'rw_kk': 0.85 + nrm((L, GROUP_W), 0.02),
        'rw_ka': 1.0 + nrm((L, GROUP_W), 0.02),
        'rw_rk': nrm((L, H, HEAD_DIM), 0.1),
        'rw_ln_w': 1.0 + nrm((L, GROUP_W), 0.02),
        'rw_ln_b': nrm((L, GROUP_W), 0.02),
        'rw_v0': nrm((L - 1, GROUP_W), 0.1),
        'rw_v2': nrm((L - 1, RWKV_V_LORA, GROUP_W), 0.1),
        'ret_lambda': ret_base * jnp.exp(nrm((L, 2, H), 0.1)),
        'gdn_conv_w': nrm((L, SHORT_CONV, 3 * GROUP_W), SHORT_CONV ** -0.5),
        'gdn_a_log': jnp.log(unif((L, 2, H), 1.0, 16.0)),
        'gdn_dt_bias': dt + jnp.log(-jnp.expm1(-dt)),
        'gdn_norm_w': 1.0 + nrm((L, HEAD_DIM), 0.02),
        'lru_conv_w': nrm((L, LRU_CONV, GROUP_W), LRU_CONV ** -0.5),
        'lru_conv_b': nrm((L, GROUP_W), 0.02),
        'lru_w_a': nrm((L, 2, H, HEAD_DIM, HEAD_DIM), HEAD_DIM ** -0.5),
        'lru_b_a': nrm((L, 2, GROUP_W), 0.02),
        'lru_w_x': nrm((L, 2, H, HEAD_DIM, HEAD_DIM), HEAD_DIM ** -0.5),
        'lru_b_x': nrm((L, 2, GROUP_W), 0.02),
        'lru_lambda': jnp.log(lru_a) - jnp.log1p(-lru_a),
        'router_w': nrm((L, D, N_EXPERTS), D ** -0.5),
        'router_bias': nrm((L, N_EXPERTS), 0.01),
        'exp_w_gate': nrm((L, N_EXPERTS, D, EXPERT_FF), D ** -0.5),
        'exp_w_up': nrm((L, N_EXPERTS, D, EXPERT_FF), D ** -0.5),
        'exp_w_down': nrm((L, N_EXPERTS, EXPERT_FF, D), EXPERT_FF ** -0.5),
        'sh_w_gate': nrm((L, D, SHARED_FF), D ** -0.5),
        'sh_w_up': nrm((L, D, SHARED_FF), D ** -0.5),
        'sh_w_down': nrm((L, SHARED_FF, D), SHARED_FF ** -0.5),
    }


def reference(x, c, ctx, c_ctx, ada_w, ada_b, norm_mix, norm_ffn, norm_final, w_in, w_vres, w_out,
              rw_mu, rw_w0, rw_w2, rw_a0, rw_a2, rw_g2, rw_kk, rw_ka, rw_rk, rw_ln_w, rw_ln_b, rw_v0, rw_v2,
              ret_lambda, gdn_conv_w, gdn_a_log, gdn_dt_bias, gdn_norm_w,
              lru_conv_w, lru_conv_b, lru_w_a, lru_b_a, lru_w_x, lru_b_x, lru_lambda,
              router_w, router_bias, exp_w_gate, exp_w_up, exp_w_down, sh_w_gate, sh_w_up, sh_w_down):
    B_, L, D = x.shape
    n_lat = B_ * L
    vfirst = None
    for l in range(DEPTH):
        last = l == DEPTH - 1
        ctx_out = not last
        mod_x = [m[:, None, :] for m in jnp.split(jax.nn.silu(c) @ ada_w[l] + ada_b[l], 6, -1)]
        mod_c = jnp.split(jax.nn.silu(c_ctx) @ ada_w[l] + ada_b[l], 6, -1)
        hx = modulate(rmsnorm(x, norm_mix[l]), mod_x[0], mod_x[1])
        hc = modulate(rmsnorm(ctx, norm_mix[l]), mod_c[0], mod_c[1])
        if l == 0:
            w_l = w_in[l]
            cols = (N_RWKV, N_RET, N_GDN, N_LRU)
        else:
            w_l = jnp.concatenate([w_in[l], w_vres[l - 1]], -1)
            cols = (N_RWKV, N_RET, N_GDN, N_LRU, RWKV_V_LORA)
        px = split_cols(hx @ w_l, cols)
        pc = split_cols(hc @ w_l, cols)
        vres = None if l == 0 else (vfirst[0], vfirst[1], pc[4], px[4], rw_v0[l - 1], rw_v2[l - 1])
        a_c, a_x, v_c, v_x = rwkv7_mixer(pc[0], px[0], vres, rw_mu[l], rw_w0[l], rw_w2[l], rw_a0[l], rw_a2[l],
                                         rw_g2[l], rw_kk[l], rw_ka[l], rw_rk[l], rw_ln_w[l], rw_ln_b[l], ctx_out)
        if l == 0:
            vfirst = (v_c, v_x)
        b_c, b_x = retention_mixer(pc[1], px[1], ret_lambda[l], ctx_out)
        g_c, g_x = gdn_mixer(pc[2], px[2], gdn_conv_w[l], gdn_a_log[l], gdn_dt_bias[l], gdn_norm_w[l], ctx_out)
        r_c, r_x = rglru_mixer(pc[3], px[3], lru_conv_w[l], lru_conv_b[l], lru_w_a[l], lru_b_a[l],
                               lru_w_x[l], lru_b_x[l], lru_lambda[l], ctx_out)
        mix_x = jnp.concatenate([a_x, b_x, g_x, r_x], -1).astype(x.dtype) @ w_out[l]
        x = x + mod_x[2] * mix_x
        hx2 = modulate(rmsnorm(x, norm_ffn[l]), mod_x[3], mod_x[4]).reshape(n_lat, D)
        moe_prm = (router_w[l], router_bias[l], exp_w_gate[l], exp_w_up[l], exp_w_down[l],
                   sh_w_gate[l], sh_w_up[l], sh_w_down[l])
        if last:
            f_x = moe_ffn(hx2, *moe_prm)
        else:
            mix_c = jnp.concatenate([a_c, b_c, g_c, r_c], -1).astype(ctx.dtype) @ w_out[l]
            ctx = ctx + mod_c[2] * mix_c
            hc2 = modulate(rmsnorm(ctx, norm_ffn[l]), mod_c[3], mod_c[4]).reshape(-1, D)
            f = moe_ffn(jnp.concatenate([hx2, hc2], 0), *moe_prm)
            f_x = f[:n_lat]
            ctx = ctx + mod_c[5] * f[n_lat:].reshape(ctx.shape)
        x = x + mod_x[5] * f_x.reshape(x.shape)
    return rmsnorm(x, norm_final)
```

```cpp
#include <hip/hip_runtime.h>
#include <cstdio>
#include <cstdint>

typedef unsigned short bf16;
__device__ __forceinline__ float bf2f(bf16 v) { return __uint_as_float(((unsigned)v) << 16); }
__device__ __forceinline__ bf16 f2bf(float f) { unsigned u = __float_as_uint(f); u += 0x7fffu + ((u >> 16) & 1u); return (bf16)(u >> 16); }

constexpr int D = 1024, NB = 4, SEQ = 4096, CTXL = 256;
constexpr int NX = NB * SEQ;
constexpr int NC = NB * CTXL;
constexpr int MT = NX + NC;
constexpr int NIN = 3536, NINV = 3568, LDP = 3584;
constexpr int RW_OFF = 0, RET_OFF = 960, GDN_OFF = 1984, LRU_OFF = 3024, VRES_OFF = 3536;
constexpr int NE = 64, TOPK = 8, EFF = 256;
constexpr int NSTEP = CTXL + SEQ;

constexpr size_t MiB = 1u << 20;
constexpr size_t WS_MOD = 1 * MiB;
constexpr size_t WS_XN = 2 * MiB;
constexpr size_t WS_XR = 36 * MiB;
constexpr size_t WS_VF = 104 * MiB;
constexpr size_t WS_TOP = 121 * MiB;
constexpr size_t WS_BON = 123 * MiB;
constexpr size_t WS_G = 140 * MiB;
constexpr size_t WS_YS = 157 * MiB;
constexpr size_t WS_SV = 191 * MiB;
constexpr size_t WS_P = 208 * MiB;
constexpr size_t WS_SI = 327 * MiB;
constexpr size_t WS_END = 497 * MiB;

struct Row { int b, t, L, isx; };
__device__ __forceinline__ Row row_of(int m) { Row r; if (m < NX) { r.b = m >> 12; r.t = m & 4095; r.L = SEQ; r.isx = 1; } else { int q = m - NX; r.b = q >> 8; r.t = q & 255; r.L = CTXL; r.isx = 0; } return r; }
__device__ __forceinline__ float sigmoidf_(float x) { return 1.f / (1.f + __expf(-x)); }
__device__ __forceinline__ float softplusf_(float x) { return x > 20.f ? x : log1pf(__expf(x)); }
__device__ __forceinline__ float siluf_(float x) { return x / (1.f + __expf(-x)); }
__device__ __forceinline__ float wave_sum(float v) {
#pragma unroll
    for (int o = 1; o < 64; o <<= 1) v += __shfl_xor(v, o);
    return v;
}

__global__ __launch_bounds__(256) void k_mod(const float* c, const float* cctx, const float* ada_w, const float* ada_b, float* MOD) {
    __shared__ float s[5][1024];
    const int l = blockIdx.y, j = blockIdx.x * 256 + threadIdx.x;
    for (int i = threadIdx.x; i < 5 * 1024; i += 256) { const int r = i >> 10, k = i & 1023; const float v = r < 4 ? c[r * 1024 + k] : cctx[k]; s[r][k] = siluf_(v); }
    __syncthreads();
    float acc[5] = {0.f, 0.f, 0.f, 0.f, 0.f};
    const float* W = ada_w + (size_t)l * 1024 * 6144 + j;
    for (int k = 0; k < 1024; ++k) { const float w = W[(size_t)k * 6144];
#pragma unroll
        for (int r = 0; r < 5; ++r) acc[r] += s[r][k] * w; }
    const float bb = ada_b[l * 6144 + j];
#pragma unroll
    for (int r = 0; r < 5; ++r) MOD[((size_t)l * 5 + r) * 6144 + j] = acc[r] + bb;
}

__global__ __launch_bounds__(256) void k_norm_mod(const float* xs, const float* cs, const float* gain, const float* MODl, int si, bf16* XN) {
    const int m = blockIdx.x * 4 + (threadIdx.x >> 6), lane = threadIdx.x & 63;
    if (m >= MT) return;
    const float* src = m < NX ? xs + (size_t)m * D : cs + (size_t)(m - NX) * D;
    const int rb = m < NX ? (m >> 12) : 4;
    const float* md = MODl + (size_t)rb * 6144;
    float v[16]; float ss = 0.f;
#pragma unroll
    for (int j = 0; j < 16; ++j) { v[j] = src[lane + 64 * j]; ss += v[j] * v[j]; }
    ss = wave_sum(ss);
    const float rs = rsqrtf(ss * (1.f / D) + 1e-6f);
#pragma unroll
    for (int j = 0; j < 16; ++j) { const int cidx = lane + 64 * j; const float y = v[j] * rs * gain[cidx]; XN[(size_t)m * D + cidx] = f2bf(y * (1.f + md[(si + 1) * 1024 + cidx]) + md[si * 1024 + cidx]); }
}

struct EpiP { bf16* P; __device__ void operator()(int m, int n, float v) const { P[(size_t)m * LDP + n] = f2bf(v); } };
struct EpiRes { const float* xs; const float* cs; const float* MODl; float* XR; __device__ void operator()(int m, int n, float v) const {
    const float xin = m < NX ? xs[(size_t)m * D + n] : cs[(size_t)(m - NX) * D + n]; const int rb = m < NX ? (m >> 12) : 4;
    XR[(size_t)m * D + n] = xin + MODl[(size_t)rb * 6144 + 2 * 1024 + n] * v; } };
template <class Epi>
__global__ __launch_bounds__(256) void k_gemm_naive(const bf16* A, int M, int N, int K, const float* B0, int N0, const float* B1, int N1, Epi epi) {
    __shared__ float As[16][65], Bs[16][64];
    const int tid = threadIdx.x, tx = tid & 15, ty = tid >> 4, m0 = blockIdx.y * 64, n0 = blockIdx.x * 64;
    float acc[4][4] = {};
    for (int k0 = 0; k0 < K; k0 += 16) {
        for (int i = tid; i < 1024; i += 256) { const int r = i >> 4, kk = i & 15; As[kk][r] = bf2f(A[(size_t)(m0 + r) * K + k0 + kk]); }
        for (int i = tid; i < 1024; i += 256) { const int kk = i >> 6, cc = i & 63, n = n0 + cc; float v = 0.f;
            if (n < N0) v = B0[(size_t)(k0 + kk) * N0 + n]; else if (n < N0 + N1) v = B1[(size_t)(k0 + kk) * N1 + (n - N0)];
            Bs[kk][cc] = v; }
        __syncthreads();
#pragma unroll
        for (int kk = 0; kk < 16; ++kk) { float a[4], b[4];
#pragma unroll
            for (int i = 0; i < 4; ++i) { a[i] = As[kk][ty * 4 + i]; b[i] = Bs[kk][tx * 4 + i]; }
#pragma unroll
            for (int i = 0; i < 4; ++i)
#pragma unroll
                for (int j = 0; j < 4; ++j) acc[i][j] += a[i] * b[j]; }
        __syncthreads();
    }
#pragma unroll
    for (int i = 0; i < 4; ++i)
#pragma unroll
        for (int j = 0; j < 4; ++j) { const int m = m0 + ty * 4 + i, n = n0 + tx * 4 + j; if (m < M && n < N0 + N1) epi(m, n, acc[i][j]); }
}

__device__ __forceinline__ float* si_ptr(float* SI, int d, int m, int h, int vec) { return SI + ((((size_t)d * MT + m) * 4 + h) * 5 + vec) * 64; }

struct RwP { const float *mu, *w0, *w2, *a0, *a2, *g2, *kk, *ka, *rk, *v0, *v2; };
__global__ __launch_bounds__(256) void k_rwkv_prep(const bf16* P, RwP w, int layer, float* VF, float* SI, float* SV, float* BON, float* G) {
    __shared__ float sp[960]; __shared__ float vd[32];
    const int m = blockIdx.x, c = threadIdx.x, h = c >> 6; const Row rw = row_of(m);
    const bf16* pr = P + (size_t)m * LDP;
    for (int j = c; j < 960; j += 256) { const float p = bf2f(pr[j]); const float pp = rw.t > 0 ? bf2f(pr[j - LDP]) : 0.f; const float pn = rw.t < rw.L - 1 ? bf2f(pr[j + LDP]) : 0.f;
        sp[j] = p + (0.5f * (pp + pn) - p) * w.mu[j]; }
    if (c < 32) vd[c] = bf2f(pr[VRES_OFF + c]);
    __syncthreads();
    const float r = sp[c], kv = sp[256 + c]; float v = sp[512 + c];
    float g = 0.f; for (int j = 0; j < 64; ++j) g += sigmoidf_(sp[896 + j]) * w.g2[j * 256 + c];
    const float kkr = kv * w.kk[c]; const float ss = wave_sum(kkr * kkr); const float kkn = kkr * rsqrtf(ss + 1e-6f);
    if (layer == 0) VF[(size_t)m * 256 + c] = v;
    else { float z = w.v0[c]; for (int j = 0; j < 32; ++j) z += vd[j] * w.v2[j * 256 + c]; v = v + (VF[(size_t)m * 256 + c] - v) * sigmoidf_(z); }
    float bsum = 0.f;
    for (int d = 0; d < 2; ++d) {
        float z = w.w0[d * 256 + c]; for (int j = 0; j < 32; ++j) z += tanhf(sp[768 + d * 32 + j]) * w.w2[(d * 32 + j) * 256 + c];
        const float lw = -0.6065306597f * sigmoidf_(z);
        float za = w.a0[d * 256 + c]; for (int j = 0; j < 32; ++j) za += sp[832 + d * 32 + j] * w.a2[(d * 32 + j) * 256 + c];
        const float a = sigmoidf_(za);
        const float kd = kv * (1.f + (a - 1.f) * w.ka[c]);
        const float bs = wave_sum(r * kd * w.rk[c]);
        bsum += bs * v;
        const int k = c & 63;
        si_ptr(SI, d, m, h, 0)[k] = __expf(lw); si_ptr(SI, d, m, h, 1)[k] = kkn; si_ptr(SI, d, m, h, 2)[k] = kkn * a; si_ptr(SI, d, m, h, 3)[k] = kd; si_ptr(SI, d, m, h, 4)[k] = r;
    }
    SV[(size_t)m * 256 + c] = v; BON[(size_t)m * 256 + c] = bsum; G[(size_t)m * 256 + c] = g;
}
__global__ __launch_bounds__(256) void k_rwkv_post(const float* YS, const float* BON, const float* G, const float* lnw, const float* lnb, bf16* MIX) {
    const int m = blockIdx.x, c = threadIdx.x;
    const float y = YS[(size_t)m * 256 + c] + YS[((size_t)MT + m) * 256 + c];
    const float mu = wave_sum(y) * (1.f / 64.f); const float dlt = y - mu; const float var = wave_sum(dlt * dlt) * (1.f / 64.f);
    const float yn = dlt * rsqrtf(var + 64e-5f);
    MIX[(size_t)m * D + c] = f2bf((yn * lnw[c] + lnb[c] + BON[(size_t)m * 256 + c]) * G[(size_t)m * 256 + c]);
}

__global__ __launch_bounds__(256) void k_ret_prep(const bf16* P, const float* lam  , float* SI, float* SV) {
    __shared__ float sq[256], sk[256];
    const int m = blockIdx.x, c = threadIdx.x, h = c >> 6, i = c & 63; const Row rw = row_of(m);
    const bf16* pr = P + (size_t)m * LDP + RET_OFF;
    float q = bf2f(pr[c]), k = bf2f(pr[256 + c]); const float v = bf2f(pr[512 + c]);
    sq[c] = q; sk[c] = k; __syncthreads();
    if (rw.isx) {
        const int j = i & 31, jj = j & 15; const float pos = j < 16 ? (float)(rw.t >> 6) : (float)(rw.t & 63);
        const float inv = powf(10000.f, -(float)jj / 16.f); const float ang = pos * inv; const float cs = cosf(ang), sn = sinf(ang);
        const int pc = i < 32 ? c + 32 : c - 32;
        const float q1 = i < 32 ? q : sq[pc], q2 = i < 32 ? sq[pc] : q, k1 = i < 32 ? k : sk[pc], k2 = i < 32 ? sk[pc] : k;
        q = i < 32 ? q1 * cs - q2 * sn : q1 * sn + q2 * cs; k = i < 32 ? k1 * cs - k2 * sn : k1 * sn + k2 * cs;
    }
    k *= 0.125f;
    for (int d = 0; d < 2; ++d) { const float gm = __expf(-lam[d * 4 + h]);
        si_ptr(SI, d, m, h, 0)[i] = gm; si_ptr(SI, d, m, h, 1)[i] = 0.f; si_ptr(SI, d, m, h, 2)[i] = 0.f; si_ptr(SI, d, m, h, 3)[i] = k; si_ptr(SI, d, m, h, 4)[i] = q; }
    SV[(size_t)m * 256 + c] = v;
}
__global__ __launch_bounds__(256) void k_hnorm_post(const float* YS, const bf16* P, int gate_off, const float* nw, bf16* MIX, int mix_off) {
    const int m = blockIdx.x, c = threadIdx.x;
    const float o = YS[(size_t)m * 256 + c] + YS[((size_t)MT + m) * 256 + c];
    const float ms = wave_sum(o * o) * (1.f / 64.f);
    const float g = bf2f(P[(size_t)m * LDP + gate_off + c]);
    float y = o * rsqrtf(ms + 1e-6f) * siluf_(g); if (nw) y *= nw[c & 63];
    MIX[(size_t)m * D + mix_off + c] = f2bf(y);
}
__global__ __launch_bounds__(256) void k_gdn_prep(const bf16* P, const float* cw  , const float* alog, const float* dtb, float* SI, float* SV) {
    const int m = blockIdx.x, c = threadIdx.x, h = c >> 6, i = c & 63; const Row rw = row_of(m);
    const bf16* pr = P + (size_t)m * LDP + GDN_OFF;
    float o[3];
#pragma unroll
    for (int s = 0; s < 3; ++s) { const int ch = s * 256 + c; float a = 0.f;
#pragma unroll
        for (int j = 0; j < 4; ++j) { const int tt = rw.t + j - 2; if (tt >= 0 && tt < rw.L) a += bf2f(pr[(ptrdiff_t)(j - 2) * LDP + ch]) * cw[j * 768 + ch]; }
        o[s] = siluf_(a); }
    const float qs = wave_sum(o[0] * o[0]), ks = wave_sum(o[1] * o[1]);
    const float q = o[0] * rsqrtf(qs + 1e-6f) * 0.125f, k = o[1] * rsqrtf(ks + 1e-6f);
    for (int d = 0; d < 2; ++d) {
        const float a = bf2f(pr[768 + d * 4 + h]), b = bf2f(pr[776 + d * 4 + h]);
        const float al = __expf(-__expf(alog[d * 4 + h]) * softplusf_(a + dtb[d * 4 + h])), be = sigmoidf_(b);
        si_ptr(SI, d, m, h, 0)[i] = al; si_ptr(SI, d, m, h, 1)[i] = k; si_ptr(SI, d, m, h, 2)[i] = al * be * k; si_ptr(SI, d, m, h, 3)[i] = be * k; si_ptr(SI, d, m, h, 4)[i] = q; }
    SV[(size_t)m * 256 + c] = o[2];
}
__device__ __forceinline__ int step_row(int b, int d, int s) { if (s < CTXL) { const int tc = d ? CTXL - 1 - s : s; return NX + b * CTXL + tc; } const int tx = d ? SEQ - 1 - (s - CTXL) : (s - CTXL); return b * SEQ + tx; }
__global__ __launch_bounds__(64) void k_rowscan(const float* SI, const float* SV, float* YS) {
    __shared__ float sh[2][5][64];
    const int seq = blockIdx.x, d = seq & 1, h = (seq >> 1) & 3, b = seq >> 3, v = threadIdx.x;
    float s[64];
#pragma unroll
    for (int k = 0; k < 64; ++k) s[k] = 0.f;
    float nx[5], nv; { const int m = step_row(b, d, 0); const float* p = SI + (((size_t)d * MT + m) * 4 + h) * 320;
#pragma unroll
        for (int j = 0; j < 5; ++j) nx[j] = p[j * 64 + v]; nv = SV[(size_t)m * 256 + h * 64 + v]; }
    for (int st = 0; st < NSTEP; ++st) {
        const int buf = st & 1; const int m = step_row(b, d, st);
#pragma unroll
        for (int j = 0; j < 5; ++j) sh[buf][j][v] = nx[j];
        const float vv = nv;
        __syncthreads();
        if (st + 1 < NSTEP) { const int m2 = step_row(b, d, st + 1); const float* p = SI + (((size_t)d * MT + m2) * 4 + h) * 320;
#pragma unroll
            for (int j = 0; j < 5; ++j) nx[j] = p[j * 64 + v]; nv = SV[(size_t)m2 * 256 + h * 64 + v]; }
        float sa = 0.f;
#pragma unroll
        for (int k = 0; k < 64; ++k) sa += s[k] * sh[buf][1][k];
        float y = 0.f;
#pragma unroll
        for (int k = 0; k < 64; ++k) { s[k] = s[k] * sh[buf][0][k] - sa * sh[buf][2][k] + vv * sh[buf][3][k]; y += s[k] * sh[buf][4][k]; }
        YS[((size_t)d * MT + m) * 256 + h * 64 + v] = y;
    }
}
struct LruP { const float *cw, *cb, *wa, *ba, *wx, *bx, *lam; };
__global__ __launch_bounds__(256) void k_lru_prep(const bf16* P, LruP w, float* LA, float* LB) {
    __shared__ float xs[256];
    const int m = blockIdx.x, c = threadIdx.x, h = c >> 6, i = c & 63; const Row rw = row_of(m);
    const bf16* pr = P + (size_t)m * LDP + LRU_OFF;
    float xm = w.cb[c];
#pragma unroll
    for (int j = 0; j < 4; ++j) { const int tt = rw.t + j - 2; if (tt >= 0 && tt < rw.L) xm += bf2f(pr[(ptrdiff_t)(j - 2) * LDP + c]) * w.cw[j * 256 + c]; }
    xs[c] = xm; __syncthreads();
    for (int d = 0; d < 2; ++d) {
        float ra = w.ba[d * 256 + c], rx = w.bx[d * 256 + c];
        const float* wa = w.wa + ((size_t)(d * 4 + h) * 64) * 64 + i; const float* wx = w.wx + ((size_t)(d * 4 + h) * 64) * 64 + i;
        for (int j = 0; j < 64; ++j) { const float xv = xs[h * 64 + j]; ra += xv * wa[j * 64]; rx += xv * wx[j * 64]; }
        const float r = sigmoidf_(ra), ig = sigmoidf_(rx);
        const float la = -8.f * softplusf_(-w.lam[d * 256 + c]) * r;
        LA[((size_t)d * MT + m) * 256 + c] = __expf(la); LB[((size_t)d * MT + m) * 256 + c] = sqrtf(-expm1f(2.f * la)) * ig * xm;
    }
}
__global__ __launch_bounds__(256) void k_lru_scan(const float* LA, const float* LB, float* YS) {
    const int d = blockIdx.x & 1, b = blockIdx.x >> 1, c = threadIdx.x;
    float hst = 0.f;
    for (int st = 0; st < NSTEP; st += 8) { float a[8], bb[8]; int mm[8];
#pragma unroll
        for (int u = 0; u < 8; ++u) { mm[u] = step_row(b, d, st + u); a[u] = LA[((size_t)d * MT + mm[u]) * 256 + c]; bb[u] = LB[((size_t)d * MT + mm[u]) * 256 + c]; }
#pragma unroll
        for (int u = 0; u < 8; ++u) { hst = a[u] * hst + bb[u]; YS[((size_t)d * MT + mm[u]) * 256 + c] = hst; } }
}
__global__ __launch_bounds__(256) void k_lru_post(const float* YS, const bf16* P, bf16* MIX) {
    const int m = blockIdx.x, c = threadIdx.x;
    const float hs = YS[(size_t)m * 256 + c] + YS[((size_t)MT + m) * 256 + c];
    const float g = bf2f(P[(size_t)m * LDP + LRU_OFF + 256 + c]);
    const float ge = 0.5f * g * (1.f + tanhf(0.7978845608f * (g + 0.044715f * g * g * g)));
    MIX[(size_t)m * D + 768 + c] = f2bf(hs * ge);
}

__global__ __launch_bounds__(256) void k_norm_route(const float* XR, const float* gain, const float* MODl, const float* rw  , const float* rbias, bf16* XN, int* TOPI, float* TOPG) {
    __shared__ float hs[1024]; __shared__ float part[4][64]; __shared__ float red[4]; __shared__ float sc[64]; __shared__ int sidx[8];
    const int m = blockIdx.x, tid = threadIdx.x, lane = tid & 63, wv = tid >> 6;
    const float* src = XR + (size_t)m * D; const int rb = m < NX ? (m >> 12) : 4; const float* md = MODl + (size_t)rb * 6144;
    float v[4]; float ss = 0.f;
#pragma unroll
    for (int j = 0; j < 4; ++j) { v[j] = src[tid + 256 * j]; ss += v[j] * v[j]; }
    ss = wave_sum(ss); if (lane == 0) red[wv] = ss; __syncthreads();
    const float rs = rsqrtf((red[0] + red[1] + red[2] + red[3]) * (1.f / D) + 1e-6f);
#pragma unroll
    for (int j = 0; j < 4; ++j) { const int ci = tid + 256 * j; const float y = v[j] * rs * gain[ci] * (1.f + md[4 * 1024 + ci]) + md[3 * 1024 + ci]; hs[ci] = y; XN[(size_t)m * D + ci] = f2bf(y); }
    __syncthreads();
    { float a = 0.f; const float* wp = rw + (size_t)(wv * 256) * 64 + lane; for (int k = 0; k < 256; ++k) a += hs[wv * 256 + k] * wp[(size_t)k * 64]; part[wv][lane] = a; }
    __syncthreads();
    if (tid < 64) sc[tid] = sigmoidf_(part[0][tid] + part[1][tid] + part[2][tid] + part[3][tid]);
    __syncthreads();
    if (tid == 0) { unsigned long long used = 0ull; float sum = 0.f;
        for (int k = 0; k < 8; ++k) { float best = -1e30f; int bi = 0; for (int e = 0; e < 64; ++e) { if ((used >> e) & 1ull) continue; const float sv = sc[e] + rbias[e]; if (sv > best) { best = sv; bi = e; } }
            used |= 1ull << bi; sidx[k] = bi; sum += sc[bi]; }
        for (int k = 0; k < 8; ++k) { const int e = sidx[k]; TOPI[(size_t)m * 8 + k] = e; TOPG[(size_t)m * 8 + k] = 2.5f * sc[e] / sum; } }
}
struct MoeW { const float *wg, *wu, *wd, *sg, *su, *sd; };
__global__ __launch_bounds__(256) void k_moe_naive(const bf16* XN, const int* TOPI, const float* TOPG, MoeW w, const float* MODl, float* XR) {
    __shared__ float hs[1024]; __shared__ float act[256];
    const int m = blockIdx.x, j = threadIdx.x;
    for (int i = j; i < 1024; i += 256) hs[i] = bf2f(XN[(size_t)m * D + i]);
    float acc[4] = {0.f, 0.f, 0.f, 0.f};
    for (int s = 0; s < 9; ++s) {
        const float *Wg, *Wu, *Wd; float gw;
        if (s < 8) { const int e = TOPI[(size_t)m * 8 + s]; gw = TOPG[(size_t)m * 8 + s]; Wg = w.wg + (size_t)e * 1024 * 256; Wu = w.wu + (size_t)e * 1024 * 256; Wd = w.wd + (size_t)e * 256 * 1024; }
        else { gw = 1.f; Wg = w.sg; Wu = w.su; Wd = w.sd; }
        __syncthreads();
        float g = 0.f, u = 0.f;
        for (int k = 0; k < 1024; ++k) { const float hv = hs[k]; g += hv * Wg[(size_t)k * 256 + j]; u += hv * Wu[(size_t)k * 256 + j]; }
        act[j] = siluf_(g) * u * gw;
        __syncthreads();
        for (int jj = 0; jj < 256; ++jj) { const float a = act[jj];
#pragma unroll
            for (int i = 0; i < 4; ++i) acc[i] += a * Wd[(size_t)jj * 1024 + j + 256 * i]; }
    }
    const int rb = m < NX ? (m >> 12) : 4;
#pragma unroll
    for (int i = 0; i < 4; ++i) { const int ci = j + 256 * i; XR[(size_t)m * D + ci] += MODl[(size_t)rb * 6144 + 5 * 1024 + ci] * acc[i]; }
}
__global__ __launch_bounds__(256) void k_final_norm(const float* XR, const float* gain, float* out) {
    const int m = blockIdx.x * 4 + (threadIdx.x >> 6), lane = threadIdx.x & 63;
    const float* src = XR + (size_t)m * D; float v[16]; float ss = 0.f;
#pragma unroll
    for (int j = 0; j < 16; ++j) { v[j] = src[lane + 64 * j]; ss += v[j] * v[j]; }
    ss = wave_sum(ss); const float rs = rsqrtf(ss * (1.f / D) + 1e-6f);
#pragma unroll
    for (int j = 0; j < 16; ++j) out[(size_t)m * D + lane + 64 * j] = v[j] * rs * gain[lane + 64 * j];
}

enum { I_X = 0, I_C, I_CTX, I_CCTX, I_ADAW, I_ADAB, I_NMIX, I_NFFN, I_NFIN, I_WIN, I_WVRES, I_WOUT, I_RWMU, I_RWW0, I_RWW2, I_RWA0, I_RWA2, I_RWG2, I_RWKK, I_RWKA, I_RWRK, I_RWLNW, I_RWLNB, I_RWV0, I_RWV2,
       I_RETL, I_GCW, I_GALOG, I_GDT, I_GNW, I_LCW, I_LCB, I_LWA, I_LBA, I_LWX, I_LBX, I_LLAM, I_RTW, I_RTB, I_EWG, I_EWU, I_EWD, I_SWG, I_SWU, I_SWD, I_N };

extern "C" void kernel_launch(void* const* d_in, const int* in_sizes, int n_in, void* d_out, int out_size, void* d_ws, size_t ws_size, hipStream_t stream) {
    if (n_in != I_N || ws_size < WS_END) { fprintf(stderr, "kernel_launch: bad n_in %d or ws %zu\n", n_in, ws_size); return; }
    const float* in[I_N]; for (int i = 0; i < I_N; ++i) in[i] = (const float*)d_in[i];
    unsigned char* ws = (unsigned char*)d_ws;
    float* MOD = (float*)(ws + WS_MOD); bf16* XN = (bf16*)(ws + WS_XN); bf16* MIX = XN; float* XR = (float*)(ws + WS_XR); float* VF = (float*)(ws + WS_VF);
    int* TOPI = (int*)(ws + WS_TOP); float* TOPG = (float*)(ws + WS_TOP + (size_t)MT * 8 * 4);
    float* BON = (float*)(ws + WS_BON); float* G = (float*)(ws + WS_G); float* YS = (float*)(ws + WS_YS); float* SV = (float*)(ws + WS_SV);
    bf16* P = (bf16*)(ws + WS_P); float* SI = (float*)(ws + WS_SI);
    float* out = (float*)d_out;

    k_mod<<<dim3(24, 2), 256, 0, stream>>>(in[I_C], in[I_CCTX], in[I_ADAW], in[I_ADAB], MOD);
    for (int l = 0; l < 2; ++l) {
        const float* MODl = MOD + (size_t)l * 5 * 6144;
        const float* xs = l == 0 ? in[I_X] : XR; const float* cs = l == 0 ? in[I_CTX] : XR + (size_t)NX * D;
        k_norm_mod<<<MT / 4, 256, 0, stream>>>(xs, cs, in[I_NMIX] + l * D, MODl, 0, XN);
        { const int N = l == 0 ? NIN : NINV; EpiP e{P};
          k_gemm_naive<EpiP><<<dim3((N + 63) / 64, MT / 64), 256, 0, stream>>>(XN, MT, N, D, in[I_WIN] + (size_t)l * D * NIN, NIN, in[I_WVRES], l == 0 ? 0 : 32, e); }
        { RwP w{in[I_RWMU] + l * 960, in[I_RWW0] + l * 512, in[I_RWW2] + l * 2 * 32 * 256, in[I_RWA0] + l * 512, in[I_RWA2] + l * 2 * 32 * 256, in[I_RWG2] + l * 64 * 256, in[I_RWKK] + l * 256, in[I_RWKA] + l * 256,
                in[I_RWRK] + l * 256, in[I_RWV0], in[I_RWV2]};
          k_rwkv_prep<<<MT, 256, 0, stream>>>(P, w, l, VF, SI, SV, BON, G);
          k_rowscan<<<32, 64, 0, stream>>>(SI, SV, YS);
          k_rwkv_post<<<MT, 256, 0, stream>>>(YS, BON, G, in[I_RWLNW] + l * 256, in[I_RWLNB] + l * 256, MIX); }
        k_ret_prep<<<MT, 256, 0, stream>>>(P, in[I_RETL] + l * 8, SI, SV);
        k_rowscan<<<32, 64, 0, stream>>>(SI, SV, YS);
        k_hnorm_post<<<MT, 256, 0, stream>>>(YS, P, RET_OFF + 768, nullptr, MIX, 256);
        k_gdn_prep<<<MT, 256, 0, stream>>>(P, in[I_GCW] + l * 4 * 768, in[I_GALOG] + l * 8, in[I_GDT] + l * 8, SI, SV);
        k_rowscan<<<32, 64, 0, stream>>>(SI, SV, YS);
        k_hnorm_post<<<MT, 256, 0, stream>>>(YS, P, GDN_OFF + 784, in[I_GNW] + l * 64, MIX, 512);
        { LruP w{in[I_LCW] + l * 4 * 256, in[I_LCB] + l * 256, in[I_LWA] + (size_t)l * 2 * 4 * 64 * 64, in[I_LBA] + l * 512, in[I_LWX] + (size_t)l * 2 * 4 * 64 * 64, in[I_LBX] + l * 512, in[I_LLAM] + l * 512};
          float* LA = SI; float* LB = SI + (size_t)2 * MT * 256;
          k_lru_prep<<<MT, 256, 0, stream>>>(P, w, LA, LB);
          k_lru_scan<<<8, 256, 0, stream>>>(LA, LB, YS);
          k_lru_post<<<MT, 256, 0, stream>>>(YS, P, MIX); }
        { EpiRes e{xs, cs, MODl, XR};
          k_gemm_naive<EpiRes><<<dim3(D / 64, MT / 64), 256, 0, stream>>>(MIX, MT, D, D, in[I_WOUT] + (size_t)l * D * D, D, nullptr, 0, e); }
        k_norm_route<<<MT, 256, 0, stream>>>(XR, in[I_NFFN] + l * D, MODl, in[I_RTW] + (size_t)l * D * NE, in[I_RTB] + l * NE, XN, TOPI, TOPG);
        { MoeW w{in[I_EWG] + (size_t)l * NE * D * EFF, in[I_EWU] + (size_t)l * NE * D * EFF, in[I_EWD] + (size_t)l * NE * EFF * D, in[I_SWG] + (size_t)l * D * EFF, in[I_SWU] + (size_t)l * D * EFF, in[I_SWD] + (size_t)l * EFF * D};
          k_moe_naive<<<MT, 256, 0, stream>>>(XN, TOPI, TOPG, w, MODl, XR); }
    }
    k_final_norm<<<NX / 4, 256, 0, stream>>>(XR, in[I_NFIN], out);
}
```

```cpp
#include <hip/hip_runtime.h>
#include <cstdio>
#include <cstdint>

typedef unsigned short bf16;
__device__ __forceinline__ float bf2f(bf16 v) { return __uint_as_float(((unsigned)v) << 16); }
__device__ __forceinline__ bf16 f2bf(float f) { unsigned u = __float_as_uint(f); u += 0x7fffu + ((u >> 16) & 1u); return (bf16)(u >> 16); }

constexpr int D = 1024, NB = 4, SEQ = 4096, CTXL = 256;
constexpr int NX = NB * SEQ;
constexpr int NC = NB * CTXL;
constexpr int MT = NX + NC;
constexpr int NIN = 3536, NINV = 3568, LDP = 3584;
constexpr int RW_OFF = 0, RET_OFF = 960, GDN_OFF = 1984, LRU_OFF = 3024, VRES_OFF = 3536;
constexpr int NE = 64, TOPK = 8, EFF = 256;
constexpr int NSTEP = CTXL + SEQ;

constexpr size_t MiB = 1u << 20;
constexpr size_t WS_MOD = 1 * MiB;
constexpr size_t WS_XN = 2 * MiB;
constexpr size_t WS_XR = 36 * MiB;
constexpr size_t WS_VF = 104 * MiB;
constexpr size_t WS_LIST = 121 * MiB;
constexpr size_t WS_SLOT = 130 * MiB;
constexpr size_t WS_WIN = 131 * MiB;
constexpr size_t WS_WOUT = 145 * MiB;
constexpr size_t WS_SI = 149 * MiB;
constexpr size_t WS_P = 319 * MiB;
constexpr size_t WS_BON = 438 * MiB;
constexpr size_t WS_G = 455 * MiB;
constexpr size_t WS_YS = 472 * MiB;
constexpr size_t WS_SV = 506 * MiB;
constexpr size_t WS_WD = 149 * MiB;
constexpr size_t WS_HACT = 182 * MiB;
constexpr size_t WS_Y = 267 * MiB;
constexpr size_t WS_WGU = 267 * MiB;
constexpr size_t WS_END = 539 * MiB;

struct Row { int b, t, L, isx; };
__device__ __forceinline__ Row row_of(int m) { Row r; if (m < NX) { r.b = m >> 12; r.t = m & 4095; r.L = SEQ; r.isx = 1; } else { int q = m - NX; r.b = q >> 8; r.t = q & 255; r.L = CTXL; r.isx = 0; } return r; }
__device__ __forceinline__ float sigmoidf_(float x) { return 1.f / (1.f + __expf(-x)); }
__device__ __forceinline__ float softplusf_(float x) { return x > 20.f ? x : log1pf(__expf(x)); }
__device__ __forceinline__ float siluf_(float x) { return x / (1.f + __expf(-x)); }
__device__ __forceinline__ float wave_sum(float v) {
#pragma unroll
    for (int o = 1; o < 64; o <<= 1) v += __shfl_xor(v, o);
    return v;
}

__global__ __launch_bounds__(256) void k_mod(const float* c, const float* cctx, const float* ada_w, const float* ada_b, float* MOD) {
    __shared__ float s[5][1024];
    const int l = blockIdx.y, j = blockIdx.x * 256 + threadIdx.x;
    for (int i = threadIdx.x; i < 5 * 1024; i += 256) { const int r = i >> 10, k = i & 1023; const float v = r < 4 ? c[r * 1024 + k] : cctx[k]; s[r][k] = siluf_(v); }
    __syncthreads();
    float acc[5] = {0.f, 0.f, 0.f, 0.f, 0.f};
    const float* W = ada_w + (size_t)l * 1024 * 6144 + j;
    for (int k = 0; k < 1024; ++k) { const float w = W[(size_t)k * 6144];
#pragma unroll
        for (int r = 0; r < 5; ++r) acc[r] += s[r][k] * w; }
    const float bb = ada_b[l * 6144 + j];
#pragma unroll
    for (int r = 0; r < 5; ++r) MOD[((size_t)l * 5 + r) * 6144 + j] = acc[r] + bb;
}

__global__ __launch_bounds__(256) void k_norm_mod(const float* xs, const float* cs, const float* gain, const float* MODl, int si, bf16* XN) {
    const int m = blockIdx.x * 4 + (threadIdx.x >> 6), lane = threadIdx.x & 63;
    if (m >= MT) return;
    const float* src = m < NX ? xs + (size_t)m * D : cs + (size_t)(m - NX) * D;
    const int rb = m < NX ? (m >> 12) : 4;
    const float* md = MODl + (size_t)rb * 6144;
    float v[16]; float ss = 0.f;
#pragma unroll
    for (int j = 0; j < 16; ++j) { v[j] = src[lane + 64 * j]; ss += v[j] * v[j]; }
    ss = wave_sum(ss);
    const float rs = rsqrtf(ss * (1.f / D) + 1e-6f);
#pragma unroll
    for (int j = 0; j < 16; ++j) { const int cidx = lane + 64 * j; const float y = v[j] * rs * gain[cidx]; XN[(size_t)m * D + cidx] = f2bf(y * (1.f + md[(si + 1) * 1024 + cidx]) + md[si * 1024 + cidx]); }
}

struct EpiP { bf16* P; __device__ void operator()(int m, int n, float v) const { P[(size_t)m * LDP + n] = f2bf(v); } };
struct EpiRes { const float* xs; const float* cs; const float* MODl; float* XR; __device__ void operator()(int m, int n, float v) const {
    const float xin = m < NX ? xs[(size_t)m * D + n] : cs[(size_t)(m - NX) * D + n]; const int rb = m < NX ? (m >> 12) : 4;
    XR[(size_t)m * D + n] = xin + MODl[(size_t)rb * 6144 + 2 * 1024 + n] * v; } };
template <class Epi>
__global__ __launch_bounds__(256) void k_gemm_naive(const bf16* A, int M, int N, int K, const float* B0, int N0, const float* B1, int N1, Epi epi) {
    __shared__ float As[16][65], Bs[16][64];
    const int tid = threadIdx.x, tx = tid & 15, ty = tid >> 4, m0 = blockIdx.y * 64, n0 = blockIdx.x * 64;
    float acc[4][4] = {};
    for (int k0 = 0; k0 < K; k0 += 16) {
        for (int i = tid; i < 1024; i += 256) { const int r = i >> 4, kk = i & 15; As[kk][r] = bf2f(A[(size_t)(m0 + r) * K + k0 + kk]); }
        for (int i = tid; i < 1024; i += 256) { const int kk = i >> 6, cc = i & 63, n = n0 + cc; float v = 0.f;
            if (n < N0) v = B0[(size_t)(k0 + kk) * N0 + n]; else if (n < N0 + N1) v = B1[(size_t)(k0 + kk) * N1 + (n - N0)];
            Bs[kk][cc] = v; }
        __syncthreads();
#pragma unroll
        for (int kk = 0; kk < 16; ++kk) { float a[4], b[4];
#pragma unroll
            for (int i = 0; i < 4; ++i) { a[i] = As[kk][ty * 4 + i]; b[i] = Bs[kk][tx * 4 + i]; }
#pragma unroll
            for (int i = 0; i < 4; ++i)
#pragma unroll
                for (int j = 0; j < 4; ++j) acc[i][j] += a[i] * b[j]; }
        __syncthreads();
    }
#pragma unroll
    for (int i = 0; i < 4; ++i)
#pragma unroll
        for (int j = 0; j < 4; ++j) { const int m = m0 + ty * 4 + i, n = n0 + tx * 4 + j; if (m < M && n < N0 + N1) epi(m, n, acc[i][j]); }
}

__device__ __forceinline__ float* si_ptr(float* SI, int d, int m, int h, int vec) { return SI + ((((size_t)d * MT + m) * 4 + h) * 5 + vec) * 64; }

struct RwP { const float *mu, *w0, *w2, *a0, *a2, *g2, *kk, *ka, *rk, *v0, *v2; };
__global__ __launch_bounds__(256) void k_rwkv_prep(const bf16* P, RwP w, int layer, float* VF, float* SI, float* SV, float* BON, float* G) {
    __shared__ float sp[960]; __shared__ float vd[32];
    const int m = blockIdx.x, c = threadIdx.x, h = c >> 6; const Row rw = row_of(m);
    const bf16* pr = P + (size_t)m * LDP;
    for (int j = c; j < 960; j += 256) { const float p = bf2f(pr[j]); const float pp = rw.t > 0 ? bf2f(pr[j - LDP]) : 0.f; const float pn = rw.t < rw.L - 1 ? bf2f(pr[j + LDP]) : 0.f;
        sp[j] = p + (0.5f * (pp + pn) - p) * w.mu[j]; }
    if (c < 32) vd[c] = bf2f(pr[VRES_OFF + c]);
    __syncthreads();
    const float r = sp[c], kv = sp[256 + c]; float v = sp[512 + c];
    float g = 0.f; for (int j = 0; j < 64; ++j) g += sigmoidf_(sp[896 + j]) * w.g2[j * 256 + c];
    const float kkr = kv * w.kk[c]; const float ss = wave_sum(kkr * kkr); const float kkn = kkr * rsqrtf(ss + 1e-6f);
    if (layer == 0) VF[(size_t)m * 256 + c] = v;
    else { float z = w.v0[c]; for (int j = 0; j < 32; ++j) z += vd[j] * w.v2[j * 256 + c]; v = v + (VF[(size_t)m * 256 + c] - v) * sigmoidf_(z); }
    float bsum = 0.f;
    for (int d = 0; d < 2; ++d) {
        float z = w.w0[d * 256 + c]; for (int j = 0; j < 32; ++j) z += tanhf(sp[768 + d * 32 + j]) * w.w2[(d * 32 + j) * 256 + c];
        const float lw = -0.6065306597f * sigmoidf_(z);
        float za = w.a0[d * 256 + c]; for (int j = 0; j < 32; ++j) za += sp[832 + d * 32 + j] * w.a2[(d * 32 + j) * 256 + c];
        const float a = sigmoidf_(za);
        const float kd = kv * (1.f + (a - 1.f) * w.ka[c]);
        const float bs = wave_sum(r * kd * w.rk[c]);
        bsum += bs * v;
        const int k = c & 63;
        si_ptr(SI, d, m, h, 0)[k] = __expf(lw); si_ptr(SI, d, m, h, 1)[k] = kkn; si_ptr(SI, d, m, h, 2)[k] = kkn * a; si_ptr(SI, d, m, h, 3)[k] = kd; si_ptr(SI, d, m, h, 4)[k] = r;
    }
    SV[(size_t)m * 256 + c] = v; BON[(size_t)m * 256 + c] = bsum; G[(size_t)m * 256 + c] = g;
}
__global__ __launch_bounds__(256) void k_rwkv_post(const float* YS, const float* BON, const float* G, const float* lnw, const float* lnb, bf16* MIX) {
    const int m = blockIdx.x, c = threadIdx.x;
    const float y = YS[(size_t)m * 256 + c] + YS[((size_t)MT + m) * 256 + c];
    const float mu = wave_sum(y) * (1.f / 64.f); const float dlt = y - mu; const float var = wave_sum(dlt * dlt) * (1.f / 64.f);
    const float yn = dlt * rsqrtf(var + 64e-5f);
    MIX[(size_t)m * D + c] = f2bf((yn * lnw[c] + lnb[c] + BON[(size_t)m * 256 + c]) * G[(size_t)m * 256 + c]);
}

__global__ __launch_bounds__(256) void k_ret_prep(const bf16* P, const float* lam  , float* SI, float* SV) {
    __shared__ float sq[256], sk[256];
    const int m = blockIdx.x, c = threadIdx.x, h = c >> 6, i = c & 63; const Row rw = row_of(m);
    const bf16* pr = P + (size_t)m * LDP + RET_OFF;
    float q = bf2f(pr[c]), k = bf2f(pr[256 + c]); const float v = bf2f(pr[512 + c]);
    sq[c] = q; sk[c] = k; __syncthreads();
    if (rw.isx) {
        const int j = i & 31, jj = j & 15; const float pos = j < 16 ? (float)(rw.t >> 6) : (float)(rw.t & 63);
        const float inv = powf(10000.f, -(float)jj / 16.f); const float ang = pos * inv; const float cs = cosf(ang), sn = sinf(ang);
        const int pc = i < 32 ? c + 32 : c - 32;
        const float q1 = i < 32 ? q : sq[pc], q2 = i < 32 ? sq[pc] : q, k1 = i < 32 ? k : sk[pc], k2 = i < 32 ? sk[pc] : k;
        q = i < 32 ? q1 * cs - q2 * sn : q1 * sn + q2 * cs; k = i < 32 ? k1 * cs - k2 * sn : k1 * sn + k2 * cs;
    }
    k *= 0.125f;
    for (int d = 0; d < 2; ++d) { const float gm = __expf(-lam[d * 4 + h]);
        si_ptr(SI, d, m, h, 0)[i] = gm; si_ptr(SI, d, m, h, 1)[i] = 0.f; si_ptr(SI, d, m, h, 2)[i] = 0.f; si_ptr(SI, d, m, h, 3)[i] = k; si_ptr(SI, d, m, h, 4)[i] = q; }
    SV[(size_t)m * 256 + c] = v;
}
__global__ __launch_bounds__(256) void k_hnorm_post(const float* YS, const bf16* P, int gate_off, const float* nw, bf16* MIX, int mix_off) {
    const int m = blockIdx.x, c = threadIdx.x;
    const float o = YS[(size_t)m * 256 + c] + YS[((size_t)MT + m) * 256 + c];
    const float ms = wave_sum(o * o) * (1.f / 64.f);
    const float g = bf2f(P[(size_t)m * LDP + gate_off + c]);
    float y = o * rsqrtf(ms + 1e-6f) * siluf_(g); if (nw) y *= nw[c & 63];
    MIX[(size_t)m * D + mix_off + c] = f2bf(y);
}
__global__ __launch_bounds__(256) void k_gdn_prep(const bf16* P, const float* cw  , const float* alog, const float* dtb, float* SI, float* SV) {
    const int m = blockIdx.x, c = threadIdx.x, h = c >> 6, i = c & 63; const Row rw = row_of(m);
    const bf16* pr = P + (size_t)m * LDP + GDN_OFF;
    float o[3];
#pragma unroll
    for (int s = 0; s < 3; ++s) { const int ch = s * 256 + c; float a = 0.f;
#pragma unroll
        for (int j = 0; j < 4; ++j) { const int tt = rw.t + j - 2; if (tt >= 0 && tt < rw.L) a += bf2f(pr[(ptrdiff_t)(j - 2) * LDP + ch]) * cw[j * 768 + ch]; }
        o[s] = siluf_(a); }
    const float qs = wave_sum(o[0] * o[0]), ks = wave_sum(o[1] * o[1]);
    const float q = o[0] * rsqrtf(qs + 1e-6f) * 0.125f, k = o[1] * rsqrtf(ks + 1e-6f);
    for (int d = 0; d < 2; ++d) {
        const float a = bf2f(pr[768 + d * 4 + h]), b = bf2f(pr[776 + d * 4 + h]);
        const float al = __expf(-__expf(alog[d * 4 + h]) * softplusf_(a + dtb[d * 4 + h])), be = sigmoidf_(b);
        si_ptr(SI, d, m, h, 0)[i] = al; si_ptr(SI, d, m, h, 1)[i] = k; si_ptr(SI, d, m, h, 2)[i] = al * be * k; si_ptr(SI, d, m, h, 3)[i] = be * k; si_ptr(SI, d, m, h, 4)[i] = q; }
    SV[(size_t)m * 256 + c] = o[2];
}
__device__ __forceinline__ int step_row(int b, int d, int s) { if (s < CTXL) { const int tc = d ? CTXL - 1 - s : s; return NX + b * CTXL + tc; } const int tx = d ? SEQ - 1 - (s - CTXL) : (s - CTXL); return b * SEQ + tx; }
__global__ __launch_bounds__(64) void k_rowscan(const float* SI, const float* SV, float* YS) {
    __shared__ float sh[2][5][64];
    const int seq = blockIdx.x, d = seq & 1, h = (seq >> 1) & 3, b = seq >> 3, v = threadIdx.x;
    float s[64];
#pragma unroll
    for (int k = 0; k < 64; ++k) s[k] = 0.f;
    float nx[5], nv; { const int m = step_row(b, d, 0); const float* p = SI + (((size_t)d * MT + m) * 4 + h) * 320;
#pragma unroll
        for (int j = 0; j < 5; ++j) nx[j] = p[j * 64 + v]; nv = SV[(size_t)m * 256 + h * 64 + v]; }
    for (int st = 0; st < NSTEP; ++st) {
        const int buf = st & 1; const int m = step_row(b, d, st);
#pragma unroll
        for (int j = 0; j < 5; ++j) sh[buf][j][v] = nx[j];
        const float vv = nv;
        __syncthreads();
        if (st + 1 < NSTEP) { const int m2 = step_row(b, d, st + 1); const float* p = SI + (((size_t)d * MT + m2) * 4 + h) * 320;
#pragma unroll
            for (int j = 0; j < 5; ++j) nx[j] = p[j * 64 + v]; nv = SV[(size_t)m2 * 256 + h * 64 + v]; }
        float sa = 0.f;
#pragma unroll
        for (int k = 0; k < 64; ++k) sa += s[k] * sh[buf][1][k];
        float y = 0.f;
#pragma unroll
        for (int k = 0; k < 64; ++k) { s[k] = s[k] * sh[buf][0][k] - sa * sh[buf][2][k] + vv * sh[buf][3][k]; y += s[k] * sh[buf][4][k]; }
        YS[((size_t)d * MT + m) * 256 + h * 64 + v] = y;
    }
}
struct LruP { const float *cw, *cb, *wa, *ba, *wx, *bx, *lam; };
__global__ __launch_bounds__(256) void k_lru_prep(const bf16* P, LruP w, float* LA, float* LB) {
    __shared__ float xs[256];
    const int m = blockIdx.x, c = threadIdx.x, h = c >> 6, i = c & 63; const Row rw = row_of(m);
    const bf16* pr = P + (size_t)m * LDP + LRU_OFF;
    float xm = w.cb[c];
#pragma unroll
    for (int j = 0; j < 4; ++j) { const int tt = rw.t + j - 2; if (tt >= 0 && tt < rw.L) xm += bf2f(pr[(ptrdiff_t)(j - 2) * LDP + c]) * w.cw[j * 256 + c]; }
    xs[c] = xm; __syncthreads();
    for (int d = 0; d < 2; ++d) {
        float ra = w.ba[d * 256 + c], rx = w.bx[d * 256 + c];
        const float* wa = w.wa + ((size_t)(d * 4 + h) * 64) * 64 + i; const float* wx = w.wx + ((size_t)(d * 4 + h) * 64) * 64 + i;
        for (int j = 0; j < 64; ++j) { const float xv = xs[h * 64 + j]; ra += xv * wa[j * 64]; rx += xv * wx[j * 64]; }
        const float r = sigmoidf_(ra), ig = sigmoidf_(rx);
        const float la = -8.f * softplusf_(-w.lam[d * 256 + c]) * r;
        LA[((size_t)d * MT + m) * 256 + c] = __expf(la); LB[((size_t)d * MT + m) * 256 + c] = sqrtf(-expm1f(2.f * la)) * ig * xm;
    }
}
__global__ __launch_bounds__(256) void k_lru_scan(const float* LA, const float* LB, float* YS) {
    const int d = blockIdx.x & 1, b = blockIdx.x >> 1, c = threadIdx.x;
    float hst = 0.f;
    for (int st = 0; st < NSTEP; st += 8) { float a[8], bb[8]; int mm[8];
#pragma unroll
        for (int u = 0; u < 8; ++u) { mm[u] = step_row(b, d, st + u); a[u] = LA[((size_t)d * MT + mm[u]) * 256 + c]; bb[u] = LB[((size_t)d * MT + mm[u]) * 256 + c]; }
#pragma unroll
        for (int u = 0; u < 8; ++u) { hst = a[u] * hst + bb[u]; YS[((size_t)d * MT + mm[u]) * 256 + c] = hst; } }
}
__global__ __launch_bounds__(256) void k_lru_post(const float* YS, const bf16* P, bf16* MIX) {
    const int m = blockIdx.x, c = threadIdx.x;
    const float hs = YS[(size_t)m * 256 + c] + YS[((size_t)MT + m) * 256 + c];
    const float g = bf2f(P[(size_t)m * LDP + LRU_OFF + 256 + c]);
    const float ge = 0.5f * g * (1.f + tanhf(0.7978845608f * (g + 0.044715f * g * g * g)));
    MIX[(size_t)m * D + 768 + c] = f2bf(hs * ge);
}

__global__ __launch_bounds__(256) void k_norm_route(const float* XR, const float* gain, const float* MODl, const float* rw  , const float* rbias, bf16* XN, int* TOPI, float* TOPG) {
    __shared__ float hs[1024]; __shared__ float part[4][64]; __shared__ float red[4]; __shared__ float sc[64]; __shared__ int sidx[8];
    const int m = blockIdx.x, tid = threadIdx.x, lane = tid & 63, wv = tid >> 6;
    const float* src = XR + (size_t)m * D; const int rb = m < NX ? (m >> 12) : 4; const float* md = MODl + (size_t)rb * 6144;
    float v[4]; float ss = 0.f;
#pragma unroll
    for (int j = 0; j < 4; ++j) { v[j] = src[tid + 256 * j]; ss += v[j] * v[j]; }
    ss = wave_sum(ss); if (lane == 0) red[wv] = ss; __syncthreads();
    const float rs = rsqrtf((red[0] + red[1] + red[2] + red[3]) * (1.f / D) + 1e-6f);
#pragma unroll
    for (int j = 0; j < 4; ++j) { const int ci = tid + 256 * j; const float y = v[j] * rs * gain[ci] * (1.f + md[4 * 1024 + ci]) + md[3 * 1024 + ci]; hs[ci] = y; XN[(size_t)m * D + ci] = f2bf(y); }
    __syncthreads();
    { float a = 0.f; const float* wp = rw + (size_t)(wv * 256) * 64 + lane; for (int k = 0; k < 256; ++k) a += hs[wv * 256 + k] * wp[(size_t)k * 64]; part[wv][lane] = a; }
    __syncthreads();
    if (tid < 64) sc[tid] = sigmoidf_(part[0][tid] + part[1][tid] + part[2][tid] + part[3][tid]);
    __syncthreads();
    if (tid == 0) { unsigned long long used = 0ull; float sum = 0.f;
        for (int k = 0; k < 8; ++k) { float best = -1e30f; int bi = 0; for (int e = 0; e < 64; ++e) { if ((used >> e) & 1ull) continue; const float sv = sc[e] + rbias[e]; if (sv > best) { best = sv; bi = e; } }
            used |= 1ull << bi; sidx[k] = bi; sum += sc[bi]; }
        for (int k = 0; k < 8; ++k) { const int e = sidx[k]; TOPI[(size_t)m * 8 + k] = e; TOPG[(size_t)m * 8 + k] = 2.5f * sc[e] / sum; } }
}
struct MoeW { const float *wg, *wu, *wd, *sg, *su, *sd; };
__global__ __launch_bounds__(256) void k_moe_naive(const bf16* XN, const int* TOPI, const float* TOPG, MoeW w, const float* MODl, float* XR) {
    __shared__ float hs[1024]; __shared__ float act[256];
    const int m = blockIdx.x, j = threadIdx.x;
    for (int i = j; i < 1024; i += 256) hs[i] = bf2f(XN[(size_t)m * D + i]);
    float acc[4] = {0.f, 0.f, 0.f, 0.f};
    for (int s = 0; s < 9; ++s) {
        const float *Wg, *Wu, *Wd; float gw;
        if (s < 8) { const int e = TOPI[(size_t)m * 8 + s]; gw = TOPG[(size_t)m * 8 + s]; Wg = w.wg + (size_t)e * 1024 * 256; Wu = w.wu + (size_t)e * 1024 * 256; Wd = w.wd + (size_t)e * 256 * 1024; }
        else { gw = 1.f; Wg = w.sg; Wu = w.su; Wd = w.sd; }
        __syncthreads();
        float g = 0.f, u = 0.f;
        for (int k = 0; k < 1024; ++k) { const float hv = hs[k]; g += hv * Wg[(size_t)k * 256 + j]; u += hv * Wu[(size_t)k * 256 + j]; }
        act[j] = siluf_(g) * u * gw;
        __syncthreads();
        for (int jj = 0; jj < 256; ++jj) { const float a = act[jj];
#pragma unroll
            for (int i = 0; i < 4; ++i) acc[i] += a * Wd[(size_t)jj * 1024 + j + 256 * i]; }
    }
    const int rb = m < NX ? (m >> 12) : 4;
#pragma unroll
    for (int i = 0; i < 4; ++i) { const int ci = j + 256 * i; XR[(size_t)m * D + ci] += MODl[(size_t)rb * 6144 + 5 * 1024 + ci] * acc[i]; }
}
__global__ __launch_bounds__(256) void k_final_norm(const float* XR, const float* gain, float* out) {
    const int m = blockIdx.x * 4 + (threadIdx.x >> 6), lane = threadIdx.x & 63;
    const float* src = XR + (size_t)m * D; float v[16]; float ss = 0.f;
#pragma unroll
    for (int j = 0; j < 16; ++j) { v[j] = src[lane + 64 * j]; ss += v[j] * v[j]; }
    ss = wave_sum(ss); const float rs = rsqrtf(ss * (1.f / D) + 1e-6f);
#pragma unroll
    for (int j = 0; j < 16; ++j) out[(size_t)m * D + lane + 64 * j] = v[j] * rs * gain[lane + 64 * j];
}

enum { I_X = 0, I_C, I_CTX, I_CCTX, I_ADAW, I_ADAB, I_NMIX, I_NFFN, I_NFIN, I_WIN, I_WVRES, I_WOUT, I_RWMU, I_RWW0, I_RWW2, I_RWA0, I_RWA2, I_RWG2, I_RWKK, I_RWKA, I_RWRK, I_RWLNW, I_RWLNB, I_RWV0, I_RWV2,
       I_RETL, I_GCW, I_GALOG, I_GDT, I_GNW, I_LCW, I_LCB, I_LWA, I_LBA, I_LWX, I_LBX, I_LLAM, I_RTW, I_RTB, I_EWG, I_EWU, I_EWD, I_SWG, I_SWU, I_SWD, I_N };
#define GAS __attribute__((address_space(1)))
#define LAS __attribute__((address_space(3)))
typedef unsigned v4u __attribute__((ext_vector_type(4)));
typedef float f32x4 __attribute__((ext_vector_type(4)));
typedef short bf16x8 __attribute__((ext_vector_type(8)));
typedef GAS unsigned gu32;
#define RLX_AGENT __ATOMIC_RELAXED, __HIP_MEMORY_SCOPE_AGENT
#define LDS_WAIT() asm volatile("s_waitcnt lgkmcnt(0)" ::: "memory")
#define VM_WAIT() asm volatile("s_waitcnt vmcnt(0)" ::: "memory")
__device__ __forceinline__ unsigned pk2(float lo, float hi) { return (unsigned)f2bf(lo) | ((unsigned)f2bf(hi) << 16); }

namespace pg8 {
#define PG8_LAS __attribute__((address_space(3)))
typedef unsigned short bf16_t;
typedef unsigned u32x4 __attribute__((ext_vector_type(4)));
constexpr int BM = 256, BK = 64, HALF = 128, HTB = HALF * BK * 2, STAGE_BYTES = 8 * HTB, NXCD = 8, WGM = 8;
__host__ __device__ __forceinline__ int lds_byte(int r, int c) { const int st = (r >> 4) * 2 + (c >> 5), rr = r & 15, cc = c & 31, ob = rr * 64 + cc * 2; return st * 1024 + (ob ^ (((ob >> 9) & 1) << 5)); }
__host__ __device__ __forceinline__ void stage_rc(int b, int& R, int& C) { const int st = b / 1024, sb = b % 1024, swz = sb ^ (((sb >> 9) & 1) << 5); R = (st >> 1) * 16 + swz / 64; C = (st & 1) * 32 + (swz % 64) / 2; }
__host__ __device__ __forceinline__ int perm32(int rho) { const int n = rho >> 4, i = rho & 15; return 8 * (i >> 2) + 4 * n + (i & 3); }
__device__ __forceinline__ unsigned cvt_pk_bf16(float lo, float hi) { unsigned r; asm volatile("v_cvt_pk_bf16_f32 %0, %1, %2" : "=v"(r) : "v"(lo), "v"(hi)); return r; }

struct Unit { const char* A; const char* B; int pm, pn, e, nrows, rb; };

struct DenseOrder {
    const bf16_t* A; const bf16_t* Bt; int K, nM, nN, nwg, G, c;
    __device__ void init(const bf16_t* A_, const bf16_t* Bt_, int M, int N, int K_, int G_, int c_) { A = A_; Bt = Bt_; K = K_; nM = M / BM; nN = N / BM; nwg = nM * nN; G = G_; c = c_; }
    __device__ bool next(int i, Unit& u) const {
        const long L = (long)i * G + c; if (L >= nwg) return false;
        int wgid = (int)L; { const int q = nwg / NXCD, r = nwg % NXCD, xcd = wgid % NXCD, off = wgid / NXCD; wgid = (xcd < r ? xcd * (q + 1) : r * (q + 1) + (xcd - r) * q) + off; }
        const int nig = WGM * nN, gid = wgid / nig, fm = gid * WGM, gsz = (nM - fm) < WGM ? (nM - fm) : WGM;
        u.pm = fm + ((wgid % nig) % gsz); u.pn = (wgid % nig) / gsz; u.e = 0; u.nrows = BM; u.rb = 0;
        u.A = (const char*)A + (size_t)u.pm * BM * K * 2; u.B = (const char*)Bt + (size_t)u.pn * BM * K * 2; return true;
    }
    __device__ __forceinline__ unsigned a_off(const Unit&, int h, int R, int C) const { return (unsigned)((h * HALF + R) * K + C) * 2u; }
};

template <class Epi, class Sched, bool ALIGN_EPI = false>
__device__ __forceinline__ void gemm_phase(PG8_LAS unsigned char* lds, const int K, const Sched& S, const Epi& E) {
    const int tid = threadIdx.x, wid = __builtin_amdgcn_readfirstlane(tid >> 6), lane = tid & 63, wr = wid >> 2, wc = wid & 3, fr = lane & 15, fq = lane >> 4;
    const int nt = K / BK;
    int sR[2], sC[2]; unsigned voffB[2];
#pragma unroll
    for (int i = 0; i < 2; ++i) { int R, C; stage_rc(tid * 16 + i * 8192, R, C); sR[i] = R; sC[i] = C; const int Rb = Epi::PERM ? ((R & ~31) + perm32(R & 31)) : R; voffB[i] = (unsigned)(Rb * K + C) * 2u; }
    const size_t kstep = (size_t)(BK * 2);
    const size_t hstep = (size_t)HALF * K * 2;
    const unsigned ldsw = (unsigned)wid * 1024u;
    const int aoff = lds_byte(wr * 64 + fr, fq * 8), boff = lds_byte(wc * 32 + fr, fq * 8);
#define PG8_SA(b, h) (((b) * 2 + (h)) * HTB)
#define PG8_SB(b, h) ((4 + (b) * 2 + (h)) * HTB)
#define PG8_STAGE(bufoff, gbase, voff) do { _Pragma("unroll") for (int _i = 0; _i < 2; ++_i) \
        __builtin_amdgcn_global_load_lds((const unsigned*)((const char*)(gbase) + (voff)[_i]), (PG8_LAS unsigned*)(lds + (bufoff) + ldsw + _i * 8192), 16, 0, 0); } while (0)
#define PG8_LDA(dst, b, h) do { _Pragma("unroll") for (int m = 0; m < 4; ++m) _Pragma("unroll") for (int k = 0; k < 2; ++k) dst[m][k] = *(const PG8_LAS bf16x8*)(lds + PG8_SA(b, h) + aoff + m * 2048 + k * 1024); } while (0)
#define PG8_LDB(dst, b, h) do { _Pragma("unroll") for (int n = 0; n < 2; ++n) _Pragma("unroll") for (int k = 0; k < 2; ++k) dst[n][k] = *(const PG8_LAS bf16x8*)(lds + PG8_SB(b, h) + boff + n * 2048 + k * 1024); } while (0)
#define PG8_MMA(ai, bj, At, Bt) do { __builtin_amdgcn_s_setprio(1); _Pragma("unroll") for (int m = 0; m < 4; ++m) _Pragma("unroll") for (int n = 0; n < 2; ++n) _Pragma("unroll") for (int k = 0; k < 2; ++k) \
        acc[ai][bj][m][n] = __builtin_amdgcn_mfma_f32_16x16x32_bf16(Bt[n][k], At[m][k], acc[ai][bj][m][n], 0, 0, 0); __builtin_amdgcn_s_setprio(0); } while (0)
#define PG8_WAIT_V(n) asm volatile("s_waitcnt vmcnt(" #n ")" ::: "memory")
#define PG8_WAIT_L(n) asm volatile("s_waitcnt lgkmcnt(" #n ")" ::: "memory")
#define PG8_BAR __builtin_amdgcn_s_barrier()
#define PG8_SCHED __builtin_amdgcn_sched_barrier(0)
    Unit cur, nxt; int ui = 0;
    if (!S.next(0, cur)) return;
    f32x4 acc[2][2][4][2];
#pragma unroll
    for (int a = 0; a < 2; ++a)
#pragma unroll
        for (int b = 0; b < 2; ++b)
#pragma unroll
            for (int m = 0; m < 4; ++m)
#pragma unroll
                for (int n = 0; n < 2; ++n) acc[a][b][m][n] = (f32x4){0.f, 0.f, 0.f, 0.f};
    bf16x8 At[4][2], B0[2][2], B1[2][2];
    unsigned cv0[2], cv1[2], nv0[2], nv1[2];
#pragma unroll
    for (int i = 0; i < 2; ++i) { cv0[i] = S.a_off(cur, 0, sR[i], sC[i]); cv1[i] = S.a_off(cur, 1, sR[i], sC[i]); nv0[i] = cv0[i]; nv1[i] = cv1[i]; }
    const char* cA = cur.A; const char* cB = cur.B;
    PG8_STAGE(PG8_SB(0, 0), cB, voffB); PG8_STAGE(PG8_SB(0, 1), cB + hstep, voffB); PG8_STAGE(PG8_SA(0, 0), cA, cv0); PG8_STAGE(PG8_SA(0, 1), cA, cv1);
    if (wr == 1) PG8_BAR;
    PG8_WAIT_V(2); PG8_BAR;
    PG8_STAGE(PG8_SB(1, 0), cB + kstep, voffB); PG8_STAGE(PG8_SA(1, 0), cA + kstep, cv0); PG8_STAGE(PG8_SB(1, 1), cB + hstep + kstep, voffB);
    PG8_WAIT_V(6); PG8_BAR;
    for (;;) {
        const bool has_next = S.next(ui + 1, nxt);
        const char* nA = has_next ? nxt.A : cA; const char* nB = has_next ? nxt.B : cB;
        if (has_next) {
#pragma unroll
            for (int i = 0; i < 2; ++i) { nv0[i] = S.a_off(nxt, 0, sR[i], sC[i]); nv1[i] = S.a_off(nxt, 1, sR[i], sC[i]); } }
        else {
#pragma unroll
            for (int i = 0; i < 2; ++i) { nv0[i] = cv0[i]; nv1[i] = cv1[i]; } }
        for (int t = 0; t < nt; t += 2) {
            const bool last = (t == nt - 2);
            const char* a1 = cA + (size_t)(t + 1) * kstep;
            const char* a2 = last ? nA : cA + (size_t)(t + 2) * kstep; const char* b2 = last ? nB : cB + (size_t)(t + 2) * kstep;
            const char* a3 = a2 + kstep; const char* b3 = b2 + kstep;
            unsigned x0[2], x1[2];
#pragma unroll
            for (int i = 0; i < 2; ++i) { x0[i] = last ? nv0[i] : cv0[i]; x1[i] = last ? nv1[i] : cv1[i]; }
            PG8_LDB(B0, 0, 0); PG8_LDB(B1, 0, 1); PG8_SCHED; PG8_LDA(At, 0, 0); PG8_STAGE(PG8_SA(1, 1), a1, cv1);
            PG8_WAIT_V(8); PG8_WAIT_L(0); PG8_BAR; PG8_MMA(0, 0, At, B0); PG8_MMA(0, 1, At, B1); PG8_BAR; PG8_SCHED;
            PG8_LDA(At, 0, 1); PG8_STAGE(PG8_SB(0, 0), b2, voffB); PG8_STAGE(PG8_SB(0, 1), b2 + hstep, voffB); PG8_STAGE(PG8_SA(0, 0), a2, x0);
            PG8_WAIT_V(8); PG8_WAIT_L(0); PG8_BAR; PG8_MMA(1, 0, At, B0); PG8_MMA(1, 1, At, B1); PG8_BAR; PG8_SCHED;
            PG8_LDB(B0, 1, 0); PG8_LDB(B1, 1, 1); PG8_SCHED; PG8_LDA(At, 1, 0); PG8_STAGE(PG8_SA(0, 1), a2, x1);
            PG8_WAIT_V(8); PG8_WAIT_L(0); PG8_BAR; PG8_MMA(0, 0, At, B0); PG8_MMA(0, 1, At, B1); PG8_BAR; PG8_SCHED;
            PG8_LDA(At, 1, 1); PG8_STAGE(PG8_SB(1, 0), b3, voffB); PG8_STAGE(PG8_SB(1, 1), b3 + hstep, voffB); PG8_STAGE(PG8_SA(1, 0), a3, x0);
            PG8_WAIT_V(8); PG8_WAIT_L(0); PG8_BAR; PG8_MMA(1, 0, At, B0); PG8_MMA(1, 1, At, B1); PG8_BAR; PG8_SCHED;
        }
        if constexpr (ALIGN_EPI) { if (wr == 0) PG8_BAR; }
        E(acc, cur, wr, wc, fr, fq);
        if (!has_next) break;
#pragma unroll
        for (int a = 0; a < 2; ++a)
#pragma unroll
            for (int b = 0; b < 2; ++b)
#pragma unroll
                for (int m = 0; m < 4; ++m)
#pragma unroll
                    for (int n = 0; n < 2; ++n) acc[a][b][m][n] = (f32x4){0.f, 0.f, 0.f, 0.f};
        cur = nxt; cA = nA; cB = nB; ++ui;
#pragma unroll
        for (int i = 0; i < 2; ++i) { cv0[i] = nv0[i]; cv1[i] = nv1[i]; }
        if constexpr (ALIGN_EPI) { if (wr == 1) PG8_BAR; }
    }
    PG8_WAIT_V(0);
    if constexpr (!ALIGN_EPI) { if (wr == 0) PG8_BAR; }
    PG8_BAR;
#undef PG8_SA
#undef PG8_SB
#undef PG8_STAGE
#undef PG8_LDA
#undef PG8_LDB
#undef PG8_MMA
#undef PG8_WAIT_V
#undef PG8_WAIT_L
#undef PG8_BAR
#undef PG8_SCHED
}

struct EpiStoreBf16 {
    static constexpr bool PERM = true;
    bf16_t* O; int ldc;
    __device__ __forceinline__ void operator()(const f32x4 (&acc)[2][2][4][2], const Unit& u, int wr, int wc, int fr, int fq) const {
        const int row0 = u.pm * BM + wr * 64 + fr, col0 = u.pn * BM + wc * 32 + 8 * fq;
#pragma unroll
        for (int ai = 0; ai < 2; ++ai)
#pragma unroll
            for (int m = 0; m < 4; ++m) { bf16_t* rowp = O + (size_t)(row0 + ai * HALF + m * 16) * ldc + col0;
#pragma unroll
                for (int bj = 0; bj < 2; ++bj) { const f32x4 v0 = acc[ai][bj][m][0], v1 = acc[ai][bj][m][1];
                    u32x4 w; w.x = cvt_pk_bf16(v0[0], v0[1]); w.y = cvt_pk_bf16(v0[2], v0[3]); w.z = cvt_pk_bf16(v1[0], v1[1]); w.w = cvt_pk_bf16(v1[2], v1[3]);
                    *(u32x4*)(rowp + bj * HALF) = w; } }
    }
};
struct EpiResidual {
    static constexpr bool PERM = false;
    const float* xs; const float* cs; const float* MODl; float* XR;
    __device__ __forceinline__ void operator()(const f32x4 (&acc)[2][2][4][2], const Unit& u, int wr, int wc, int fr, int fq) const {
        const int row0 = u.pm * BM + wr * 64 + fr, col0 = u.pn * BM + wc * 32 + 4 * fq;
#pragma unroll
        for (int ai = 0; ai < 2; ++ai)
#pragma unroll
            for (int m = 0; m < 4; ++m) { const int row = row0 + ai * HALF + m * 16;
                const float* xin = row < NX ? xs + (size_t)row * D : cs + (size_t)(row - NX) * D; const int rb = row < NX ? (row >> 12) : 4;
                const float* md = MODl + (size_t)rb * 6144 + 2 * 1024; float* o = XR + (size_t)row * D;
#pragma unroll
                for (int bj = 0; bj < 2; ++bj)
#pragma unroll
                    for (int n = 0; n < 2; ++n) { const int c = col0 + bj * HALF + n * 16; const f32x4 xi = *(const f32x4*)(xin + c), mm = *(const f32x4*)(md + c); *(f32x4*)(o + c) = xi + mm * acc[ai][bj][m][n]; } }
    }
};
}

#define XB_TMO      128
#define XB_XCNT(j)  (256  + 64 * (j))
#define XB_XSUB(j)  (1280 + 64 * (j))
#define XB_XGEN(j)  (2304 + 64 * (j))
#define XB_TOP      3328
#define XB_TOPGEN   3392
#define XCD_BAR_WORDS 3456
#define XB_SPIN_CAP (1u << 22)
__device__ __forceinline__ unsigned xb_ld(unsigned* p)              { return __hip_atomic_load(p, __ATOMIC_RELAXED, __HIP_MEMORY_SCOPE_AGENT); }
__device__ __forceinline__ unsigned xb_add(unsigned* p, unsigned v) { return __hip_atomic_fetch_add(p, v, __ATOMIC_RELAXED, __HIP_MEMORY_SCOPE_AGENT); }
__device__ __forceinline__ unsigned xb_xcc_id() { return (unsigned)__builtin_amdgcn_s_getreg((3 << 11) | 20) & 0xFu; }
#define XB_SPIN(cond, bar) do { unsigned _sp = 0; while (cond) { __builtin_amdgcn_s_sleep(1); \
    if ((++_sp & 255u) == 0u) { if (xb_ld(&(bar)[XB_TMO])) break; if (_sp > XB_SPIN_CAP) { atomicAdd(&(bar)[XB_TMO], 1u); break; } } } } while (0)
struct XcdBarrier { unsigned* bar; unsigned x; volatile LAS unsigned* st; };
__device__ __forceinline__ XcdBarrier xcd_barrier_post(unsigned* bar, volatile LAS unsigned* st) {
    XcdBarrier b; b.bar = bar; b.x = xb_xcc_id(); b.st = st;
    if (threadIdx.x == 0) (void)xb_add(&bar[XB_XCNT(b.x)], 1u);
    return b;
}
__device__ __forceinline__ void xcd_barrier_complete(unsigned* bar, unsigned x, unsigned& nloc, unsigned& nx) {
    const unsigned G = gridDim.x * gridDim.y * gridDim.z;
    unsigned sum, cnt, mine, sp = 0u;
    for (;;) {
        sum = 0u; cnt = 0u; mine = 0u;
#pragma unroll
        for (unsigned j = 0; j < 16; ++j) { const unsigned c = xb_ld(&bar[XB_XCNT(j)]); sum += c; cnt += (c > 0u) ? 1u : 0u; mine = (j == x) ? c : mine; }
        if (sum == G) break;
        __builtin_amdgcn_s_sleep(1);
        if ((++sp & 255u) == 0u) { if (xb_ld(&bar[XB_TMO])) break; if (sp > XB_SPIN_CAP) { atomicAdd(&bar[XB_TMO], 1u); break; } }
    }
    nloc = mine > 0u ? mine : 1u; nx = cnt > 0u ? cnt : 1u;
}
__device__ __forceinline__ void xcd_barrier(const XcdBarrier& b) {
    asm volatile("s_waitcnt vmcnt(0)" ::: "memory");
    __syncthreads();
    if (threadIdx.x == 0) {
        unsigned* bar = b.bar;
        __builtin_amdgcn_s_waitcnt(0);
        unsigned nloc = b.st[0], nx = b.st[1];
        if (nloc == 0u) { xcd_barrier_complete(bar, b.x, nloc, nx); b.st[0] = nloc; b.st[1] = nx; }
        const unsigned old = xb_add(&bar[XB_XSUB(b.x)], 1u);
        const unsigned gen = old / nloc;
        if (old + 1u == (gen + 1u) * nloc) {
            __builtin_amdgcn_fence(__ATOMIC_RELEASE, "agent");
            asm volatile("s_waitcnt vmcnt(0)" ::: "memory");
            const unsigned og = xb_add(&bar[XB_TOP], 1u);
            const unsigned tg = og / nx;
            if (og + 1u == (tg + 1u) * nx) xb_add(&bar[XB_TOPGEN], 1u);
            else XB_SPIN(xb_ld(&bar[XB_TOPGEN]) == tg, bar);
            __builtin_amdgcn_fence(__ATOMIC_ACQUIRE, "agent");
            xb_add(&bar[XB_XGEN(b.x)], 1u);
            asm volatile("s_waitcnt vmcnt(0)" ::: "memory");
        } else {
            XB_SPIN(xb_ld(&bar[XB_XGEN(b.x)]) == gen, bar);
            __builtin_amdgcn_fence(__ATOMIC_ACQUIRE, "agent");
            asm volatile("s_waitcnt vmcnt(0)" ::: "memory");
        }
    }
    __syncthreads();
}

constexpr int NWAVES = 8, NTHR = 512;
constexpr int RING_OFF = 0, RING_BYTES = 131072;
constexpr int LDSCTL_OFF = RING_BYTES, MISC_OFF = LDSCTL_OFF + 320;
constexpr int LDS_BYTES = 147456;
constexpr int CW_BAR = 4096;
constexpr size_t CTL_ZERO_BYTES = 1 * MiB;

struct MArgs {
    const float* in[45]; float* out; unsigned char* ws; int ph_lo, ph_hi, layer, bar_region;
};
struct Frame { LAS unsigned char* lds; volatile LAS unsigned* MISC; gu32* ctl; int tid, lane, wave, vcu, G; };

__device__ __forceinline__ void transpose_item(const float* W, int ldw, int N, int k0, int n0, bf16* WT, int ldt, int drow0, LAS float* scr, int lane) {
    const int nn = n0 + (lane & 31); const bool okn = nn < N;
#pragma unroll 8
    for (int i = 0; i < 32; ++i) { const int kk = 2 * i + (lane >> 5); scr[kk * 33 + (lane & 31)] = okn ? W[(size_t)(k0 + kk) * ldw + nn] : 0.f; }
    LDS_WAIT(); asm volatile("" ::: "memory");
    const int c = lane & 7;
#pragma unroll
    for (int j = 0; j < 4; ++j) { const int n = (lane >> 3) + 8 * j; const LAS float* s = scr + (8 * c) * 33 + n;
        v4u o; o.x = pk2(s[0 * 33], s[1 * 33]); o.y = pk2(s[2 * 33], s[3 * 33]); o.z = pk2(s[4 * 33], s[5 * 33]); o.w = pk2(s[6 * 33], s[7 * 33]);
        if (n0 + n < N) *(GAS v4u*)(WT + (size_t)(drow0 + n) * ldt + k0 + 8 * c) = o; }
    LDS_WAIT(); asm volatile("" ::: "memory");
}

__device__ __forceinline__ void ph_mod(Frame& F, const float* c, const float* cctx, const float* ada_w, const float* ada_b, float* MOD) {
    LAS float* s = (LAS float*)(F.lds + RING_OFF);
    LAS float* red = s + 5 * 1024;
    for (int i = F.tid; i < 5 * 1024; i += NTHR) { const int r = i >> 10, k = i & 1023; const float v = r < 4 ? c[r * 1024 + k] : cctx[k]; s[i] = siluf_(v); }
    __syncthreads();
    for (int u = F.vcu; u < 192; u += F.G) {
        const int l = u / 96, j0 = (u % 96) * 64, cl = F.tid & 63, kp = F.tid >> 6;
        const float* W = ada_w + (size_t)l * 1024 * 6144 + j0 + cl;
        float acc[5] = {0.f, 0.f, 0.f, 0.f, 0.f};
        for (int k = kp * 128; k < kp * 128 + 128; ++k) { const float w = W[(size_t)k * 6144];
#pragma unroll
            for (int r = 0; r < 5; ++r) acc[r] += s[r * 1024 + k] * w; }
#pragma unroll
        for (int r = 0; r < 5; ++r) red[(kp * 5 + r) * 64 + cl] = acc[r];
        __syncthreads();
        if (F.tid < 320) { const int r = F.tid >> 6; float a = ada_b[l * 6144 + j0 + cl];
#pragma unroll
            for (int q = 0; q < 8; ++q) a += red[(q * 5 + r) * 64 + cl];
            MOD[((size_t)l * 5 + r) * 6144 + j0 + cl] = a; }
        __syncthreads();
    }
}
__device__ __forceinline__ void ph_convert_small(Frame& F, const float* w_in, const float* w_vres, const float* w_out, bf16* WIN_T  , bf16* WOUT_T  ) {
    LAS float* scr = (LAS float*)(F.lds + RING_OFF + 32768 + F.wave * 16384 / 2);
    scr = (LAS float*)(F.lds + RING_OFF + 32768 + F.wave * 9216);
    const int gw = F.vcu * NWAVES + F.wave, NGW = F.G * NWAVES;
    constexpr int NB_IN = (NIN + 31) / 32;
    constexpr int I_IN = 16 * NB_IN, I_VR = 16 * 1, I_OUT = 16 * 32;
    constexpr int PER_L = I_IN + I_VR + I_OUT;
    for (int it = gw; it < 2 * PER_L; it += NGW) {
        const int l = it / PER_L; int r = it % PER_L;
        if (r < I_IN) { const int kb = r / NB_IN, nb = r % NB_IN; transpose_item(w_in + (size_t)l * D * NIN, NIN, NIN, kb * 64, nb * 32, WIN_T + (size_t)l * LDP * D, D, nb * 32, scr, F.lane); continue; } r -= I_IN;
        if (r < I_VR) { if (l == 1) transpose_item(w_vres, 32, 32, r * 64, 0, WIN_T + (size_t)LDP * D, D, NIN, scr, F.lane); continue; } r -= I_VR;
        { const int kb = r / 32, nb = r % 32; transpose_item(w_out + (size_t)l * D * D, D, D, kb * 64, nb * 32, WOUT_T + (size_t)l * D * D, D, nb * 32, scr, F.lane); }
    }
}
__device__ __forceinline__ void ph_norm_mod(Frame& F, const float* xs, const float* cs, const float* gain, const float* MODl, int si, bf16* XN, int nrows) {
    const int gw = F.vcu * NWAVES + F.wave, NGW = F.G * NWAVES, lane = F.lane;
    for (int m = gw; m < nrows; m += NGW) {
        const float* src = m < NX ? xs + (size_t)m * D : cs + (size_t)(m - NX) * D; const int rb = m < NX ? (m >> 12) : 4;
        const float* md = MODl + (size_t)rb * 6144;
        f32x4 v[4]; float ss = 0.f;
#pragma unroll
        for (int j = 0; j < 4; ++j) { v[j] = *(const f32x4*)(src + 4 * lane + 256 * j); ss += (v[j].x * v[j].x + v[j].y * v[j].y) + (v[j].z * v[j].z + v[j].w * v[j].w); }
        ss = wave_sum(ss); const float rs = rsqrtf(ss * (1.f / D) + 1e-6f);
#pragma unroll
        for (int j = 0; j < 4; ++j) { const int ci = 4 * lane + 256 * j; const f32x4 g = *(const f32x4*)(gain + ci), sh = *(const f32x4*)(md + si * 1024 + ci), sc = *(const f32x4*)(md + (si + 1) * 1024 + ci);
            const f32x4 y = v[j] * rs * g * (sc + 1.f) + sh;
            unsigned long long o = (unsigned long long)pk2(y.x, y.y) | ((unsigned long long)pk2(y.z, y.w) << 32);
            *(unsigned long long*)(XN + (size_t)m * D + ci) = o; }
    }
}

constexpr int CW_CNT = 2048;
constexpr int TAB_OFF = LDSCTL_OFF + 1024;
struct MoeTab { LAS int* cnt; LAS int* ups; LAS int* ro; };
__device__ __forceinline__ MoeTab moe_tab(Frame& F) { MoeTab t; t.cnt = (LAS int*)(F.lds + TAB_OFF); t.ups = t.cnt + 80; t.ro = t.ups + 80; return t; }
__device__ __forceinline__ void moe_build_tab(Frame& F, int layer, int ntok) {
    MoeTab T = moe_tab(F);
    if (F.tid < 64) T.cnt[F.tid] = (int)__hip_atomic_load(F.ctl + CW_CNT + layer * 64 + F.tid, RLX_AGENT);
    if (F.tid == 64) T.cnt[64] = ntok;
    __syncthreads();
    if (F.tid == 0) { int u = 0, r = 0; for (int e = 0; e < 65; ++e) { T.ups[e] = u; T.ro[e] = r; u += (T.cnt[e] + 255) >> 8; r += T.cnt[e]; } T.ups[65] = u; T.ro[65] = r; }
    __syncthreads();
}
__device__ __forceinline__ int uni(int v) { return __builtin_amdgcn_readfirstlane(v); }
__device__ __forceinline__ const char* uni_ptr(const char* p) { unsigned long long v = (unsigned long long)p; unsigned lo = __builtin_amdgcn_readfirstlane((unsigned)v), hi = __builtin_amdgcn_readfirstlane((unsigned)(v >> 32)); return (const char*)(((unsigned long long)hi << 32) | lo); }

__device__ __forceinline__ void ph_route(Frame& F, const float* XR, const float* gain, const float* MODl, const float* rw, const float* rbias, bf16* XN, int layer,
                                         unsigned* LIST, int* SLOTPOS, float* SLOTG, int ntok) {
    LAS float* hs = (LAS float*)(F.lds + RING_OFF);
    LAS float* part = (LAS float*)(F.lds + RING_OFF + 65536);
    LAS float* sc = (LAS float*)(F.lds + RING_OFF + 98304);
    const int lane = F.lane, wv = F.wave, tid = F.tid;
    const int ngrp = ntok / 16;
    for (int g = F.vcu; g < ngrp; g += F.G) {
#pragma unroll
        for (int tt = 0; tt < 2; ++tt) {
            const int tl = 2 * wv + tt, m = g * 16 + tl;
            const float* src = XR + (size_t)m * D; const int rb = m < NX ? (m >> 12) : 4; const float* md = MODl + (size_t)rb * 6144;
            f32x4 v[4]; float ss = 0.f;
#pragma unroll
            for (int j = 0; j < 4; ++j) { v[j] = *(const f32x4*)(src + 4 * lane + 256 * j); ss += (v[j].x * v[j].x + v[j].y * v[j].y) + (v[j].z * v[j].z + v[j].w * v[j].w); }
            ss = wave_sum(ss); const float rs = rsqrtf(ss * (1.f / D) + 1e-6f);
#pragma unroll
            for (int j = 0; j < 4; ++j) { const int ci = 4 * lane + 256 * j; const f32x4 gg = *(const f32x4*)(gain + ci), sh = *(const f32x4*)(md + 3 * 1024 + ci), scl = *(const f32x4*)(md + 4 * 1024 + ci);
                const f32x4 y = v[j] * rs * gg * (scl + 1.f) + sh;
                *(LAS f32x4*)(hs + tl * 1024 + ci) = y;
                *(unsigned long long*)(XN + (size_t)m * D + ci) = (unsigned long long)pk2(y.x, y.y) | ((unsigned long long)pk2(y.z, y.w) << 32); }
        }
        __syncthreads();
        { const int e = tid & 63, kp = tid >> 6; float acc[16];
#pragma unroll
            for (int t = 0; t < 16; ++t) acc[t] = 0.f;
            const float* wp = rw + (size_t)(kp * 128) * 64 + e;
            for (int k = 0; k < 128; k += 4) { const float w0 = wp[(k + 0) * 64], w1 = wp[(k + 1) * 64], w2 = wp[(k + 2) * 64], w3 = wp[(k + 3) * 64];
#pragma unroll
                for (int t = 0; t < 16; ++t) { const f32x4 h4 = *(const LAS f32x4*)(hs + t * 1024 + kp * 128 + k); acc[t] += (h4.x * w0 + h4.y * w1) + (h4.z * w2 + h4.w * w3); } }
#pragma unroll
            for (int t = 0; t < 16; ++t) part[(kp * 16 + t) * 64 + e] = acc[t]; }
        __syncthreads();
#pragma unroll
        for (int q = 0; q < 2; ++q) { const int t = (tid >> 6) + 8 * q, e = tid & 63; float a = 0.f;
#pragma unroll
            for (int kp = 0; kp < 8; ++kp) a += part[(kp * 16 + t) * 64 + e];
            sc[t * 64 + e] = sigmoidf_(a); }
        __syncthreads();
#pragma unroll
        for (int tt = 0; tt < 2; ++tt) {
            const int tl = 2 * wv + tt, m = g * 16 + tl;
            const float s = sc[tl * 64 + lane]; float sel = s + rbias[lane]; int myk = -1; float ssum = 0.f;
            for (int k = 0; k < 8; ++k) {
                float bv = sel; int bi = lane;
#pragma unroll
                for (int o = 1; o < 64; o <<= 1) { const float ov = __shfl_xor(bv, o); const int oi = __shfl_xor(bi, o); if (ov > bv || (ov == bv && oi < bi)) { bv = ov; bi = oi; } }
                ssum += __shfl(s, bi);
                if (lane == bi) { myk = k; sel = -3.0e38f; }
            }
            if (myk >= 0) { const float gw = 2.5f * s / ssum;
                const unsigned rank = __hip_atomic_fetch_add(F.ctl + CW_CNT + layer * 64 + lane, 1u, RLX_AGENT);
                LIST[(size_t)lane * MT + rank] = (unsigned)m;
                SLOTPOS[(size_t)m * 8 + myk] = (lane << 16) | (int)rank; SLOTG[(size_t)m * 8 + myk] = gw; }
        }
        __syncthreads();
    }
}
__device__ __forceinline__ void ph_convert_experts(Frame& F, const float* wg, const float* wu, const float* wd, const float* sg, const float* su, const float* sd, bf16* WGU_T, bf16* WD_T) {
    LAS float* scr = (LAS float*)(F.lds + RING_OFF + F.wave * 9216);
    const int gw = F.vcu * NWAVES + F.wave, NGW = F.G * NWAVES;
    for (int it = gw; it < 65 * 384; it += NGW) {
        const int e = it / 384; int r = it % 384;
        const float* Wg = e < 64 ? wg + (size_t)e * D * EFF : sg; const float* Wu = e < 64 ? wu + (size_t)e * D * EFF : su; const float* Wd = e < 64 ? wd + (size_t)e * EFF * D : sd;
        if (r < 256) { const float* W = r < 128 ? Wg : Wu; const int up = r >= 128; r &= 127; const int kb = r >> 3, nb = r & 7, n0 = nb * 32;
            transpose_item(W, EFF, EFF, kb * 64, n0, WGU_T + (size_t)e * 512 * D, D, (n0 >> 7) * 256 + (n0 & 127) + up * 128, scr, F.lane); }
        else { r -= 256; const int kb = r >> 5, nb = r & 31; transpose_item(Wd, D, D, kb * 64, nb * 32, WD_T + (size_t)e * D * EFF, EFF, nb * 32, scr, F.lane); }
    }
}
namespace pg8 {
struct MoeOrder1 {
    const bf16_t* XN; const bf16_t* WGU; const unsigned* LIST; MoeTab T; int G, c, total;
    __device__ bool next(int i, Unit& u) const {
        const int L = i * G + c; if (L >= total) return false;
        const int pn = L & 1, ru = L >> 1; int lo = 0, hi = 64;
        while (lo < hi) { const int mid = (lo + hi + 1) >> 1; if (T.ups[mid] <= ru) lo = mid; else hi = mid - 1; }
        const int e = uni(lo), j = uni(ru - T.ups[lo]);
        u.e = e; u.pm = j; u.pn = pn; u.nrows = uni(min(256, T.cnt[e] - j * 256)); u.rb = uni(T.ro[e] + j * 256);
        u.A = (const char*)XN; u.B = uni_ptr((const char*)WGU + ((size_t)e * 512 + (size_t)pn * 256) * D * 2); return true;
    }
    __device__ __forceinline__ unsigned a_off(const Unit& u, int h, int R, int C) const {
        const int idx = h * HALF + R; int tok = 0;
        if (idx < u.nrows) tok = u.e < 64 ? (int)LIST[(size_t)u.e * MT + u.pm * 256 + idx] : u.pm * 256 + idx;
        return (unsigned)(tok * D + C) * 2u;
    }
};
struct MoeOrder2 {
    const bf16_t* HACT; const bf16_t* WD; MoeTab T; int G, c, total;
    __device__ bool next(int i, Unit& u) const {
        const int L = i * G + c; if (L >= total) return false;
        const int pn = L & 3, ru = L >> 2; int lo = 0, hi = 64;
        while (lo < hi) { const int mid = (lo + hi + 1) >> 1; if (T.ups[mid] <= ru) lo = mid; else hi = mid - 1; }
        const int e = uni(lo), j = uni(ru - T.ups[lo]);
        u.e = e; u.pm = j; u.pn = pn; u.nrows = uni(min(256, T.cnt[e] - j * 256)); u.rb = uni(T.ro[e] + j * 256);
        u.A = uni_ptr((const char*)HACT + (size_t)u.rb * EFF * 2); u.B = uni_ptr((const char*)WD + ((size_t)e * D + (size_t)pn * 256) * EFF * 2); return true;
    }
    __device__ __forceinline__ unsigned a_off(const Unit&, int h, int R, int C) const { return (unsigned)((h * HALF + R) * EFF + C) * 2u; }
};
struct EpiSwiglu {
    static constexpr bool PERM = true;
    bf16_t* HACT;
    __device__ __forceinline__ void operator()(const f32x4 (&acc)[2][2][4][2], const Unit& u, int wr, int wc, int fr, int fq) const {
#pragma unroll
        for (int ai = 0; ai < 2; ++ai)
#pragma unroll
            for (int m = 0; m < 4; ++m) { const int r = ai * HALF + wr * 64 + m * 16 + fr;
                if (r < u.nrows) { const f32x4 g0 = acc[ai][0][m][0], g1 = acc[ai][0][m][1], u0 = acc[ai][1][m][0], u1 = acc[ai][1][m][1];
                    float o[8];
#pragma unroll
                    for (int q = 0; q < 4; ++q) { o[q] = g0[q] / (1.f + __expf(-g0[q])) * u0[q]; o[4 + q] = g1[q] / (1.f + __expf(-g1[q])) * u1[q]; }
                    u32x4 w; w.x = cvt_pk_bf16(o[0], o[1]); w.y = cvt_pk_bf16(o[2], o[3]); w.z = cvt_pk_bf16(o[4], o[5]); w.w = cvt_pk_bf16(o[6], o[7]);
                    *(u32x4*)(HACT + (size_t)(u.rb + r) * EFF + u.pn * 128 + wc * 32 + 8 * fq) = w; } }
    }
};
struct EpiDown {
    static constexpr bool PERM = true;
    bf16_t* Y; float* XR; const float* MODl;
    __device__ __forceinline__ void operator()(const f32x4 (&acc)[2][2][4][2], const Unit& u, int wr, int wc, int fr, int fq) const {
        asm volatile("" : "+v"(fr), "+v"(fq));
        const unsigned lcol = (unsigned)(wc * 32 + 8 * fq);
        if (u.e < 64) {
            char* ybase = (char*)uni_ptr((const char*)(Y + (size_t)u.rb * D + u.pn * BM));
#pragma unroll
            for (int ai = 0; ai < 2; ++ai)
#pragma unroll
                for (int m = 0; m < 4; ++m) { const int r = ai * HALF + wr * 64 + m * 16 + fr;
                    if (r < u.nrows) { const unsigned off = ((unsigned)r * D + lcol) * 2u;
#pragma unroll
                        for (int bj = 0; bj < 2; ++bj) { const f32x4 v0 = acc[ai][bj][m][0], v1 = acc[ai][bj][m][1];
                            u32x4 w; w.x = cvt_pk_bf16(v0[0], v0[1]); w.y = cvt_pk_bf16(v0[2], v0[3]); w.z = cvt_pk_bf16(v1[0], v1[1]); w.w = cvt_pk_bf16(v1[2], v1[3]);
                            *(u32x4*)(ybase + off + bj * HALF * 2) = w; } } }
        } else {
            const int m0 = u.pm * 256; const int rb = m0 < NX ? (m0 >> 12) : 4;
            const char* mdb = uni_ptr((const char*)(MODl + (size_t)rb * 6144 + 5 * 1024 + u.pn * BM)); char* xb = (char*)uni_ptr((const char*)(XR + (size_t)m0 * D + u.pn * BM));
#pragma unroll
            for (int ai = 0; ai < 2; ++ai)
#pragma unroll
                for (int m = 0; m < 4; ++m) { const int r = ai * HALF + wr * 64 + m * 16 + fr;
                    if (r < u.nrows) {
#pragma unroll
                        for (int bj = 0; bj < 2; ++bj)
#pragma unroll
                            for (int n = 0; n < 2; ++n) { const unsigned c = (unsigned)(bj * HALF) + lcol + 4u * n; const unsigned off = ((unsigned)r * D + c) * 4u;
                                const f32x4 xi = *(const f32x4*)(xb + off), mm = *(const f32x4*)(mdb + c * 4u); *(f32x4*)(xb + off) = xi + mm * acc[ai][bj][m][n]; } }
                    asm volatile("" ::: "memory"); }
        }
    }
};
}
__device__ __forceinline__ void ph_combine(Frame& F, const bf16* Y, const int* SLOTPOS, const float* SLOTG, const float* MODl, float* XR, int ntok) {
    MoeTab T = moe_tab(F);
    const int gw = F.vcu * NWAVES + F.wave, NGW = F.G * NWAVES, lane = F.lane;
    for (int m = gw; m < ntok; m += NGW) {
        const int rb = m < NX ? (m >> 12) : 4; const float* md = MODl + (size_t)rb * 6144 + 5 * 1024;
        float acc[16];
#pragma unroll
        for (int q = 0; q < 16; ++q) acc[q] = 0.f;
#pragma unroll
        for (int s = 0; s < 8; ++s) { const int sp = SLOTPOS[(size_t)m * 8 + s]; const int row = T.ro[sp >> 16] + (sp & 0xffff); const float gs = SLOTG[(size_t)m * 8 + s];
            const bf16* yr = Y + (size_t)row * D;
#pragma unroll
            for (int j = 0; j < 4; ++j) { const unsigned long long w = *(const unsigned long long*)(yr + 4 * lane + 256 * j);
                acc[4 * j + 0] += gs * __uint_as_float((unsigned)(w & 0xffffull) << 16); acc[4 * j + 1] += gs * __uint_as_float((unsigned)((w >> 16) & 0xffffull) << 16);
                acc[4 * j + 2] += gs * __uint_as_float((unsigned)((w >> 32) & 0xffffull) << 16); acc[4 * j + 3] += gs * __uint_as_float((unsigned)((w >> 48) & 0xffffull) << 16); } }
#pragma unroll
        for (int j = 0; j < 4; ++j) { const int ci = 4 * lane + 256 * j; float* o = XR + (size_t)m * D + ci; const f32x4 xi = *(const f32x4*)o, mm = *(const f32x4*)(md + ci);
            *(f32x4*)o = xi + mm * (f32x4){acc[4 * j], acc[4 * j + 1], acc[4 * j + 2], acc[4 * j + 3]}; }
    }
}

__global__ void __launch_bounds__(NTHR, 2) mega(MArgs a) {
    extern __shared__ __attribute__((aligned(16))) unsigned char lds_raw[];
    Frame F; F.lds = (LAS unsigned char*)lds_raw; F.MISC = (volatile LAS unsigned*)(F.lds + MISC_OFF);
    F.tid = threadIdx.x; F.lane = F.tid & 63; F.wave = __builtin_amdgcn_readfirstlane(F.tid >> 6);
    F.G = gridDim.x; { const int bx = blockIdx.x; F.vcu = (F.G % 8 == 0) ? (bx % 8) * (F.G / 8) + bx / 8 : bx; }
    unsigned char* ws = a.ws; F.ctl = (gu32*)ws;
    for (int u = F.tid; u < (LDS_BYTES - LDSCTL_OFF) / 4; u += NTHR) ((LAS unsigned*)(F.lds + LDSCTL_OFF))[u] = 0u;
    __syncthreads();
    XcdBarrier bar = xcd_barrier_post((unsigned*)(F.ctl + CW_BAR) + a.bar_region * XCD_BAR_WORDS, F.MISC + 8);
    const int lo = a.ph_lo, hi = a.ph_hi, l = a.layer;
#ifndef PH_MASK
#define PH_MASK 0xffff
#endif
#define IN(k) (((PH_MASK >> (k)) & 1) && lo <= (k) && (k) < hi)
#define BOTH(k) (IN(k) && IN((k) + 1))
    float* MOD = (float*)(ws + WS_MOD); bf16* XN = (bf16*)(ws + WS_XN); float* XR = (float*)(ws + WS_XR); bf16* P = (bf16*)(ws + WS_P);
    bf16* WIN_T = (bf16*)(ws + WS_WIN); bf16* WOUT_T = (bf16*)(ws + WS_WOUT);
    const float* MODl = MOD + (size_t)l * 5 * 6144;
    const float* xs = l == 0 ? a.in[I_X] : XR; const float* cs = l == 0 ? a.in[I_CTX] : XR + (size_t)NX * D;
    if (IN(0)) { ph_mod(F, a.in[I_C], a.in[I_CCTX], a.in[I_ADAW], a.in[I_ADAB], MOD); ph_convert_small(F, a.in[I_WIN], a.in[I_WVRES], a.in[I_WOUT], WIN_T, WOUT_T); if (BOTH(0)) xcd_barrier(bar); }
    if (IN(1)) { ph_norm_mod(F, xs, cs, a.in[I_NMIX] + l * D, MODl, 0, XN, MT); if (BOTH(1)) xcd_barrier(bar); }
    if (IN(2)) { pg8::DenseOrder S; S.init(XN, WIN_T + (size_t)l * LDP * D, MT, LDP, D, F.G, (int)blockIdx.x); pg8::EpiStoreBf16 E{P, LDP};
        pg8::gemm_phase<pg8::EpiStoreBf16, pg8::DenseOrder, true>(F.lds + RING_OFF, D, S, E); if (BOTH(2)) xcd_barrier(bar); }
    if (IN(3)) { pg8::DenseOrder S; S.init(XN  , WOUT_T + (size_t)l * D * D, MT, D, D, F.G, (int)blockIdx.x); pg8::EpiResidual E{xs, cs, MODl, XR};
        pg8::gemm_phase<pg8::EpiResidual, pg8::DenseOrder, true>(F.lds + RING_OFF, D, S, E); if (BOTH(3)) xcd_barrier(bar); }
    bf16* WGU_T = (bf16*)(ws + WS_WGU); bf16* WD_T = (bf16*)(ws + WS_WD); bf16* HACT = (bf16*)(ws + WS_HACT); bf16* Y = (bf16*)(ws + WS_Y);
    unsigned* LIST = (unsigned*)(ws + WS_LIST); int* SLOTPOS = (int*)(ws + WS_SLOT); float* SLOTG = (float*)(ws + WS_SLOT + (size_t)MT * 8 * 4);
    const int ntok = l == 0 ? MT : NX;
    if (IN(4)) { ph_route(F, XR, a.in[I_NFFN] + l * D, MODl, a.in[I_RTW] + (size_t)l * D * NE, a.in[I_RTB] + l * NE, XN, l, LIST, SLOTPOS, SLOTG, ntok); __syncthreads();
        ph_convert_experts(F, a.in[I_EWG] + (size_t)l * NE * D * EFF, a.in[I_EWU] + (size_t)l * NE * D * EFF, a.in[I_EWD] + (size_t)l * NE * EFF * D,
                           a.in[I_SWG] + (size_t)l * D * EFF, a.in[I_SWU] + (size_t)l * D * EFF, a.in[I_SWD] + (size_t)l * EFF * D, WGU_T, WD_T);
        if (BOTH(4)) xcd_barrier(bar); }
    if (IN(5)) { moe_build_tab(F, l, ntok); MoeTab T = moe_tab(F);
        pg8::MoeOrder1 S{XN, WGU_T, LIST, T, F.G, (int)blockIdx.x, T.ups[65] * 2}; pg8::EpiSwiglu E{HACT};
        pg8::gemm_phase<pg8::EpiSwiglu, pg8::MoeOrder1, true>(F.lds + RING_OFF, D, S, E); if (BOTH(5)) xcd_barrier(bar); }
    if (IN(6)) { moe_build_tab(F, l, ntok); MoeTab T = moe_tab(F);
        pg8::MoeOrder2 S{HACT, WD_T, T, F.G, (int)blockIdx.x, T.ups[65] * 4}; pg8::EpiDown E{Y, XR, MODl};
        int k2 = EFF; asm volatile("" : "+s"(k2));
        pg8::gemm_phase<pg8::EpiDown, pg8::MoeOrder2, true>(F.lds + RING_OFF, k2, S, E); if (BOTH(6)) xcd_barrier(bar); }
    if (IN(7)) { moe_build_tab(F, l, ntok); ph_combine(F, Y, SLOTPOS, SLOTG, MODl, XR, ntok); if (BOTH(7)) xcd_barrier(bar); }
#undef IN
#undef BOTH
}

static void launch_mega(MArgs a, int lo, int hi, int layer, int region, int grid, hipStream_t stream) {
    a.ph_lo = lo; a.ph_hi = hi; a.layer = layer; a.bar_region = region;
    hipLaunchKernelGGL(mega, dim3(grid), dim3(NTHR), LDS_BYTES, stream, a);
}
extern "C" void kernel_launch(void* const* d_in, const int* in_sizes, int n_in, void* d_out, int out_size, void* d_ws, size_t ws_size, hipStream_t stream) {
    static int grid = 0;
    if (grid == 0) {
        if (n_in != I_N || ws_size < WS_END) { fprintf(stderr, "kernel_launch: bad n_in %d or ws %zu\n", n_in, ws_size); grid = -1; return; }
        int dev = 0, cus = 0;
        if (hipGetDevice(&dev) != hipSuccess || hipDeviceGetAttribute(&cus, hipDeviceAttributeMultiprocessorCount, dev) != hipSuccess) { grid = -1; return; }
        if (hipFuncSetAttribute((const void*)mega, hipFuncAttributeMaxDynamicSharedMemorySize, LDS_BYTES) != hipSuccess) { grid = -1; return; }
        int per_cu = 0; (void)hipOccupancyMaxActiveBlocksPerMultiprocessor(&per_cu, (const void*)mega, NTHR, LDS_BYTES); (void)hipGetLastError();
        grid = cus;
    }
    if (grid < 0) return;
    const float* in[I_N]; for (int i = 0; i < I_N; ++i) in[i] = (const float*)d_in[i];
    unsigned char* ws = (unsigned char*)d_ws;
    hipMemsetAsync(ws, 0, CTL_ZERO_BYTES, stream);
    MArgs ma{}; for (int i = 0; i < I_N; ++i) ma.in[i] = in[i]; ma.out = (float*)d_out; ma.ws = ws;
    float* MOD = (float*)(ws + WS_MOD); bf16* XN = (bf16*)(ws + WS_XN); bf16* MIX = XN; float* XR = (float*)(ws + WS_XR); float* VF = (float*)(ws + WS_VF);
    float* BON = (float*)(ws + WS_BON); float* G = (float*)(ws + WS_G); float* YS = (float*)(ws + WS_YS); float* SV = (float*)(ws + WS_SV);
    bf16* P = (bf16*)(ws + WS_P); float* SI = (float*)(ws + WS_SI);
    float* out = (float*)d_out;
    int region = 0;
    for (int l = 0; l < 2; ++l) {
        const float* MODl = MOD + (size_t)l * 5 * 6144;
        launch_mega(ma, l == 0 ? 0 : 1, 3, l, region++, grid, stream);
        { RwP w{in[I_RWMU] + l * 960, in[I_RWW0] + l * 512, in[I_RWW2] + l * 2 * 32 * 256, in[I_RWA0] + l * 512, in[I_RWA2] + l * 2 * 32 * 256, in[I_RWG2] + l * 64 * 256, in[I_RWKK] + l * 256, in[I_RWKA] + l * 256,
                in[I_RWRK] + l * 256, in[I_RWV0], in[I_RWV2]};
          k_rwkv_prep<<<MT, 256, 0, stream>>>(P, w, l, VF, SI, SV, BON, G);
          k_rowscan<<<32, 64, 0, stream>>>(SI, SV, YS);
          k_rwkv_post<<<MT, 256, 0, stream>>>(YS, BON, G, in[I_RWLNW] + l * 256, in[I_RWLNB] + l * 256, MIX); }
        k_ret_prep<<<MT, 256, 0, stream>>>(P, in[I_RETL] + l * 8, SI, SV);
        k_rowscan<<<32, 64, 0, stream>>>(SI, SV, YS);
        k_hnorm_post<<<MT, 256, 0, stream>>>(YS, P, RET_OFF + 768, nullptr, MIX, 256);
        k_gdn_prep<<<MT, 256, 0, stream>>>(P, in[I_GCW] + l * 4 * 768, in[I_GALOG] + l * 8, in[I_GDT] + l * 8, SI, SV);
        k_rowscan<<<32, 64, 0, stream>>>(SI, SV, YS);
        k_hnorm_post<<<MT, 256, 0, stream>>>(YS, P, GDN_OFF + 784, in[I_GNW] + l * 64, MIX, 512);
        { LruP w{in[I_LCW] + l * 4 * 256, in[I_LCB] + l * 256, in[I_LWA] + (size_t)l * 2 * 4 * 64 * 64, in[I_LBA] + l * 512, in[I_LWX] + (size_t)l * 2 * 4 * 64 * 64, in[I_LBX] + l * 512, in[I_LLAM] + l * 512};
          float* LA = SI; float* LB = SI + (size_t)2 * MT * 256;
          k_lru_prep<<<MT, 256, 0, stream>>>(P, w, LA, LB);
          k_lru_scan<<<8, 256, 0, stream>>>(LA, LB, YS);
          k_lru_post<<<MT, 256, 0, stream>>>(YS, P, MIX); }
        launch_mega(ma, 3, 8, l, region++, grid, stream);
    }
    k_final_norm<<<NX / 4, 256, 0, stream>>>(XR, in[I_NFIN], out);
}
```

```cpp
#include <hip/hip_runtime.h>
#include <cstdio>
#include <cstdint>

typedef unsigned short bf16;
__device__ __forceinline__ float bf2f(bf16 v) { return __uint_as_float(((unsigned)v) << 16); }
__device__ __forceinline__ bf16 f2bf(float f) { unsigned u = __float_as_uint(f); u += 0x7fffu + ((u >> 16) & 1u); return (bf16)(u >> 16); }

constexpr int D = 1024, NB = 4, SEQ = 4096, CTXL = 256;
constexpr int NX = NB * SEQ;
constexpr int NC = NB * CTXL;
constexpr int MT = NX + NC;
constexpr int NIN = 3536, NINV = 3568, LDP = 3584;
constexpr int RW_OFF = 0, RET_OFF = 960, GDN_OFF = 1984, LRU_OFF = 3024, VRES_OFF = 3536;
constexpr int NE = 64, TOPK = 8, EFF = 256;
constexpr int NSTEP = CTXL + SEQ;

constexpr size_t MiB = 1u << 20;
constexpr size_t WS_MOD = 1 * MiB;
constexpr size_t WS_XN = 2 * MiB;
constexpr size_t WS_XR = 36 * MiB;
constexpr size_t WS_VF = 104 * MiB;
constexpr size_t WS_LIST = 121 * MiB;
constexpr size_t WS_SLOT = 130 * MiB;
constexpr size_t WS_WIN = 131 * MiB;
constexpr size_t WS_WOUT = 145 * MiB;
constexpr size_t WS_SI = 149 * MiB;
constexpr size_t WS_P = 319 * MiB;
constexpr size_t WS_BON = 438 * MiB;
constexpr size_t WS_G = 455 * MiB;
constexpr size_t WS_YS = 472 * MiB;
constexpr size_t WS_SV = 506 * MiB;
constexpr size_t WS_WD = 149 * MiB;
constexpr size_t WS_HACT = 182 * MiB;
constexpr size_t WS_Y = 267 * MiB;
constexpr size_t WS_WGU = 267 * MiB;
constexpr size_t WS_END = 539 * MiB;

struct Row { int b, t, L, isx; };
__device__ __forceinline__ Row row_of(int m) { Row r; if (m < NX) { r.b = m >> 12; r.t = m & 4095; r.L = SEQ; r.isx = 1; } else { int q = m - NX; r.b = q >> 8; r.t = q & 255; r.L = CTXL; r.isx = 0; } return r; }
__device__ __forceinline__ float sigmoidf_(float x) { return 1.f / (1.f + __expf(-x)); }
__device__ __forceinline__ float softplusf_(float x) { return x > 20.f ? x : log1pf(__expf(x)); }
__device__ __forceinline__ float siluf_(float x) { return x / (1.f + __expf(-x)); }
__device__ __forceinline__ float wave_sum(float v) {
#pragma unroll
    for (int o = 1; o < 64; o <<= 1) v += __shfl_xor(v, o);
    return v;
}


struct EpiP { bf16* P; __device__ void operator()(int m, int n, float v) const { P[(size_t)m * LDP + n] = f2bf(v); } };
struct EpiRes { const float* xs; const float* cs; const float* MODl; float* XR; __device__ void operator()(int m, int n, float v) const {
    const float xin = m < NX ? xs[(size_t)m * D + n] : cs[(size_t)(m - NX) * D + n]; const int rb = m < NX ? (m >> 12) : 4;
    XR[(size_t)m * D + n] = xin + MODl[(size_t)rb * 6144 + 2 * 1024 + n] * v; } };

__device__ __forceinline__ float* si_ptr(float* SI, int d, int m, int h, int vec) { return SI + ((((size_t)d * MT + m) * 4 + h) * 5 + vec) * 64; }

struct RwP { const float *mu, *w0, *w2, *a0, *a2, *g2, *kk, *ka, *rk, *v0, *v2; };

__device__ __forceinline__ int step_row(int b, int d, int s) { if (s < CTXL) { const int tc = d ? CTXL - 1 - s : s; return NX + b * CTXL + tc; } const int tx = d ? SEQ - 1 - (s - CTXL) : (s - CTXL); return b * SEQ + tx; }
struct LruP { const float *cw, *cb, *wa, *ba, *wx, *bx, *lam; };

struct MoeW { const float *wg, *wu, *wd, *sg, *su, *sd; };

enum { I_X = 0, I_C, I_CTX, I_CCTX, I_ADAW, I_ADAB, I_NMIX, I_NFFN, I_NFIN, I_WIN, I_WVRES, I_WOUT, I_RWMU, I_RWW0, I_RWW2, I_RWA0, I_RWA2, I_RWG2, I_RWKK, I_RWKA, I_RWRK, I_RWLNW, I_RWLNB, I_RWV0, I_RWV2,
       I_RETL, I_GCW, I_GALOG, I_GDT, I_GNW, I_LCW, I_LCB, I_LWA, I_LBA, I_LWX, I_LBX, I_LLAM, I_RTW, I_RTB, I_EWG, I_EWU, I_EWD, I_SWG, I_SWU, I_SWD, I_N };
#define GAS __attribute__((address_space(1)))
#define LAS __attribute__((address_space(3)))
typedef unsigned v4u __attribute__((ext_vector_type(4)));
typedef float f32x4 __attribute__((ext_vector_type(4)));
typedef short bf16x8 __attribute__((ext_vector_type(8)));
typedef GAS unsigned gu32;
#define RLX_AGENT __ATOMIC_RELAXED, __HIP_MEMORY_SCOPE_AGENT
#define LDS_WAIT() asm volatile("s_waitcnt lgkmcnt(0)" ::: "memory")
#define VM_WAIT() asm volatile("s_waitcnt vmcnt(0)" ::: "memory")
__device__ __forceinline__ unsigned pk2(float lo, float hi) { return (unsigned)f2bf(lo) | ((unsigned)f2bf(hi) << 16); }

namespace pg8 {
#define PG8_LAS __attribute__((address_space(3)))
typedef unsigned short bf16_t;
typedef unsigned u32x4 __attribute__((ext_vector_type(4)));
constexpr int BM = 256, BK = 64, HALF = 128, HTB = HALF * BK * 2, STAGE_BYTES = 8 * HTB, NXCD = 8, WGM = 8;
__host__ __device__ __forceinline__ int lds_byte(int r, int c) { const int st = (r >> 4) * 2 + (c >> 5), rr = r & 15, cc = c & 31, ob = rr * 64 + cc * 2; return st * 1024 + (ob ^ (((ob >> 9) & 1) << 5)); }
__host__ __device__ __forceinline__ void stage_rc(int b, int& R, int& C) { const int st = b / 1024, sb = b % 1024, swz = sb ^ (((sb >> 9) & 1) << 5); R = (st >> 1) * 16 + swz / 64; C = (st & 1) * 32 + (swz % 64) / 2; }
__host__ __device__ __forceinline__ int perm32(int rho) { const int n = rho >> 4, i = rho & 15; return 8 * (i >> 2) + 4 * n + (i & 3); }
__device__ __forceinline__ unsigned cvt_pk_bf16(float lo, float hi) { unsigned r; asm volatile("v_cvt_pk_bf16_f32 %0, %1, %2" : "=v"(r) : "v"(lo), "v"(hi)); return r; }

struct Unit { const char* A; const char* B; int pm, pn, e, nrows, rb; };

struct DenseOrder {
    const bf16_t* A; const bf16_t* Bt; int K, nM, nN, nwg, G, c;
    __device__ void init(const bf16_t* A_, const bf16_t* Bt_, int M, int N, int K_, int G_, int c_) { A = A_; Bt = Bt_; K = K_; nM = M / BM; nN = N / BM; nwg = nM * nN; G = G_; c = c_; }
    __device__ bool next(int i, Unit& u) const {
        const long L = (long)i * G + c; if (L >= nwg) return false;
        int wgid = (int)L; { const int q = nwg / NXCD, r = nwg % NXCD, xcd = wgid % NXCD, off = wgid / NXCD; wgid = (xcd < r ? xcd * (q + 1) : r * (q + 1) + (xcd - r) * q) + off; }
        const int nig = WGM * nN, gid = wgid / nig, fm = gid * WGM, gsz = (nM - fm) < WGM ? (nM - fm) : WGM;
        u.pm = fm + ((wgid % nig) % gsz); u.pn = (wgid % nig) / gsz; u.e = 0; u.nrows = BM; u.rb = 0;
        u.A = (const char*)A + (size_t)u.pm * BM * K * 2; u.B = (const char*)Bt + (size_t)u.pn * BM * K * 2; return true;
    }
    __device__ __forceinline__ unsigned a_off(const Unit&, int h, int R, int C) const { return (unsigned)((h * HALF + R) * K + C) * 2u; }
};

template <class Epi, class Sched, bool ALIGN_EPI = false>
__device__ __forceinline__ void gemm_phase(PG8_LAS unsigned char* lds, const int K, const Sched& S, const Epi& E) {
    int tid = threadIdx.x; asm volatile("" : "+v"(tid));
    const int wid = __builtin_amdgcn_readfirstlane(tid >> 6), lane = tid & 63, wr = wid >> 2, wc = wid & 3, fr = lane & 15, fq = lane >> 4;
    const int nt = K / BK;
    int sR[2], sC[2]; unsigned voffB[2];
#pragma unroll
    for (int i = 0; i < 2; ++i) { int R, C; stage_rc(tid * 16 + i * 8192, R, C); sR[i] = R; sC[i] = C; const int Rb = Epi::PERM ? ((R & ~31) + perm32(R & 31)) : R; voffB[i] = (unsigned)(Rb * K + C) * 2u; }
    const size_t kstep = (size_t)(BK * 2);
    const size_t hstep = (size_t)HALF * K * 2;
    const unsigned ldsw = (unsigned)wid * 1024u;
    const int aoff = lds_byte(wr * 64 + fr, fq * 8), boff = lds_byte(wc * 32 + fr, fq * 8);
#define PG8_SA(b, h) (((b) * 2 + (h)) * HTB)
#define PG8_SB(b, h) ((4 + (b) * 2 + (h)) * HTB)
#define PG8_STAGE(bufoff, gbase, voff) do { _Pragma("unroll") for (int _i = 0; _i < 2; ++_i) \
        __builtin_amdgcn_global_load_lds((const unsigned*)((const char*)(gbase) + (voff)[_i]), (PG8_LAS unsigned*)(lds + (bufoff) + ldsw + _i * 8192), 16, 0, 0); } while (0)
#define PG8_LDA(dst, b, h) do { _Pragma("unroll") for (int m = 0; m < 4; ++m) _Pragma("unroll") for (int k = 0; k < 2; ++k) dst[m][k] = *(const PG8_LAS bf16x8*)(lds + PG8_SA(b, h) + aoff + m * 2048 + k * 1024); } while (0)
#define PG8_LDB(dst, b, h) do { _Pragma("unroll") for (int n = 0; n < 2; ++n) _Pragma("unroll") for (int k = 0; k < 2; ++k) dst[n][k] = *(const PG8_LAS bf16x8*)(lds + PG8_SB(b, h) + boff + n * 2048 + k * 1024); } while (0)
#define PG8_MMA(ai, bj, At, Bt) do { __builtin_amdgcn_s_setprio(1); _Pragma("unroll") for (int m = 0; m < 4; ++m) _Pragma("unroll") for (int n = 0; n < 2; ++n) _Pragma("unroll") for (int k = 0; k < 2; ++k) \
        acc[ai][bj][m][n] = __builtin_amdgcn_mfma_f32_16x16x32_bf16(Bt[n][k], At[m][k], acc[ai][bj][m][n], 0, 0, 0); __builtin_amdgcn_s_setprio(0); } while (0)
#define PG8_WAIT_V(n) asm volatile("s_waitcnt vmcnt(" #n ")" ::: "memory")
#define PG8_WAIT_L(n) asm volatile("s_waitcnt lgkmcnt(" #n ")" ::: "memory")
#define PG8_BAR __builtin_amdgcn_s_barrier()
#define PG8_SCHED __builtin_amdgcn_sched_barrier(0)
    Unit cur, nxt; int ui = 0;
    if (!S.next(0, cur)) return;
    f32x4 acc[2][2][4][2];
#pragma unroll
    for (int a = 0; a < 2; ++a)
#pragma unroll
        for (int b = 0; b < 2; ++b)
#pragma unroll
            for (int m = 0; m < 4; ++m)
#pragma unroll
                for (int n = 0; n < 2; ++n) acc[a][b][m][n] = (f32x4){0.f, 0.f, 0.f, 0.f};
    bf16x8 At[4][2], B0[2][2], B1[2][2];
    unsigned cv0[2], cv1[2], nv0[2], nv1[2];
#pragma unroll
    for (int i = 0; i < 2; ++i) { cv0[i] = S.a_off(cur, 0, sR[i], sC[i]); cv1[i] = S.a_off(cur, 1, sR[i], sC[i]); nv0[i] = cv0[i]; nv1[i] = cv1[i]; }
    const char* cA = cur.A; const char* cB = cur.B;
    PG8_STAGE(PG8_SB(0, 0), cB, voffB); PG8_STAGE(PG8_SB(0, 1), cB + hstep, voffB); PG8_STAGE(PG8_SA(0, 0), cA, cv0); PG8_STAGE(PG8_SA(0, 1), cA, cv1);
    if (wr == 1) PG8_BAR;
    PG8_WAIT_V(2); PG8_BAR;
    PG8_STAGE(PG8_SB(1, 0), cB + kstep, voffB); PG8_STAGE(PG8_SA(1, 0), cA + kstep, cv0); PG8_STAGE(PG8_SB(1, 1), cB + hstep + kstep, voffB);
    PG8_WAIT_V(6); PG8_BAR;
    for (;;) {
        const bool has_next = S.next(ui + 1, nxt);
        const char* nA = has_next ? nxt.A : cA; const char* nB = has_next ? nxt.B : cB;
        if (has_next) {
#pragma unroll
            for (int i = 0; i < 2; ++i) { nv0[i] = S.a_off(nxt, 0, sR[i], sC[i]); nv1[i] = S.a_off(nxt, 1, sR[i], sC[i]); } }
        else {
#pragma unroll
            for (int i = 0; i < 2; ++i) { nv0[i] = cv0[i]; nv1[i] = cv1[i]; } }
        for (int t = 0; t < nt; t += 2) {
            const bool last = (t == nt - 2);
            const char* a1 = cA + (size_t)(t + 1) * kstep;
            const char* a2 = last ? nA : cA + (size_t)(t + 2) * kstep; const char* b2 = last ? nB : cB + (size_t)(t + 2) * kstep;
            const char* a3 = a2 + kstep; const char* b3 = b2 + kstep;
            unsigned x0[2], x1[2];
#pragma unroll
            for (int i = 0; i < 2; ++i) { x0[i] = last ? nv0[i] : cv0[i]; x1[i] = last ? nv1[i] : cv1[i]; }
            PG8_LDB(B0, 0, 0); PG8_LDB(B1, 0, 1); PG8_SCHED; PG8_LDA(At, 0, 0); PG8_STAGE(PG8_SA(1, 1), a1, cv1);
            PG8_WAIT_V(8); PG8_WAIT_L(0); PG8_BAR; PG8_MMA(0, 0, At, B0); PG8_MMA(0, 1, At, B1); PG8_BAR; PG8_SCHED;
            PG8_LDA(At, 0, 1); PG8_STAGE(PG8_SB(0, 0), b2, voffB); PG8_STAGE(PG8_SB(0, 1), b2 + hstep, voffB); PG8_STAGE(PG8_SA(0, 0), a2, x0);
            PG8_WAIT_V(8); PG8_WAIT_L(0); PG8_BAR; PG8_MMA(1, 0, At, B0); PG8_MMA(1, 1, At, B1); PG8_BAR; PG8_SCHED;
            PG8_LDB(B0, 1, 0); PG8_LDB(B1, 1, 1); PG8_SCHED; PG8_LDA(At, 1, 0); PG8_STAGE(PG8_SA(0, 1), a2, x1);
            PG8_WAIT_V(8); PG8_WAIT_L(0); PG8_BAR; PG8_MMA(0, 0, At, B0); PG8_MMA(0, 1, At, B1); PG8_BAR; PG8_SCHED;
            PG8_LDA(At, 1, 1); PG8_STAGE(PG8_SB(1, 0), b3, voffB); PG8_STAGE(PG8_SB(1, 1), b3 + hstep, voffB); PG8_STAGE(PG8_SA(1, 0), a3, x0);
            PG8_WAIT_V(8); PG8_WAIT_L(0); PG8_BAR; PG8_MMA(1, 0, At, B0); PG8_MMA(1, 1, At, B1); PG8_BAR; PG8_SCHED;
        }
        if constexpr (ALIGN_EPI) { if (wr == 0) PG8_BAR; }
        E(acc, cur, wr, wc, fr, fq);
        if (!has_next) break;
#pragma unroll
        for (int a = 0; a < 2; ++a)
#pragma unroll
            for (int b = 0; b < 2; ++b)
#pragma unroll
                for (int m = 0; m < 4; ++m)
#pragma unroll
                    for (int n = 0; n < 2; ++n) acc[a][b][m][n] = (f32x4){0.f, 0.f, 0.f, 0.f};
        cur = nxt; cA = nA; cB = nB; ++ui;
#pragma unroll
        for (int i = 0; i < 2; ++i) { cv0[i] = nv0[i]; cv1[i] = nv1[i]; }
        if constexpr (ALIGN_EPI) { if (wr == 1) PG8_BAR; }
    }
    PG8_WAIT_V(0);
    if constexpr (!ALIGN_EPI) { if (wr == 0) PG8_BAR; }
    PG8_BAR;
#undef PG8_SA
#undef PG8_SB
#undef PG8_STAGE
#undef PG8_LDA
#undef PG8_LDB
#undef PG8_MMA
#undef PG8_WAIT_V
#undef PG8_WAIT_L
#undef PG8_BAR
#undef PG8_SCHED
}

struct EpiStoreBf16 {
    static constexpr bool PERM = true;
    bf16_t* O; int ldc;
    __device__ __forceinline__ void operator()(const f32x4 (&acc)[2][2][4][2], const Unit& u, int wr, int wc, int fr, int fq) const {
        asm volatile("" : "+v"(fr), "+v"(fq));
        const int row0 = u.pm * BM + wr * 64 + fr, col0 = u.pn * BM + wc * 32 + 8 * fq;
#pragma unroll
        for (int ai = 0; ai < 2; ++ai)
#pragma unroll
            for (int m = 0; m < 4; ++m) { bf16_t* rowp = O + (size_t)(row0 + ai * HALF + m * 16) * ldc + col0;
#pragma unroll
                for (int bj = 0; bj < 2; ++bj) { const f32x4 v0 = acc[ai][bj][m][0], v1 = acc[ai][bj][m][1];
                    u32x4 w; w.x = cvt_pk_bf16(v0[0], v0[1]); w.y = cvt_pk_bf16(v0[2], v0[3]); w.z = cvt_pk_bf16(v1[0], v1[1]); w.w = cvt_pk_bf16(v1[2], v1[3]);
                    *(u32x4*)(rowp + bj * HALF) = w; } }
    }
};
struct EpiResidual {
    static constexpr bool PERM = false;
    const float* xs; const float* cs; const float* MODl; float* XR;
    __device__ __forceinline__ void operator()(const f32x4 (&acc)[2][2][4][2], const Unit& u, int wr, int wc, int fr, int fq) const {
        asm volatile("" : "+v"(fr), "+v"(fq));
        const int row0 = u.pm * BM + wr * 64 + fr, col0 = u.pn * BM + wc * 32 + 4 * fq;
#pragma unroll
        for (int ai = 0; ai < 2; ++ai)
#pragma unroll
            for (int m = 0; m < 4; ++m) { const int row = row0 + ai * HALF + m * 16;
                const float* xin = row < NX ? xs + (size_t)row * D : cs + (size_t)(row - NX) * D; const int rb = row < NX ? (row >> 12) : 4;
                const float* md = MODl + (size_t)rb * 6144 + 2 * 1024; float* o = XR + (size_t)row * D;
#pragma unroll
                for (int bj = 0; bj < 2; ++bj)
#pragma unroll
                    for (int n = 0; n < 2; ++n) { const int c = col0 + bj * HALF + n * 16; const f32x4 xi = *(const f32x4*)(xin + c), mm = *(const f32x4*)(md + c); *(f32x4*)(o + c) = xi + mm * acc[ai][bj][m][n]; } }
    }
};
}

#define XB_TMO      128
#define XB_XCNT(j)  (256  + 64 * (j))
#define XB_XSUB(j)  (1280 + 64 * (j))
#define XB_XGEN(j)  (2304 + 64 * (j))
#define XB_TOP      3328
#define XB_TOPGEN   3392
#define XCD_BAR_WORDS 3456
#define XB_SPIN_CAP (1u << 22)
__device__ __forceinline__ unsigned xb_ld(unsigned* p)              { return __hip_atomic_load(p, __ATOMIC_RELAXED, __HIP_MEMORY_SCOPE_AGENT); }
__device__ __forceinline__ unsigned xb_add(unsigned* p, unsigned v) { return __hip_atomic_fetch_add(p, v, __ATOMIC_RELAXED, __HIP_MEMORY_SCOPE_AGENT); }
__device__ __forceinline__ unsigned xb_xcc_id() { return (unsigned)__builtin_amdgcn_s_getreg((3 << 11) | 20) & 0xFu; }
#define XB_SPIN(cond, bar) do { unsigned _sp = 0; while (cond) { __builtin_amdgcn_s_sleep(1); \
    if ((++_sp & 255u) == 0u) { if (xb_ld(&(bar)[XB_TMO])) break; if (_sp > XB_SPIN_CAP) { atomicAdd(&(bar)[XB_TMO], 1u); break; } } } } while (0)
struct XcdBarrier { unsigned* bar; unsigned x; volatile LAS unsigned* st; };
__device__ __forceinline__ XcdBarrier xcd_barrier_post(unsigned* bar, volatile LAS unsigned* st) {
    XcdBarrier b; b.bar = bar; b.x = xb_xcc_id(); b.st = st;
    if (threadIdx.x == 0) (void)xb_add(&bar[XB_XCNT(b.x)], 1u);
    return b;
}
__device__ __forceinline__ void xcd_barrier_complete(unsigned* bar, unsigned x, unsigned& nloc, unsigned& nx) {
    const unsigned G = gridDim.x * gridDim.y * gridDim.z;
    unsigned sum, cnt, mine, sp = 0u;
    for (;;) {
        sum = 0u; cnt = 0u; mine = 0u;
#pragma unroll
        for (unsigned j = 0; j < 16; ++j) { const unsigned c = xb_ld(&bar[XB_XCNT(j)]); sum += c; cnt += (c > 0u) ? 1u : 0u; mine = (j == x) ? c : mine; }
        if (sum == G) break;
        __builtin_amdgcn_s_sleep(1);
        if ((++sp & 255u) == 0u) { if (xb_ld(&bar[XB_TMO])) break; if (sp > XB_SPIN_CAP) { atomicAdd(&bar[XB_TMO], 1u); break; } }
    }
    nloc = mine > 0u ? mine : 1u; nx = cnt > 0u ? cnt : 1u;
}
__device__ __forceinline__ void xcd_barrier(const XcdBarrier& b) {
    asm volatile("s_waitcnt vmcnt(0)" ::: "memory");
    __syncthreads();
    if (threadIdx.x == 0) {
        unsigned* bar = b.bar;
        __builtin_amdgcn_s_waitcnt(0);
        unsigned nloc = b.st[0], nx = b.st[1];
        if (nloc == 0u) { xcd_barrier_complete(bar, b.x, nloc, nx); b.st[0] = nloc; b.st[1] = nx; }
        const unsigned old = xb_add(&bar[XB_XSUB(b.x)], 1u);
        const unsigned gen = old / nloc;
        if (old + 1u == (gen + 1u) * nloc) {
            __builtin_amdgcn_fence(__ATOMIC_RELEASE, "agent");
            asm volatile("s_waitcnt vmcnt(0)" ::: "memory");
            const unsigned og = xb_add(&bar[XB_TOP], 1u);
            const unsigned tg = og / nx;
            if (og + 1u == (tg + 1u) * nx) xb_add(&bar[XB_TOPGEN], 1u);
            else XB_SPIN(xb_ld(&bar[XB_TOPGEN]) == tg, bar);
            __builtin_amdgcn_fence(__ATOMIC_ACQUIRE, "agent");
            xb_add(&bar[XB_XGEN(b.x)], 1u);
            asm volatile("s_waitcnt vmcnt(0)" ::: "memory");
        } else {
            XB_SPIN(xb_ld(&bar[XB_XGEN(b.x)]) == gen, bar);
            __builtin_amdgcn_fence(__ATOMIC_ACQUIRE, "agent");
            asm volatile("s_waitcnt vmcnt(0)" ::: "memory");
        }
    }
    __syncthreads();
}

constexpr int NWAVES = 8, NTHR = 512;
constexpr int RING_OFF = 0, RING_BYTES = 131072;
constexpr int LDSCTL_OFF = RING_BYTES, MISC_OFF = LDSCTL_OFF + 320;
constexpr int LDS_BYTES = 147456;
constexpr int CW_BAR = 4096;
constexpr size_t CTL_ZERO_BYTES = 1 * MiB;

struct MArgs {
    const float* in[45]; float* out; unsigned char* ws; int ph_lo, ph_hi, l_lo, l_hi, bar_region, pad;
};
struct Frame { LAS unsigned char* lds; volatile LAS unsigned* MISC; gu32* ctl; int tid, lane, wave, vcu, G; };

__device__ __forceinline__ void transpose_item(const float* W, int ldw, int N, int k0, int n0, bf16* WT, int ldt, int drow0, LAS float* scr, int lane) {
    const int nn = n0 + (lane & 31); const bool okn = nn < N;
#pragma unroll 8
    for (int i = 0; i < 32; ++i) { const int kk = 2 * i + (lane >> 5); scr[kk * 33 + (lane & 31)] = okn ? W[(size_t)(k0 + kk) * ldw + nn] : 0.f; }
    LDS_WAIT(); asm volatile("" ::: "memory");
    const int c = lane & 7;
#pragma unroll
    for (int j = 0; j < 4; ++j) { const int n = (lane >> 3) + 8 * j; const LAS float* s = scr + (8 * c) * 33 + n;
        v4u o; o.x = pk2(s[0 * 33], s[1 * 33]); o.y = pk2(s[2 * 33], s[3 * 33]); o.z = pk2(s[4 * 33], s[5 * 33]); o.w = pk2(s[6 * 33], s[7 * 33]);
        if (n0 + n < N) *(GAS v4u*)(WT + (size_t)(drow0 + n) * ldt + k0 + 8 * c) = o; }
    LDS_WAIT(); asm volatile("" ::: "memory");
}

__device__ __forceinline__ void ph_mod(Frame& F, const float* c, const float* cctx, const float* ada_w, const float* ada_b, float* MOD) {
    LAS float* s = (LAS float*)(F.lds + RING_OFF);
    LAS float* red = s + 5 * 1024;
    for (int i = F.tid; i < 5 * 1024; i += NTHR) { const int r = i >> 10, k = i & 1023; const float v = r < 4 ? c[r * 1024 + k] : cctx[k]; s[i] = siluf_(v); }
    __syncthreads();
    for (int u = F.vcu; u < 192; u += F.G) {
        const int l = u / 96, j0 = (u % 96) * 64, cl = F.tid & 63, kp = F.tid >> 6;
        const float* W = ada_w + (size_t)l * 1024 * 6144 + j0 + cl;
        float acc[5] = {0.f, 0.f, 0.f, 0.f, 0.f};
        for (int k = kp * 128; k < kp * 128 + 128; ++k) { const float w = W[(size_t)k * 6144];
#pragma unroll
            for (int r = 0; r < 5; ++r) acc[r] += s[r * 1024 + k] * w; }
#pragma unroll
        for (int r = 0; r < 5; ++r) red[(kp * 5 + r) * 64 + cl] = acc[r];
        __syncthreads();
        if (F.tid < 320) { const int r = F.tid >> 6; float a = ada_b[l * 6144 + j0 + cl];
#pragma unroll
            for (int q = 0; q < 8; ++q) a += red[(q * 5 + r) * 64 + cl];
            MOD[((size_t)l * 5 + r) * 6144 + j0 + cl] = a; }
        __syncthreads();
    }
}
__device__ __forceinline__ void ph_convert_small(Frame& F, const float* w_in, const float* w_vres, const float* w_out, bf16* WIN_T  , bf16* WOUT_T  ) {
    LAS float* scr = (LAS float*)(F.lds + RING_OFF + 32768 + F.wave * 16384 / 2);
    scr = (LAS float*)(F.lds + RING_OFF + 32768 + F.wave * 9216);
    const int gw = F.vcu * NWAVES + F.wave, NGW = F.G * NWAVES;
    constexpr int NB_IN = (NIN + 31) / 32;
    constexpr int I_IN = 16 * NB_IN, I_VR = 16 * 1, I_OUT = 16 * 32;
    constexpr int PER_L = I_IN + I_VR + I_OUT;
    for (int it = gw; it < 2 * PER_L; it += NGW) {
        const int l = it / PER_L; int r = it % PER_L;
        if (r < I_IN) { const int kb = r / NB_IN, nb = r % NB_IN; transpose_item(w_in + (size_t)l * D * NIN, NIN, NIN, kb * 64, nb * 32, WIN_T + (size_t)l * LDP * D, D, nb * 32, scr, F.lane); continue; } r -= I_IN;
        if (r < I_VR) { if (l == 1) transpose_item(w_vres, 32, 32, r * 64, 0, WIN_T + (size_t)LDP * D, D, NIN, scr, F.lane); continue; } r -= I_VR;
        { const int kb = r / 32, nb = r % 32; transpose_item(w_out + (size_t)l * D * D, D, D, kb * 64, nb * 32, WOUT_T + (size_t)l * D * D, D, nb * 32, scr, F.lane); }
    }
}
__device__ __forceinline__ void ph_norm_mod(Frame& F, const float* xs, const float* cs, const float* gain, const float* MODl, int si, bf16* XN, int nrows) {
    const int gw = F.vcu * NWAVES + F.wave, NGW = F.G * NWAVES, lane = F.lane;
    for (int m = gw; m < nrows; m += NGW) {
        const float* src = m < NX ? xs + (size_t)m * D : cs + (size_t)(m - NX) * D; const int rb = m < NX ? (m >> 12) : 4;
        const float* md = MODl + (size_t)rb * 6144;
        f32x4 v[4]; float ss = 0.f;
#pragma unroll
        for (int j = 0; j < 4; ++j) { v[j] = *(const f32x4*)(src + 4 * lane + 256 * j); ss += (v[j].x * v[j].x + v[j].y * v[j].y) + (v[j].z * v[j].z + v[j].w * v[j].w); }
        ss = wave_sum(ss); const float rs = rsqrtf(ss * (1.f / D) + 1e-6f);
#pragma unroll
        for (int j = 0; j < 4; ++j) { const int ci = 4 * lane + 256 * j; const f32x4 g = *(const f32x4*)(gain + ci), sh = *(const f32x4*)(md + si * 1024 + ci), sc = *(const f32x4*)(md + (si + 1) * 1024 + ci);
            const f32x4 y = v[j] * rs * g * (sc + 1.f) + sh;
            unsigned long long o = (unsigned long long)pk2(y.x, y.y) | ((unsigned long long)pk2(y.z, y.w) << 32);
            *(unsigned long long*)(XN + (size_t)m * D + ci) = o; }
    }
}

constexpr int CW_CNT = 2048;
constexpr int TAB_OFF = LDSCTL_OFF + 1024;
struct MoeTab { LAS int* cnt; LAS int* ups; LAS int* ro; };
__device__ __forceinline__ MoeTab moe_tab(Frame& F) { MoeTab t; t.cnt = (LAS int*)(F.lds + TAB_OFF); t.ups = t.cnt + 80; t.ro = t.ups + 80; return t; }
__device__ __forceinline__ void moe_build_tab(Frame& F, int layer, int ntok) {
    MoeTab T = moe_tab(F);
    if (F.tid < 64) T.cnt[F.tid] = (int)__hip_atomic_load(F.ctl + CW_CNT + layer * 64 + F.tid, RLX_AGENT);
    if (F.tid == 64) T.cnt[64] = ntok;
    __syncthreads();
    if (F.tid == 0) { int u = 0, r = 0; for (int e = 0; e < 65; ++e) { T.ups[e] = u; T.ro[e] = r; u += (T.cnt[e] + 255) >> 8; r += T.cnt[e]; } T.ups[65] = u; T.ro[65] = r; }
    __syncthreads();
}
__device__ __forceinline__ int uni(int v) { return __builtin_amdgcn_readfirstlane(v); }
__device__ __forceinline__ const char* uni_ptr(const char* p) { unsigned long long v = (unsigned long long)p; unsigned lo = __builtin_amdgcn_readfirstlane((unsigned)v), hi = __builtin_amdgcn_readfirstlane((unsigned)(v >> 32)); return (const char*)(((unsigned long long)hi << 32) | lo); }

__device__ __forceinline__ void ph_route(Frame& F, const float* XR, const float* gain, const float* MODl, const float* rw, const float* rbias, bf16* XN, int layer,
                                         unsigned* LIST, int* SLOTPOS, float* SLOTG, int ntok) {
    LAS float* hs = (LAS float*)(F.lds + RING_OFF);
    LAS float* part = (LAS float*)(F.lds + RING_OFF + 65536);
    LAS float* sc = (LAS float*)(F.lds + RING_OFF + 98304);
    const int lane = F.lane, wv = F.wave, tid = F.tid;
    const int ngrp = ntok / 16;
    for (int g = F.vcu; g < ngrp; g += F.G) {
#pragma unroll
        for (int tt = 0; tt < 2; ++tt) {
            const int tl = 2 * wv + tt, m = g * 16 + tl;
            const float* src = XR + (size_t)m * D; const int rb = m < NX ? (m >> 12) : 4; const float* md = MODl + (size_t)rb * 6144;
            f32x4 v[4]; float ss = 0.f;
#pragma unroll
            for (int j = 0; j < 4; ++j) { v[j] = *(const f32x4*)(src + 4 * lane + 256 * j); ss += (v[j].x * v[j].x + v[j].y * v[j].y) + (v[j].z * v[j].z + v[j].w * v[j].w); }
            ss = wave_sum(ss); const float rs = rsqrtf(ss * (1.f / D) + 1e-6f);
#pragma unroll
            for (int j = 0; j < 4; ++j) { const int ci = 4 * lane + 256 * j; const f32x4 gg = *(const f32x4*)(gain + ci), sh = *(const f32x4*)(md + 3 * 1024 + ci), scl = *(const f32x4*)(md + 4 * 1024 + ci);
                const f32x4 y = v[j] * rs * gg * (scl + 1.f) + sh;
                *(LAS f32x4*)(hs + tl * 1024 + ci) = y;
                *(unsigned long long*)(XN + (size_t)m * D + ci) = (unsigned long long)pk2(y.x, y.y) | ((unsigned long long)pk2(y.z, y.w) << 32); }
        }
        __syncthreads();
        { const int e = tid & 63, kp = tid >> 6; float acc[16];
#pragma unroll
            for (int t = 0; t < 16; ++t) acc[t] = 0.f;
            const float* wp = rw + (size_t)(kp * 128) * 64 + e;
            for (int k = 0; k < 128; k += 4) { const float w0 = wp[(k + 0) * 64], w1 = wp[(k + 1) * 64], w2 = wp[(k + 2) * 64], w3 = wp[(k + 3) * 64];
#pragma unroll
                for (int t = 0; t < 16; ++t) { const f32x4 h4 = *(const LAS f32x4*)(hs + t * 1024 + kp * 128 + k); acc[t] += (h4.x * w0 + h4.y * w1) + (h4.z * w2 + h4.w * w3); } }
#pragma unroll
            for (int t = 0; t < 16; ++t) part[(kp * 16 + t) * 64 + e] = acc[t]; }
        __syncthreads();
#pragma unroll
        for (int q = 0; q < 2; ++q) { const int t = (tid >> 6) + 8 * q, e = tid & 63; float a = 0.f;
#pragma unroll
            for (int kp = 0; kp < 8; ++kp) a += part[(kp * 16 + t) * 64 + e];
            sc[t * 64 + e] = sigmoidf_(a); }
        __syncthreads();
#pragma unroll
        for (int tt = 0; tt < 2; ++tt) {
            const int tl = 2 * wv + tt, m = g * 16 + tl;
            const float s = sc[tl * 64 + lane]; float sel = s + rbias[lane]; int myk = -1; float ssum = 0.f;
            for (int k = 0; k < 8; ++k) {
                float bv = sel; int bi = lane;
#pragma unroll
                for (int o = 1; o < 64; o <<= 1) { const float ov = __shfl_xor(bv, o); const int oi = __shfl_xor(bi, o); if (ov > bv || (ov == bv && oi < bi)) { bv = ov; bi = oi; } }
                ssum += __shfl(s, bi);
                if (lane == bi) { myk = k; sel = -3.0e38f; }
            }
            if (myk >= 0) { const float gw = 2.5f * s / ssum;
                const unsigned rank = __hip_atomic_fetch_add(F.ctl + CW_CNT + layer * 64 + lane, 1u, RLX_AGENT);
                LIST[(size_t)lane * MT + rank] = (unsigned)m;
                SLOTPOS[(size_t)m * 8 + myk] = (lane << 16) | (int)rank; SLOTG[(size_t)m * 8 + myk] = gw; }
        }
        __syncthreads();
    }
}
__device__ __forceinline__ void ph_convert_experts(Frame& F, const float* wg, const float* wu, const float* wd, const float* sg, const float* su, const float* sd, bf16* WGU_T, bf16* WD_T) {
    LAS float* scr = (LAS float*)(F.lds + RING_OFF + F.wave * 9216);
    const int gw = F.vcu * NWAVES + F.wave, NGW = F.G * NWAVES;
    for (int it = gw; it < 65 * 384; it += NGW) {
        const int e = it / 384; int r = it % 384;
        const float* Wg = e < 64 ? wg + (size_t)e * D * EFF : sg; const float* Wu = e < 64 ? wu + (size_t)e * D * EFF : su; const float* Wd = e < 64 ? wd + (size_t)e * EFF * D : sd;
        if (r < 256) { const float* W = r < 128 ? Wg : Wu; const int up = r >= 128; r &= 127; const int kb = r >> 3, nb = r & 7, n0 = nb * 32;
            transpose_item(W, EFF, EFF, kb * 64, n0, WGU_T + (size_t)e * 512 * D, D, (n0 >> 7) * 256 + (n0 & 127) + up * 128, scr, F.lane); }
        else { r -= 256; const int kb = r >> 5, nb = r & 31; transpose_item(Wd, D, D, kb * 64, nb * 32, WD_T + (size_t)e * D * EFF, EFF, nb * 32, scr, F.lane); }
    }
}
namespace pg8 {
struct MoeOrder1 {
    const bf16_t* XN; const bf16_t* WGU; const unsigned* LIST; MoeTab T; int G, c, total;
    __device__ bool next(int i, Unit& u) const {
        const int L = i * G + c; if (L >= total) return false;
        const int pn = L & 1, ru = L >> 1; int lo = 0, hi = 64;
        while (lo < hi) { const int mid = (lo + hi + 1) >> 1; if (T.ups[mid] <= ru) lo = mid; else hi = mid - 1; }
        const int e = uni(lo), j = uni(ru - T.ups[lo]);
        u.e = e; u.pm = j; u.pn = pn; u.nrows = uni(min(256, T.cnt[e] - j * 256)); u.rb = uni(T.ro[e] + j * 256);
        u.A = (const char*)XN; u.B = uni_ptr((const char*)WGU + ((size_t)e * 512 + (size_t)pn * 256) * D * 2); return true;
    }
    __device__ __forceinline__ unsigned a_off(const Unit& u, int h, int R, int C) const {
        const int idx = h * HALF + R; int tok = 0;
        if (idx < u.nrows) tok = u.e < 64 ? (int)LIST[(size_t)u.e * MT + u.pm * 256 + idx] : u.pm * 256 + idx;
        return (unsigned)(tok * D + C) * 2u;
    }
};
struct MoeOrder2 {
    const bf16_t* HACT; const bf16_t* WD; MoeTab T; int G, c, total;
    __device__ bool next(int i, Unit& u) const {
        const int L = i * G + c; if (L >= total) return false;
        const int pn = L & 3, ru = L >> 2; int lo = 0, hi = 64;
        while (lo < hi) { const int mid = (lo + hi + 1) >> 1; if (T.ups[mid] <= ru) lo = mid; else hi = mid - 1; }
        const int e = uni(lo), j = uni(ru - T.ups[lo]);
        u.e = e; u.pm = j; u.pn = pn; u.nrows = uni(min(256, T.cnt[e] - j * 256)); u.rb = uni(T.ro[e] + j * 256);
        u.A = uni_ptr((const char*)HACT + (size_t)u.rb * EFF * 2); u.B = uni_ptr((const char*)WD + ((size_t)e * D + (size_t)pn * 256) * EFF * 2); return true;
    }
    __device__ __forceinline__ unsigned a_off(const Unit&, int h, int R, int C) const { return (unsigned)((h * HALF + R) * EFF + C) * 2u; }
};
struct EpiSwiglu {
    static constexpr bool PERM = true;
    bf16_t* HACT;
    __device__ __forceinline__ void operator()(const f32x4 (&acc)[2][2][4][2], const Unit& u, int wr, int wc, int fr, int fq) const {
        asm volatile("" : "+v"(fr), "+v"(fq));
#pragma unroll
        for (int ai = 0; ai < 2; ++ai)
#pragma unroll
            for (int m = 0; m < 4; ++m) { const int r = ai * HALF + wr * 64 + m * 16 + fr;
                if (r < u.nrows) { const f32x4 g0 = acc[ai][0][m][0], g1 = acc[ai][0][m][1], u0 = acc[ai][1][m][0], u1 = acc[ai][1][m][1];
                    float o[8];
#pragma unroll
                    for (int q = 0; q < 4; ++q) { o[q] = g0[q] / (1.f + __expf(-g0[q])) * u0[q]; o[4 + q] = g1[q] / (1.f + __expf(-g1[q])) * u1[q]; }
                    u32x4 w; w.x = cvt_pk_bf16(o[0], o[1]); w.y = cvt_pk_bf16(o[2], o[3]); w.z = cvt_pk_bf16(o[4], o[5]); w.w = cvt_pk_bf16(o[6], o[7]);
                    *(u32x4*)(HACT + (size_t)(u.rb + r) * EFF + u.pn * 128 + wc * 32 + 8 * fq) = w; } }
    }
};
struct EpiDown {
    static constexpr bool PERM = true;
    bf16_t* Y; float* XR; const float* MODl;
    __device__ __forceinline__ void operator()(const f32x4 (&acc)[2][2][4][2], const Unit& u, int wr, int wc, int fr, int fq) const {
        asm volatile("" : "+v"(fr), "+v"(fq));
        const unsigned lcol = (unsigned)(wc * 32 + 8 * fq);
        if (u.e < 64) {
            char* ybase = (char*)uni_ptr((const char*)(Y + (size_t)u.rb * D + u.pn * BM));
#pragma unroll
            for (int ai = 0; ai < 2; ++ai)
#pragma unroll
                for (int m = 0; m < 4; ++m) { const int r = ai * HALF + wr * 64 + m * 16 + fr;
                    if (r < u.nrows) { const unsigned off = ((unsigned)r * D + lcol) * 2u;
#pragma unroll
                        for (int bj = 0; bj < 2; ++bj) { const f32x4 v0 = acc[ai][bj][m][0], v1 = acc[ai][bj][m][1];
                            u32x4 w; w.x = cvt_pk_bf16(v0[0], v0[1]); w.y = cvt_pk_bf16(v0[2], v0[3]); w.z = cvt_pk_bf16(v1[0], v1[1]); w.w = cvt_pk_bf16(v1[2], v1[3]);
                            *(u32x4*)(ybase + off + bj * HALF * 2) = w; } } }
        } else {
            const int m0 = u.pm * 256; const int rb = m0 < NX ? (m0 >> 12) : 4;
            const char* mdb = uni_ptr((const char*)(MODl + (size_t)rb * 6144 + 5 * 1024 + u.pn * BM)); char* xb = (char*)uni_ptr((const char*)(XR + (size_t)m0 * D + u.pn * BM));
#pragma unroll
            for (int ai = 0; ai < 2; ++ai)
#pragma unroll
                for (int m = 0; m < 4; ++m) { const int r = ai * HALF + wr * 64 + m * 16 + fr;
                    if (r < u.nrows) {
#pragma unroll
                        for (int bj = 0; bj < 2; ++bj)
#pragma unroll
                            for (int n = 0; n < 2; ++n) { const unsigned c = (unsigned)(bj * HALF) + lcol + 4u * n; const unsigned off = ((unsigned)r * D + c) * 4u;
                                const f32x4 xi = *(const f32x4*)(xb + off), mm = *(const f32x4*)(mdb + c * 4u); *(f32x4*)(xb + off) = xi + mm * acc[ai][bj][m][n]; } }
                    asm volatile("" ::: "memory"); }
        }
    }
};
}
__device__ __forceinline__ void ph_combine(Frame& F, const bf16* Y, const int* SLOTPOS, const float* SLOTG, const float* MODl, float* XR, int ntok) {
    MoeTab T = moe_tab(F);
    const int gw = F.vcu * NWAVES + F.wave, NGW = F.G * NWAVES, lane = F.lane;
    for (int m = gw; m < ntok; m += NGW) {
        const int rb = m < NX ? (m >> 12) : 4; const float* md = MODl + (size_t)rb * 6144 + 5 * 1024;
        float acc[16];
#pragma unroll
        for (int q = 0; q < 16; ++q) acc[q] = 0.f;
#pragma unroll
        for (int s = 0; s < 8; ++s) { const int sp = SLOTPOS[(size_t)m * 8 + s]; const int row = T.ro[sp >> 16] + (sp & 0xffff); const float gs = SLOTG[(size_t)m * 8 + s];
            const bf16* yr = Y + (size_t)row * D;
#pragma unroll
            for (int j = 0; j < 4; ++j) { const unsigned long long w = *(const unsigned long long*)(yr + 4 * lane + 256 * j);
                acc[4 * j + 0] += gs * __uint_as_float((unsigned)(w & 0xffffull) << 16); acc[4 * j + 1] += gs * __uint_as_float((unsigned)((w >> 16) & 0xffffull) << 16);
                acc[4 * j + 2] += gs * __uint_as_float((unsigned)((w >> 32) & 0xffffull) << 16); acc[4 * j + 3] += gs * __uint_as_float((unsigned)((w >> 48) & 0xffffull) << 16); } }
#pragma unroll
        for (int j = 0; j < 4; ++j) { const int ci = 4 * lane + 256 * j; float* o = XR + (size_t)m * D + ci; const f32x4 xi = *(const f32x4*)o, mm = *(const f32x4*)(md + ci);
            *(f32x4*)o = xi + mm * (f32x4){acc[4 * j], acc[4 * j + 1], acc[4 * j + 2], acc[4 * j + 3]}; }
    }
}

__device__ __forceinline__ void d_rwkv_prep(int m_, int c_, LAS float* shm_, const bf16* P, RwP w, int layer, float* VF, float* SI, float* SV, float* BON, float* G) {
    LAS float* sp = shm_; LAS float* vd = shm_ + 960;
    const int m = m_, c = c_, h = c >> 6; const Row rw = row_of(m);
    const bf16* pr = P + (size_t)m * LDP;
    for (int j = c; j < 960; j += 256) { const float p = bf2f(pr[j]); const float pp = rw.t > 0 ? bf2f(pr[j - LDP]) : 0.f; const float pn = rw.t < rw.L - 1 ? bf2f(pr[j + LDP]) : 0.f;
        sp[j] = p + (0.5f * (pp + pn) - p) * w.mu[j]; }
    if (c < 32) vd[c] = bf2f(pr[VRES_OFF + c]);
    __syncthreads();
    const float r = sp[c], kv = sp[256 + c]; float v = sp[512 + c];
    float g = 0.f;
#pragma unroll 4
    for (int j = 0; j < 64; ++j) g += sigmoidf_(sp[896 + j]) * w.g2[j * 256 + c];
    const float kkr = kv * w.kk[c]; const float ss = wave_sum(kkr * kkr); const float kkn = kkr * rsqrtf(ss + 1e-6f);
    if (layer == 0) VF[(size_t)m * 256 + c] = v;
    else { float z = w.v0[c];
#pragma unroll 4
        for (int j = 0; j < 32; ++j) z += vd[j] * w.v2[j * 256 + c]; v = v + (VF[(size_t)m * 256 + c] - v) * sigmoidf_(z); }
    float bsum = 0.f;
#pragma nounroll
    for (int d = 0; d < 2; ++d) {
        float z = w.w0[d * 256 + c];
#pragma unroll 4
        for (int j = 0; j < 32; ++j) z += tanhf(sp[768 + d * 32 + j]) * w.w2[(d * 32 + j) * 256 + c];
        const float lw = -0.6065306597f * sigmoidf_(z);
        float za = w.a0[d * 256 + c];
#pragma unroll 4
        for (int j = 0; j < 32; ++j) za += sp[832 + d * 32 + j] * w.a2[(d * 32 + j) * 256 + c];
        const float a = sigmoidf_(za);
        const float kd = kv * (1.f + (a - 1.f) * w.ka[c]);
        const float bs = wave_sum(r * kd * w.rk[c]);
        bsum += bs * v;
        const int k = c & 63;
        si_ptr(SI, d, m, h, 0)[k] = __expf(lw); si_ptr(SI, d, m, h, 1)[k] = kkn; si_ptr(SI, d, m, h, 2)[k] = kkn * a; si_ptr(SI, d, m, h, 3)[k] = kd; si_ptr(SI, d, m, h, 4)[k] = r;
    }
    SV[(size_t)m * 256 + c] = v; BON[(size_t)m * 256 + c] = bsum; G[(size_t)m * 256 + c] = g;
}

__device__ __forceinline__ void d_rwkv_post(int m_, int c_, const float* YS, const float* BON, const float* G, const float* lnw, const float* lnb, bf16* MIX) {
    const int m = m_, c = c_;
    const float y = YS[(size_t)m * 256 + c] + YS[((size_t)MT + m) * 256 + c];
    const float mu = wave_sum(y) * (1.f / 64.f); const float dlt = y - mu; const float var = wave_sum(dlt * dlt) * (1.f / 64.f);
    const float yn = dlt * rsqrtf(var + 64e-5f);
    MIX[(size_t)m * D + c] = f2bf((yn * lnw[c] + lnb[c] + BON[(size_t)m * 256 + c]) * G[(size_t)m * 256 + c]);
}

__device__ __forceinline__ void d_ret_prep(int m_, int c_, LAS float* shm_, const bf16* P, const float* lam  , float* SI, float* SV) {
    LAS float* sq = shm_; LAS float* sk = shm_ + 256;
    const int m = m_, c = c_, h = c >> 6, i = c & 63; const Row rw = row_of(m);
    const bf16* pr = P + (size_t)m * LDP + RET_OFF;
    float q = bf2f(pr[c]), k = bf2f(pr[256 + c]); const float v = bf2f(pr[512 + c]);
    sq[c] = q; sk[c] = k; __syncthreads();
    if (rw.isx) {
        const int j = i & 31, jj = j & 15; const float pos = j < 16 ? (float)(rw.t >> 6) : (float)(rw.t & 63);
        const float inv = powf(10000.f, -(float)jj / 16.f); const float ang = pos * inv; const float cs = cosf(ang), sn = sinf(ang);
        const int pc = i < 32 ? c + 32 : c - 32;
        const float q1 = i < 32 ? q : sq[pc], q2 = i < 32 ? sq[pc] : q, k1 = i < 32 ? k : sk[pc], k2 = i < 32 ? sk[pc] : k;
        q = i < 32 ? q1 * cs - q2 * sn : q1 * sn + q2 * cs; k = i < 32 ? k1 * cs - k2 * sn : k1 * sn + k2 * cs;
    }
    k *= 0.125f;
    for (int d = 0; d < 2; ++d) { const float gm = __expf(-lam[d * 4 + h]);
        si_ptr(SI, d, m, h, 0)[i] = gm; si_ptr(SI, d, m, h, 1)[i] = 0.f; si_ptr(SI, d, m, h, 2)[i] = 0.f; si_ptr(SI, d, m, h, 3)[i] = k; si_ptr(SI, d, m, h, 4)[i] = q; }
    SV[(size_t)m * 256 + c] = v;
}

__device__ __forceinline__ void d_hnorm_post(int m_, int c_, const float* YS, const bf16* P, int gate_off, const float* nw, bf16* MIX, int mix_off) {
    const int m = m_, c = c_;
    const float o = YS[(size_t)m * 256 + c] + YS[((size_t)MT + m) * 256 + c];
    const float ms = wave_sum(o * o) * (1.f / 64.f);
    const float g = bf2f(P[(size_t)m * LDP + gate_off + c]);
    float y = o * rsqrtf(ms + 1e-6f) * siluf_(g); if (nw) y *= nw[c & 63];
    MIX[(size_t)m * D + mix_off + c] = f2bf(y);
}

__device__ __forceinline__ void d_gdn_prep(int m_, int c_, const bf16* P, const float* cw  , const float* alog, const float* dtb, float* SI, float* SV) {
    const int m = m_, c = c_, h = c >> 6, i = c & 63; const Row rw = row_of(m);
    const bf16* pr = P + (size_t)m * LDP + GDN_OFF;
    float o[3];
#pragma unroll
    for (int s = 0; s < 3; ++s) { const int ch = s * 256 + c; float a = 0.f;
#pragma unroll
        for (int j = 0; j < 4; ++j) { const int tt = rw.t + j - 2; if (tt >= 0 && tt < rw.L) a += bf2f(pr[(ptrdiff_t)(j - 2) * LDP + ch]) * cw[j * 768 + ch]; }
        o[s] = siluf_(a); }
    const float qs = wave_sum(o[0] * o[0]), ks = wave_sum(o[1] * o[1]);
    const float q = o[0] * rsqrtf(qs + 1e-6f) * 0.125f, k = o[1] * rsqrtf(ks + 1e-6f);
    for (int d = 0; d < 2; ++d) {
        const float a = bf2f(pr[768 + d * 4 + h]), b = bf2f(pr[776 + d * 4 + h]);
        const float al = __expf(-__expf(alog[d * 4 + h]) * softplusf_(a + dtb[d * 4 + h])), be = sigmoidf_(b);
        si_ptr(SI, d, m, h, 0)[i] = al; si_ptr(SI, d, m, h, 1)[i] = k; si_ptr(SI, d, m, h, 2)[i] = al * be * k; si_ptr(SI, d, m, h, 3)[i] = be * k; si_ptr(SI, d, m, h, 4)[i] = q; }
    SV[(size_t)m * 256 + c] = o[2];
}

__device__ __forceinline__ void d_rowscan(int seq_, int v_, LAS float* shm_, const float* SI, const float* SV, float* YS) {
    LAS float (*sh)[5][64] = (LAS float (*)[5][64])shm_;
    const int seq = seq_, d = seq & 1, h = (seq >> 1) & 3, b = seq >> 3, v = v_;
    float s[64];
#pragma unroll
    for (int k = 0; k < 64; ++k) s[k] = 0.f;
    float nx[5], nv; { const int m = step_row(b, d, 0); const float* p = SI + (((size_t)d * MT + m) * 4 + h) * 320;
#pragma unroll
        for (int j = 0; j < 5; ++j) nx[j] = p[j * 64 + v]; nv = SV[(size_t)m * 256 + h * 64 + v]; }
    for (int st = 0; st < NSTEP; ++st) {
        const int buf = st & 1; const int m = step_row(b, d, st);
#pragma unroll
        for (int j = 0; j < 5; ++j) sh[buf][j][v] = nx[j];
        const float vv = nv;
        __syncthreads();
        if (st + 1 < NSTEP) { const int m2 = step_row(b, d, st + 1); const float* p = SI + (((size_t)d * MT + m2) * 4 + h) * 320;
#pragma unroll
            for (int j = 0; j < 5; ++j) nx[j] = p[j * 64 + v]; nv = SV[(size_t)m2 * 256 + h * 64 + v]; }
        float sa = 0.f;
#pragma unroll
        for (int k = 0; k < 64; ++k) sa += s[k] * sh[buf][1][k];
        float y = 0.f;
#pragma unroll
        for (int k = 0; k < 64; ++k) { s[k] = s[k] * sh[buf][0][k] - sa * sh[buf][2][k] + vv * sh[buf][3][k]; y += s[k] * sh[buf][4][k]; }
        YS[((size_t)d * MT + m) * 256 + h * 64 + v] = y;
    }
}

__device__ __forceinline__ void d_lru_prep(int m_, int c_, LAS float* shm_, const bf16* P, LruP w, float* LA, float* LB) {
    LAS float* xs = shm_;
    const int m = m_, c = c_, h = c >> 6, i = c & 63; const Row rw = row_of(m);
    const bf16* pr = P + (size_t)m * LDP + LRU_OFF;
    float xm = w.cb[c];
#pragma unroll
    for (int j = 0; j < 4; ++j) { const int tt = rw.t + j - 2; if (tt >= 0 && tt < rw.L) xm += bf2f(pr[(ptrdiff_t)(j - 2) * LDP + c]) * w.cw[j * 256 + c]; }
    xs[c] = xm; __syncthreads();
#pragma nounroll
    for (int d = 0; d < 2; ++d) {
        float ra = w.ba[d * 256 + c], rx = w.bx[d * 256 + c];
        const float* wa = w.wa + ((size_t)(d * 4 + h) * 64) * 64 + i; const float* wx = w.wx + ((size_t)(d * 4 + h) * 64) * 64 + i;
#pragma unroll 4
        for (int j = 0; j < 64; ++j) { const float xv = xs[h * 64 + j]; ra += xv * wa[j * 64]; rx += xv * wx[j * 64]; }
        const float r = sigmoidf_(ra), ig = sigmoidf_(rx);
        const float la = -8.f * softplusf_(-w.lam[d * 256 + c]) * r;
        LA[((size_t)d * MT + m) * 256 + c] = __expf(la); LB[((size_t)d * MT + m) * 256 + c] = sqrtf(-expm1f(2.f * la)) * ig * xm;
    }
}

__device__ __forceinline__ void d_lru_scan(int bd_, int c_, const float* LA, const float* LB, float* YS) {
    const int d = bd_ & 1, b = bd_ >> 1, c = c_;
    float hst = 0.f;
    for (int st = 0; st < NSTEP; st += 8) { float a[8], bb[8]; int mm[8];
#pragma unroll
        for (int u = 0; u < 8; ++u) { mm[u] = step_row(b, d, st + u); a[u] = LA[((size_t)d * MT + mm[u]) * 256 + c]; bb[u] = LB[((size_t)d * MT + mm[u]) * 256 + c]; }
#pragma unroll
        for (int u = 0; u < 8; ++u) { hst = a[u] * hst + bb[u]; YS[((size_t)d * MT + mm[u]) * 256 + c] = hst; } }
}

__device__ __forceinline__ void d_lru_post(int m_, int c_, const float* YS, const bf16* P, bf16* MIX) {
    const int m = m_, c = c_;
    const float hs = YS[(size_t)m * 256 + c] + YS[((size_t)MT + m) * 256 + c];
    const float g = bf2f(P[(size_t)m * LDP + LRU_OFF + 256 + c]);
    const float ge = 0.5f * g * (1.f + tanhf(0.7978845608f * (g + 0.044715f * g * g * g)));
    MIX[(size_t)m * D + 768 + c] = f2bf(hs * ge);
}

__device__ __forceinline__ void ph_final_norm(Frame& F, const float* XR, const float* gain, float* out) {
    const int gw = F.vcu * NWAVES + F.wave, NGW = F.G * NWAVES, lane = F.lane;
    for (int m = gw; m < NX; m += NGW) {
        const float* src = XR + (size_t)m * D; f32x4 v[4]; float ss = 0.f;
#pragma unroll
        for (int j = 0; j < 4; ++j) { v[j] = *(const f32x4*)(src + 4 * lane + 256 * j); ss += (v[j].x * v[j].x + v[j].y * v[j].y) + (v[j].z * v[j].z + v[j].w * v[j].w); }
        ss = wave_sum(ss); const float rs = rsqrtf(ss * (1.f / D) + 1e-6f);
#pragma unroll
        for (int j = 0; j < 4; ++j) { const int ci = 4 * lane + 256 * j; *(f32x4*)(out + (size_t)m * D + ci) = v[j] * rs * *(const f32x4*)(gain + ci); }
    }
}

__global__ void __launch_bounds__(NTHR, 2) mega(MArgs a) {
    extern __shared__ __attribute__((aligned(16))) unsigned char lds_raw[];
    Frame F; F.lds = (LAS unsigned char*)lds_raw; F.MISC = (volatile LAS unsigned*)(F.lds + MISC_OFF);
    F.tid = threadIdx.x; F.lane = F.tid & 63; F.wave = __builtin_amdgcn_readfirstlane(F.tid >> 6);
    F.G = gridDim.x; { const int bx = blockIdx.x; F.vcu = (F.G % 8 == 0) ? (bx % 8) * (F.G / 8) + bx / 8 : bx; }
    unsigned char* ws = a.ws; F.ctl = (gu32*)ws;
    for (int u = F.tid; u < (LDS_BYTES - LDSCTL_OFF) / 4; u += NTHR) ((LAS unsigned*)(F.lds + LDSCTL_OFF))[u] = 0u;
    __syncthreads();
    XcdBarrier bar = xcd_barrier_post((unsigned*)(F.ctl + CW_BAR) + a.bar_region * XCD_BAR_WORDS, F.MISC + 8);
    const int lo = a.ph_lo, hi = a.ph_hi;
#ifndef PH_MASK
#define PH_MASK 0xfffff
#endif
#define IN(k) (((PH_MASK >> (k)) & 1) && lo <= (k) && (k) < hi)
#define SEAM() xcd_barrier(bar)
    float* MOD = (float*)(ws + WS_MOD); bf16* XN = (bf16*)(ws + WS_XN); bf16* MIX = XN; float* XR = (float*)(ws + WS_XR); bf16* P = (bf16*)(ws + WS_P);
    bf16* WIN_T = (bf16*)(ws + WS_WIN); bf16* WOUT_T = (bf16*)(ws + WS_WOUT);
    float* VF = (float*)(ws + WS_VF); float* BON = (float*)(ws + WS_BON); float* GG = (float*)(ws + WS_G); float* YS = (float*)(ws + WS_YS); float* SV = (float*)(ws + WS_SV); float* SI = (float*)(ws + WS_SI);
    bf16* WGU_T = (bf16*)(ws + WS_WGU); bf16* WD_T = (bf16*)(ws + WS_WD); bf16* HACT = (bf16*)(ws + WS_HACT); bf16* Y = (bf16*)(ws + WS_Y);
    unsigned* LIST = (unsigned*)(ws + WS_LIST); int* SLOTPOS = (int*)(ws + WS_SLOT); float* SLOTG = (float*)(ws + WS_SLOT + (size_t)MT * 8 * 4);
    int half = 0, c256 = 0; LAS float* shh = nullptr;
#define PH() do { int t_ = threadIdx.x; asm volatile("" : "+v"(t_)); F.tid = t_; F.lane = t_ & 63; F.wave = __builtin_amdgcn_readfirstlane(t_ >> 6); half = t_ >> 8; c256 = t_ & 255; \
        shh = (LAS float*)(F.lds + RING_OFF + half * 8192); } while (0)
    if (IN(0)) { PH(); ph_mod(F, a.in[I_C], a.in[I_CCTX], a.in[I_ADAW], a.in[I_ADAB], MOD); ph_convert_small(F, a.in[I_WIN], a.in[I_WVRES], a.in[I_WOUT], WIN_T, WOUT_T); SEAM(); }
    for (int l = a.l_lo; l < a.l_hi; ++l) {
        const float* MODl = MOD + (size_t)l * 5 * 6144;
        const float* xs = l == 0 ? a.in[I_X] : XR; const float* cs = l == 0 ? a.in[I_CTX] : XR + (size_t)NX * D;
        const int ntok = l == 0 ? MT : NX;
        if (IN(1)) { PH(); ph_norm_mod(F, xs, cs, a.in[I_NMIX] + l * D, MODl, 0, XN, MT); SEAM(); }
        if (IN(2)) { PH(); pg8::DenseOrder S; S.init(XN, WIN_T + (size_t)l * LDP * D, MT, LDP, D, F.G, (int)blockIdx.x); pg8::EpiStoreBf16 E{P, LDP};
            pg8::gemm_phase<pg8::EpiStoreBf16, pg8::DenseOrder, true>(F.lds + RING_OFF, D, S, E); SEAM(); }
        const RwP rwp{a.in[I_RWMU] + l * 960, a.in[I_RWW0] + l * 512, a.in[I_RWW2] + l * 2 * 32 * 256, a.in[I_RWA0] + l * 512, a.in[I_RWA2] + l * 2 * 32 * 256, a.in[I_RWG2] + l * 64 * 256, a.in[I_RWKK] + l * 256, a.in[I_RWKA] + l * 256,
                      a.in[I_RWRK] + l * 256, a.in[I_RWV0], a.in[I_RWV2]};
        const LruP lrp{a.in[I_LCW] + l * 4 * 256, a.in[I_LCB] + l * 256, a.in[I_LWA] + (size_t)l * 2 * 4 * 64 * 64, a.in[I_LBA] + l * 512, a.in[I_LWX] + (size_t)l * 2 * 4 * 64 * 64, a.in[I_LBX] + l * 512, a.in[I_LLAM] + l * 512};
        float* LA = SI; float* LB = SI + (size_t)2 * MT * 256;
        if (IN(3)) { PH(); for (int it = F.vcu; it < MT / 2; it += F.G) { const int m = it * 2 + half; d_rwkv_prep(m, c256, shh, P, rwp, l, VF, SI, SV, BON, GG); __syncthreads(); } SEAM(); }
        if (IN(4)) { PH(); if (blockIdx.x < 4) d_rowscan(blockIdx.x * 8 + F.wave, F.lane, (LAS float*)(F.lds + RING_OFF + F.wave * 4096), SI, SV, YS); SEAM(); }
        if (IN(5)) { PH(); for (int it = F.vcu; it < MT / 2; it += F.G) { const int m = it * 2 + half; d_rwkv_post(m, c256, YS, BON, GG, a.in[I_RWLNW] + l * 256, a.in[I_RWLNB] + l * 256, MIX);
                d_ret_prep(m, c256, shh, P, a.in[I_RETL] + l * 8, SI, SV); __syncthreads(); } SEAM(); }
        if (IN(6)) { PH(); if (blockIdx.x < 4) d_rowscan(blockIdx.x * 8 + F.wave, F.lane, (LAS float*)(F.lds + RING_OFF + F.wave * 4096), SI, SV, YS); SEAM(); }
        if (IN(7)) { PH(); for (int it = F.vcu; it < MT / 2; it += F.G) { const int m = it * 2 + half; d_hnorm_post(m, c256, YS, P, RET_OFF + 768, nullptr, MIX, 256);
                d_gdn_prep(m, c256, P, a.in[I_GCW] + l * 4 * 768, a.in[I_GALOG] + l * 8, a.in[I_GDT] + l * 8, SI, SV); } SEAM(); }
        if (IN(8)) { PH(); if (blockIdx.x < 4) d_rowscan(blockIdx.x * 8 + F.wave, F.lane, (LAS float*)(F.lds + RING_OFF + F.wave * 4096), SI, SV, YS); SEAM(); }
        if (IN(9)) { PH(); for (int it = F.vcu; it < MT / 2; it += F.G) { const int m = it * 2 + half; d_hnorm_post(m, c256, YS, P, GDN_OFF + 784, a.in[I_GNW] + l * 64, MIX, 512);
                d_lru_prep(m, c256, shh, P, lrp, LA, LB); __syncthreads(); } SEAM(); }
        if (IN(10)) { PH(); if (blockIdx.x < 4) d_lru_scan(blockIdx.x * 2 + half, c256, LA, LB, YS); SEAM(); }
        if (IN(11)) { PH(); for (int it = F.vcu; it < MT / 2; it += F.G) { const int m = it * 2 + half; d_lru_post(m, c256, YS, P, MIX); } SEAM(); }
        if (IN(12)) { PH(); pg8::DenseOrder S; S.init(MIX, WOUT_T + (size_t)l * D * D, MT, D, D, F.G, (int)blockIdx.x); pg8::EpiResidual E{xs, cs, MODl, XR};
            pg8::gemm_phase<pg8::EpiResidual, pg8::DenseOrder, true>(F.lds + RING_OFF, D, S, E); SEAM(); }
        if (IN(13)) { PH(); ph_route(F, XR, a.in[I_NFFN] + l * D, MODl, a.in[I_RTW] + (size_t)l * D * NE, a.in[I_RTB] + l * NE, XN, l, LIST, SLOTPOS, SLOTG, ntok); __syncthreads();
            ph_convert_experts(F, a.in[I_EWG] + (size_t)l * NE * D * EFF, a.in[I_EWU] + (size_t)l * NE * D * EFF, a.in[I_EWD] + (size_t)l * NE * EFF * D,
                               a.in[I_SWG] + (size_t)l * D * EFF, a.in[I_SWU] + (size_t)l * D * EFF, a.in[I_SWD] + (size_t)l * EFF * D, WGU_T, WD_T);
            SEAM(); }
        if (IN(14)) { PH(); moe_build_tab(F, l, ntok); MoeTab T = moe_tab(F);
            pg8::MoeOrder1 S{XN, WGU_T, LIST, T, F.G, (int)blockIdx.x, T.ups[65] * 2}; pg8::EpiSwiglu E{HACT};
            pg8::gemm_phase<pg8::EpiSwiglu, pg8::MoeOrder1, true>(F.lds + RING_OFF, D, S, E); SEAM(); }
        if (IN(15)) { PH(); moe_build_tab(F, l, ntok); MoeTab T = moe_tab(F);
            pg8::MoeOrder2 S{HACT, WD_T, T, F.G, (int)blockIdx.x, T.ups[65] * 4}; pg8::EpiDown E{Y, XR, MODl};
            int k2 = EFF; asm volatile("" : "+s"(k2));
            pg8::gemm_phase<pg8::EpiDown, pg8::MoeOrder2, true>(F.lds + RING_OFF, k2, S, E); SEAM(); }
        if (IN(16)) { PH(); moe_build_tab(F, l, ntok); ph_combine(F, Y, SLOTPOS, SLOTG, MODl, XR, ntok); SEAM(); }
    }
    if (IN(17)) { PH(); ph_final_norm(F, XR, a.in[I_NFIN], a.out); }
#undef PH
#undef IN
#undef SEAM
}

extern "C" void kernel_launch(void* const* d_in, const int* in_sizes, int n_in, void* d_out, int out_size, void* d_ws, size_t ws_size, hipStream_t stream) {
    static int grid = 0;
    if (grid == 0) {
        if (n_in != I_N || ws_size < WS_END) { fprintf(stderr, "kernel_launch: bad n_in %d or ws %zu\n", n_in, ws_size); grid = -1; return; }
        int dev = 0, cus = 0;
        if (hipGetDevice(&dev) != hipSuccess || hipDeviceGetAttribute(&cus, hipDeviceAttributeMultiprocessorCount, dev) != hipSuccess) { grid = -1; return; }
        if (hipFuncSetAttribute((const void*)mega, hipFuncAttributeMaxDynamicSharedMemorySize, LDS_BYTES) != hipSuccess) { grid = -1; return; }
        int per_cu = 0; (void)hipOccupancyMaxActiveBlocksPerMultiprocessor(&per_cu, (const void*)mega, NTHR, LDS_BYTES); (void)hipGetLastError();
        grid = cus;
    }
    if (grid < 0) return;
    unsigned char* ws = (unsigned char*)d_ws;
    (void)hipMemsetAsync(ws, 0, CTL_ZERO_BYTES, stream);
    MArgs ma{}; for (int i = 0; i < I_N; ++i) ma.in[i] = (const float*)d_in[i]; ma.out = (float*)d_out; ma.ws = ws;
    ma.ph_lo = 0; ma.ph_hi = 18; ma.l_lo = 0; ma.l_hi = 2; ma.bar_region = 0;
    hipLaunchKernelGGL(mega, dim3(grid), dim3(NTHR), LDS_BYTES, stream, ma);
}
```

```cpp
#include <hip/hip_runtime.h>
#include <cstdio>
#include <cstdint>

typedef unsigned short bf16;
__device__ __forceinline__ float bf2f(bf16 v) { return __uint_as_float(((unsigned)v) << 16); }
__device__ __forceinline__ bf16 f2bf(float f) { unsigned u = __float_as_uint(f); u += 0x7fffu + ((u >> 16) & 1u); return (bf16)(u >> 16); }

constexpr int D = 1024, NB = 4, SEQ = 4096, CTXL = 256;
constexpr int NX = NB * SEQ;
constexpr int NC = NB * CTXL;
constexpr int MT = NX + NC;
constexpr int NIN = 3536, NINV = 3568, LDP = 3584;
constexpr int RW_OFF = 0, RET_OFF = 960, GDN_OFF = 1984, LRU_OFF = 3024, VRES_OFF = 3536;
constexpr int NE = 64, TOPK = 8, EFF = 256;
constexpr int NSTEP = CTXL + SEQ;

constexpr size_t MiB = 1u << 20;
constexpr size_t WS_MOD = 1 * MiB;
constexpr size_t WS_XN = 2 * MiB;
constexpr size_t WS_XR = 36 * MiB;
constexpr size_t WS_VF = 104 * MiB;
constexpr size_t WS_LIST = 121 * MiB;
constexpr size_t WS_SLOT = 130 * MiB;
constexpr size_t WS_WIN = 131 * MiB;
constexpr size_t WS_WOUT = 145 * MiB;
constexpr size_t WS_SI = 149 * MiB;
constexpr size_t WS_P = 319 * MiB;
constexpr size_t WS_BON = 438 * MiB;
constexpr size_t WS_G = 455 * MiB;
constexpr size_t WS_YS = 472 * MiB;
constexpr size_t WS_SV = 506 * MiB;
constexpr size_t WS_DZ = 523 * MiB;
constexpr size_t WS_WD = 149 * MiB;
constexpr size_t WS_HACT = 182 * MiB;
constexpr size_t WS_Y = 267 * MiB;
constexpr size_t WS_WGU = 267 * MiB;
constexpr size_t WS_END = 540 * MiB;

struct Row { int b, t, L, isx; };
__device__ __forceinline__ Row row_of(int m) { Row r; if (m < NX) { r.b = m >> 12; r.t = m & 4095; r.L = SEQ; r.isx = 1; } else { int q = m - NX; r.b = q >> 8; r.t = q & 255; r.L = CTXL; r.isx = 0; } return r; }
__device__ __forceinline__ float sigmoidf_(float x) { return 1.f / (1.f + __expf(-x)); }
__device__ __forceinline__ float softplusf_(float x) { return x > 20.f ? x : log1pf(__expf(x)); }
__device__ __forceinline__ float siluf_(float x) { return x / (1.f + __expf(-x)); }
__device__ __forceinline__ float dpp_f(float v, const int ctrl) { return v; }
#define DPPF(v, ctrl) __int_as_float(__builtin_amdgcn_update_dpp(0, __float_as_int(v), (ctrl), 0xf, 0xf, true))
__device__ __forceinline__ float wave_sum(float v) {
    v += DPPF(v, 0xB1); v += DPPF(v, 0x4E); v += DPPF(v, 0x141); v += DPPF(v, 0x140);
    return (__int_as_float(__builtin_amdgcn_readlane(__float_as_int(v), 0)) + __int_as_float(__builtin_amdgcn_readlane(__float_as_int(v), 16))) +
           (__int_as_float(__builtin_amdgcn_readlane(__float_as_int(v), 32)) + __int_as_float(__builtin_amdgcn_readlane(__float_as_int(v), 48)));
}

struct EpiP { bf16* P; __device__ void operator()(int m, int n, float v) const { P[(size_t)m * LDP + n] = f2bf(v); } };
struct EpiRes { const float* xs; const float* cs; const float* MODl; float* XR; __device__ void operator()(int m, int n, float v) const {
    const float xin = m < NX ? xs[(size_t)m * D + n] : cs[(size_t)(m - NX) * D + n]; const int rb = m < NX ? (m >> 12) : 4;
    XR[(size_t)m * D + n] = xin + MODl[(size_t)rb * 6144 + 2 * 1024 + n] * v; } };

__device__ __forceinline__ float* si_ptr(float* SI, int d, int m, int h, int vec) { return SI + ((((size_t)d * MT + m) * 4 + h) * 5 + vec) * 64; }

struct RwP { const float *mu, *w0, *w2, *a0, *a2, *g2, *kk, *ka, *rk, *v0, *v2; };

__device__ __forceinline__ int step_row(int b, int d, int s) { if (s < CTXL) { const int tc = d ? CTXL - 1 - s : s; return NX + b * CTXL + tc; } const int tx = d ? SEQ - 1 - (s - CTXL) : (s - CTXL); return b * SEQ + tx; }
struct LruP { const float *cw, *cb, *wa, *ba, *wx, *bx, *lam; };

struct MoeW { const float *wg, *wu, *wd, *sg, *su, *sd; };

enum { I_X = 0, I_C, I_CTX, I_CCTX, I_ADAW, I_ADAB, I_NMIX, I_NFFN, I_NFIN, I_WIN, I_WVRES, I_WOUT, I_RWMU, I_RWW0, I_RWW2, I_RWA0, I_RWA2, I_RWG2, I_RWKK, I_RWKA, I_RWRK, I_RWLNW, I_RWLNB, I_RWV0, I_RWV2,
       I_RETL, I_GCW, I_GALOG, I_GDT, I_GNW, I_LCW, I_LCB, I_LWA, I_LBA, I_LWX, I_LBX, I_LLAM, I_RTW, I_RTB, I_EWG, I_EWU, I_EWD, I_SWG, I_SWU, I_SWD, I_N };
#define GAS __attribute__((address_space(1)))
#define LAS __attribute__((address_space(3)))
typedef unsigned v4u __attribute__((ext_vector_type(4)));
typedef float f32x4 __attribute__((ext_vector_type(4)));
typedef short bf16x8 __attribute__((ext_vector_type(8)));
typedef GAS unsigned gu32;
#define RLX_AGENT __ATOMIC_RELAXED, __HIP_MEMORY_SCOPE_AGENT
#define LDS_WAIT() asm volatile("s_waitcnt lgkmcnt(0)" ::: "memory")
#define VM_WAIT() asm volatile("s_waitcnt vmcnt(0)" ::: "memory")
__device__ __forceinline__ unsigned pk2(float lo, float hi) { return (unsigned)f2bf(lo) | ((unsigned)f2bf(hi) << 16); }

namespace pg8 {
#define PG8_LAS __attribute__((address_space(3)))
typedef unsigned short bf16_t;
typedef unsigned u32x4 __attribute__((ext_vector_type(4)));
constexpr int BM = 256, BK = 64, HALF = 128, HTB = HALF * BK * 2, STAGE_BYTES = 8 * HTB, NXCD = 8, WGM = 8;
__host__ __device__ __forceinline__ int lds_byte(int r, int c) { const int st = (r >> 4) * 2 + (c >> 5), rr = r & 15, cc = c & 31, ob = rr * 64 + cc * 2; return st * 1024 + (ob ^ (((ob >> 9) & 1) << 5)); }
__host__ __device__ __forceinline__ void stage_rc(int b, int& R, int& C) { const int st = b / 1024, sb = b % 1024, swz = sb ^ (((sb >> 9) & 1) << 5); R = (st >> 1) * 16 + swz / 64; C = (st & 1) * 32 + (swz % 64) / 2; }
__host__ __device__ __forceinline__ int perm32(int rho) { const int n = rho >> 4, i = rho & 15; return 8 * (i >> 2) + 4 * n + (i & 3); }
__device__ __forceinline__ unsigned cvt_pk_bf16(float lo, float hi) { unsigned r; asm volatile("v_cvt_pk_bf16_f32 %0, %1, %2" : "=v"(r) : "v"(lo), "v"(hi)); return r; }

struct Unit { const char* A; const char* B; int pm, pn, e, nrows, rb; };

struct DenseOrder {
    const bf16_t* A; const bf16_t* Bt; int K, nM, nN, nwg, G, c;
    __device__ void init(const bf16_t* A_, const bf16_t* Bt_, int M, int N, int K_, int G_, int c_) { A = A_; Bt = Bt_; K = K_; nM = M / BM; nN = N / BM; nwg = nM * nN; G = G_; c = c_; }
    __device__ bool next(int i, Unit& u) const {
        const long L = (long)i * G + c; if (L >= nwg) return false;
        int wgid = (int)L; { const int q = nwg / NXCD, r = nwg % NXCD, xcd = wgid % NXCD, off = wgid / NXCD; wgid = (xcd < r ? xcd * (q + 1) : r * (q + 1) + (xcd - r) * q) + off; }
        const int nig = WGM * nN, gid = wgid / nig, fm = gid * WGM, gsz = (nM - fm) < WGM ? (nM - fm) : WGM;
        u.pm = fm + ((wgid % nig) % gsz); u.pn = (wgid % nig) / gsz; u.e = 0; u.nrows = BM; u.rb = 0;
        u.A = (const char*)A + (size_t)u.pm * BM * K * 2; u.B = (const char*)Bt + (size_t)u.pn * BM * K * 2; return true;
    }
    __device__ __forceinline__ unsigned a_off(const Unit&, int h, int R, int C) const { return (unsigned)((h * HALF + R) * K + C) * 2u; }
};

template <class Epi, class Sched, bool ALIGN_EPI = false>
__device__ __forceinline__ void gemm_phase(PG8_LAS unsigned char* lds, const int K, const Sched& S, const Epi& E) {
    int tid = threadIdx.x; asm volatile("" : "+v"(tid));
    const int wid = __builtin_amdgcn_readfirstlane(tid >> 6), lane = tid & 63, wr = wid >> 2, wc = wid & 3, fr = lane & 15, fq = lane >> 4;
    const int nt = K / BK;
    unsigned voffB[2];
#pragma unroll
    for (int i = 0; i < 2; ++i) { int R, C; stage_rc(tid * 16 + i * 8192, R, C); const int Rb = Epi::PERM ? ((R & ~31) + perm32(R & 31)) : R; voffB[i] = (unsigned)(Rb * K + C) * 2u; }
    const size_t kstep = (size_t)(BK * 2);
    const size_t hstep = (size_t)HALF * K * 2;
    const unsigned ldsw = (unsigned)wid * 1024u;
    const int aoff = lds_byte(wr * 64 + fr, fq * 8), boff = lds_byte(wc * 32 + fr, fq * 8);
#define PG8_SA(b, h) (((b) * 2 + (h)) * HTB)
#define PG8_SB(b, h) ((4 + (b) * 2 + (h)) * HTB)
#define PG8_STAGE(bufoff, gbase, voff) do { _Pragma("unroll") for (int _i = 0; _i < 2; ++_i) \
        __builtin_amdgcn_global_load_lds((const unsigned*)((const char*)(gbase) + (voff)[_i]), (PG8_LAS unsigned*)(lds + (bufoff) + ldsw + _i * 8192), 16, 0, 0); } while (0)
#define PG8_LDA(dst, b, h) do { _Pragma("unroll") for (int m = 0; m < 4; ++m) _Pragma("unroll") for (int k = 0; k < 2; ++k) dst[m][k] = *(const PG8_LAS bf16x8*)(lds + PG8_SA(b, h) + aoff + m * 2048 + k * 1024); } while (0)
#define PG8_LDB(dst, b, h) do { _Pragma("unroll") for (int n = 0; n < 2; ++n) _Pragma("unroll") for (int k = 0; k < 2; ++k) dst[n][k] = *(const PG8_LAS bf16x8*)(lds + PG8_SB(b, h) + boff + n * 2048 + k * 1024); } while (0)
#define PG8_MMA(ai, bj, At, Bt) do { __builtin_amdgcn_s_setprio(1); _Pragma("unroll") for (int m = 0; m < 4; ++m) _Pragma("unroll") for (int n = 0; n < 2; ++n) _Pragma("unroll") for (int k = 0; k < 2; ++k) \
        acc[ai][bj][m][n] = __builtin_amdgcn_mfma_f32_16x16x32_bf16(Bt[n][k], At[m][k], acc[ai][bj][m][n], 0, 0, 0); __builtin_amdgcn_s_setprio(0); } while (0)
#define PG8_WAIT_V(n) asm volatile("s_waitcnt vmcnt(" #n ")" ::: "memory")
#define PG8_WAIT_L(n) asm volatile("s_waitcnt lgkmcnt(" #n ")" ::: "memory")
#define PG8_BAR __builtin_amdgcn_s_barrier()
#define PG8_SCHED __builtin_amdgcn_sched_barrier(0)
    Unit cur, nxt; int ui = 0;
    if (!S.next(0, cur)) return;
    f32x4 acc[2][2][4][2];
#pragma unroll
    for (int a = 0; a < 2; ++a)
#pragma unroll
        for (int b = 0; b < 2; ++b)
#pragma unroll
            for (int m = 0; m < 4; ++m)
#pragma unroll
                for (int n = 0; n < 2; ++n) acc[a][b][m][n] = (f32x4){0.f, 0.f, 0.f, 0.f};
    bf16x8 At[4][2], B0[2][2], B1[2][2];
    unsigned cv0[2], cv1[2], nv0[2], nv1[2];
#pragma unroll
    for (int i = 0; i < 2; ++i) { int R, C; stage_rc(tid * 16 + i * 8192, R, C); cv0[i] = S.a_off(cur, 0, R, C); cv1[i] = S.a_off(cur, 1, R, C); nv0[i] = cv0[i]; nv1[i] = cv1[i]; }
    const char* cA = cur.A; const char* cB = cur.B;
    PG8_STAGE(PG8_SB(0, 0), cB, voffB); PG8_STAGE(PG8_SB(0, 1), cB + hstep, voffB); PG8_STAGE(PG8_SA(0, 0), cA, cv0); PG8_STAGE(PG8_SA(0, 1), cA, cv1);
    if (wr == 1) PG8_BAR;
    PG8_WAIT_V(2); PG8_BAR;
    PG8_STAGE(PG8_SB(1, 0), cB + kstep, voffB); PG8_STAGE(PG8_SA(1, 0), cA + kstep, cv0); PG8_STAGE(PG8_SB(1, 1), cB + hstep + kstep, voffB);
    PG8_WAIT_V(6); PG8_BAR;
    for (;;) {
        const bool has_next = S.next(ui + 1, nxt);
        const char* nA = has_next ? nxt.A : cA; const char* nB = has_next ? nxt.B : cB;
        if (has_next) {
#pragma unroll
            for (int i = 0; i < 2; ++i) { int tt = threadIdx.x; asm volatile("" : "+v"(tt)); int R, C; stage_rc(tt * 16 + i * 8192, R, C); nv0[i] = S.a_off(nxt, 0, R, C); nv1[i] = S.a_off(nxt, 1, R, C); } }
        else {
#pragma unroll
            for (int i = 0; i < 2; ++i) { nv0[i] = cv0[i]; nv1[i] = cv1[i]; } }
        for (int t = 0; t < nt; t += 2) {
            const bool last = (t == nt - 2);
            const char* a1 = cA + (size_t)(t + 1) * kstep;
            const char* a2 = last ? nA : cA + (size_t)(t + 2) * kstep; const char* b2 = last ? nB : cB + (size_t)(t + 2) * kstep;
            const char* a3 = a2 + kstep; const char* b3 = b2 + kstep;
            unsigned x0[2], x1[2];
#pragma unroll
            for (int i = 0; i < 2; ++i) { x0[i] = last ? nv0[i] : cv0[i]; x1[i] = last ? nv1[i] : cv1[i]; }
            PG8_LDB(B0, 0, 0); PG8_LDB(B1, 0, 1); PG8_SCHED; PG8_LDA(At, 0, 0); PG8_STAGE(PG8_SA(1, 1), a1, cv1);
            PG8_WAIT_V(8); PG8_WAIT_L(0); PG8_BAR; PG8_MMA(0, 0, At, B0); PG8_MMA(0, 1, At, B1); PG8_BAR; PG8_SCHED;
            PG8_LDA(At, 0, 1); PG8_STAGE(PG8_SB(0, 0), b2, voffB); PG8_STAGE(PG8_SB(0, 1), b2 + hstep, voffB); PG8_STAGE(PG8_SA(0, 0), a2, x0);
            PG8_WAIT_V(8); PG8_WAIT_L(0); PG8_BAR; PG8_MMA(1, 0, At, B0); PG8_MMA(1, 1, At, B1); PG8_BAR; PG8_SCHED;
            PG8_LDB(B0, 1, 0); PG8_LDB(B1, 1, 1); PG8_SCHED; PG8_LDA(At, 1, 0); PG8_STAGE(PG8_SA(0, 1), a2, x1);
            PG8_WAIT_V(8); PG8_WAIT_L(0); PG8_BAR; PG8_MMA(0, 0, At, B0); PG8_MMA(0, 1, At, B1); PG8_BAR; PG8_SCHED;
            PG8_LDA(At, 1, 1); PG8_STAGE(PG8_SB(1, 0), b3, voffB); PG8_STAGE(PG8_SB(1, 1), b3 + hstep, voffB); PG8_STAGE(PG8_SA(1, 0), a3, x0);
            PG8_WAIT_V(8); PG8_WAIT_L(0); PG8_BAR; PG8_MMA(1, 0, At, B0); PG8_MMA(1, 1, At, B1); PG8_BAR; PG8_SCHED;
        }
        if constexpr (ALIGN_EPI) { if (wr == 0) PG8_BAR; }
        E(acc, cur, wr, wc, fr, fq);
        if (!has_next) break;
#pragma unroll
        for (int a = 0; a < 2; ++a)
#pragma unroll
            for (int b = 0; b < 2; ++b)
#pragma unroll
                for (int m = 0; m < 4; ++m)
#pragma unroll
                    for (int n = 0; n < 2; ++n) acc[a][b][m][n] = (f32x4){0.f, 0.f, 0.f, 0.f};
        cur = nxt; cA = nA; cB = nB; ++ui;
#pragma unroll
        for (int i = 0; i < 2; ++i) { cv0[i] = nv0[i]; cv1[i] = nv1[i]; }
        if constexpr (ALIGN_EPI) { if (wr == 1) PG8_BAR; }
    }
    PG8_WAIT_V(0);
    if constexpr (!ALIGN_EPI) { if (wr == 0) PG8_BAR; }
    PG8_BAR;
#undef PG8_SA
#undef PG8_SB
#undef PG8_STAGE
#undef PG8_LDA
#undef PG8_LDB
#undef PG8_MMA
#undef PG8_WAIT_V
#undef PG8_WAIT_L
#undef PG8_BAR
#undef PG8_SCHED
}

struct EpiStoreBf16 {
    static constexpr bool PERM = true;
    bf16_t* O; int ldc;
    __device__ __forceinline__ void operator()(const f32x4 (&acc)[2][2][4][2], const Unit& u, int wr, int wc, int fr, int fq) const {
        asm volatile("" : "+v"(fr), "+v"(fq));
        const int row0 = u.pm * BM + wr * 64 + fr, col0 = u.pn * BM + wc * 32 + 8 * fq;
#pragma unroll
        for (int ai = 0; ai < 2; ++ai)
#pragma unroll
            for (int m = 0; m < 4; ++m) { bf16_t* rowp = O + (size_t)(row0 + ai * HALF + m * 16) * ldc + col0;
#pragma unroll
                for (int bj = 0; bj < 2; ++bj) { const f32x4 v0 = acc[ai][bj][m][0], v1 = acc[ai][bj][m][1];
                    u32x4 w; w.x = cvt_pk_bf16(v0[0], v0[1]); w.y = cvt_pk_bf16(v0[2], v0[3]); w.z = cvt_pk_bf16(v1[0], v1[1]); w.w = cvt_pk_bf16(v1[2], v1[3]);
                    *(u32x4*)(rowp + bj * HALF) = w; } }
    }
};
struct EpiResidual {
    static constexpr bool PERM = false;
    const float* xs; const float* cs; const float* MODl; float* XR;
    __device__ __forceinline__ void operator()(const f32x4 (&acc)[2][2][4][2], const Unit& u, int wr, int wc, int fr, int fq) const {
        asm volatile("" : "+v"(fr), "+v"(fq));
        const int row0 = u.pm * BM + wr * 64 + fr, col0 = u.pn * BM + wc * 32 + 4 * fq;
#pragma unroll
        for (int ai = 0; ai < 2; ++ai)
#pragma unroll
            for (int m = 0; m < 4; ++m) { const int row = row0 + ai * HALF + m * 16;
                const float* xin = row < NX ? xs + (size_t)row * D : cs + (size_t)(row - NX) * D; const int rb = row < NX ? (row >> 12) : 4;
                const float* md = MODl + (size_t)rb * 6144 + 2 * 1024; float* o = XR + (size_t)row * D;
#pragma unroll
                for (int bj = 0; bj < 2; ++bj)
#pragma unroll
                    for (int n = 0; n < 2; ++n) { const int c = col0 + bj * HALF + n * 16; const f32x4 xi = *(const f32x4*)(xin + c), mm = *(const f32x4*)(md + c); *(f32x4*)(o + c) = xi + mm * acc[ai][bj][m][n]; } }
    }
};
}

#define XB_TMO      128
#define XB_XCNT(j)  (256  + 64 * (j))
#define XB_XSUB(j)  (1280 + 64 * (j))
#define XB_XGEN(j)  (2304 + 64 * (j))
#define XB_TOP      3328
#define XB_TOPGEN   3392
#define XCD_BAR_WORDS 3456
#define XB_SPIN_CAP (1u << 22)
__device__ __forceinline__ unsigned xb_ld(unsigned* p)              { return __hip_atomic_load(p, __ATOMIC_RELAXED, __HIP_MEMORY_SCOPE_AGENT); }
__device__ __forceinline__ unsigned xb_add(unsigned* p, unsigned v) { return __hip_atomic_fetch_add(p, v, __ATOMIC_RELAXED, __HIP_MEMORY_SCOPE_AGENT); }
__device__ __forceinline__ unsigned xb_xcc_id() { return (unsigned)__builtin_amdgcn_s_getreg((3 << 11) | 20) & 0xFu; }
#define XB_SPIN(cond, bar) do { unsigned _sp = 0; while (cond) { __builtin_amdgcn_s_sleep(1); \
    if ((++_sp & 255u) == 0u) { if (xb_ld(&(bar)[XB_TMO])) break; if (_sp > XB_SPIN_CAP) { atomicAdd(&(bar)[XB_TMO], 1u); break; } } } } while (0)
struct XcdBarrier { unsigned* bar; unsigned x; volatile LAS unsigned* st; };
__device__ __forceinline__ XcdBarrier xcd_barrier_post(unsigned* bar, volatile LAS unsigned* st) {
    XcdBarrier b; b.bar = bar; b.x = (unsigned)__builtin_amdgcn_readfirstlane((int)xb_xcc_id()); b.st = st;
    if (threadIdx.x == 0) (void)xb_add(&bar[XB_XCNT(b.x)], 1u);
    return b;
}
__device__ __forceinline__ void xcd_barrier_complete(unsigned* bar, unsigned x, unsigned& nloc, unsigned& nx) {
    const unsigned G = gridDim.x * gridDim.y * gridDim.z;
    unsigned sum, cnt, mine, sp = 0u;
    for (;;) {
        sum = 0u; cnt = 0u; mine = 0u;
#pragma unroll
        for (unsigned j = 0; j < 16; ++j) { const unsigned c = xb_ld(&bar[XB_XCNT(j)]); sum += c; cnt += (c > 0u) ? 1u : 0u; mine = (j == x) ? c : mine; }
        if (sum == G) break;
        __builtin_amdgcn_s_sleep(1);
        if ((++sp & 255u) == 0u) { if (xb_ld(&bar[XB_TMO])) break; if (sp > XB_SPIN_CAP) { atomicAdd(&bar[XB_TMO], 1u); break; } }
    }
    nloc = mine > 0u ? mine : 1u; nx = cnt > 0u ? cnt : 1u;
}
__device__ __forceinline__ void xcd_barrier(const XcdBarrier& b) {
    asm volatile("s_waitcnt vmcnt(0)" ::: "memory");
    __syncthreads();
    if (threadIdx.x == 0) {
        unsigned* bar = b.bar; const unsigned bx = (unsigned)__builtin_amdgcn_readfirstlane((int)xb_xcc_id());
        __builtin_amdgcn_s_waitcnt(0);
        unsigned nloc = b.st[0], nx = b.st[1];
        if (nloc == 0u) { xcd_barrier_complete(bar, bx, nloc, nx); b.st[0] = nloc; b.st[1] = nx; }
        const unsigned old = xb_add(&bar[XB_XSUB(bx)], 1u);
        const unsigned gen = old / nloc;
        if (old + 1u == (gen + 1u) * nloc) {
            __builtin_amdgcn_fence(__ATOMIC_RELEASE, "agent");
            asm volatile("s_waitcnt vmcnt(0)" ::: "memory");
            const unsigned og = xb_add(&bar[XB_TOP], 1u);
            const unsigned tg = og / nx;
            if (og + 1u == (tg + 1u) * nx) xb_add(&bar[XB_TOPGEN], 1u);
            else XB_SPIN(xb_ld(&bar[XB_TOPGEN]) == tg, bar);
            __builtin_amdgcn_fence(__ATOMIC_ACQUIRE, "agent");
            xb_add(&bar[XB_XGEN(bx)], 1u);
            asm volatile("s_waitcnt vmcnt(0)" ::: "memory");
        } else {
            XB_SPIN(xb_ld(&bar[XB_XGEN(bx)]) == gen, bar);
            __builtin_amdgcn_fence(__ATOMIC_ACQUIRE, "agent");
            asm volatile("s_waitcnt vmcnt(0)" ::: "memory");
        }
    }
    __syncthreads();
}

constexpr int NWAVES = 8, NTHR = 512;
constexpr int RING_OFF = 0, RING_BYTES = 131072;
constexpr int LDSCTL_OFF = RING_BYTES, MISC_OFF = LDSCTL_OFF + 320;
constexpr int LDS_BYTES = 147456;
constexpr int CW_BAR = 4096;
constexpr size_t CTL_ZERO_BYTES = 1 * MiB;

struct MArgs {
    const float* in[45]; float* out; unsigned char* ws; int ph_lo, ph_hi, l_lo, l_hi, bar_region, pad;
};
struct Frame { LAS unsigned char* lds; volatile LAS unsigned* MISC; gu32* ctl; int tid, lane, wave, vcu, G; };

__device__ __forceinline__ void transpose_item(const float* W, int ldw, int N, int k0, int n0, bf16* WT, int ldt, int drow0, LAS float* scr, int lane) {
    const int nn = n0 + (lane & 31); const bool okn = nn < N;
#pragma unroll 8
    for (int i = 0; i < 32; ++i) { const int kk = 2 * i + (lane >> 5); scr[kk * 33 + (lane & 31)] = okn ? W[(size_t)(k0 + kk) * ldw + nn] : 0.f; }
    LDS_WAIT(); asm volatile("" ::: "memory");
    const int c = lane & 7;
#pragma unroll
    for (int j = 0; j < 4; ++j) { const int n = (lane >> 3) + 8 * j; const LAS float* s = scr + (8 * c) * 33 + n;
        v4u o; o.x = pk2(s[0 * 33], s[1 * 33]); o.y = pk2(s[2 * 33], s[3 * 33]); o.z = pk2(s[4 * 33], s[5 * 33]); o.w = pk2(s[6 * 33], s[7 * 33]);
        if (n0 + n < N) *(GAS v4u*)(WT + (size_t)(drow0 + n) * ldt + k0 + 8 * c) = o; }
    LDS_WAIT(); asm volatile("" ::: "memory");
}

__device__ __forceinline__ void ph_mod(Frame& F, const float* c, const float* cctx, const float* ada_w, const float* ada_b, float* MOD) {
    LAS float* s = (LAS float*)(F.lds + RING_OFF);
    LAS float* red = s + 5 * 1024;
    for (int i = F.tid; i < 5 * 1024; i += NTHR) { const int r = i >> 10, k = i & 1023; const float v = r < 4 ? c[r * 1024 + k] : cctx[k]; s[i] = siluf_(v); }
    __syncthreads();
    for (int u = F.vcu; u < 192; u += F.G) {
        const int l = u / 96, j0 = (u % 96) * 64, cl = F.tid & 63, kp = F.tid >> 6;
        const float* W = ada_w + (size_t)l * 1024 * 6144 + j0 + cl;
        float acc[5] = {0.f, 0.f, 0.f, 0.f, 0.f};
        for (int k = kp * 128; k < kp * 128 + 128; ++k) { const float w = W[(size_t)k * 6144];
#pragma unroll
            for (int r = 0; r < 5; ++r) acc[r] += s[r * 1024 + k] * w; }
#pragma unroll
        for (int r = 0; r < 5; ++r) red[(kp * 5 + r) * 64 + cl] = acc[r];
        __syncthreads();
        if (F.tid < 320) { const int r = F.tid >> 6; float a = ada_b[l * 6144 + j0 + cl];
#pragma unroll
            for (int q = 0; q < 8; ++q) a += red[(q * 5 + r) * 64 + cl];
            MOD[((size_t)l * 5 + r) * 6144 + j0 + cl] = a; }
        __syncthreads();
    }
}
__device__ __forceinline__ void ph_convert_small(Frame& F, const float* w_in, const float* w_vres, const float* w_out, bf16* WIN_T  , bf16* WOUT_T  ) {
    LAS float* scr = (LAS float*)(F.lds + RING_OFF + 32768 + F.wave * 16384 / 2);
    scr = (LAS float*)(F.lds + RING_OFF + 32768 + F.wave * 9216);
    const int gw = F.vcu * NWAVES + F.wave, NGW = F.G * NWAVES;
    constexpr int NB_IN = (NIN + 31) / 32;
    constexpr int I_IN = 16 * NB_IN, I_VR = 16 * 1, I_OUT = 16 * 32;
    constexpr int PER_L = I_IN + I_VR + I_OUT;
    for (int it = gw; it < 2 * PER_L; it += NGW) {
        const int l = it / PER_L; int r = it % PER_L;
        if (r < I_IN) { const int kb = r / NB_IN, nb = r % NB_IN; transpose_item(w_in + (size_t)l * D * NIN, NIN, NIN, kb * 64, nb * 32, WIN_T + (size_t)l * LDP * D, D, nb * 32, scr, F.lane); continue; } r -= I_IN;
        if (r < I_VR) { if (l == 1) transpose_item(w_vres, 32, 32, r * 64, 0, WIN_T + (size_t)LDP * D, D, NIN, scr, F.lane); continue; } r -= I_VR;
        { const int kb = r / 32, nb = r % 32; transpose_item(w_out + (size_t)l * D * D, D, D, kb * 64, nb * 32, WOUT_T + (size_t)l * D * D, D, nb * 32, scr, F.lane); }
    }
}
__device__ __forceinline__ void ph_norm_mod(Frame& F, const float* xs, const float* cs, const float* gain, const float* MODl, int si, bf16* XN, int nrows) {
    const int gw = F.vcu * NWAVES + F.wave, NGW = F.G * NWAVES, lane = F.lane;
    for (int m = gw; m < nrows; m += NGW) {
        const float* src = m < NX ? xs + (size_t)m * D : cs + (size_t)(m - NX) * D; const int rb = m < NX ? (m >> 12) : 4;
        const float* md = MODl + (size_t)rb * 6144;
        f32x4 v[4]; float ss = 0.f;
#pragma unroll
        for (int j = 0; j < 4; ++j) { v[j] = *(const f32x4*)(src + 4 * lane + 256 * j); ss += (v[j].x * v[j].x + v[j].y * v[j].y) + (v[j].z * v[j].z + v[j].w * v[j].w); }
        ss = wave_sum(ss); const float rs = rsqrtf(ss * (1.f / D) + 1e-6f);
#pragma unroll
        for (int j = 0; j < 4; ++j) { const int ci = 4 * lane + 256 * j; const f32x4 g = *(const f32x4*)(gain + ci), sh = *(const f32x4*)(md + si * 1024 + ci), sc = *(const f32x4*)(md + (si + 1) * 1024 + ci);
            const f32x4 y = v[j] * rs * g * (sc + 1.f) + sh;
            unsigned long long o = (unsigned long long)pk2(y.x, y.y) | ((unsigned long long)pk2(y.z, y.w) << 32);
            *(unsigned long long*)(XN + (size_t)m * D + ci) = o; }
    }
}

constexpr int CW_CNT = 2048;
constexpr int TAB_OFF = LDSCTL_OFF + 1024;
struct MoeTab { LAS int* cnt; LAS int* ups; LAS int* ro; };
__device__ __forceinline__ MoeTab moe_tab(Frame& F) { MoeTab t; t.cnt = (LAS int*)(F.lds + TAB_OFF); t.ups = t.cnt + 80; t.ro = t.ups + 80; return t; }
__device__ __forceinline__ void moe_build_tab(Frame& F, int layer, int ntok) {
    MoeTab T = moe_tab(F);
    if (F.tid < 64) T.cnt[F.tid] = (int)__hip_atomic_load(F.ctl + CW_CNT + layer * 64 + F.tid, RLX_AGENT);
    if (F.tid == 64) T.cnt[64] = ntok;
    __syncthreads();
    if (F.tid == 0) { int u = 0, r = 0; for (int e = 0; e < 65; ++e) { T.ups[e] = u; T.ro[e] = r; u += (T.cnt[e] + 255) >> 8; r += T.cnt[e]; } T.ups[65] = u; T.ro[65] = r; }
    __syncthreads();
}
__device__ __forceinline__ int uni(int v) { return __builtin_amdgcn_readfirstlane(v); }
__device__ __forceinline__ const char* uni_ptr(const char* p) { unsigned long long v = (unsigned long long)p; unsigned lo = __builtin_amdgcn_readfirstlane((unsigned)v), hi = __builtin_amdgcn_readfirstlane((unsigned)(v >> 32)); return (const char*)(((unsigned long long)hi << 32) | lo); }

__device__ __forceinline__ void ph_route(Frame& F, const float* XR, const float* gain, const float* MODl, const float* rw, const float* rbias, bf16* XN, int layer,
                                         unsigned* LIST, int* SLOTPOS, float* SLOTG, int ntok) {
    LAS float* hs = (LAS float*)(F.lds + RING_OFF);
    LAS float* part = (LAS float*)(F.lds + RING_OFF + 65536);
    LAS float* sc = (LAS float*)(F.lds + RING_OFF + 98304);
    const int lane = F.lane, wv = F.wave, tid = F.tid;
    const int ngrp = ntok / 16;
    for (int g = F.vcu; g < ngrp; g += F.G) {
#pragma unroll
        for (int tt = 0; tt < 2; ++tt) {
            const int tl = 2 * wv + tt, m = g * 16 + tl;
            const float* src = XR + (size_t)m * D; const int rb = m < NX ? (m >> 12) : 4; const float* md = MODl + (size_t)rb * 6144;
            f32x4 v[4]; float ss = 0.f;
#pragma unroll
            for (int j = 0; j < 4; ++j) { v[j] = *(const f32x4*)(src + 4 * lane + 256 * j); ss += (v[j].x * v[j].x + v[j].y * v[j].y) + (v[j].z * v[j].z + v[j].w * v[j].w); }
            ss = wave_sum(ss); const float rs = rsqrtf(ss * (1.f / D) + 1e-6f);
#pragma unroll
            for (int j = 0; j < 4; ++j) { const int ci = 4 * lane + 256 * j; const f32x4 gg = *(const f32x4*)(gain + ci), sh = *(const f32x4*)(md + 3 * 1024 + ci), scl = *(const f32x4*)(md + 4 * 1024 + ci);
                const f32x4 y = v[j] * rs * gg * (scl + 1.f) + sh;
                *(LAS f32x4*)(hs + tl * 1024 + ci) = y;
                *(unsigned long long*)(XN + (size_t)m * D + ci) = (unsigned long long)pk2(y.x, y.y) | ((unsigned long long)pk2(y.z, y.w) << 32); }
        }
        __syncthreads();
        { const int e = tid & 63, kp = tid >> 6; float acc[16];
#pragma unroll
            for (int t = 0; t < 16; ++t) acc[t] = 0.f;
            const float* wp = rw + (size_t)(kp * 128) * 64 + e;
            for (int k = 0; k < 128; k += 4) { const float w0 = wp[(k + 0) * 64], w1 = wp[(k + 1) * 64], w2 = wp[(k + 2) * 64], w3 = wp[(k + 3) * 64];
#pragma unroll
                for (int t = 0; t < 16; ++t) { const f32x4 h4 = *(const LAS f32x4*)(hs + t * 1024 + kp * 128 + k); acc[t] += (h4.x * w0 + h4.y * w1) + (h4.z * w2 + h4.w * w3); } }
#pragma unroll
            for (int t = 0; t < 16; ++t) part[(kp * 16 + t) * 64 + e] = acc[t]; }
        __syncthreads();
#pragma unroll
        for (int q = 0; q < 2; ++q) { const int t = (tid >> 6) + 8 * q, e = tid & 63; float a = 0.f;
#pragma unroll
            for (int kp = 0; kp < 8; ++kp) a += part[(kp * 16 + t) * 64 + e];
            sc[t * 64 + e] = sigmoidf_(a); }
        __syncthreads();
#pragma unroll
        for (int tt = 0; tt < 2; ++tt) {
            const int tl = 2 * wv + tt, m = g * 16 + tl;
            const float s = sc[tl * 64 + lane]; float sel = s + rbias[lane]; int myk = -1; float ssum = 0.f;
            for (int k = 0; k < 8; ++k) {
                float bv = sel; int bi = lane;
#pragma unroll
                for (int o = 1; o < 64; o <<= 1) { const float ov = __shfl_xor(bv, o); const int oi = __shfl_xor(bi, o); if (ov > bv || (ov == bv && oi < bi)) { bv = ov; bi = oi; } }
                ssum += __shfl(s, bi);
                if (lane == bi) { myk = k; sel = -3.0e38f; }
            }
            if (myk >= 0) { const float gw = 2.5f * s / ssum;
                const unsigned rank = __hip_atomic_fetch_add(F.ctl + CW_CNT + layer * 64 + lane, 1u, RLX_AGENT);
                LIST[(size_t)lane * MT + rank] = (unsigned)m;
                SLOTPOS[(size_t)m * 8 + myk] = (lane << 16) | (int)rank; SLOTG[(size_t)m * 8 + myk] = gw; }
        }
        __syncthreads();
    }
}
__device__ __forceinline__ void ph_convert_experts(Frame& F, const float* wg, const float* wu, const float* wd, const float* sg, const float* su, const float* sd, bf16* WGU_T, bf16* WD_T) {
    LAS float* scr = (LAS float*)(F.lds + RING_OFF + F.wave * 9216);
    const int gw = F.vcu * NWAVES + F.wave, NGW = F.G * NWAVES;
    for (int it = gw; it < 65 * 384; it += NGW) {
        const int e = it / 384; int r = it % 384;
        const float* Wg = e < 64 ? wg + (size_t)e * D * EFF : sg; const float* Wu = e < 64 ? wu + (size_t)e * D * EFF : su; const float* Wd = e < 64 ? wd + (size_t)e * EFF * D : sd;
        if (r < 256) { const float* W = r < 128 ? Wg : Wu; const int up = r >= 128; r &= 127; const int kb = r >> 3, nb = r & 7, n0 = nb * 32;
            transpose_item(W, EFF, EFF, kb * 64, n0, WGU_T + (size_t)e * 512 * D, D, (n0 >> 7) * 256 + (n0 & 127) + up * 128, scr, F.lane); }
        else { r -= 256; const int kb = r >> 5, nb = r & 31; transpose_item(Wd, D, D, kb * 64, nb * 32, WD_T + (size_t)e * D * EFF, EFF, nb * 32, scr, F.lane); }
    }
}
namespace pg8 {
struct MoeOrder1 {
    const bf16_t* XN; const bf16_t* WGU; const unsigned* LIST; MoeTab T; int G, c, total;
    __device__ bool next(int i, Unit& u) const {
        const int L = i * G + c; if (L >= total) return false;
        const int pn = L & 1, ru = L >> 1; int lo = 0, hi = 64;
        while (lo < hi) { const int mid = (lo + hi + 1) >> 1; if (T.ups[mid] <= ru) lo = mid; else hi = mid - 1; }
        const int e = uni(lo), j = uni(ru - T.ups[lo]);
        u.e = e; u.pm = j; u.pn = pn; u.nrows = uni(min(256, T.cnt[e] - j * 256)); u.rb = uni(T.ro[e] + j * 256);
        u.A = (const char*)XN; u.B = uni_ptr((const char*)WGU + ((size_t)e * 512 + (size_t)pn * 256) * D * 2); return true;
    }
    __device__ __forceinline__ unsigned a_off(const Unit& u, int h, int R, int C) const {
        const int idx = h * HALF + R; int tok = 0;
        if (idx < u.nrows) tok = u.e < 64 ? (int)LIST[(size_t)u.e * MT + u.pm * 256 + idx] : u.pm * 256 + idx;
        return (unsigned)(tok * D + C) * 2u;
    }
};
struct MoeOrder2 {
    const bf16_t* HACT; const bf16_t* WD; MoeTab T; int G, c, total;
    __device__ bool next(int i, Unit& u) const {
        const int L = i * G + c; if (L >= total) return false;
        const int pn = L & 3, ru = L >> 2; int lo = 0, hi = 64;
        while (lo < hi) { const int mid = (lo + hi + 1) >> 1; if (T.ups[mid] <= ru) lo = mid; else hi = mid - 1; }
        const int e = uni(lo), j = uni(ru - T.ups[lo]);
        u.e = e; u.pm = j; u.pn = pn; u.nrows = uni(min(256, T.cnt[e] - j * 256)); u.rb = uni(T.ro[e] + j * 256);
        u.A = uni_ptr((const char*)HACT + (size_t)u.rb * EFF * 2); u.B = uni_ptr((const char*)WD + ((size_t)e * D + (size_t)pn * 256) * EFF * 2); return true;
    }
    __device__ __forceinline__ unsigned a_off(const Unit&, int h, int R, int C) const { return (unsigned)((h * HALF + R) * EFF + C) * 2u; }
};
struct EpiSwiglu {
    static constexpr bool PERM = true;
    bf16_t* HACT;
    __device__ __forceinline__ void operator()(const f32x4 (&acc)[2][2][4][2], const Unit& u, int wr, int wc, int fr, int fq) const {
        asm volatile("" : "+v"(fr), "+v"(fq));
#pragma unroll
        for (int ai = 0; ai < 2; ++ai)
#pragma unroll
            for (int m = 0; m < 4; ++m) { const int r = ai * HALF + wr * 64 + m * 16 + fr;
                if (r < u.nrows) { const f32x4 g0 = acc[ai][0][m][0], g1 = acc[ai][0][m][1], u0 = acc[ai][1][m][0], u1 = acc[ai][1][m][1];
                    float o[8];
#pragma unroll
                    for (int q = 0; q < 4; ++q) { o[q] = g0[q] / (1.f + __expf(-g0[q])) * u0[q]; o[4 + q] = g1[q] / (1.f + __expf(-g1[q])) * u1[q]; }
                    u32x4 w; w.x = cvt_pk_bf16(o[0], o[1]); w.y = cvt_pk_bf16(o[2], o[3]); w.z = cvt_pk_bf16(o[4], o[5]); w.w = cvt_pk_bf16(o[6], o[7]);
                    *(u32x4*)(HACT + (size_t)(u.rb + r) * EFF + u.pn * 128 + wc * 32 + 8 * fq) = w; } }
    }
};
struct EpiDown {
    static constexpr bool PERM = true;
    bf16_t* Y; float* XR; const float* MODl;
    __device__ __forceinline__ void operator()(const f32x4 (&acc)[2][2][4][2], const Unit& u, int wr, int wc, int fr, int fq) const {
        asm volatile("" : "+v"(fr), "+v"(fq));
        const unsigned lcol = (unsigned)(wc * 32 + 8 * fq);
        if (u.e < 64) {
            char* ybase = (char*)uni_ptr((const char*)(Y + (size_t)u.rb * D + u.pn * BM));
#pragma unroll
            for (int ai = 0; ai < 2; ++ai)
#pragma unroll
                for (int m = 0; m < 4; ++m) { const int r = ai * HALF + wr * 64 + m * 16 + fr;
                    if (r < u.nrows) { const unsigned off = ((unsigned)r * D + lcol) * 2u;
#pragma unroll
                        for (int bj = 0; bj < 2; ++bj) { const f32x4 v0 = acc[ai][bj][m][0], v1 = acc[ai][bj][m][1];
                            u32x4 w; w.x = cvt_pk_bf16(v0[0], v0[1]); w.y = cvt_pk_bf16(v0[2], v0[3]); w.z = cvt_pk_bf16(v1[0], v1[1]); w.w = cvt_pk_bf16(v1[2], v1[3]);
                            *(u32x4*)(ybase + off + bj * HALF * 2) = w; } } }
        } else {
            const int m0 = u.pm * 256; const int rb = m0 < NX ? (m0 >> 12) : 4;
            const char* mdb = uni_ptr((const char*)(MODl + (size_t)rb * 6144 + 5 * 1024 + u.pn * BM)); char* xb = (char*)uni_ptr((const char*)(XR + (size_t)m0 * D + u.pn * BM));
#pragma unroll
            for (int ai = 0; ai < 2; ++ai)
#pragma unroll
                for (int m = 0; m < 4; ++m) { const int r = ai * HALF + wr * 64 + m * 16 + fr;
                    if (r < u.nrows) {
#pragma unroll
                        for (int bj = 0; bj < 2; ++bj)
#pragma unroll
                            for (int n = 0; n < 2; ++n) { const unsigned c = (unsigned)(bj * HALF) + lcol + 4u * n; const unsigned off = ((unsigned)r * D + c) * 4u;
                                const f32x4 xi = *(const f32x4*)(xb + off), mm = *(const f32x4*)(mdb + c * 4u); *(f32x4*)(xb + off) = xi + mm * acc[ai][bj][m][n]; } }
                    asm volatile("" ::: "memory"); }
        }
    }
};
}
__device__ __forceinline__ void ph_combine(Frame& F, const bf16* Y, const int* SLOTPOS, const float* SLOTG, const float* MODl, float* XR, int ntok) {
    MoeTab T = moe_tab(F);
    const int gw = F.vcu * NWAVES + F.wave, NGW = F.G * NWAVES, lane = F.lane;
    for (int m = gw; m < ntok; m += NGW) {
        const int rb = m < NX ? (m >> 12) : 4; const float* md = MODl + (size_t)rb * 6144 + 5 * 1024;
        float acc[16];
#pragma unroll
        for (int q = 0; q < 16; ++q) acc[q] = 0.f;
#pragma unroll
        for (int s = 0; s < 8; ++s) { const int sp = SLOTPOS[(size_t)m * 8 + s]; const int row = T.ro[sp >> 16] + (sp & 0xffff); const float gs = SLOTG[(size_t)m * 8 + s];
            const bf16* yr = Y + (size_t)row * D;
#pragma unroll
            for (int j = 0; j < 4; ++j) { const unsigned long long w = *(const unsigned long long*)(yr + 4 * lane + 256 * j);
                acc[4 * j + 0] += gs * __uint_as_float((unsigned)(w & 0xffffull) << 16); acc[4 * j + 1] += gs * __uint_as_float((unsigned)((w >> 16) & 0xffffull) << 16);
                acc[4 * j + 2] += gs * __uint_as_float((unsigned)((w >> 32) & 0xffffull) << 16); acc[4 * j + 3] += gs * __uint_as_float((unsigned)((w >> 48) & 0xffffull) << 16); } }
#pragma unroll
        for (int j = 0; j < 4; ++j) { const int ci = 4 * lane + 256 * j; float* o = XR + (size_t)m * D + ci; const f32x4 xi = *(const f32x4*)o, mm = *(const f32x4*)(md + ci);
            *(f32x4*)o = xi + mm * (f32x4){acc[4 * j], acc[4 * j + 1], acc[4 * j + 2], acc[4 * j + 3]}; }
    }
}

__device__ __forceinline__ void d_rwkv_prep(int m_, int c_, LAS float* shm_, const bf16* P, RwP w, int layer, float* VF, float* SI, float* SV, float* BON, float* G) {
    LAS float* sp = shm_; LAS float* vd = shm_ + 960;
    const int m = m_, c = c_, h = c >> 6; const Row rw = row_of(m);
    const bf16* pr = P + (size_t)m * LDP;
    for (int j = c; j < 960; j += 256) { const float p = bf2f(pr[j]); const float pp = rw.t > 0 ? bf2f(pr[j - LDP]) : 0.f; const float pn = rw.t < rw.L - 1 ? bf2f(pr[j + LDP]) : 0.f;
        sp[j] = p + (0.5f * (pp + pn) - p) * w.mu[j]; }
    if (c < 32) vd[c] = bf2f(pr[VRES_OFF + c]);
    __syncthreads();
    const float r = sp[c], kv = sp[256 + c]; float v = sp[512 + c];
    float g = 0.f;
#pragma unroll 4
    for (int j = 0; j < 64; ++j) g += sigmoidf_(sp[896 + j]) * w.g2[j * 256 + c];
    const float kkr = kv * w.kk[c]; const float ss = wave_sum(kkr * kkr); const float kkn = kkr * rsqrtf(ss + 1e-6f);
    if (layer == 0) VF[(size_t)m * 256 + c] = v;
    else { float z = w.v0[c];
#pragma unroll 4
        for (int j = 0; j < 32; ++j) z += vd[j] * w.v2[j * 256 + c]; v = v + (VF[(size_t)m * 256 + c] - v) * sigmoidf_(z); }
    float bsum = 0.f;
#pragma nounroll
    for (int d = 0; d < 2; ++d) {
        float z = w.w0[d * 256 + c];
#pragma unroll 4
        for (int j = 0; j < 32; ++j) z += tanhf(sp[768 + d * 32 + j]) * w.w2[(d * 32 + j) * 256 + c];
        const float lw = -0.6065306597f * sigmoidf_(z);
        float za = w.a0[d * 256 + c];
#pragma unroll 4
        for (int j = 0; j < 32; ++j) za += sp[832 + d * 32 + j] * w.a2[(d * 32 + j) * 256 + c];
        const float a = sigmoidf_(za);
        const float kd = kv * (1.f + (a - 1.f) * w.ka[c]);
        const float bs = wave_sum(r * kd * w.rk[c]);
        bsum += bs * v;
        const int k = c & 63;
        si_ptr(SI, d, m, h, 0)[k] = __expf(lw); si_ptr(SI, d, m, h, 1)[k] = kkn; si_ptr(SI, d, m, h, 2)[k] = kkn * a; si_ptr(SI, d, m, h, 3)[k] = kd; si_ptr(SI, d, m, h, 4)[k] = r;
    }
    SV[(size_t)m * 256 + c] = v; BON[(size_t)m * 256 + c] = bsum; G[(size_t)m * 256 + c] = g;
}

__device__ __forceinline__ void d_rwkv_post(int m_, int c_, const float* YS, const float* BON, const float* G, const float* lnw, const float* lnb, bf16* MIX) {
    const int m = m_, c = c_;
    const float y = YS[(size_t)m * 256 + c] + YS[((size_t)MT + m) * 256 + c];
    const float mu = wave_sum(y) * (1.f / 64.f); const float dlt = y - mu; const float var = wave_sum(dlt * dlt) * (1.f / 64.f);
    const float yn = dlt * rsqrtf(var + 64e-5f);
    MIX[(size_t)m * D + c] = f2bf((yn * lnw[c] + lnb[c] + BON[(size_t)m * 256 + c]) * G[(size_t)m * 256 + c]);
}

__device__ __forceinline__ void d_ret_prep(int m_, int c_, LAS float* shm_, const bf16* P, const float* lam  , float* SI, float* SV) {
    LAS float* sq = shm_; LAS float* sk = shm_ + 256;
    const int m = m_, c = c_, h = c >> 6, i = c & 63; const Row rw = row_of(m);
    const bf16* pr = P + (size_t)m * LDP + RET_OFF;
    float q = bf2f(pr[c]), k = bf2f(pr[256 + c]); const float v = bf2f(pr[512 + c]);
    sq[c] = q; sk[c] = k; __syncthreads();
    if (rw.isx) {
        const int j = i & 31, jj = j & 15; const float pos = j < 16 ? (float)(rw.t >> 6) : (float)(rw.t & 63);
        const float inv = powf(10000.f, -(float)jj / 16.f); const float ang = pos * inv; const float cs = cosf(ang), sn = sinf(ang);
        const int pc = i < 32 ? c + 32 : c - 32;
        const float q1 = i < 32 ? q : sq[pc], q2 = i < 32 ? sq[pc] : q, k1 = i < 32 ? k : sk[pc], k2 = i < 32 ? sk[pc] : k;
        q = i < 32 ? q1 * cs - q2 * sn : q1 * sn + q2 * cs; k = i < 32 ? k1 * cs - k2 * sn : k1 * sn + k2 * cs;
    }
    k *= 0.125f;
    for (int d = 0; d < 2; ++d) { const float gm = __expf(-lam[d * 4 + h]);
        si_ptr(SI, d, m, h, 0)[i] = gm; si_ptr(SI, d, m, h, 1)[i] = 0.f; si_ptr(SI, d, m, h, 2)[i] = 0.f; si_ptr(SI, d, m, h, 3)[i] = k; si_ptr(SI, d, m, h, 4)[i] = q; }
    SV[(size_t)m * 256 + c] = v;
}

__device__ __forceinline__ void d_hnorm_post(int m_, int c_, const float* YS, const bf16* P, int gate_off, const float* nw, bf16* MIX, int mix_off) {
    const int m = m_, c = c_;
    const float o = YS[(size_t)m * 256 + c] + YS[((size_t)MT + m) * 256 + c];
    const float ms = wave_sum(o * o) * (1.f / 64.f);
    const float g = bf2f(P[(size_t)m * LDP + gate_off + c]);
    float y = o * rsqrtf(ms + 1e-6f) * siluf_(g); if (nw) y *= nw[c & 63];
    MIX[(size_t)m * D + mix_off + c] = f2bf(y);
}

__device__ __forceinline__ void d_gdn_prep(int m_, int c_, const bf16* P, const float* cw  , const float* alog, const float* dtb, float* SI, float* SV) {
    const int m = m_, c = c_, h = c >> 6, i = c & 63; const Row rw = row_of(m);
    const bf16* pr = P + (size_t)m * LDP + GDN_OFF;
    float o[3];
#pragma unroll
    for (int s = 0; s < 3; ++s) { const int ch = s * 256 + c; float a = 0.f;
#pragma unroll
        for (int j = 0; j < 4; ++j) { const int tt = rw.t + j - 2; if (tt >= 0 && tt < rw.L) a += bf2f(pr[(ptrdiff_t)(j - 2) * LDP + ch]) * cw[j * 768 + ch]; }
        o[s] = siluf_(a); }
    const float qs = wave_sum(o[0] * o[0]), ks = wave_sum(o[1] * o[1]);
    const float q = o[0] * rsqrtf(qs + 1e-6f) * 0.125f, k = o[1] * rsqrtf(ks + 1e-6f);
    for (int d = 0; d < 2; ++d) {
        const float a = bf2f(pr[768 + d * 4 + h]), b = bf2f(pr[776 + d * 4 + h]);
        const float al = __expf(-__expf(alog[d * 4 + h]) * softplusf_(a + dtb[d * 4 + h])), be = sigmoidf_(b);
        si_ptr(SI, d, m, h, 0)[i] = al; si_ptr(SI, d, m, h, 1)[i] = k; si_ptr(SI, d, m, h, 2)[i] = al * be * k; si_ptr(SI, d, m, h, 3)[i] = be * k; si_ptr(SI, d, m, h, 4)[i] = q; }
    SV[(size_t)m * 256 + c] = o[2];
}

__device__ __forceinline__ void d_rowscan(int seq_, int v_, LAS float* shm_, const float* SI, const float* SV, float* YS) {
    LAS float (*sh)[5][64] = (LAS float (*)[5][64])shm_;
    const int seq = seq_, d = seq & 1, h = (seq >> 1) & 3, b = seq >> 3, v = v_;
    float s[64];
#pragma unroll
    for (int k = 0; k < 64; ++k) s[k] = 0.f;
    float nx[5], nv; { const int m = step_row(b, d, 0); const float* p = SI + (((size_t)d * MT + m) * 4 + h) * 320;
#pragma unroll
        for (int j = 0; j < 5; ++j) nx[j] = p[j * 64 + v]; nv = SV[(size_t)m * 256 + h * 64 + v]; }
    for (int st = 0; st < NSTEP; ++st) {
        const int buf = st & 1; const int m = step_row(b, d, st);
#pragma unroll
        for (int j = 0; j < 5; ++j) sh[buf][j][v] = nx[j];
        const float vv = nv;
        __syncthreads();
        if (st + 1 < NSTEP) { const int m2 = step_row(b, d, st + 1); const float* p = SI + (((size_t)d * MT + m2) * 4 + h) * 320;
#pragma unroll
            for (int j = 0; j < 5; ++j) nx[j] = p[j * 64 + v]; nv = SV[(size_t)m2 * 256 + h * 64 + v]; }
        float sa = 0.f;
#pragma unroll
        for (int k = 0; k < 64; ++k) sa += s[k] * sh[buf][1][k];
        float y = 0.f;
#pragma unroll
        for (int k = 0; k < 64; ++k) { s[k] = s[k] * sh[buf][0][k] - sa * sh[buf][2][k] + vv * sh[buf][3][k]; y += s[k] * sh[buf][4][k]; }
        YS[((size_t)d * MT + m) * 256 + h * 64 + v] = y;
    }
}

__device__ __forceinline__ void d_lru_prep(int m_, int c_, LAS float* shm_, const bf16* P, LruP w, float* LA, float* LB) {
    LAS float* xs = shm_;
    const int m = m_, c = c_, h = c >> 6, i = c & 63; const Row rw = row_of(m);
    const bf16* pr = P + (size_t)m * LDP + LRU_OFF;
    float xm = w.cb[c];
#pragma unroll
    for (int j = 0; j < 4; ++j) { const int tt = rw.t + j - 2; if (tt >= 0 && tt < rw.L) xm += bf2f(pr[(ptrdiff_t)(j - 2) * LDP + c]) * w.cw[j * 256 + c]; }
    xs[c] = xm; __syncthreads();
#pragma nounroll
    for (int d = 0; d < 2; ++d) {
        float ra = w.ba[d * 256 + c], rx = w.bx[d * 256 + c];
        const float* wa = w.wa + ((size_t)(d * 4 + h) * 64) * 64 + i; const float* wx = w.wx + ((size_t)(d * 4 + h) * 64) * 64 + i;
#pragma unroll 4
        for (int j = 0; j < 64; ++j) { const float xv = xs[h * 64 + j]; ra += xv * wa[j * 64]; rx += xv * wx[j * 64]; }
        const float r = sigmoidf_(ra), ig = sigmoidf_(rx);
        const float la = -8.f * softplusf_(-w.lam[d * 256 + c]) * r;
        LA[((size_t)d * MT + m) * 256 + c] = __expf(la); LB[((size_t)d * MT + m) * 256 + c] = sqrtf(-expm1f(2.f * la)) * ig * xm;
    }
}

__device__ __forceinline__ void d_lru_scan(int bd_, int c_, const float* LA, const float* LB, float* YS) {
    const int d = bd_ & 1, b = bd_ >> 1, c = c_;
    float hst = 0.f;
    for (int st = 0; st < NSTEP; st += 8) { float a[8], bb[8]; int mm[8];
#pragma unroll
        for (int u = 0; u < 8; ++u) { mm[u] = step_row(b, d, st + u); a[u] = LA[((size_t)d * MT + mm[u]) * 256 + c]; bb[u] = LB[((size_t)d * MT + mm[u]) * 256 + c]; }
#pragma unroll
        for (int u = 0; u < 8; ++u) { hst = a[u] * hst + bb[u]; YS[((size_t)d * MT + mm[u]) * 256 + c] = hst; } }
}

__device__ __forceinline__ void d_lru_post(int m_, int c_, const float* YS, const bf16* P, bf16* MIX) {
    const int m = m_, c = c_;
    const float hs = YS[(size_t)m * 256 + c] + YS[((size_t)MT + m) * 256 + c];
    const float g = bf2f(P[(size_t)m * LDP + LRU_OFF + 256 + c]);
    const float ge = 0.5f * g * (1.f + tanhf(0.7978845608f * (g + 0.044715f * g * g * g)));
    MIX[(size_t)m * D + 768 + c] = f2bf(hs * ge);
}

typedef short bf16x4 __attribute__((ext_vector_type(4)));
#define MFMA16(a, b, c) __builtin_amdgcn_mfma_f32_16x16x16bf16_1k((a), (b), (c), 0, 0, 0)
constexpr int LSTR = 144;
constexpr int IMG = 64 * LSTR;
constexpr int ROPE_OFF = 120 * 1024;
__device__ __forceinline__ bf16x4 ldsfrag(const LAS unsigned char* img, int row, int k0) { return *(const LAS bf16x4*)(img + row * LSTR + k0 * 2); }
__device__ __forceinline__ f32x4 zero4() { return (f32x4){0.f, 0.f, 0.f, 0.f}; }
__device__ __forceinline__ f32x4 nt_tile64(const LAS unsigned char* A, int m0, const LAS unsigned char* B, int n0, int lane, f32x4 acc) {
    const int r = lane & 15, g = lane >> 4;
#pragma unroll
    for (int s = 0; s < 4; ++s) acc = MFMA16(ldsfrag(A, m0 + r, 16 * s + 4 * g), ldsfrag(B, n0 + r, 16 * s + 4 * g), acc);
    return acc;
}
__device__ __forceinline__ unsigned long long pack4(f32x4 v) { return (unsigned long long)pk2(v.x, v.y) | ((unsigned long long)pk2(v.z, v.w) << 32); }
__device__ __forceinline__ void unpack8(v4u w, float (&o)[8]) {
    o[0] = __uint_as_float(w.x << 16); o[1] = __uint_as_float(w.x & 0xffff0000u); o[2] = __uint_as_float(w.y << 16); o[3] = __uint_as_float(w.y & 0xffff0000u);
    o[4] = __uint_as_float(w.z << 16); o[5] = __uint_as_float(w.z & 0xffff0000u); o[6] = __uint_as_float(w.w << 16); o[7] = __uint_as_float(w.w & 0xffff0000u); }
struct TB { int m0, b, j, isx, t0; };
__device__ __forceinline__ TB tb_of(int tb) { TB r; if (tb < 256) { r.b = tb >> 6; r.j = tb & 63; r.isx = 1; r.m0 = tb * 64; r.t0 = r.j * 64; } else { const int q = tb - 256; r.b = q >> 2; r.j = q & 3; r.isx = 0; r.m0 = NX + q * 64; r.t0 = r.j * 64; } return r; }
__device__ __forceinline__ int chunk_of(const TB& t, int d) { return t.isx ? 4 + (d ? 63 - t.j : t.j) : (d ? 3 - t.j : t.j); }
__device__ __forceinline__ void build_rope(Frame& F) {
    LAS float* tab = (LAS float*)(F.lds + ROPE_OFF);
    for (int i = F.tid; i < 1024; i += NTHR) { const int pos = i >> 4, jj = i & 15; const float inv = __powf(10000.f, -(float)jj * (1.f / 16.f)); float sn, cs; sincosf((float)pos * inv, &sn, &cs); tab[2 * i] = cs; tab[2 * i + 1] = sn; }
}
__device__ __forceinline__ void load16(const bf16* P, int m, int col0, int dq, float (&lo)[8], float (&hi)[8]) {
    const v4u a = *(const v4u*)(P + (size_t)m * LDP + col0 + 8 * dq), b = *(const v4u*)(P + (size_t)m * LDP + col0 + 32 + 8 * dq); unpack8(a, lo); unpack8(b, hi); }
__device__ __forceinline__ void rope16(Frame& F, int t, int dq, float (&lo)[8], float (&hi)[8]) {
    const LAS float* tab = (const LAS float*)(F.lds + ROPE_OFF); const int pos = dq < 2 ? (t >> 6) : (t & 63); const int j0 = (8 * dq) & 15;
#pragma unroll
    for (int e = 0; e < 8; ++e) { const float cs = tab[2 * (pos * 16 + j0 + e)], sn = tab[2 * (pos * 16 + j0 + e) + 1]; const float a = lo[e], b = hi[e]; lo[e] = a * cs - b * sn; hi[e] = a * sn + b * cs; }
}
__device__ __forceinline__ void st_tok16(LAS unsigned char* img, int s, int dq, const float (&lo)[8], const float (&hi)[8]) {
    v4u a, b; a.x = pk2(lo[0], lo[1]); a.y = pk2(lo[2], lo[3]); a.z = pk2(lo[4], lo[5]); a.w = pk2(lo[6], lo[7]); b.x = pk2(hi[0], hi[1]); b.y = pk2(hi[2], hi[3]); b.z = pk2(hi[4], hi[5]); b.w = pk2(hi[6], hi[7]);
    *(LAS v4u*)(img + s * LSTR + 16 * dq) = a; *(LAS v4u*)(img + s * LSTR + 64 + 16 * dq) = b; }
__device__ __forceinline__ void st_chn16(LAS unsigned char* img, int s, int dq, const float (&lo)[8], const float (&hi)[8], float scale) {
#pragma unroll
    for (int e = 0; e < 8; ++e) { *(LAS bf16*)(img + (8 * dq + e) * LSTR + 2 * s) = f2bf(lo[e] * scale); *(LAS bf16*)(img + (32 + 8 * dq + e) * LSTR + 2 * s) = f2bf(hi[e] * scale); } }

__device__ __forceinline__ bf16* dz_blob(bf16* DZ, int d, int b, int h, int n) { return DZ + ((size_t)(((d * 4 + b) * 4 + h) * 68 + n)) * 4096; }
__device__ __forceinline__ void ph_ret_pre(Frame& F, const bf16* P, const float* lam, bf16* DZ) {
    const int half = F.tid >> 8, ht = F.tid & 255, s = ht & 63, dq = ht >> 6, wq = F.wave & 3, lane = F.lane;
    LAS unsigned char* hb = F.lds + RING_OFF + half * (3 * IMG);
    LAS unsigned char* KFT = hb, * KBT = hb + IMG, * VT = hb + 2 * IMG;
    for (int it = F.vcu; it < 544; it += F.G) {
        const int item = it * 2 + half, tbi = item >> 2, h = item & 3; const TB tb = tb_of(tbi);
        const float lgf = -lam[h], lgb = -lam[4 + h];
        { float lo[8], hi[8]; const int m = tb.m0 + s;
          load16(P, m, RET_OFF + 256 + h * 64, dq, lo, hi); if (tb.isx) rope16(F, tb.t0 + s, dq, lo, hi);
          st_chn16(KFT, s, dq, lo, hi, 0.125f * __expf((float)(63 - s) * lgf)); st_chn16(KBT, s, dq, lo, hi, 0.125f * __expf((float)s * lgb));
          load16(P, m, RET_OFF + 512 + h * 64, dq, lo, hi); st_chn16(VT, s, dq, lo, hi, 1.f); }
        __syncthreads();
#pragma unroll
        for (int d = 0; d < 2; ++d) { bf16* blob = dz_blob(DZ, d, tb.b, h, chunk_of(tb, d)); const LAS unsigned char* KT = d ? KBT : KFT;
#pragma unroll
            for (int vt = 0; vt < 4; ++vt) { const f32x4 acc = nt_tile64(KT, 16 * wq, VT, 16 * vt, lane, zero4());
                *(unsigned long long*)(blob + (16 * vt + (lane & 15)) * 64 + 16 * wq + 4 * (lane >> 4)) = pack4(acc); } }
        __syncthreads();
    }
}
__device__ __forceinline__ void ph_ret_prefix(Frame& F, const float* lam, bf16* DZ) {
    const int e = F.vcu * NTHR + F.tid;
    if (e >= 32 * 4096) return;
    const int seq = e >> 12, el = e & 4095, d = seq >> 4, h = seq & 3;
    const float gC = __expf(-64.f * lam[d * 4 + h]);
    bf16* base = DZ + (size_t)seq * 68 * 4096 + el; float z = 0.f;
    for (int n = 0; n < 68; n += 4) { float tmp[4];
#pragma unroll
        for (int u = 0; u < 4; ++u) tmp[u] = bf2f(base[(size_t)(n + u) * 4096]);
#pragma unroll
        for (int u = 0; u < 4; ++u) { base[(size_t)(n + u) * 4096] = f2bf(z); z = gC * z + tmp[u]; } }
}
__device__ __forceinline__ void ph_ret_post(Frame& F, const bf16* P, const float* lam, const bf16* DZ, bf16* MIX) {
    const int half = F.tid >> 8, ht = F.tid & 255, s = ht & 63, dq = ht >> 6, wq = F.wave & 3, lane = F.lane, r = lane & 15, g = lane >> 4;
    LAS unsigned char* hb = F.lds + RING_OFF + half * (4 * IMG);
    LAS unsigned char* Qi = hb, * Ki = hb + IMG, * VT = hb + 2 * IMG, * Wi = hb + 3 * IMG;
    for (int it = F.vcu; it < 544; it += F.G) {
        const int item = it * 2 + half, tbi = item >> 2, h = item & 3; const TB tb = tb_of(tbi);
        const float lgf = -lam[h], lgb = -lam[4 + h];
        { float lo[8], hi[8]; const int m = tb.m0 + s;
          load16(P, m, RET_OFF + h * 64, dq, lo, hi); if (tb.isx) rope16(F, tb.t0 + s, dq, lo, hi); st_tok16(Qi, s, dq, lo, hi);
          load16(P, m, RET_OFF + 256 + h * 64, dq, lo, hi); if (tb.isx) rope16(F, tb.t0 + s, dq, lo, hi);
#pragma unroll
          for (int e = 0; e < 8; ++e) { lo[e] *= 0.125f; hi[e] *= 0.125f; }
          st_tok16(Ki, s, dq, lo, hi);
          load16(P, m, RET_OFF + 512 + h * 64, dq, lo, hi); st_chn16(VT, s, dq, lo, hi, 1.f); }
        __syncthreads();
        const int s0 = 16 * wq, sl = s0 + r;
#pragma unroll
        for (int jt = 0; jt < 4; ++jt) { f32x4 acc = nt_tile64(Ki, 16 * jt, Qi, s0, lane, zero4());
#pragma unroll
            for (int i = 0; i < 4; ++i) { const int j = 16 * jt + 4 * g + i; const float wf = j <= sl ? __expf((float)(sl - j) * lgf) : 0.f, wb = j >= sl ? __expf((float)(j - sl) * lgb) : 0.f; acc[i] *= (wf + wb); }
            *(LAS unsigned long long*)(Wi + sl * LSTR + 2 * (16 * jt + 4 * g)) = pack4(acc); }
        LDS_WAIT();
        const bf16* Zf = dz_blob((bf16*)DZ, 0, tb.b, h, chunk_of(tb, 0)); const bf16* Zb = dz_blob((bf16*)DZ, 1, tb.b, h, chunk_of(tb, 1));
        const float ef = __expf((float)(sl + 1) * lgf), eb = __expf((float)(64 - sl) * lgb);
        f32x4 o[4]; float ssq = 0.f;
#pragma unroll
        for (int vt = 0; vt < 4; ++vt) { f32x4 aw = nt_tile64(VT, 16 * vt, Wi, s0, lane, zero4()), af = zero4(), ab = zero4();
#pragma unroll
            for (int ks = 0; ks < 4; ++ks) { const bf16x4 qf = ldsfrag(Qi, sl, 16 * ks + 4 * g);
                const bf16x4 zf = *(const bf16x4*)(Zf + (16 * vt + r) * 64 + 16 * ks + 4 * g), zb = *(const bf16x4*)(Zb + (16 * vt + r) * 64 + 16 * ks + 4 * g);
                af = MFMA16(zf, qf, af); ab = MFMA16(zb, qf, ab); }
            o[vt] = aw + af * ef + ab * eb; ssq += (o[vt].x * o[vt].x + o[vt].y * o[vt].y) + (o[vt].z * o[vt].z + o[vt].w * o[vt].w); }
        ssq += __shfl_xor(ssq, 16); ssq += __shfl_xor(ssq, 32);
        const float rs = rsqrtf(ssq * (1.f / 64.f) + 1e-6f); const int m = tb.m0 + sl;
#pragma unroll
        for (int vt = 0; vt < 4; ++vt) { const int vd = 16 * vt + 4 * g; const unsigned long long gw = *(const unsigned long long*)(P + (size_t)m * LDP + RET_OFF + 768 + h * 64 + vd);
            f32x4 y; y.x = o[vt].x * rs * siluf_(__uint_as_float((unsigned)(gw & 0xffffull) << 16)); y.y = o[vt].y * rs * siluf_(__uint_as_float((unsigned)((gw >> 16) & 0xffffull) << 16));
            y.z = o[vt].z * rs * siluf_(__uint_as_float((unsigned)((gw >> 32) & 0xffffull) << 16)); y.w = o[vt].w * rs * siluf_(__uint_as_float((unsigned)((gw >> 48) & 0xffffull) << 16));
            *(unsigned long long*)(MIX + (size_t)m * D + 256 + h * 64 + vd) = pack4(y); }
        __syncthreads();
    }
}

constexpr int IT_KP = 0, IT_RP = 8192, IT_BH = 16384, IT_UT = 24576, IT_Y0 = 32768, IT_D0 = 40960, IT_GC = 49152, ITEM_BYTES = 49664;
__device__ __forceinline__ int swz(int r, int c) { return r * 128 + (((c >> 2) ^ (r & 15)) << 3) + (c & 3) * 2; }
__device__ __forceinline__ unsigned char* item_ptr(unsigned char* BL, int seq, int n) { return BL + ((size_t)seq * 68 + n) * ITEM_BYTES; }
__device__ __forceinline__ bf16x4 cvt4(f32x4 v) { unsigned long long p = pack4(v); return __builtin_bit_cast(bf16x4, p); }
__device__ __forceinline__ f32x4 up4(unsigned long long w) { f32x4 r; r.x = __uint_as_float((unsigned)(w & 0xffffull) << 16); r.y = __uint_as_float((unsigned)((w >> 16) & 0xffffull) << 16);
    r.z = __uint_as_float((unsigned)((w >> 32) & 0xffffull) << 16); r.w = __uint_as_float((unsigned)((w >> 48) & 0xffffull) << 16); return r; }
constexpr int PI_A0 = 0, PI_A1 = 1, PI_A2 = 2, PI_A3 = 3, PI_KAPT = 4, PI_RHOT = 5, PI_VT = 6, PI_KHT = 7, PI_M1 = 8, PI_M2 = 9, PI_M3 = 10, PI_M4 = 11;
constexpr int PRE_TINV = 12 * IMG;
constexpr int PRE_ARR = PRE_TINV + 4 * 16 * 40;
__device__ __forceinline__ LAS unsigned char* pimg(Frame& F, int i) { return F.lds + RING_OFF + i * IMG; }

template <bool SCALAR>
__device__ __forceinline__ void dplr_core(Frame& F, unsigned char* item) {
    int lane = F.lane; asm volatile("" : "+v"(lane));
    const int w = F.wave, r = lane & 15, g = lane >> 4;
    const LAS float* Gs = (const LAS float*)(F.lds + RING_OFF + PRE_ARR); const LAS float* GM1 = Gs + 64; const LAS float* BETA = Gs + 128;
    if (SCALAR) {
#pragma unroll
        for (int q = 0; q < 4; ++q) { const int e = w * 4 + q, which = e >> 4, tj = (e >> 2) & 3, tt = e & 3;
            LAS unsigned char* Ma = pimg(F, which ? PI_M3 : PI_M1); LAS unsigned char* Mb = pimg(F, which ? PI_M4 : PI_M2);
            f32x4 va = zero4(), vb = zero4(); const int t = 16 * tt + r;
            if (tj <= tt) { const f32x4 acc = nt_tile64(pimg(F, PI_A0), 16 * tj, pimg(F, which ? PI_A1 : PI_A0), 16 * tt, lane, zero4());
                const float gt = which ? Gs[t] : GM1[t];
#pragma unroll
                for (int i = 0; i < 4; ++i) { const int j = 16 * tj + 4 * g + i; const bool ok = which ? (j <= t) : (j < t); const float bj = BETA[j];
                    va[i] = ok ? acc[i] * bj * __expf(gt - GM1[j]) : 0.f; vb[i] = ok ? acc[i] * bj * __expf(gt - Gs[j]) : 0.f; } }
            *(LAS unsigned long long*)(Ma + t * LSTR + 2 * (16 * tj + 4 * g)) = pack4(va); *(LAS unsigned long long*)(Mb + t * LSTR + 2 * (16 * tj + 4 * g)) = pack4(vb); }
    } else {
#pragma unroll
        for (int q = 0; q < 8; ++q) { const int e = w * 8 + q, mi = e >> 4, tj = (e >> 2) & 3, tt = e & 3;
            LAS unsigned char* M = pimg(F, PI_M1 + mi); f32x4 va = zero4(); const int t = 16 * tt + r;
            if (tj <= tt) { const f32x4 acc = nt_tile64(pimg(F, (mi & 1) ? PI_A2 : PI_A1), 16 * tj, pimg(F, (mi & 2) ? PI_A3 : PI_A0), 16 * tt, lane, zero4());
#pragma unroll
                for (int i = 0; i < 4; ++i) { const int j = 16 * tj + 4 * g + i; const bool ok = (mi & 2) ? (j <= t) : (j < t); va[i] = ok ? acc[i] : 0.f; } }
            *(LAS unsigned long long*)(M + t * LSTR + 2 * (16 * tj + 4 * g)) = pack4(va); }
    }
    __syncthreads();
    if (w == 0) { const int blk = lane >> 4, c = lane & 15; const LAS unsigned char* M1 = pimg(F, PI_M1); float x[16];
#pragma unroll
        for (int rr = 0; rr < 16; ++rr) { float a[16]; const v4u lo = *(const LAS v4u*)(M1 + (16 * blk + rr) * LSTR + 32 * blk), hi = *(const LAS v4u*)(M1 + (16 * blk + rr) * LSTR + 32 * blk + 16);
            { float t8[8]; unpack8(lo, t8);
#pragma unroll
              for (int q = 0; q < 8; ++q) a[q] = t8[q]; unpack8(hi, t8);
#pragma unroll
              for (int q = 0; q < 8; ++q) a[8 + q] = t8[q]; }
            float s = (rr == c) ? 1.f : 0.f;
#pragma unroll
            for (int j = 0; j < rr; ++j) s -= a[j] * x[j];
            x[rr] = s; }
        LAS unsigned char* TI = F.lds + RING_OFF + PRE_TINV + blk * 16 * 40;
#pragma unroll
        for (int rr = 0; rr < 16; ++rr) *(LAS bf16*)(TI + rr * 40 + 2 * c) = f2bf(x[rr]); }
    __syncthreads();
    const LAS unsigned char* M1 = pimg(F, PI_M1); const LAS unsigned char* M2 = pimg(F, PI_M2); const LAS unsigned char* M3 = pimg(F, PI_M3); const LAS unsigned char* M4 = pimg(F, PI_M4);
    const LAS unsigned char* VT = pimg(F, PI_VT);
    f32x4 x[4];
    if (w < 4) {
#pragma unroll
        for (int tb = 0; tb < 4; ++tb) { f32x4 acc = zero4();
#pragma unroll
            for (int jb = 0; jb <= tb; ++jb) acc = MFMA16(ldsfrag(M2, 16 * tb + r, 16 * jb + 4 * g), ldsfrag(VT, 16 * w + r, 16 * jb + 4 * g), acc);
            x[tb] = acc; }
    } else { const LAS unsigned char* KAPT = pimg(F, PI_KAPT);
#pragma unroll
        for (int tb = 0; tb < 4; ++tb) x[tb] = up4(*(const LAS unsigned long long*)(KAPT + (16 * (w - 4) + r) * LSTR + 2 * (16 * tb + 4 * g))); }
#pragma unroll
    for (int i = 0; i < 4; ++i) { f32x4 acc = zero4();
#pragma unroll
        for (int j = 0; j < i; ++j) acc = MFMA16(ldsfrag(M1, 16 * i + r, 16 * j + 4 * g), cvt4(x[j]), acc);
        const f32x4 rhs = x[i] - acc;
        const bf16x4 tf = *(const LAS bf16x4*)(F.lds + RING_OFF + PRE_TINV + (i * 16 + r) * 40 + 8 * g);
        x[i] = MFMA16(tf, cvt4(rhs), zero4()); }
    if (w < 4) {
        const int v = 16 * w + r; bf16* UT = (bf16*)(item + IT_UT) + v * 64; bf16* Y0T = (bf16*)(item + IT_Y0) + v * 64; bf16* D0T = (bf16*)(item + IT_D0) + v * 64;
        const LAS unsigned char* KHT = pimg(F, PI_KHT);
#pragma unroll
        for (int tb = 0; tb < 4; ++tb) { *(unsigned long long*)(UT + 16 * tb + 4 * g) = pack4(x[tb]);
            f32x4 a4 = zero4(), a3 = zero4();
#pragma unroll
            for (int jb = 0; jb <= tb; ++jb) { a4 = MFMA16(ldsfrag(M4, 16 * tb + r, 16 * jb + 4 * g), ldsfrag(VT, v, 16 * jb + 4 * g), a4); a3 = MFMA16(ldsfrag(M3, 16 * tb + r, 16 * jb + 4 * g), cvt4(x[jb]), a3); }
            *(unsigned long long*)(Y0T + 16 * tb + 4 * g) = pack4(a4 - a3);
            f32x4 d0 = zero4();
#pragma unroll
            for (int sb = 0; sb < 4; ++sb) d0 = MFMA16(ldsfrag(KHT, 16 * tb + r, 16 * sb + 4 * g), ldsfrag(VT, v, 16 * sb + 4 * g), d0);
            *(unsigned long long*)(D0T + 16 * tb + 4 * g) = pack4(d0); }
    } else {
        const int k = 16 * (w - 4) + r; const LAS unsigned char* RHOT = pimg(F, PI_RHOT); LAS unsigned char* KPi = pimg(F, PI_A0); LAS unsigned char* RPi = pimg(F, PI_A1);
#pragma unroll
        for (int tb = 0; tb < 4; ++tb) { f32x4 a3 = zero4();
#pragma unroll
            for (int jb = 0; jb <= tb; ++jb) a3 = MFMA16(ldsfrag(M3, 16 * tb + r, 16 * jb + 4 * g), cvt4(x[jb]), a3);
            const f32x4 rp = up4(*(const LAS unsigned long long*)(RHOT + k * LSTR + 2 * (16 * tb + 4 * g))) - a3;
#pragma unroll
            for (int i = 0; i < 4; ++i) { const int t = 16 * tb + 4 * g + i; *(LAS bf16*)(KPi + swz(t, k)) = f2bf(x[tb][i]); *(LAS bf16*)(RPi + swz(t, k)) = f2bf(rp[i]); } }
    }
    __syncthreads();
    { const v4u a = *(const LAS v4u*)(pimg(F, PI_A0) + F.tid * 16), b = *(const LAS v4u*)(pimg(F, PI_A1) + F.tid * 16);
      *(v4u*)(item + IT_KP + F.tid * 16) = a; *(v4u*)(item + IT_RP + F.tid * 16) = b; }
    __syncthreads();
}

__device__ __forceinline__ void gdn_pre_item(Frame& F, const bf16* P, const float* cw, const float* alog, const float* dtb, unsigned char* BL, int tbi, int h, int d) {
    const TB tb = tb_of(tbi); const int w = F.wave, lane = F.lane, L = tb.isx ? SEQ : CTXL;
    LAS float* Gs = (LAS float*)(F.lds + RING_OFF + PRE_ARR); LAS float* GM1 = Gs + 64; LAS float* BETA = Gs + 128; LAS float* LAa = Gs + 192;
    const int seq = (d * 4 + tb.b) * 4 + h; unsigned char* item = item_ptr(BL, seq, chunk_of(tb, d));
    float qv[8], kv[8], vv[8];
    const float Aexp = __expf(alog[d * 4 + h]), dt = dtb[d * 4 + h];
#pragma unroll
    for (int u = 0; u < 8; ++u) { const int s = 8 * w + u, tau = d ? 63 - s : s, m = tb.m0 + tau, t = tb.t0 + tau; const bf16* pr = P + (size_t)m * LDP + GDN_OFF + h * 64 + lane;
        float o[3];
#pragma unroll
        for (int c3 = 0; c3 < 3; ++c3) { float a = 0.f;
#pragma unroll
            for (int j = 0; j < 4; ++j) { const int tt = t + j - 2; if (tt >= 0 && tt < L) a += bf2f(pr[(ptrdiff_t)(j - 2) * LDP + c3 * 256]) * cw[j * 768 + c3 * 256 + h * 64 + lane]; }
            o[c3] = siluf_(a); }
        const float qs = wave_sum(o[0] * o[0]), ks = wave_sum(o[1] * o[1]);
        qv[u] = o[0] * rsqrtf(qs + 1e-6f) * 0.125f; kv[u] = o[1] * rsqrtf(ks + 1e-6f); vv[u] = o[2];
        if (lane == 0) { const float ar = bf2f(P[(size_t)m * LDP + GDN_OFF + 768 + d * 4 + h]), br = bf2f(P[(size_t)m * LDP + GDN_OFF + 776 + d * 4 + h]);
            LAa[s] = -Aexp * softplusf_(ar + dt); BETA[s] = sigmoidf_(br); } }
    __syncthreads();
    if (w == 0) { const float la = LAa[lane]; float gsum = la;
#pragma unroll
        for (int o = 1; o < 64; o <<= 1) { const float t = __shfl_up(gsum, o); if (lane >= o) gsum += t; }
        Gs[lane] = gsum; GM1[lane] = gsum - la; }
    __syncthreads();
    const float gc = Gs[63];
#pragma unroll
    for (int u = 0; u < 8; ++u) { const int s = 8 * w + u; const float gg = Gs[s], gm = GM1[s], be = BETA[s];
        *(LAS bf16*)(pimg(F, PI_A0) + s * LSTR + 2 * lane) = f2bf(kv[u]); *(LAS bf16*)(pimg(F, PI_A1) + s * LSTR + 2 * lane) = f2bf(qv[u]);
        *(LAS bf16*)(pimg(F, PI_KAPT) + lane * LSTR + 2 * s) = f2bf(kv[u] * __expf(gm)); *(LAS bf16*)(pimg(F, PI_RHOT) + lane * LSTR + 2 * s) = f2bf(qv[u] * __expf(gg));
        *(LAS bf16*)(pimg(F, PI_VT) + lane * LSTR + 2 * s) = f2bf(vv[u]); *(LAS bf16*)(pimg(F, PI_KHT) + lane * LSTR + 2 * s) = f2bf(be * kv[u] * __expf(gc - gg));
        *(bf16*)(item + IT_BH + swz(lane, s)) = f2bf(be * kv[u] * __expf(gc - gm)); }
    if (w == 0) ((float*)(item + IT_GC))[lane] = __expf(gc);
    __syncthreads();
    dplr_core<true>(F, item);
}
__device__ __forceinline__ void ph_gdn_pre(Frame& F, const bf16* P, const float* cw, const float* alog, const float* dtb, unsigned char* BL) {
    for (int it = F.vcu; it < 272 * 8; it += F.G) { const int tbi = it >> 3, h = (it >> 1) & 3, d = it & 1; gdn_pre_item(F, P, cw, alog, dtb, BL, tbi, h, d); }
}

constexpr int SLOT_BYTES = 24576;
__device__ __forceinline__ void dplr_scan_seq(Frame& F, const unsigned char* BL, int seq, float* YS) {
    const int w = F.wave, lane = F.lane, r = lane & 15, g = lane >> 4;
    const int d = seq >> 4, b = (seq >> 2) & 3, h = seq & 3;
    LAS unsigned char* ring = F.lds + RING_OFF;
    if (w >= 4) {
        const int lw = w - 4;
#define SCAN_ISSUE(n) do { const unsigned char* src = BL + ((size_t)seq * 68 + (n)) * ITEM_BYTES + lw * 6144 + lane * 16; LAS unsigned char* dst = ring + ((n) & 3) * SLOT_BYTES + lw * 6144; \
        _Pragma("unroll") for (int q = 0; q < 6; ++q) __builtin_amdgcn_global_load_lds((const unsigned*)(src + q * 1024), (LAS unsigned*)(dst + q * 1024), 16, 0, 0); } while (0)
        SCAN_ISSUE(0); SCAN_ISSUE(1); SCAN_ISSUE(2);
        asm volatile("s_waitcnt vmcnt(12)" ::: "memory");
        __builtin_amdgcn_s_barrier(); asm volatile("" ::: "memory");
        for (int n = 0; n < 68; ++n) {
            if (n + 3 < 68) { SCAN_ISSUE(n + 3); asm volatile("s_waitcnt vmcnt(12)" ::: "memory"); }
            else asm volatile("s_waitcnt vmcnt(0)" ::: "memory");
            __builtin_amdgcn_s_barrier(); asm volatile("" ::: "memory");
        }
#undef SCAN_ISSUE
    } else {
        const int v = 16 * w + r;
        f32x4 z[4];
#pragma unroll
        for (int kb = 0; kb < 4; ++kb) z[kb] = zero4();
        __builtin_amdgcn_s_barrier();
        for (int n = 0; n < 68; ++n) {
            const unsigned char* item = BL + ((size_t)seq * 68 + n) * ITEM_BYTES; const LAS unsigned char* slot = ring + (n & 3) * SLOT_BYTES;
            const bf16* UT = (const bf16*)(item + IT_UT) + v * 64; const bf16* Y0T = (const bf16*)(item + IT_Y0) + v * 64; const bf16* D0T = (const bf16*)(item + IT_D0) + v * 64; const float* GC = (const float*)(item + IT_GC);
            unsigned long long ut[4], y0[4], d0[4]; f32x4 gcv[4];
#pragma unroll
            for (int q = 0; q < 4; ++q) { ut[q] = *(const unsigned long long*)(UT + 16 * q + 4 * g); y0[q] = *(const unsigned long long*)(Y0T + 16 * q + 4 * g); d0[q] = *(const unsigned long long*)(D0T + 16 * q + 4 * g); gcv[q] = *(const f32x4*)(GC + 16 * q + 4 * g); }
            bf16x4 zb[4];
#pragma unroll
            for (int kb = 0; kb < 4; ++kb) zb[kb] = cvt4(z[kb]);
            f32x4 sa[4], y[4];
#pragma unroll
            for (int tt = 0; tt < 4; ++tt) { f32x4 a = up4(ut[tt]), c = up4(y0[tt]); const int row = 16 * tt + r;
#pragma unroll
                for (int kb = 0; kb < 4; ++kb) { const int off = row * 128 + (((4 * kb + g) ^ r) << 3);
                    a = MFMA16(*(const LAS bf16x4*)(slot + IT_KP + off), zb[kb], a); c = MFMA16(*(const LAS bf16x4*)(slot + IT_RP + off), zb[kb], c); }
                sa[tt] = a; y[tt] = c; }
            bf16x4 sb[4];
#pragma unroll
            for (int tt = 0; tt < 4; ++tt) sb[tt] = cvt4(sa[tt]);
#pragma unroll
            for (int kb = 0; kb < 4; ++kb) { f32x4 a = zero4(); const int row = 16 * kb + r;
#pragma unroll
                for (int tt = 0; tt < 4; ++tt) a = MFMA16(*(const LAS bf16x4*)(slot + IT_BH + row * 128 + (((4 * tt + g) ^ r) << 3)), sb[tt], a);
                z[kb] = gcv[kb] * z[kb] + up4(d0[kb]) - a; }
            { int m0; if (n < 4) { const int j = d ? 3 - n : n; m0 = NX + (b * 4 + j) * 64; } else { const int j = d ? 63 - (n - 4) : (n - 4); m0 = (b * 64 + j) * 64; }
              float* yb = YS + ((size_t)d * MT + m0) * 256 + h * 64 + v;
#pragma unroll
              for (int tt = 0; tt < 4; ++tt)
#pragma unroll
                  for (int i = 0; i < 4; ++i) { const int t = 16 * tt + 4 * g + i, tau = d ? 63 - t : t; yb[(size_t)tau * 256] = y[tt][i]; } }
            asm volatile("" ::: "memory"); __builtin_amdgcn_s_barrier(); asm volatile("" ::: "memory");
        }
    }
}

__device__ __forceinline__ void rwkv_pre_item(Frame& F, const bf16* P, const RwP& wp, int layer, float* VF, float* SV, float* GB, float* BSC, unsigned char* BL, int tbi, int h, int d) {
    const TB tb = tb_of(tbi); const int w = F.wave, lane = F.lane, L = tb.isx ? SEQ : CTXL, c = h * 64 + lane;
    LAS float* WT = (LAS float*)(F.lds + RING_OFF + PRE_ARR);
    const int seq = (d * 4 + tb.b) * 4 + h; unsigned char* item = item_ptr(BL, seq, chunk_of(tb, d));
    float rv[8], kn[8], kd[8], bv[8], vv[8], lwv[8], gl[8]; float run = 0.f;
    {   float w2r[32], a2r[32];
#pragma unroll
        for (int j = 0; j < 32; ++j) { w2r[j] = wp.w2[(d * 32 + j) * 256 + c]; a2r[j] = wp.a2[(d * 32 + j) * 256 + c]; }
        const float w0c = wp.w0[d * 256 + c], a0c = wp.a0[d * 256 + c], kkc = wp.kk[c], kac = wp.ka[c], rkc = wp.rk[c];
        const float mur = wp.mu[c], muk = wp.mu[256 + c], muv = wp.mu[512 + c];
        const int wacol = lane < 32 ? 768 + d * 32 + lane : 832 + d * 32 + (lane - 32); const float muw = wp.mu[wacol];
#pragma unroll
        for (int u = 0; u < 8; ++u) { const int s = 8 * w + u, tau = d ? 63 - s : s, m = tb.m0 + tau, t = tb.t0 + tau; const bf16* pr = P + (size_t)m * LDP; const bool hp = t > 0, hn = t < L - 1;
#define SHF(col, mu_) ([&]() { const float p_ = bf2f(pr[(col)]); const float pp_ = hp ? bf2f(pr[(col) - LDP]) : 0.f; const float pn_ = hn ? bf2f(pr[(col) + LDP]) : 0.f; return p_ + (0.5f * (pp_ + pn_) - p_) * (mu_); }())
            const float r = SHF(c, mur), kraw = SHF(256 + c, muk); const float v = SHF(512 + c, muv); const float wav = SHF(wacol, muw);
#undef SHF
            const float wa = lane < 32 ? tanhf(wav) : wav;
            float z = w0c, za = a0c;
#pragma unroll
            for (int j = 0; j < 32; ++j) { z += __int_as_float(__builtin_amdgcn_readlane(__float_as_int(wa), j)) * w2r[j]; za += __int_as_float(__builtin_amdgcn_readlane(__float_as_int(wa), 32 + j)) * a2r[j]; }
            const float lw = -0.6065306597f * sigmoidf_(z), a = sigmoidf_(za);
            const float kkr = kraw * kkc; const float kkn = kkr * rsqrtf(wave_sum(kkr * kkr) + 1e-6f);
            const float kdv = kraw * (1.f + (a - 1.f) * kac);
            const float bs = wave_sum(r * kdv * rkc);
            if (lane == 0) BSC[((size_t)d * MT + m) * 4 + h] = bs;
            run += lw; rv[u] = r; kn[u] = kkn; kd[u] = kdv; bv[u] = kkn * a; vv[u] = v; lwv[u] = lw; gl[u] = run;
            asm volatile("" ::: "memory"); }
    }
    if (layer) { float v2r[32]; const float v0c = wp.v0[c];
#pragma unroll
        for (int j = 0; j < 32; ++j) v2r[j] = wp.v2[j * 256 + c];
#pragma unroll
        for (int u = 0; u < 8; ++u) { const int s = 8 * w + u, tau = d ? 63 - s : s, m = tb.m0 + tau; const float vdl = lane < 32 ? bf2f(P[(size_t)m * LDP + VRES_OFF + lane]) : 0.f; float zv = v0c;
#pragma unroll
            for (int j = 0; j < 32; ++j) zv += __int_as_float(__builtin_amdgcn_readlane(__float_as_int(vdl), j)) * v2r[j];
            vv[u] = vv[u] + (VF[(size_t)m * 256 + c] - vv[u]) * sigmoidf_(zv); asm volatile("" ::: "memory"); } }
    if (d == 0) {
#pragma unroll
        for (int u = 0; u < 8; ++u) { const int m = tb.m0 + 8 * w + u; if (!layer) VF[(size_t)m * 256 + c] = vv[u]; SV[(size_t)m * 256 + c] = vv[u]; } }
    WT[w * 64 + lane] = run;
    __syncthreads();
    float off = 0.f, gc = 0.f;
#pragma unroll
    for (int q = 0; q < 8; ++q) { const float t = WT[q * 64 + lane]; gc += t; if (q < w) off += t; }
#pragma unroll
    for (int u = 0; u < 8; ++u) { const int s = 8 * w + u; const float G = off + gl[u]; const float eg = __expf(G), eng = __expf(-G), egc = __expf(gc - G); const bf16 kap = f2bf(kn[u] * __expf(G - lwv[u])), rho = f2bf(rv[u] * eg);
        *(LAS bf16*)(pimg(F, PI_A0) + s * LSTR + 2 * lane) = kap; *(LAS bf16*)(pimg(F, PI_KAPT) + lane * LSTR + 2 * s) = kap;
        *(LAS bf16*)(pimg(F, PI_A1) + s * LSTR + 2 * lane) = f2bf(bv[u] * eng); *(LAS bf16*)(pimg(F, PI_A2) + s * LSTR + 2 * lane) = f2bf(kd[u] * eng);
        *(LAS bf16*)(pimg(F, PI_A3) + s * LSTR + 2 * lane) = rho; *(LAS bf16*)(pimg(F, PI_RHOT) + lane * LSTR + 2 * s) = rho;
        *(LAS bf16*)(pimg(F, PI_VT) + lane * LSTR + 2 * s) = f2bf(vv[u]); *(LAS bf16*)(pimg(F, PI_KHT) + lane * LSTR + 2 * s) = f2bf(kd[u] * egc);
        *(bf16*)(item + IT_BH + swz(lane, s)) = f2bf(bv[u] * egc); }
    if (w == 0) ((float*)(item + IT_GC))[lane] = __expf(gc);
    if (d == 0) { const float mug = wp.mu[896 + lane];
        float gacc[8];
#pragma unroll
        for (int u = 0; u < 8; ++u) { const int s = 8 * w + u, m = tb.m0 + s, t = tb.t0 + s; const bf16* pr = P + (size_t)m * LDP; const bool hp = t > 0, hn = t < L - 1;
            const float p_ = bf2f(pr[896 + lane]); const float pp_ = hp ? bf2f(pr[896 + lane - LDP]) : 0.f; const float pn_ = hn ? bf2f(pr[896 + lane + LDP]) : 0.f;
            gacc[u] = sigmoidf_(p_ + (0.5f * (pp_ + pn_) - p_) * mug); }
        float gs[8];
#pragma unroll
        for (int u = 0; u < 8; ++u) gs[u] = 0.f;
#pragma unroll 4
        for (int j = 0; j < 64; ++j) { const float g2v = wp.g2[j * 256 + c];
#pragma unroll
            for (int u = 0; u < 8; ++u) gs[u] += __shfl(gacc[u], j) * g2v; }
#pragma unroll
        for (int u = 0; u < 8; ++u) GB[(size_t)(tb.m0 + 8 * w + u) * 256 + c] = gs[u]; }
    __syncthreads();
    dplr_core<false>(F, item);
}
__device__ __forceinline__ void ph_rwkv_pre(Frame& F, const bf16* P, const RwP& wp, int layer, float* VF, float* SV, float* GB, float* BSC, unsigned char* BL) {
    for (int it = F.vcu; it < 272 * 8; it += F.G) { const int tbi = it >> 3, h = (it >> 1) & 3, d = it & 1; rwkv_pre_item(F, P, wp, layer, VF, SV, GB, BSC, BL, tbi, h, d); }
}
__device__ __forceinline__ void d_rwkv_post2(int m_, int c_, const float* YS, const float* BSC, const float* SV, const float* G, const float* lnw, const float* lnb, bf16* MIX) {
    const int m = m_, c = c_, h = c >> 6;
    const float y = YS[(size_t)m * 256 + c] + YS[((size_t)MT + m) * 256 + c];
    const float mu = wave_sum(y) * (1.f / 64.f); const float dlt = y - mu; const float var = wave_sum(dlt * dlt) * (1.f / 64.f);
    const float yn = dlt * rsqrtf(var + 64e-5f);
    const float bon = (BSC[(size_t)m * 4 + h] + BSC[((size_t)MT + m) * 4 + h]) * SV[(size_t)m * 256 + c];
    MIX[(size_t)m * D + c] = f2bf((yn * lnw[c] + lnb[c] + bon) * G[(size_t)m * 256 + c]);
}

__device__ __forceinline__ void ph_final_norm(Frame& F, const float* XR, const float* gain, float* out) {
    const int gw = F.vcu * NWAVES + F.wave, NGW = F.G * NWAVES, lane = F.lane;
    for (int m = gw; m < NX; m += NGW) {
        const float* src = XR + (size_t)m * D; f32x4 v[4]; float ss = 0.f;
#pragma unroll
        for (int j = 0; j < 4; ++j) { v[j] = *(const f32x4*)(src + 4 * lane + 256 * j); ss += (v[j].x * v[j].x + v[j].y * v[j].y) + (v[j].z * v[j].z + v[j].w * v[j].w); }
        ss = wave_sum(ss); const float rs = rsqrtf(ss * (1.f / D) + 1e-6f);
#pragma unroll
        for (int j = 0; j < 4; ++j) { const int ci = 4 * lane + 256 * j; *(f32x4*)(out + (size_t)m * D + ci) = v[j] * rs * *(const f32x4*)(gain + ci); }
    }
}

#define INP(i) ([&]() { int ii_ = (i); asm volatile("" : "+s"(ii_)); return a.in[ii_]; }())
#ifndef PH_MASK
#define PH_MASK 0xfffff
#endif
#define IN(k) ((PH_MASK >> (k)) & 1)
#define SEAM() xcd_barrier(bar)
#define MOD ((float*)(wsb + WS_MOD))
#define XN ((bf16*)(wsb + WS_XN))
#define XR ((float*)(wsb + WS_XR))
#define P ((bf16*)(wsb + WS_P))
#define WIN_T ((bf16*)(wsb + WS_WIN))
#define WOUT_T ((bf16*)(wsb + WS_WOUT))
#define VF ((float*)(wsb + WS_VF))
#define BON ((float*)(wsb + WS_BON))
#define GG ((float*)(wsb + WS_G))
#define YS ((float*)(wsb + WS_YS))
#define SV ((float*)(wsb + WS_SV))
#define SI ((float*)(wsb + WS_SI))
#define WGU_T ((bf16*)(wsb + WS_WGU))
#define WD_T ((bf16*)(wsb + WS_WD))
#define HACT ((bf16*)(wsb + WS_HACT))
#define Y ((bf16*)(wsb + WS_Y))
#define DZ ((bf16*)(wsb + WS_DZ))
#define LIST ((unsigned*)(wsb + WS_LIST))
#define SLOTPOS ((int*)(wsb + WS_SLOT))
#define SLOTG ((float*)(wsb + WS_SLOT + (size_t)MT * 8 * 4))
#define MIX XN
#define PH() do { wsb = ws; asm volatile("" : "+s"(wsb)); int t_ = threadIdx.x; asm volatile("" : "+v"(t_)); F.tid = t_; F.lane = t_ & 63; F.wave = __builtin_amdgcn_readfirstlane(t_ >> 6); half = t_ >> 8; c256 = t_ & 255; \
        shh = (LAS float*)(F.lds + RING_OFF + half * 8192); } while (0)

template <int l>
__device__ __forceinline__ void layer_body(Frame& F, const MArgs& a, const XcdBarrier& bar, unsigned char* ws) {
    unsigned char* wsb = ws; int half = 0, c256 = 0; LAS float* shh = nullptr;
        const float* MODl = MOD + (size_t)l * 5 * 6144;
        const float* xs = l == 0 ? INP(I_X) : XR; const float* cs = l == 0 ? INP(I_CTX) : XR + (size_t)NX * D;
        const int ntok = l == 0 ? MT : NX;
        if (IN(1)) { PH(); ph_norm_mod(F, xs, cs, INP(I_NMIX) + l * D, MODl, 0, XN, MT); SEAM(); }
        if (IN(2)) { PH(); pg8::DenseOrder S; S.init(XN, WIN_T + (size_t)l * LDP * D, MT, LDP, D, F.G, (int)blockIdx.x); pg8::EpiStoreBf16 E{P, LDP};
            pg8::gemm_phase<pg8::EpiStoreBf16, pg8::DenseOrder, true>(F.lds + RING_OFF, D, S, E); SEAM(); }
        float* LA = SI; float* LB = SI + (size_t)2 * MT * 256;
        if (IN(3)) { PH(); const RwP rwp{INP(I_RWMU) + l * 960, INP(I_RWW0) + l * 512, INP(I_RWW2) + l * 2 * 32 * 256, INP(I_RWA0) + l * 512, INP(I_RWA2) + l * 2 * 32 * 256, INP(I_RWG2) + l * 64 * 256, INP(I_RWKK) + l * 256, INP(I_RWKA) + l * 256,
                      INP(I_RWRK) + l * 256, INP(I_RWV0), INP(I_RWV2)};
            ph_rwkv_pre(F, P, rwp, l, VF, SV, GG, BON  , (unsigned char*)SI); __syncthreads();
            build_rope(F); __syncthreads(); ph_ret_pre(F, P, INP(I_RETL) + l * 8, DZ); SEAM(); }
        if (IN(4)) { PH(); if (blockIdx.x < 32) dplr_scan_seq(F, (const unsigned char*)SI, (int)blockIdx.x, YS); ph_ret_prefix(F, INP(I_RETL) + l * 8, DZ); SEAM(); }
        if (IN(5)) { PH(); for (int it = F.vcu; it < MT / 2; it += F.G) { const int m = it * 2 + half; d_rwkv_post2(m, c256, YS, BON, SV, GG, INP(I_RWLNW) + l * 256, INP(I_RWLNB) + l * 256, MIX);
                }
            build_rope(F); __syncthreads(); ph_ret_post(F, P, INP(I_RETL) + l * 8, DZ, MIX); __syncthreads();
            ph_gdn_pre(F, P, INP(I_GCW) + l * 4 * 768, INP(I_GALOG) + l * 8, INP(I_GDT) + l * 8, (unsigned char*)SI); SEAM(); }
        if (IN(8)) { PH(); if (blockIdx.x < 32) dplr_scan_seq(F, (const unsigned char*)SI, (int)blockIdx.x, YS); SEAM(); }
        if (IN(9)) { PH(); const LruP lrp{INP(I_LCW) + l * 4 * 256, INP(I_LCB) + l * 256, INP(I_LWA) + (size_t)l * 2 * 4 * 64 * 64, INP(I_LBA) + l * 512, INP(I_LWX) + (size_t)l * 2 * 4 * 64 * 64, INP(I_LBX) + l * 512, INP(I_LLAM) + l * 512};
            for (int it = F.vcu; it < MT / 2; it += F.G) { const int m = it * 2 + half; d_hnorm_post(m, c256, YS, P, GDN_OFF + 784, INP(I_GNW) + l * 64, MIX, 512);
                d_lru_prep(m, c256, shh, P, lrp, LA, LB); __syncthreads(); } SEAM(); }
        if (IN(10)) { PH(); if (blockIdx.x < 4) d_lru_scan(blockIdx.x * 2 + half, c256, LA, LB, YS); SEAM(); }
        if (IN(11)) { PH(); for (int it = F.vcu; it < MT / 2; it += F.G) { const int m = it * 2 + half; d_lru_post(m, c256, YS, P, MIX); } SEAM(); }
        if (IN(12)) { PH(); pg8::DenseOrder S; S.init(MIX, WOUT_T + (size_t)l * D * D, MT, D, D, F.G, (int)blockIdx.x); pg8::EpiResidual E{xs, cs, MODl, XR};
            pg8::gemm_phase<pg8::EpiResidual, pg8::DenseOrder, true>(F.lds + RING_OFF, D, S, E); SEAM(); }
        if (IN(13)) { PH(); ph_route(F, XR, INP(I_NFFN) + l * D, MODl, INP(I_RTW) + (size_t)l * D * NE, INP(I_RTB) + l * NE, XN, l, LIST, SLOTPOS, SLOTG, ntok); __syncthreads();
            ph_convert_experts(F, INP(I_EWG) + (size_t)l * NE * D * EFF, INP(I_EWU) + (size_t)l * NE * D * EFF, INP(I_EWD) + (size_t)l * NE * EFF * D,
                               INP(I_SWG) + (size_t)l * D * EFF, INP(I_SWU) + (size_t)l * D * EFF, INP(I_SWD) + (size_t)l * EFF * D, WGU_T, WD_T);
            SEAM(); }
        if (IN(14)) { PH(); moe_build_tab(F, l, ntok); MoeTab T = moe_tab(F);
            pg8::MoeOrder1 S{XN, WGU_T, LIST, T, F.G, (int)blockIdx.x, T.ups[65] * 2}; pg8::EpiSwiglu E{HACT};
            pg8::gemm_phase<pg8::EpiSwiglu, pg8::MoeOrder1, true>(F.lds + RING_OFF, D, S, E); SEAM(); }
        if (IN(15)) { PH(); moe_build_tab(F, l, ntok); MoeTab T = moe_tab(F);
            pg8::MoeOrder2 S{HACT, WD_T, T, F.G, (int)blockIdx.x, T.ups[65] * 4}; pg8::EpiDown E{Y, XR, MODl};
            int k2 = EFF; asm volatile("" : "+s"(k2));
            pg8::gemm_phase<pg8::EpiDown, pg8::MoeOrder2, true>(F.lds + RING_OFF, k2, S, E); SEAM(); }
        if (IN(16)) { PH(); moe_build_tab(F, l, ntok); ph_combine(F, Y, SLOTPOS, SLOTG, MODl, XR, ntok); SEAM(); }
    }

__global__ void __launch_bounds__(NTHR, 2) mega(MArgs a) {
    extern __shared__ __attribute__((aligned(16))) unsigned char lds_raw[];
    Frame F; F.lds = (LAS unsigned char*)lds_raw; F.MISC = (volatile LAS unsigned*)(F.lds + MISC_OFF);
    F.tid = threadIdx.x; F.lane = F.tid & 63; F.wave = __builtin_amdgcn_readfirstlane(F.tid >> 6);
    F.G = gridDim.x; { const int bx = blockIdx.x; F.vcu = (F.G % 8 == 0) ? (bx % 8) * (F.G / 8) + bx / 8 : bx; }
    unsigned char* ws = a.ws; F.ctl = (gu32*)ws;
    for (int u = F.tid; u < (LDS_BYTES - LDSCTL_OFF) / 4; u += NTHR) ((LAS unsigned*)(F.lds + LDSCTL_OFF))[u] = 0u;
    __syncthreads();
    XcdBarrier bar = xcd_barrier_post((unsigned*)(F.ctl + CW_BAR) + a.bar_region * XCD_BAR_WORDS, F.MISC + 8);
    unsigned char* wsb = ws;
    int half = 0, c256 = 0; LAS float* shh = nullptr;

    if (IN(0)) { PH(); ph_mod(F, INP(I_C), INP(I_CCTX), INP(I_ADAW), INP(I_ADAB), MOD); ph_convert_small(F, INP(I_WIN), INP(I_WVRES), INP(I_WOUT), WIN_T, WOUT_T); SEAM(); }
    layer_body<0>(F, a, bar, ws);
    layer_body<1>(F, a, bar, ws);
    if (IN(17)) { PH(); ph_final_norm(F, XR, INP(I_NFIN), a.out); }
#undef PH
#undef MOD
#undef XN
#undef XR
#undef P
#undef WIN_T
#undef WOUT_T
#undef VF
#undef BON
#undef GG
#undef YS
#undef SV
#undef SI
#undef WGU_T
#undef WD_T
#undef HACT
#undef Y
#undef DZ
#undef LIST
#undef SLOTPOS
#undef SLOTG
#undef MIX
#undef IN
#undef SEAM
}

extern "C" void kernel_launch(void* const* d_in, const int* in_sizes, int n_in, void* d_out, int out_size, void* d_ws, size_t ws_size, hipStream_t stream) {
    static int grid = 0;
    if (grid == 0) {
        if (n_in != I_N || ws_size < WS_END) { fprintf(stderr, "kernel_launch: bad n_in %d or ws %zu\n", n_in, ws_size); grid = -1; return; }
        int dev = 0, cus = 0;
        if (hipGetDevice(&dev) != hipSuccess || hipDeviceGetAttribute(&cus, hipDeviceAttributeMultiprocessorCount, dev) != hipSuccess) { grid = -1; return; }
        if (hipFuncSetAttribute((const void*)mega, hipFuncAttributeMaxDynamicSharedMemorySize, LDS_BYTES) != hipSuccess) { grid = -1; return; }
        int per_cu = 0; (void)hipOccupancyMaxActiveBlocksPerMultiprocessor(&per_cu, (const void*)mega, NTHR, LDS_BYTES); (void)hipGetLastError();
        grid = cus;
    }
    if (grid < 0) return;
    unsigned char* ws = (unsigned char*)d_ws;
    (void)hipMemsetAsync(ws, 0, CTL_ZERO_BYTES, stream);
    MArgs ma{}; for (int i = 0; i < I_N; ++i) ma.in[i] = (const float*)d_in[i]; ma.out = (float*)d_out; ma.ws = ws;
    ma.ph_lo = 0; ma.ph_hi = 18; ma.l_lo = 0; ma.l_hi = 2; ma.bar_region = 0;
    hipLaunchKernelGGL(mega, dim3(grid), dim3(NTHR), LDS_BYTES, stream, ma);
}
```

```cpp
#include <hip/hip_runtime.h>
#include <cstdio>
#include <cstdint>

typedef unsigned short bf16;
#ifndef PROBE_SEC
#define PROBE_SEC -1
#endif
__device__ unsigned long long g_tsec_dummy;
#define TSEC_BEGIN(id) unsigned long long ts0_##id = 0; if ((id) == PROBE_SEC) { asm volatile("s_waitcnt vmcnt(0) lgkmcnt(0)" ::: "memory"); ts0_##id = clock64(); }
#define TSECN_BEGIN(id) unsigned long long tn0_##id = 0; if ((id) == PROBE_SEC) { tn0_##id = clock64(); }
#define TSECN_END(id) if ((id) == PROBE_SEC) { F.tacc += clock64() - tn0_##id; }
#define TSEC_END(id) if ((id) == PROBE_SEC) { asm volatile("s_waitcnt vmcnt(0) lgkmcnt(0)" ::: "memory"); F.tacc += clock64() - ts0_##id; }
#ifndef PROBE_MASK
#define PROBE_MASK 0
#endif
#define REPS(k) (((PROBE_MASK >> (k)) & 1) ? 2 : 1)
#define RR(k) ([]() { int r_ = REPS(k); asm volatile("" : "+s"(r_)); return r_; }())
__device__ __forceinline__ float bf2f(bf16 v) { return __uint_as_float(((unsigned)v) << 16); }
typedef float f32x2_ __attribute__((ext_vector_type(2)));
typedef __bf16 bf16x2_ __attribute__((ext_vector_type(2)));
__device__ __forceinline__ unsigned cvtpk_bf16(float lo, float hi) { f32x2_ v = {lo, hi}; bf16x2_ b = __builtin_convertvector(v, bf16x2_); return __builtin_bit_cast(unsigned, b); }
__device__ __forceinline__ bf16 f2bf(float f) { return (bf16)(cvtpk_bf16(f, f) & 0xffffu); }

constexpr int D = 1024, NB = 4, SEQ = 4096, CTXL = 256;
constexpr int NX = NB * SEQ;
constexpr int NC = NB * CTXL;
constexpr int MT = NX + NC;
constexpr int NIN = 3536, NINV = 3568, LDP = 3584;
constexpr int RW_OFF = 0, RET_OFF = 960, GDN_OFF = 1984, LRU_OFF = 3024, VRES_OFF = 3536;
constexpr int NE = 64, TOPK = 8, EFF = 256;
constexpr int NSTEP = CTXL + SEQ;

constexpr size_t MiB = 1u << 20;
constexpr size_t WS_MOD = 1 * MiB;
constexpr size_t WS_XN = 2 * MiB;
constexpr size_t WS_XR = 36 * MiB;
constexpr size_t WS_VF = 104 * MiB;
constexpr size_t WS_LIST = 121 * MiB;
constexpr size_t WS_SLOTG = 126 * MiB;
constexpr size_t WS_RTW = 127 * MiB;
constexpr size_t WS_SLOT = 130 * MiB;
constexpr size_t WS_WIN = 131 * MiB;
constexpr size_t WS_WOUT = 145 * MiB;
constexpr size_t WS_SI = 149 * MiB;
constexpr size_t WS_LLA = 253 * MiB;
constexpr size_t WS_LB = 270 * MiB;
constexpr size_t WS_LSUM = 287 * MiB;
constexpr size_t WS_LCIN = 289 * MiB;
constexpr size_t WS_BSC = 290 * MiB;
constexpr size_t WS_YS2B = 291 * MiB;
constexpr size_t WS_P = 319 * MiB;
constexpr size_t WS_BON = 438 * MiB;
constexpr size_t WS_G = 455 * MiB;
constexpr size_t WS_YS = 472 * MiB;
constexpr size_t WS_SV = 506 * MiB;
constexpr size_t WS_DZ = 523 * MiB;
constexpr size_t WS_WD = 149 * MiB;
constexpr size_t WS_HACT = 182 * MiB;
constexpr size_t WS_Y = 267 * MiB;
constexpr size_t WS_WGU = 267 * MiB;
constexpr size_t WS_END = 540 * MiB;

struct Row { int b, t, L, isx; };
__device__ __forceinline__ Row row_of(int m) { Row r; if (m < NX) { r.b = m >> 12; r.t = m & 4095; r.L = SEQ; r.isx = 1; } else { int q = m - NX; r.b = q >> 8; r.t = q & 255; r.L = CTXL; r.isx = 0; } return r; }
__device__ __forceinline__ float frcp_(float x) { return __builtin_amdgcn_rcpf(x); }
__device__ __forceinline__ float sigmoidf_(float x) { return frcp_(1.f + __expf(-x)); }
__device__ __forceinline__ float softplusf_(float x) { return x > 20.f ? x : __logf(1.f + __expf(x)); }
__device__ __forceinline__ float siluf_(float x) { return x * frcp_(1.f + __expf(-x)); }
__device__ __forceinline__ float tanhf_(float x) { const float xc = fminf(fmaxf(x, -15.f), 15.f); return 1.f - 2.f * frcp_(1.f + __expf(2.f * xc)); }
__device__ __forceinline__ float dpp_f(float v, const int ctrl) { return v; }
#define DPPF(v, ctrl) __int_as_float(__builtin_amdgcn_update_dpp(0, __float_as_int(v), (ctrl), 0xf, 0xf, true))
__device__ __forceinline__ float wave_sum(float v) {
    v += DPPF(v, 0xB1); v += DPPF(v, 0x4E); v += DPPF(v, 0x141); v += DPPF(v, 0x140);
    return (__int_as_float(__builtin_amdgcn_readlane(__float_as_int(v), 0)) + __int_as_float(__builtin_amdgcn_readlane(__float_as_int(v), 16))) +
           (__int_as_float(__builtin_amdgcn_readlane(__float_as_int(v), 32)) + __int_as_float(__builtin_amdgcn_readlane(__float_as_int(v), 48)));
}

struct EpiP { bf16* P; __device__ void operator()(int m, int n, float v) const { P[(size_t)m * LDP + n] = f2bf(v); } };
struct EpiRes { const float* xs; const float* cs; const float* MODl; float* XR; __device__ void operator()(int m, int n, float v) const {
    const float xin = m < NX ? xs[(size_t)m * D + n] : cs[(size_t)(m - NX) * D + n]; const int rb = m < NX ? (m >> 12) : 4;
    XR[(size_t)m * D + n] = xin + MODl[(size_t)rb * 6144 + 2 * 1024 + n] * v; } };

__device__ __forceinline__ float* si_ptr(float* SI, int d, int m, int h, int vec) { return SI + ((((size_t)d * MT + m) * 4 + h) * 5 + vec) * 64; }

struct RwP { const float *mu, *w0, *w2, *a0, *a2, *g2, *kk, *ka, *rk, *v0, *v2; };

__device__ __forceinline__ int step_row(int b, int d, int s) { if (s < CTXL) { const int tc = d ? CTXL - 1 - s : s; return NX + b * CTXL + tc; } const int tx = d ? SEQ - 1 - (s - CTXL) : (s - CTXL); return b * SEQ + tx; }
struct LruP { const float *cw, *cb, *wa, *ba, *wx, *bx, *lam; };

struct MoeW { const float *wg, *wu, *wd, *sg, *su, *sd; };

enum { I_X = 0, I_C, I_CTX, I_CCTX, I_ADAW, I_ADAB, I_NMIX, I_NFFN, I_NFIN, I_WIN, I_WVRES, I_WOUT, I_RWMU, I_RWW0, I_RWW2, I_RWA0, I_RWA2, I_RWG2, I_RWKK, I_RWKA, I_RWRK, I_RWLNW, I_RWLNB, I_RWV0, I_RWV2,
       I_RETL, I_GCW, I_GALOG, I_GDT, I_GNW, I_LCW, I_LCB, I_LWA, I_LBA, I_LWX, I_LBX, I_LLAM, I_RTW, I_RTB, I_EWG, I_EWU, I_EWD, I_SWG, I_SWU, I_SWD, I_N };
#define GAS __attribute__((address_space(1)))
#define LAS __attribute__((address_space(3)))
typedef unsigned v4u __attribute__((ext_vector_type(4)));
typedef float f32x4 __attribute__((ext_vector_type(4)));
typedef short bf16x8 __attribute__((ext_vector_type(8)));
typedef GAS unsigned gu32;
#define RLX_AGENT __ATOMIC_RELAXED, __HIP_MEMORY_SCOPE_AGENT
#define LDS_WAIT() asm volatile("s_waitcnt lgkmcnt(0)" ::: "memory")
#define VM_WAIT() asm volatile("s_waitcnt vmcnt(0)" ::: "memory")
#define LDS_BARRIER() do { asm volatile("s_waitcnt lgkmcnt(0)" ::: "memory"); __builtin_amdgcn_s_barrier(); asm volatile("" ::: "memory"); } while (0)
__device__ __forceinline__ unsigned pk2(float lo, float hi) { return cvtpk_bf16(lo, hi); }
__device__ __forceinline__ unsigned long long pack4(f32x4 v) { return (unsigned long long)pk2(v.x, v.y) | ((unsigned long long)pk2(v.z, v.w) << 32); }

namespace pg8 {
#define PG8_LAS __attribute__((address_space(3)))
typedef unsigned short bf16_t;
typedef unsigned u32x4 __attribute__((ext_vector_type(4)));
constexpr int BM = 256, BK = 64, HALF = 128, HTB = HALF * BK * 2, STAGE_BYTES = 8 * HTB, NXCD = 8, WGM = 8;
__host__ __device__ __forceinline__ int lds_byte(int r, int c) { const int st = (r >> 4) * 2 + (c >> 5), rr = r & 15, cc = c & 31, ob = rr * 64 + cc * 2; return st * 1024 + (ob ^ (((ob >> 9) & 1) << 5)); }
__host__ __device__ __forceinline__ void stage_rc(int b, int& R, int& C) { const int st = b / 1024, sb = b % 1024, swz = sb ^ (((sb >> 9) & 1) << 5); R = (st >> 1) * 16 + swz / 64; C = (st & 1) * 32 + (swz % 64) / 2; }
__host__ __device__ __forceinline__ int perm32(int rho) { const int n = rho >> 4, i = rho & 15; return 8 * (i >> 2) + 4 * n + (i & 3); }
__device__ __forceinline__ unsigned cvt_pk_bf16(float lo, float hi) { unsigned r; asm volatile("v_cvt_pk_bf16_f32 %0, %1, %2" : "=v"(r) : "v"(lo), "v"(hi)); return r; }

struct Unit { const char* A; const char* B; int pm, pn, e, nrows, rb; };

struct DenseOrder {
    static constexpr bool GATHER = false;
    const bf16_t* A; const bf16_t* Bt; int K, nM, nN, nwg, G, c;
    __device__ void init(const bf16_t* A_, const bf16_t* Bt_, int M, int N, int K_, int G_, int c_) { A = A_; Bt = Bt_; K = K_; nM = M / BM; nN = N / BM; nwg = nM * nN; G = G_; c = c_; }
    __device__ bool next(int i, Unit& u) const {
        const long L = (long)i * G + c; if (L >= nwg) return false;
        int wgid = (int)L; { const int q = nwg / NXCD, r = nwg % NXCD, xcd = wgid % NXCD, off = wgid / NXCD; wgid = (xcd < r ? xcd * (q + 1) : r * (q + 1) + (xcd - r) * q) + off; }
        const int nig = WGM * nN, gid = wgid / nig, fm = gid * WGM, gsz = (nM - fm) < WGM ? (nM - fm) : WGM;
        u.pm = fm + ((wgid % nig) % gsz); u.pn = (wgid % nig) / gsz; u.e = 0; u.nrows = BM; u.rb = 0;
        u.A = (const char*)A + (size_t)u.pm * BM * K * 2; u.B = (const char*)Bt + (size_t)u.pn * BM * K * 2; return true;
    }
    __device__ __forceinline__ unsigned a_off(const Unit&, int h, int R, int C) const { return (unsigned)((h * HALF + R) * K + C) * 2u; }
};

template <class Epi, class Sched, bool ALIGN_EPI = false>
__device__ __forceinline__ void gemm_phase(PG8_LAS unsigned char* lds, const int K, const Sched& S, const Epi& E) {
    int tid = threadIdx.x; asm volatile("" : "+v"(tid));
    const int wid = __builtin_amdgcn_readfirstlane(tid >> 6), lane = tid & 63, wr = wid >> 2, wc = wid & 3, fr = lane & 15, fq = lane >> 4;
    const int nt = K / BK;
    unsigned voffB[2];
#pragma unroll
    for (int i = 0; i < 2; ++i) { int R, C; stage_rc(tid * 16 + i * 8192, R, C); const int Rb = Epi::PERM ? ((R & ~31) + perm32(R & 31)) : R; voffB[i] = (unsigned)(Rb * K + C) * 2u; }
    const size_t kstep = (size_t)(BK * 2);
    const size_t hstep = (size_t)HALF * K * 2;
    const unsigned ldsw = (unsigned)wid * 1024u;
    const int aoff = lds_byte(wr * 64 + fr, fq * 8), boff = lds_byte(wc * 32 + fr, fq * 8);
#define PG8_SA(b, h) (((b) * 2 + (h)) * HTB)
#define PG8_SB(b, h) ((4 + (b) * 2 + (h)) * HTB)
#define PG8_STAGE(bufoff, gbase, voff) do { _Pragma("unroll") for (int _i = 0; _i < 2; ++_i) \
        __builtin_amdgcn_global_load_lds((const unsigned*)((const char*)(gbase) + (voff)[_i]), (PG8_LAS unsigned*)(lds + (bufoff) + ldsw + _i * 8192), 16, 0, 0); } while (0)
#define PG8_LDA(dst, b, h) do { _Pragma("unroll") for (int m = 0; m < 4; ++m) _Pragma("unroll") for (int k = 0; k < 2; ++k) dst[m][k] = *(const PG8_LAS bf16x8*)(lds + PG8_SA(b, h) + aoff + m * 2048 + k * 1024); } while (0)
#define PG8_LDB(dst, b, h) do { _Pragma("unroll") for (int n = 0; n < 2; ++n) _Pragma("unroll") for (int k = 0; k < 2; ++k) dst[n][k] = *(const PG8_LAS bf16x8*)(lds + PG8_SB(b, h) + boff + n * 2048 + k * 1024); } while (0)
#define PG8_MMA(ai, bj, At, Bt) do { __builtin_amdgcn_s_setprio(1); _Pragma("unroll") for (int m = 0; m < 4; ++m) _Pragma("unroll") for (int n = 0; n < 2; ++n) _Pragma("unroll") for (int k = 0; k < 2; ++k) \
        acc[ai][bj][m][n] = __builtin_amdgcn_mfma_f32_16x16x32_bf16(Bt[n][k], At[m][k], acc[ai][bj][m][n], 0, 0, 0); __builtin_amdgcn_s_setprio(0); } while (0)
#define PG8_WAIT_V(n) asm volatile("s_waitcnt vmcnt(" #n ")" ::: "memory")
#define PG8_WAIT_L(n) asm volatile("s_waitcnt lgkmcnt(" #n ")" ::: "memory")
#define PG8_BAR __builtin_amdgcn_s_barrier()
#define PG8_SCHED __builtin_amdgcn_sched_barrier(0)
    Unit cur, nxt; int ui = 0;
    if (!S.next(0, cur)) return;
    f32x4 acc[2][2][4][2];
#pragma unroll
    for (int a = 0; a < 2; ++a)
#pragma unroll
        for (int b = 0; b < 2; ++b)
#pragma unroll
            for (int m = 0; m < 4; ++m)
#pragma unroll
                for (int n = 0; n < 2; ++n) acc[a][b][m][n] = (f32x4){0.f, 0.f, 0.f, 0.f};
    bf16x8 At[4][2], B0[2][2], B1[2][2];
    unsigned cv0[2], cv1[2], nv0[2], nv1[2];
#pragma unroll
    for (int i = 0; i < 2; ++i) { int R, C; stage_rc(tid * 16 + i * 8192, R, C); cv0[i] = S.a_off(cur, 0, R, C); cv1[i] = S.a_off(cur, 1, R, C); nv0[i] = cv0[i]; nv1[i] = cv1[i]; }
    const char* cA = cur.A; const char* cB = cur.B;
    PG8_STAGE(PG8_SB(0, 0), cB, voffB); PG8_STAGE(PG8_SB(0, 1), cB + hstep, voffB); PG8_STAGE(PG8_SA(0, 0), cA, cv0); PG8_STAGE(PG8_SA(0, 1), cA, cv1);
    if (wr == 1) PG8_BAR;
    PG8_WAIT_V(2); PG8_BAR;
    PG8_STAGE(PG8_SB(1, 0), cB + kstep, voffB); PG8_STAGE(PG8_SA(1, 0), cA + kstep, cv0); PG8_STAGE(PG8_SB(1, 1), cB + hstep + kstep, voffB);
    PG8_WAIT_V(6); PG8_BAR;
    for (;;) {
        const bool has_next = S.next(ui + 1, nxt);
        const char* nA = has_next ? nxt.A : cA; const char* nB = has_next ? nxt.B : cB;
        if constexpr (Sched::GATHER) {
        if (has_next) {
#pragma unroll
            for (int i = 0; i < 2; ++i) { int tt = threadIdx.x; asm volatile("" : "+v"(tt)); int R, C; stage_rc(tt * 16 + i * 8192, R, C); nv0[i] = S.a_off(nxt, 0, R, C); nv1[i] = S.a_off(nxt, 1, R, C); } }
        else {
#pragma unroll
            for (int i = 0; i < 2; ++i) { nv0[i] = cv0[i]; nv1[i] = cv1[i]; } } }
        for (int t = 0; t < nt; t += 2) {
            const bool last = (t == nt - 2);
            const char* a1 = cA + (size_t)(t + 1) * kstep;
            const char* a2 = last ? nA : cA + (size_t)(t + 2) * kstep; const char* b2 = last ? nB : cB + (size_t)(t + 2) * kstep;
            const char* a3 = a2 + kstep; const char* b3 = b2 + kstep;
            unsigned x0[2], x1[2];
#pragma unroll
            for (int i = 0; i < 2; ++i) { if constexpr (Sched::GATHER) { x0[i] = last ? nv0[i] : cv0[i]; x1[i] = last ? nv1[i] : cv1[i]; } else { x0[i] = cv0[i]; x1[i] = cv1[i]; } }
            PG8_LDB(B0, 0, 0); PG8_LDB(B1, 0, 1); PG8_SCHED; PG8_LDA(At, 0, 0); PG8_STAGE(PG8_SA(1, 1), a1, cv1);
            PG8_WAIT_V(8); PG8_WAIT_L(0); PG8_BAR; PG8_MMA(0, 0, At, B0); PG8_MMA(0, 1, At, B1); PG8_BAR; PG8_SCHED;
            PG8_LDA(At, 0, 1); PG8_STAGE(PG8_SB(0, 0), b2, voffB); PG8_STAGE(PG8_SB(0, 1), b2 + hstep, voffB); PG8_STAGE(PG8_SA(0, 0), a2, x0);
            PG8_WAIT_V(8); PG8_WAIT_L(0); PG8_BAR; PG8_MMA(1, 0, At, B0); PG8_MMA(1, 1, At, B1); PG8_BAR; PG8_SCHED;
            PG8_LDB(B0, 1, 0); PG8_LDB(B1, 1, 1); PG8_SCHED; PG8_LDA(At, 1, 0); PG8_STAGE(PG8_SA(0, 1), a2, x1);
            PG8_WAIT_V(8); PG8_WAIT_L(0); PG8_BAR; PG8_MMA(0, 0, At, B0); PG8_MMA(0, 1, At, B1); PG8_BAR; PG8_SCHED;
            PG8_LDA(At, 1, 1); PG8_STAGE(PG8_SB(1, 0), b3, voffB); PG8_STAGE(PG8_SB(1, 1), b3 + hstep, voffB); PG8_STAGE(PG8_SA(1, 0), a3, x0);
            PG8_WAIT_V(8); PG8_WAIT_L(0); PG8_BAR; PG8_MMA(1, 0, At, B0); PG8_MMA(1, 1, At, B1); PG8_BAR; PG8_SCHED;
        }
        if constexpr (ALIGN_EPI) { if (wr == 0) PG8_BAR; }
        E(acc, cur, wr, wc, fr, fq);
        if (!has_next) break;
#pragma unroll
        for (int a = 0; a < 2; ++a)
#pragma unroll
            for (int b = 0; b < 2; ++b)
#pragma unroll
                for (int m = 0; m < 4; ++m)
#pragma unroll
                    for (int n = 0; n < 2; ++n) acc[a][b][m][n] = (f32x4){0.f, 0.f, 0.f, 0.f};
        cur = nxt; cA = nA; cB = nB; ++ui;
        if constexpr (Sched::GATHER) {
#pragma unroll
            for (int i = 0; i < 2; ++i) { cv0[i] = nv0[i]; cv1[i] = nv1[i]; } }
        if constexpr (ALIGN_EPI) { if (wr == 1) PG8_BAR; }
    }
    PG8_WAIT_V(0);
    if constexpr (!ALIGN_EPI) { if (wr == 0) PG8_BAR; }
    PG8_BAR;
#undef PG8_SA
#undef PG8_SB
#undef PG8_STAGE
#undef PG8_LDA
#undef PG8_LDB
#undef PG8_MMA
#undef PG8_WAIT_V
#undef PG8_WAIT_L
#undef PG8_BAR
#undef PG8_SCHED
}

struct EpiStoreBf16 {
    static constexpr bool PERM = true;
    bf16_t* O; int ldc;
    __device__ __forceinline__ void operator()(const f32x4 (&acc)[2][2][4][2], const Unit& u, int wr, int wc, int fr, int fq) const {
        asm volatile("" : "+v"(fr), "+v"(fq));
        const int row0 = u.pm * BM + wr * 64 + fr, col0 = u.pn * BM + wc * 32 + 8 * fq;
#pragma unroll
        for (int ai = 0; ai < 2; ++ai)
#pragma unroll
            for (int m = 0; m < 4; ++m) { bf16_t* rowp = O + (size_t)(row0 + ai * HALF + m * 16) * ldc + col0;
#pragma unroll
                for (int bj = 0; bj < 2; ++bj) { const f32x4 v0 = acc[ai][bj][m][0], v1 = acc[ai][bj][m][1];
                    u32x4 w; w.x = cvt_pk_bf16(v0[0], v0[1]); w.y = cvt_pk_bf16(v0[2], v0[3]); w.z = cvt_pk_bf16(v1[0], v1[1]); w.w = cvt_pk_bf16(v1[2], v1[3]);
                    *(u32x4*)(rowp + bj * HALF) = w; } }
    }
};
struct EpiResidual {
    static constexpr bool PERM = false;
    const float* xs; const float* cs; const float* MODl; float* XR;
    __device__ __forceinline__ void operator()(const f32x4 (&acc)[2][2][4][2], const Unit& u, int wr, int wc, int fr, int fq) const {
        asm volatile("" : "+v"(fr), "+v"(fq));
        const int row0 = u.pm * BM + wr * 64 + fr, col0 = u.pn * BM + wc * 32 + 4 * fq;
#pragma unroll
        for (int ai = 0; ai < 2; ++ai)
#pragma unroll
            for (int m = 0; m < 4; ++m) { const int row = row0 + ai * HALF + m * 16;
                const float* xin = row < NX ? xs + (size_t)row * D : cs + (size_t)(row - NX) * D; const int rb = row < NX ? (row >> 12) : 4;
                const float* md = MODl + (size_t)rb * 6144 + 2 * 1024; float* o = XR + (size_t)row * D;
#pragma unroll
                for (int bj = 0; bj < 2; ++bj)
#pragma unroll
                    for (int n = 0; n < 2; ++n) { const int c = col0 + bj * HALF + n * 16; const f32x4 xi = *(const f32x4*)(xin + c), mm = *(const f32x4*)(md + c); *(f32x4*)(o + c) = xi + mm * acc[ai][bj][m][n]; } }
    }
};
}

#define XB_TMO      128
#define XB_XCNT(j)  (256  + 64 * (j))
#define XB_XSUB(j)  (1280 + 64 * (j))
#define XB_XGEN(j)  (2304 + 64 * (j))
#define XB_TOP      3328
#define XB_TOPGEN   3392
#define XCD_BAR_WORDS 3456
#define XB_SPIN_CAP (1u << 22)
__device__ __forceinline__ unsigned xb_ld(unsigned* p)              { return __hip_atomic_load(p, __ATOMIC_RELAXED, __HIP_MEMORY_SCOPE_AGENT); }
__device__ __forceinline__ unsigned xb_add(unsigned* p, unsigned v) { return __hip_atomic_fetch_add(p, v, __ATOMIC_RELAXED, __HIP_MEMORY_SCOPE_AGENT); }
__device__ __forceinline__ unsigned xb_xcc_id() { return (unsigned)__builtin_amdgcn_s_getreg((3 << 11) | 20) & 0xFu; }
#define XB_SPIN(cond, bar) do { unsigned _sp = 0; while (cond) { __builtin_amdgcn_s_sleep(1); \
    if ((++_sp & 255u) == 0u) { if (xb_ld(&(bar)[XB_TMO])) break; if (_sp > XB_SPIN_CAP) { atomicAdd(&(bar)[XB_TMO], 1u); break; } } } } while (0)
struct XcdBarrier { unsigned* bar; unsigned x; volatile LAS unsigned* st; };
__device__ __forceinline__ XcdBarrier xcd_barrier_post(unsigned* bar, volatile LAS unsigned* st) {
    XcdBarrier b; b.bar = bar; b.x = (unsigned)__builtin_amdgcn_readfirstlane((int)xb_xcc_id()); b.st = st;
    if (threadIdx.x == 0) (void)xb_add(&bar[XB_XCNT(b.x)], 1u);
    return b;
}
__device__ __forceinline__ void xcd_barrier_complete(unsigned* bar, unsigned x, unsigned& nloc, unsigned& nx) {
    const unsigned G = gridDim.x * gridDim.y * gridDim.z;
    unsigned sum, cnt, mine, sp = 0u;
    for (;;) {
        sum = 0u; cnt = 0u; mine = 0u;
#pragma unroll
        for (unsigned j = 0; j < 16; ++j) { const unsigned c = xb_ld(&bar[XB_XCNT(j)]); sum += c; cnt += (c > 0u) ? 1u : 0u; mine = (j == x) ? c : mine; }
        if (sum == G) break;
        __builtin_amdgcn_s_sleep(1);
        if ((++sp & 255u) == 0u) { if (xb_ld(&bar[XB_TMO])) break; if (sp > XB_SPIN_CAP) { atomicAdd(&bar[XB_TMO], 1u); break; } }
    }
    nloc = mine > 0u ? mine : 1u; nx = cnt > 0u ? cnt : 1u;
}
__device__ __forceinline__ void xcd_barrier(const XcdBarrier& b) {
    asm volatile("s_waitcnt vmcnt(0)" ::: "memory");
    __syncthreads();
    if (threadIdx.x == 0) {
        unsigned* bar = b.bar; const unsigned bx = (unsigned)__builtin_amdgcn_readfirstlane((int)xb_xcc_id());
        __builtin_amdgcn_s_waitcnt(0);
        unsigned nloc = b.st[0], nx = b.st[1];
        if (nloc == 0u) { xcd_barrier_complete(bar, bx, nloc, nx); b.st[0] = nloc; b.st[1] = nx; }
        const unsigned old = xb_add(&bar[XB_XSUB(bx)], 1u);
        const unsigned gen = old / nloc;
        if (old + 1u == (gen + 1u) * nloc) {
            __builtin_amdgcn_fence(__ATOMIC_RELEASE, "agent");
            asm volatile("s_waitcnt vmcnt(0)" ::: "memory");
            const unsigned og = xb_add(&bar[XB_TOP], 1u);
            const unsigned tg = og / nx;
            if (og + 1u == (tg + 1u) * nx) xb_add(&bar[XB_TOPGEN], 1u);
            else XB_SPIN(xb_ld(&bar[XB_TOPGEN]) == tg, bar);
            __builtin_amdgcn_fence(__ATOMIC_ACQUIRE, "agent");
            xb_add(&bar[XB_XGEN(bx)], 1u);
            asm volatile("s_waitcnt vmcnt(0)" ::: "memory");
        } else {
            XB_SPIN(xb_ld(&bar[XB_XGEN(bx)]) == gen, bar);
            __builtin_amdgcn_fence(__ATOMIC_ACQUIRE, "agent");
            asm volatile("s_waitcnt vmcnt(0)" ::: "memory");
        }
    }
    __syncthreads();
}

constexpr int NWAVES = 8, NTHR = 512;
constexpr int RING_OFF = 0, RING_BYTES = 131072;
constexpr int LDSCTL_OFF = RING_BYTES, MISC_OFF = LDSCTL_OFF + 320;
constexpr int LDS_BYTES = 147456;
constexpr int CW_BAR = 4096;
constexpr size_t CTL_ZERO_BYTES = 1 * MiB;

struct MArgs {
    const float* in[45]; float* out; unsigned char* ws; int ph_lo, ph_hi, l_lo, l_hi, bar_region, pad;
};
struct Frame { LAS unsigned char* lds; volatile LAS unsigned* MISC; gu32* ctl; int tid, lane, wave, vcu, G; unsigned long long tacc, tph0; int curk; };

__device__ __forceinline__ void transpose_item(const float* W, int ldw, int N, int k0, int n0, bf16* WT, int ldt, int drow0, LAS float* scr, int lane) {
    const int nn = n0 + (lane & 31); const bool okn = nn < N;
#pragma unroll 8
    for (int i = 0; i < 32; ++i) { const int kk = 2 * i + (lane >> 5); scr[kk * 33 + (lane & 31)] = okn ? W[(size_t)(k0 + kk) * ldw + nn] : 0.f; }
    LDS_WAIT(); asm volatile("" ::: "memory");
    const int c = lane & 7;
#pragma unroll
    for (int j = 0; j < 4; ++j) { const int n = (lane >> 3) + 8 * j; const LAS float* s = scr + (8 * c) * 33 + n;
        v4u o; o.x = pk2(s[0 * 33], s[1 * 33]); o.y = pk2(s[2 * 33], s[3 * 33]); o.z = pk2(s[4 * 33], s[5 * 33]); o.w = pk2(s[6 * 33], s[7 * 33]);
        if (n0 + n < N) *(GAS v4u*)(WT + (size_t)(drow0 + n) * ldt + k0 + 8 * c) = o; }
    LDS_WAIT(); asm volatile("" ::: "memory");
}

__device__ __forceinline__ void ph_mod(Frame& F, const float* c, const float* cctx, const float* ada_w, const float* ada_b, float* MOD) {
    LAS float* s = (LAS float*)(F.lds + RING_OFF);
    LAS float* red = s + 5 * 1024;
    for (int i = F.tid; i < 5 * 1024; i += NTHR) { const int r = i >> 10, k = i & 1023; const float v = r < 4 ? c[r * 1024 + k] : cctx[k]; s[i] = siluf_(v); }
    __syncthreads();
    for (int u = F.vcu; u < 192; u += F.G) {
        const int l = u / 96, j0 = (u % 96) * 64, cl = F.tid & 63, kp = F.tid >> 6;
        const float* W = ada_w + (size_t)l * 1024 * 6144 + j0 + cl;
        float acc[5] = {0.f, 0.f, 0.f, 0.f, 0.f};
        for (int k = kp * 128; k < kp * 128 + 128; ++k) { const float w = W[(size_t)k * 6144];
#pragma unroll
            for (int r = 0; r < 5; ++r) acc[r] += s[r * 1024 + k] * w; }
#pragma unroll
        for (int r = 0; r < 5; ++r) red[(kp * 5 + r) * 64 + cl] = acc[r];
        __syncthreads();
        if (F.tid < 320) { const int r = F.tid >> 6; float a = ada_b[l * 6144 + j0 + cl];
#pragma unroll
            for (int q = 0; q < 8; ++q) a += red[(q * 5 + r) * 64 + cl];
            MOD[((size_t)l * 5 + r) * 6144 + j0 + cl] = a; }
        __syncthreads();
    }
}
__device__ __forceinline__ void ph_convert_small(Frame& F, const float* w_in, const float* w_vres, const float* w_out, bf16* WIN_T  , bf16* WOUT_T  ) {
    LAS float* scr = (LAS float*)(F.lds + RING_OFF + 32768 + F.wave * 16384 / 2);
    scr = (LAS float*)(F.lds + RING_OFF + 32768 + F.wave * 9216);
    const int gw = F.vcu * NWAVES + F.wave, NGW = F.G * NWAVES;
    constexpr int NB_IN = (NIN + 31) / 32;
    constexpr int I_IN = 16 * NB_IN, I_VR = 16 * 1, I_OUT = 16 * 32;
    constexpr int PER_L = I_IN + I_VR + I_OUT;
    for (int it = gw; it < 2 * PER_L; it += NGW) {
        const int l = it / PER_L; int r = it % PER_L;
        if (r < I_IN) { const int kb = r / NB_IN, nb = r % NB_IN; transpose_item(w_in + (size_t)l * D * NIN, NIN, NIN, kb * 64, nb * 32, WIN_T + (size_t)l * LDP * D, D, nb * 32, scr, F.lane); continue; } r -= I_IN;
        if (r < I_VR) { if (l == 1) transpose_item(w_vres, 32, 32, r * 64, 0, WIN_T + (size_t)LDP * D, D, NIN, scr, F.lane); continue; } r -= I_VR;
        { const int kb = r / 32, nb = r % 32; transpose_item(w_out + (size_t)l * D * D, D, D, kb * 64, nb * 32, WOUT_T + (size_t)l * D * D, D, nb * 32, scr, F.lane); }
    }
}
__device__ __forceinline__ void ph_norm_mod(Frame& F, const float* xs, const float* cs, const float* gain, const float* MODl, int si, bf16* XN, int nrows) {
    const int gw = F.vcu * NWAVES + F.wave, NGW = F.G * NWAVES, lane = F.lane;
    for (int m0 = gw; m0 < nrows; m0 += 2 * NGW) {
        const int m1 = m0 + NGW < nrows ? m0 + NGW : m0;
        const float* s0 = m0 < NX ? xs + (size_t)m0 * D : cs + (size_t)(m0 - NX) * D; const float* s1 = m1 < NX ? xs + (size_t)m1 * D : cs + (size_t)(m1 - NX) * D;
        f32x4 v0[4], v1[4]; float q0 = 0.f, q1 = 0.f;
#pragma unroll
        for (int j = 0; j < 4; ++j) { v0[j] = *(const f32x4*)(s0 + 4 * lane + 256 * j); v1[j] = *(const f32x4*)(s1 + 4 * lane + 256 * j); }
#pragma unroll
        for (int j = 0; j < 4; ++j) { q0 += (v0[j].x * v0[j].x + v0[j].y * v0[j].y) + (v0[j].z * v0[j].z + v0[j].w * v0[j].w); q1 += (v1[j].x * v1[j].x + v1[j].y * v1[j].y) + (v1[j].z * v1[j].z + v1[j].w * v1[j].w); }
        q0 = wave_sum(q0); q1 = wave_sum(q1); const float r0 = rsqrtf(q0 * (1.f / D) + 1e-6f), r1 = rsqrtf(q1 * (1.f / D) + 1e-6f);
        const float* md0 = MODl + (size_t)(m0 < NX ? (m0 >> 12) : 4) * 6144; const float* md1 = MODl + (size_t)(m1 < NX ? (m1 >> 12) : 4) * 6144;
#pragma unroll
        for (int j = 0; j < 4; ++j) { const int ci = 4 * lane + 256 * j; const f32x4 g = *(const f32x4*)(gain + ci);
            const f32x4 y0 = v0[j] * r0 * g * (*(const f32x4*)(md0 + (si + 1) * 1024 + ci) + 1.f) + *(const f32x4*)(md0 + si * 1024 + ci);
            const f32x4 y1 = v1[j] * r1 * g * (*(const f32x4*)(md1 + (si + 1) * 1024 + ci) + 1.f) + *(const f32x4*)(md1 + si * 1024 + ci);
            *(unsigned long long*)(XN + (size_t)m0 * D + ci) = pack4(y0); *(unsigned long long*)(XN + (size_t)m1 * D + ci) = pack4(y1); }
    }
}

typedef short bf16x4 __attribute__((ext_vector_type(4)));
constexpr int CW_CNT = 16384;
constexpr int TAB_OFF = LDSCTL_OFF + 1024;
struct MoeTab { LAS int* cnt; LAS int* ups; LAS int* ro; };
__device__ __forceinline__ MoeTab moe_tab(Frame& F) { MoeTab t; t.cnt = (LAS int*)(F.lds + TAB_OFF); t.ups = t.cnt + 80; t.ro = t.ups + 80; return t; }
__device__ __forceinline__ void moe_build_tab(Frame& F, int layer, int ntok) {
    MoeTab T = moe_tab(F);
    if (F.tid < 64) T.cnt[F.tid] = (int)__hip_atomic_load(F.ctl + CW_CNT + (layer * 64 + F.tid) * 64, RLX_AGENT);
    if (F.tid == 64) T.cnt[64] = ntok;
    __syncthreads();
    if (F.tid == 0) { int u = 0, r = 0; for (int e = 0; e < 65; ++e) { T.ups[e] = u; T.ro[e] = r; u += (T.cnt[e] + 255) >> 8; r += T.cnt[e]; } T.ups[65] = u; T.ro[65] = r; }
    __syncthreads();
}
__device__ __forceinline__ int uni(int v) { return __builtin_amdgcn_readfirstlane(v); }
__device__ __forceinline__ const char* uni_ptr(const char* p) { unsigned long long v = (unsigned long long)p; unsigned lo = __builtin_amdgcn_readfirstlane((unsigned)v), hi = __builtin_amdgcn_readfirstlane((unsigned)(v >> 32)); return (const char*)(((unsigned long long)hi << 32) | lo); }

__device__ __forceinline__ void ph_convert_router(Frame& F, const float* rtw, bf16* RT) {
    for (int i = F.vcu * NTHR + F.tid; i < 2 * 64 * 1024; i += F.G * NTHR) { const int l = i >> 16, e = (i >> 10) & 63, k = i & 1023;
        const float x = rtw[((size_t)l * 1024 + k) * 64 + e]; const bf16 hi = f2bf(x); const bf16 lo = f2bf(x - bf2f(hi));
        RT[(((size_t)l * 2 + 0) * 64 + e) * 1024 + k] = hi; RT[(((size_t)l * 2 + 1) * 64 + e) * 1024 + k] = lo; }
}
__device__ __forceinline__ void ph_route(Frame& F, const float* XR, const float* gain, const float* MODl, const bf16* RTl  , const float* rbias, bf16* XN, int layer,
                                         unsigned* LIST, int* SLOTPOS, float* SLOTG, int ntok) {
    constexpr int HSTR = 2064;
    LAS unsigned char* HH = F.lds + RING_OFF;
    LAS unsigned char* HL = F.lds + RING_OFF + 16 * HSTR;
    LAS float* part = (LAS float*)(F.lds + RING_OFF + 32 * HSTR);
    LAS float* sc = (LAS float*)(F.lds + RING_OFF + 32 * HSTR + 32768);
    const int lane = F.lane, wv = F.wave, tid = F.tid, r = lane & 15, g = lane >> 4;
    const int ngrp = ntok / 16;
    bf16x4 BH[4][8], BL[4][8];
    { const GAS bf16* R = (const GAS bf16*)RTl;
#pragma unroll
      for (int nt = 0; nt < 4; ++nt)
#pragma unroll
          for (int ks = 0; ks < 8; ++ks) { const size_t o = (size_t)(16 * nt + r) * 1024 + 128 * wv + 16 * ks + 4 * g; BH[nt][ks] = *(const GAS bf16x4*)(R + o); BL[nt][ks] = *(const GAS bf16x4*)(R + 65536 + o); } }
    for (int gi = F.vcu; gi < ngrp; gi += F.G) {
        TSEC_BEGIN(20)
#pragma unroll
        for (int tt = 0; tt < 2; ++tt) {
            const int tl = 2 * wv + tt, m = gi * 16 + tl;
            const float* src = XR + (size_t)m * D; const int rb = m < NX ? (m >> 12) : 4; const float* md = MODl + (size_t)rb * 6144;
            f32x4 v[4]; float ss = 0.f;
#pragma unroll
            for (int j = 0; j < 4; ++j) { v[j] = *(const f32x4*)(src + 4 * lane + 256 * j); ss += (v[j].x * v[j].x + v[j].y * v[j].y) + (v[j].z * v[j].z + v[j].w * v[j].w); }
            ss = wave_sum(ss); const float rs = rsqrtf(ss * (1.f / D) + 1e-6f);
#pragma unroll
            for (int j = 0; j < 4; ++j) { const int ci = 4 * lane + 256 * j; const f32x4 gg = *(const f32x4*)(gain + ci), sh = *(const f32x4*)(md + 3 * 1024 + ci), scl = *(const f32x4*)(md + 4 * 1024 + ci);
                const f32x4 y = v[j] * rs * gg * (scl + 1.f) + sh;
                const unsigned h0 = pk2(y.x, y.y), h1 = pk2(y.z, y.w);
                const f32x4 yl = (f32x4){y.x - __uint_as_float(h0 << 16), y.y - __uint_as_float(h0 & 0xffff0000u), y.z - __uint_as_float(h1 << 16), y.w - __uint_as_float(h1 & 0xffff0000u)};
                const unsigned long long hw = (unsigned long long)h0 | ((unsigned long long)h1 << 32);
                *(LAS unsigned long long*)(HH + tl * HSTR + ci * 2) = hw; *(LAS unsigned long long*)(HL + tl * HSTR + ci * 2) = pack4(yl);
                *(unsigned long long*)(XN + (size_t)m * D + ci) = hw; }
        }
        LDS_BARRIER();
        TSEC_END(20)
        TSEC_BEGIN(21)
        { f32x4 acc[4];
#pragma unroll
          for (int nt = 0; nt < 4; ++nt) acc[nt] = (f32x4){0.f, 0.f, 0.f, 0.f};
#pragma unroll
          for (int ks = 0; ks < 8; ++ks) { const int ko = (128 * wv + 16 * ks + 4 * g) * 2; const bf16x4 ah = *(const LAS bf16x4*)(HH + r * HSTR + ko), al = *(const LAS bf16x4*)(HL + r * HSTR + ko);
#pragma unroll
              for (int nt = 0; nt < 4; ++nt) { acc[nt] = __builtin_amdgcn_mfma_f32_16x16x16bf16_1k(ah, BH[nt][ks], acc[nt], 0, 0, 0); acc[nt] = __builtin_amdgcn_mfma_f32_16x16x16bf16_1k(al, BH[nt][ks], acc[nt], 0, 0, 0);
                  acc[nt] = __builtin_amdgcn_mfma_f32_16x16x16bf16_1k(ah, BL[nt][ks], acc[nt], 0, 0, 0); } }
#pragma unroll
          for (int nt = 0; nt < 4; ++nt)
#pragma unroll
              for (int i = 0; i < 4; ++i) part[(wv * 16 + 4 * g + i) * 64 + 16 * nt + r] = acc[nt][i]; }
        LDS_BARRIER();
#pragma unroll
        for (int q = 0; q < 2; ++q) { const int t = (tid >> 6) + 8 * q, e = tid & 63; float a = 0.f;
#pragma unroll
            for (int kp = 0; kp < 8; ++kp) a += part[(kp * 16 + t) * 64 + e];
            sc[t * 64 + e] = sigmoidf_(a); }
        LDS_BARRIER();
        TSEC_END(21)
        TSEC_BEGIN(22)
#pragma unroll
        for (int tt = 0; tt < 2; ++tt) {
            const int tl = 2 * wv + tt, m = gi * 16 + tl;
            const float s = sc[tl * 64 + lane]; float sel = s + rbias[lane]; int myk = -1; float ssum = 0.f;
            for (int k = 0; k < 8; ++k) {
                float bv = sel; int bi = lane;
#pragma unroll
                for (int o = 1; o < 64; o <<= 1) { const float ov = __shfl_xor(bv, o); const int oi = __shfl_xor(bi, o); if (ov > bv || (ov == bv && oi < bi)) { bv = ov; bi = oi; } }
                ssum += __shfl(s, bi);
                if (lane == bi) { myk = k; sel = -3.0e38f; }
            }
            if (myk >= 0) { const float gw = 2.5f * s * __builtin_amdgcn_rcpf(ssum);
                const unsigned rank = __hip_atomic_fetch_add(F.ctl + CW_CNT + (layer * 64 + lane) * 64, 1u, RLX_AGENT);
                LIST[(size_t)lane * MT + rank] = (unsigned)m;
                SLOTPOS[(size_t)m * 8 + myk] = (lane << 16) | (int)rank; SLOTG[(size_t)m * 8 + myk] = gw; }
        }
        LDS_BARRIER();
        TSEC_END(22)
    }
}
__device__ __forceinline__ void ph_convert_experts(Frame& F, const float* wg, const float* wu, const float* wd, const float* sg, const float* su, const float* sd, bf16* WGU_T, bf16* WD_T) {
    LAS float* scr = (LAS float*)(F.lds + RING_OFF + F.wave * 9216);
    const int gw = F.vcu * NWAVES + F.wave, NGW = F.G * NWAVES;
    for (int it = gw; it < 65 * 384; it += NGW) {
        const int e = it / 384; int r = it % 384;
        const float* Wg = e < 64 ? wg + (size_t)e * D * EFF : sg; const float* Wu = e < 64 ? wu + (size_t)e * D * EFF : su; const float* Wd = e < 64 ? wd + (size_t)e * EFF * D : sd;
        if (r < 256) { const float* W = r < 128 ? Wg : Wu; const int up = r >= 128; r &= 127; const int kb = r >> 3, nb = r & 7, n0 = nb * 32;
            transpose_item(W, EFF, EFF, kb * 64, n0, WGU_T + (size_t)e * 512 * D, D, (n0 >> 7) * 256 + (n0 & 127) + up * 128, scr, F.lane); }
        else { r -= 256; const int kb = r >> 5, nb = r & 31; transpose_item(Wd, D, D, kb * 64, nb * 32, WD_T + (size_t)e * D * EFF, EFF, nb * 32, scr, F.lane); }
    }
}
namespace pg8 {
struct MoeOrder1 {          static constexpr bool GATHER = true;
    const bf16_t* XN; const bf16_t* WGU; const unsigned* LIST; MoeTab T; int G, c, total;
    __device__ bool next(int i, Unit& u) const {
        const int L = i * G + c; if (L >= total) return false;
        const int pn = L & 1, ru = L >> 1; int lo = 0, hi = 64;
        while (lo < hi) { const int mid = (lo + hi + 1) >> 1; if (T.ups[mid] <= ru) lo = mid; else hi = mid - 1; }
        const int e = uni(lo), j = uni(ru - T.ups[lo]);
        u.e = e; u.pm = j; u.pn = pn; u.nrows = uni(min(256, T.cnt[e] - j * 256)); u.rb = uni(T.ro[e] + j * 256);
        u.A = (const char*)XN; u.B = uni_ptr((const char*)WGU + ((size_t)e * 512 + (size_t)pn * 256) * D * 2); return true;
    }
    __device__ __forceinline__ unsigned a_off(const Unit& u, int h, int R, int C) const {
        const int idx = h * HALF + R; int tok = 0;
        if (idx < u.nrows) tok = u.e < 64 ? (int)LIST[(size_t)u.e * MT + u.pm * 256 + idx] : u.pm * 256 + idx;
        return (unsigned)(tok * D + C) * 2u;
    }
};
struct MoeOrder2 {          static constexpr bool GATHER = false;
    const bf16_t* HACT; const bf16_t* WD; MoeTab T; int G, c, total;
    __device__ bool next(int i, Unit& u) const {
        const int L = i * G + c; if (L >= total) return false;
        const int pn = L & 3, ru = L >> 2; int lo = 0, hi = 64;
        while (lo < hi) { const int mid = (lo + hi + 1) >> 1; if (T.ups[mid] <= ru) lo = mid; else hi = mid - 1; }
        const int e = uni(lo), j = uni(ru - T.ups[lo]);
        u.e = e; u.pm = j; u.pn = pn; u.nrows = uni(min(256, T.cnt[e] - j * 256)); u.rb = uni(T.ro[e] + j * 256);
        u.A = uni_ptr((const char*)HACT + (size_t)u.rb * EFF * 2); u.B = uni_ptr((const char*)WD + ((size_t)e * D + (size_t)pn * 256) * EFF * 2); return true;
    }
    __device__ __forceinline__ unsigned a_off(const Unit&, int h, int R, int C) const { return (unsigned)((h * HALF + R) * EFF + C) * 2u; }
};
struct EpiSwiglu {
    static constexpr bool PERM = true;
    bf16_t* HACT;
    __device__ __forceinline__ void operator()(const f32x4 (&acc)[2][2][4][2], const Unit& u, int wr, int wc, int fr, int fq) const {
        asm volatile("" : "+v"(fr), "+v"(fq));
#pragma unroll
        for (int ai = 0; ai < 2; ++ai)
#pragma unroll
            for (int m = 0; m < 4; ++m) { const int r = ai * HALF + wr * 64 + m * 16 + fr;
                if (r < u.nrows) { const f32x4 g0 = acc[ai][0][m][0], g1 = acc[ai][0][m][1], u0 = acc[ai][1][m][0], u1 = acc[ai][1][m][1];
                    float o[8];
#pragma unroll
                    for (int q = 0; q < 4; ++q) { o[q] = g0[q] * __builtin_amdgcn_rcpf(1.f + __expf(-g0[q])) * u0[q]; o[4 + q] = g1[q] * __builtin_amdgcn_rcpf(1.f + __expf(-g1[q])) * u1[q]; }
                    u32x4 w; w.x = cvt_pk_bf16(o[0], o[1]); w.y = cvt_pk_bf16(o[2], o[3]); w.z = cvt_pk_bf16(o[4], o[5]); w.w = cvt_pk_bf16(o[6], o[7]);
                    *(u32x4*)(HACT + (size_t)(u.rb + r) * EFF + u.pn * 128 + wc * 32 + 8 * fq) = w; } }
    }
};
struct EpiDown {
    static constexpr bool PERM = true;
    bf16_t* Y; float* XR; const float* MODl;
    __device__ __forceinline__ void operator()(const f32x4 (&acc)[2][2][4][2], const Unit& u, int wr, int wc, int fr, int fq) const {
        asm volatile("" : "+v"(fr), "+v"(fq));
        const unsigned lcol = (unsigned)(wc * 32 + 8 * fq);
        if (u.e < 64) {
            GAS char* ybase = (GAS char*)uni_ptr((const char*)(Y + (size_t)u.rb * D + u.pn * BM));
#pragma unroll
            for (int ai = 0; ai < 2; ++ai)
#pragma unroll
                for (int m = 0; m < 4; ++m) { const int r = ai * HALF + wr * 64 + m * 16 + fr;
                    if (r < u.nrows) { const unsigned off = ((unsigned)r * D + lcol) * 2u;
#pragma unroll
                        for (int bj = 0; bj < 2; ++bj) { const f32x4 v0 = acc[ai][bj][m][0], v1 = acc[ai][bj][m][1];
                            u32x4 w; w.x = cvt_pk_bf16(v0[0], v0[1]); w.y = cvt_pk_bf16(v0[2], v0[3]); w.z = cvt_pk_bf16(v1[0], v1[1]); w.w = cvt_pk_bf16(v1[2], v1[3]);
                            *(GAS u32x4*)(ybase + off + bj * HALF * 2) = w; } } }
        } else {
            const int m0 = u.pm * 256; const int rb = m0 < NX ? (m0 >> 12) : 4;
            const GAS char* mdb = (const GAS char*)uni_ptr((const char*)(MODl + (size_t)rb * 6144 + 5 * 1024 + u.pn * BM)); GAS char* xb = (GAS char*)uni_ptr((const char*)(XR + (size_t)m0 * D + u.pn * BM));
#pragma unroll
            for (int ai = 0; ai < 2; ++ai)
#pragma unroll
                for (int m = 0; m < 4; ++m) { const int r = ai * HALF + wr * 64 + m * 16 + fr;
                    if (r < u.nrows) {
#pragma unroll
                        for (int bj = 0; bj < 2; ++bj)
#pragma unroll
                            for (int n = 0; n < 2; ++n) { const unsigned c = (unsigned)(bj * HALF) + lcol + 4u * n; const unsigned off = ((unsigned)r * D + c) * 4u;
                                const f32x4 xi = *(const GAS f32x4*)(xb + off), mm = *(const GAS f32x4*)(mdb + c * 4u); *(GAS f32x4*)(xb + off) = xi + mm * acc[ai][bj][m][n]; } }
                    asm volatile("" ::: "memory"); }
        }
    }
};
}
template <bool FINAL>
__device__ __forceinline__ void ph_combine_norm(Frame& F, const bf16* Y, const int* SLOTPOS, const float* SLOTG, const float* MODl, float* XR, int ntok, const float* gainN, const float* MODn, bf16* XN, float* out) {
    MoeTab T = moe_tab(F);
    const int gw = F.vcu * NWAVES + F.wave, NGW = F.G * NWAVES, lane = F.lane;
    for (int m = gw; m < ntok; m += NGW) {
        const int rb = m < NX ? (m >> 12) : 4; const float* md = MODl + (size_t)rb * 6144 + 5 * 1024;
        float acc[16];
#pragma unroll
        for (int q = 0; q < 16; ++q) acc[q] = 0.f;
#pragma unroll
        for (int s = 0; s < 8; ++s) { const int sp = SLOTPOS[(size_t)m * 8 + s]; const int row = T.ro[sp >> 16] + (sp & 0xffff); const float gs = SLOTG[(size_t)m * 8 + s];
            const bf16* yr = Y + (size_t)row * D;
#pragma unroll
            for (int j = 0; j < 4; ++j) { const unsigned long long w = *(const unsigned long long*)(yr + 4 * lane + 256 * j);
                acc[4 * j + 0] += gs * __uint_as_float((unsigned)(w & 0xffffull) << 16); acc[4 * j + 1] += gs * __uint_as_float((unsigned)((w >> 16) & 0xffffull) << 16);
                acc[4 * j + 2] += gs * __uint_as_float((unsigned)((w >> 32) & 0xffffull) << 16); acc[4 * j + 3] += gs * __uint_as_float((unsigned)((w >> 48) & 0xffffull) << 16); } }
        f32x4 x[4]; float ss = 0.f;
#pragma unroll
        for (int j = 0; j < 4; ++j) { const int ci = 4 * lane + 256 * j; float* o = XR + (size_t)m * D + ci; const f32x4 xi = *(const f32x4*)o, mm = *(const f32x4*)(md + ci);
            x[j] = xi + mm * (f32x4){acc[4 * j], acc[4 * j + 1], acc[4 * j + 2], acc[4 * j + 3]};
            if (!FINAL) *(f32x4*)o = x[j];
            ss += (x[j].x * x[j].x + x[j].y * x[j].y) + (x[j].z * x[j].z + x[j].w * x[j].w); }
        ss = wave_sum(ss); const float rs = rsqrtf(ss * (1.f / D) + 1e-6f);
        const float* mdn = FINAL ? nullptr : MODn + (size_t)rb * 6144;
#pragma unroll
        for (int j = 0; j < 4; ++j) { const int ci = 4 * lane + 256 * j; const f32x4 g = *(const f32x4*)(gainN + ci);
            if (FINAL) *(f32x4*)(out + (size_t)m * D + ci) = x[j] * rs * g;
            else { const f32x4 y = x[j] * rs * g * (*(const f32x4*)(mdn + 1024 + ci) + 1.f) + *(const f32x4*)(mdn + ci); *(unsigned long long*)(XN + (size_t)m * D + ci) = pack4(y); } }
    }
}

__device__ __forceinline__ void d_rwkv_prep(int m_, int c_, LAS float* shm_, const bf16* P, RwP w, int layer, float* VF, float* SI, float* SV, float* BON, float* G) {
    LAS float* sp = shm_; LAS float* vd = shm_ + 960;
    const int m = m_, c = c_, h = c >> 6; const Row rw = row_of(m);
    const bf16* pr = P + (size_t)m * LDP;
    for (int j = c; j < 960; j += 256) { const float p = bf2f(pr[j]); const float pp = rw.t > 0 ? bf2f(pr[j - LDP]) : 0.f; const float pn = rw.t < rw.L - 1 ? bf2f(pr[j + LDP]) : 0.f;
        sp[j] = p + (0.5f * (pp + pn) - p) * w.mu[j]; }
    if (c < 32) vd[c] = bf2f(pr[VRES_OFF + c]);
    __syncthreads();
    const float r = sp[c], kv = sp[256 + c]; float v = sp[512 + c];
    float g = 0.f;
#pragma unroll 4
    for (int j = 0; j < 64; ++j) g += sigmoidf_(sp[896 + j]) * w.g2[j * 256 + c];
    const float kkr = kv * w.kk[c]; const float ss = wave_sum(kkr * kkr); const float kkn = kkr * rsqrtf(ss + 1e-6f);
    if (layer == 0) VF[(size_t)m * 256 + c] = v;
    else { float z = w.v0[c];
#pragma unroll 4
        for (int j = 0; j < 32; ++j) z += vd[j] * w.v2[j * 256 + c]; v = v + (VF[(size_t)m * 256 + c] - v) * sigmoidf_(z); }
    float bsum = 0.f;
#pragma nounroll
    for (int d = 0; d < 2; ++d) {
        float z = w.w0[d * 256 + c];
#pragma unroll 4
        for (int j = 0; j < 32; ++j) z += tanhf(sp[768 + d * 32 + j]) * w.w2[(d * 32 + j) * 256 + c];
        const float lw = -0.6065306597f * sigmoidf_(z);
        float za = w.a0[d * 256 + c];
#pragma unroll 4
        for (int j = 0; j < 32; ++j) za += sp[832 + d * 32 + j] * w.a2[(d * 32 + j) * 256 + c];
        const float a = sigmoidf_(za);
        const float kd = kv * (1.f + (a - 1.f) * w.ka[c]);
        const float bs = wave_sum(r * kd * w.rk[c]);
        bsum += bs * v;
        const int k = c & 63;
        si_ptr(SI, d, m, h, 0)[k] = __expf(lw); si_ptr(SI, d, m, h, 1)[k] = kkn; si_ptr(SI, d, m, h, 2)[k] = kkn * a; si_ptr(SI, d, m, h, 3)[k] = kd; si_ptr(SI, d, m, h, 4)[k] = r;
    }
    SV[(size_t)m * 256 + c] = v; BON[(size_t)m * 256 + c] = bsum; G[(size_t)m * 256 + c] = g;
}

__device__ __forceinline__ void d_rwkv_post(int m_, int c_, const float* YS, const float* BON, const float* G, const float* lnw, const float* lnb, bf16* MIX) {
    const int m = m_, c = c_;
    const float y = YS[(size_t)m * 256 + c] + YS[((size_t)MT + m) * 256 + c];
    const float mu = wave_sum(y) * (1.f / 64.f); const float dlt = y - mu; const float var = wave_sum(dlt * dlt) * (1.f / 64.f);
    const float yn = dlt * rsqrtf(var + 64e-5f);
    MIX[(size_t)m * D + c] = f2bf((yn * lnw[c] + lnb[c] + BON[(size_t)m * 256 + c]) * G[(size_t)m * 256 + c]);
}

__device__ __forceinline__ void d_ret_prep(int m_, int c_, LAS float* shm_, const bf16* P, const float* lam  , float* SI, float* SV) {
    LAS float* sq = shm_; LAS float* sk = shm_ + 256;
    const int m = m_, c = c_, h = c >> 6, i = c & 63; const Row rw = row_of(m);
    const bf16* pr = P + (size_t)m * LDP + RET_OFF;
    float q = bf2f(pr[c]), k = bf2f(pr[256 + c]); const float v = bf2f(pr[512 + c]);
    sq[c] = q; sk[c] = k; __syncthreads();
    if (rw.isx) {
        const int j = i & 31, jj = j & 15; const float pos = j < 16 ? (float)(rw.t >> 6) : (float)(rw.t & 63);
        const float inv = powf(10000.f, -(float)jj / 16.f); const float ang = pos * inv; const float cs = cosf(ang), sn = sinf(ang);
        const int pc = i < 32 ? c + 32 : c - 32;
        const float q1 = i < 32 ? q : sq[pc], q2 = i < 32 ? sq[pc] : q, k1 = i < 32 ? k : sk[pc], k2 = i < 32 ? sk[pc] : k;
        q = i < 32 ? q1 * cs - q2 * sn : q1 * sn + q2 * cs; k = i < 32 ? k1 * cs - k2 * sn : k1 * sn + k2 * cs;
    }
    k *= 0.125f;
    for (int d = 0; d < 2; ++d) { const float gm = __expf(-lam[d * 4 + h]);
        si_ptr(SI, d, m, h, 0)[i] = gm; si_ptr(SI, d, m, h, 1)[i] = 0.f; si_ptr(SI, d, m, h, 2)[i] = 0.f; si_ptr(SI, d, m, h, 3)[i] = k; si_ptr(SI, d, m, h, 4)[i] = q; }
    SV[(size_t)m * 256 + c] = v;
}

__device__ __forceinline__ void d_hnorm_post(int m_, int c_, const float* YSa, const float* YSb, const bf16* P, int gate_off, const float* nw, bf16* MIX, int mix_off) {
    const int m = m_, c = c_;
    const float o = YSa[(size_t)m * 256 + c] + YSb[(size_t)m * 256 + c];
    const float ms = wave_sum(o * o) * (1.f / 64.f);
    const float g = bf2f(P[(size_t)m * LDP + gate_off + c]);
    float y = o * rsqrtf(ms + 1e-6f) * siluf_(g); if (nw) y *= nw[c & 63];
    MIX[(size_t)m * D + mix_off + c] = f2bf(y);
}

__device__ __forceinline__ void d_gdn_prep(int m_, int c_, const bf16* P, const float* cw  , const float* alog, const float* dtb, float* SI, float* SV) {
    const int m = m_, c = c_, h = c >> 6, i = c & 63; const Row rw = row_of(m);
    const bf16* pr = P + (size_t)m * LDP + GDN_OFF;
    float o[3];
#pragma unroll
    for (int s = 0; s < 3; ++s) { const int ch = s * 256 + c; float a = 0.f;
#pragma unroll
        for (int j = 0; j < 4; ++j) { const int tt = rw.t + j - 2; if (tt >= 0 && tt < rw.L) a += bf2f(pr[(ptrdiff_t)(j - 2) * LDP + ch]) * cw[j * 768 + ch]; }
        o[s] = siluf_(a); }
    const float qs = wave_sum(o[0] * o[0]), ks = wave_sum(o[1] * o[1]);
    const float q = o[0] * rsqrtf(qs + 1e-6f) * 0.125f, k = o[1] * rsqrtf(ks + 1e-6f);
    for (int d = 0; d < 2; ++d) {
        const float a = bf2f(pr[768 + d * 4 + h]), b = bf2f(pr[776 + d * 4 + h]);
        const float al = __expf(-__expf(alog[d * 4 + h]) * softplusf_(a + dtb[d * 4 + h])), be = sigmoidf_(b);
        si_ptr(SI, d, m, h, 0)[i] = al; si_ptr(SI, d, m, h, 1)[i] = k; si_ptr(SI, d, m, h, 2)[i] = al * be * k; si_ptr(SI, d, m, h, 3)[i] = be * k; si_ptr(SI, d, m, h, 4)[i] = q; }
    SV[(size_t)m * 256 + c] = o[2];
}

__device__ __forceinline__ void d_rowscan(int seq_, int v_, LAS float* shm_, const float* SI, const float* SV, float* YS) {
    LAS float (*sh)[5][64] = (LAS float (*)[5][64])shm_;
    const int seq = seq_, d = seq & 1, h = (seq >> 1) & 3, b = seq >> 3, v = v_;
    float s[64];
#pragma unroll
    for (int k = 0; k < 64; ++k) s[k] = 0.f;
    float nx[5], nv; { const int m = step_row(b, d, 0); const float* p = SI + (((size_t)d * MT + m) * 4 + h) * 320;
#pragma unroll
        for (int j = 0; j < 5; ++j) nx[j] = p[j * 64 + v]; nv = SV[(size_t)m * 256 + h * 64 + v]; }
    for (int st = 0; st < NSTEP; ++st) {
        const int buf = st & 1; const int m = step_row(b, d, st);
#pragma unroll
        for (int j = 0; j < 5; ++j) sh[buf][j][v] = nx[j];
        const float vv = nv;
        __syncthreads();
        if (st + 1 < NSTEP) { const int m2 = step_row(b, d, st + 1); const float* p = SI + (((size_t)d * MT + m2) * 4 + h) * 320;
#pragma unroll
            for (int j = 0; j < 5; ++j) nx[j] = p[j * 64 + v]; nv = SV[(size_t)m2 * 256 + h * 64 + v]; }
        float sa = 0.f;
#pragma unroll
        for (int k = 0; k < 64; ++k) sa += s[k] * sh[buf][1][k];
        float y = 0.f;
#pragma unroll
        for (int k = 0; k < 64; ++k) { s[k] = s[k] * sh[buf][0][k] - sa * sh[buf][2][k] + vv * sh[buf][3][k]; y += s[k] * sh[buf][4][k]; }
        YS[((size_t)d * MT + m) * 256 + h * 64 + v] = y;
    }
}

__device__ __forceinline__ void d_lru_prep(int m_, int c_, LAS float* shm_, const bf16* P, LruP w, float* LA, float* LB) {
    LAS float* xs = shm_;
    const int m = m_, c = c_, h = c >> 6, i = c & 63; const Row rw = row_of(m);
    const bf16* pr = P + (size_t)m * LDP + LRU_OFF;
    float xm = w.cb[c];
#pragma unroll
    for (int j = 0; j < 4; ++j) { const int tt = rw.t + j - 2; if (tt >= 0 && tt < rw.L) xm += bf2f(pr[(ptrdiff_t)(j - 2) * LDP + c]) * w.cw[j * 256 + c]; }
    xs[c] = xm; __syncthreads();
#pragma nounroll
    for (int d = 0; d < 2; ++d) {
        float ra = w.ba[d * 256 + c], rx = w.bx[d * 256 + c];
        const float* wa = w.wa + ((size_t)(d * 4 + h) * 64) * 64 + i; const float* wx = w.wx + ((size_t)(d * 4 + h) * 64) * 64 + i;
#pragma unroll 4
        for (int j = 0; j < 64; ++j) { const float xv = xs[h * 64 + j]; ra += xv * wa[j * 64]; rx += xv * wx[j * 64]; }
        const float r = sigmoidf_(ra), ig = sigmoidf_(rx);
        const float la = -8.f * softplusf_(-w.lam[d * 256 + c]) * r;
        LA[((size_t)d * MT + m) * 256 + c] = __expf(la); LB[((size_t)d * MT + m) * 256 + c] = sqrtf(-expm1f(2.f * la)) * ig * xm;
    }
}

__device__ __forceinline__ void d_lru_scan(int bd_, int c_, const float* LA, const float* LB, float* YS) {
    const int d = bd_ & 1, b = bd_ >> 1, c = c_;
    float hst = 0.f;
    for (int st = 0; st < NSTEP; st += 8) { float a[8], bb[8]; int mm[8];
#pragma unroll
        for (int u = 0; u < 8; ++u) { mm[u] = step_row(b, d, st + u); a[u] = LA[((size_t)d * MT + mm[u]) * 256 + c]; bb[u] = LB[((size_t)d * MT + mm[u]) * 256 + c]; }
#pragma unroll
        for (int u = 0; u < 8; ++u) { hst = a[u] * hst + bb[u]; YS[((size_t)d * MT + mm[u]) * 256 + c] = hst; } }
}

__device__ __forceinline__ void d_lru_post(int m_, int c_, const float* YS, const bf16* P, bf16* MIX) {
    const int m = m_, c = c_;
    const float hs = YS[(size_t)m * 256 + c] + YS[((size_t)MT + m) * 256 + c];
    const float g = bf2f(P[(size_t)m * LDP + LRU_OFF + 256 + c]);
    const float ge = 0.5f * g * (1.f + tanhf(0.7978845608f * (g + 0.044715f * g * g * g)));
    MIX[(size_t)m * D + 768 + c] = f2bf(hs * ge);
}

#define MFMA16(a, b, c) __builtin_amdgcn_mfma_f32_16x16x16bf16_1k((a), (b), (c), 0, 0, 0)
constexpr int LSTR = 144;
constexpr int IMG = 64 * LSTR;
constexpr int ROPE_OFF = 120 * 1024;
__device__ __forceinline__ bf16x4 ldsfrag(const LAS unsigned char* img, int row, int k0) { return *(const LAS bf16x4*)(img + row * LSTR + k0 * 2); }
__device__ __forceinline__ f32x4 zero4() { return (f32x4){0.f, 0.f, 0.f, 0.f}; }
__device__ __forceinline__ f32x4 nt_tile64(const LAS unsigned char* A, int m0, const LAS unsigned char* B, int n0, int lane, f32x4 acc) {
    const int r = lane & 15, g = lane >> 4;
#pragma unroll
    for (int s = 0; s < 4; ++s) acc = MFMA16(ldsfrag(A, m0 + r, 16 * s + 4 * g), ldsfrag(B, n0 + r, 16 * s + 4 * g), acc);
    return acc;
}
__device__ __forceinline__ void unpack8(v4u w, float (&o)[8]) {
    o[0] = __uint_as_float(w.x << 16); o[1] = __uint_as_float(w.x & 0xffff0000u); o[2] = __uint_as_float(w.y << 16); o[3] = __uint_as_float(w.y & 0xffff0000u);
    o[4] = __uint_as_float(w.z << 16); o[5] = __uint_as_float(w.z & 0xffff0000u); o[6] = __uint_as_float(w.w << 16); o[7] = __uint_as_float(w.w & 0xffff0000u); }
struct TB { int m0, b, j, isx, t0; };
__device__ __forceinline__ TB tb_of(int tb) { TB r; if (tb < 256) { r.b = tb >> 6; r.j = tb & 63; r.isx = 1; r.m0 = tb * 64; r.t0 = r.j * 64; } else { const int q = tb - 256; r.b = q >> 2; r.j = q & 3; r.isx = 0; r.m0 = NX + q * 64; r.t0 = r.j * 64; } return r; }
__device__ __forceinline__ int chunk_of(const TB& t, int d) { return t.isx ? 4 + (d ? 63 - t.j : t.j) : (d ? 3 - t.j : t.j); }
__device__ __forceinline__ void build_rope(Frame& F) {
    LAS float* tab = (LAS float*)(F.lds + ROPE_OFF);
    for (int i = F.tid; i < 1024; i += NTHR) { const int pos = i >> 4, jj = i & 15; const float inv = __powf(10000.f, -(float)jj * (1.f / 16.f)); float sn, cs; sincosf((float)pos * inv, &sn, &cs); tab[2 * i] = cs; tab[2 * i + 1] = sn; }
}
__device__ __forceinline__ void load16(const bf16* P, int m, int col0, int dq, float (&lo)[8], float (&hi)[8]) {
    const v4u a = *(const v4u*)(P + (size_t)m * LDP + col0 + 8 * dq), b = *(const v4u*)(P + (size_t)m * LDP + col0 + 32 + 8 * dq); unpack8(a, lo); unpack8(b, hi); }
__device__ __forceinline__ void rope16(Frame& F, int t, int dq, float (&lo)[8], float (&hi)[8]) {
    const LAS float* tab = (const LAS float*)(F.lds + ROPE_OFF); const int pos = dq < 2 ? (t >> 6) : (t & 63); const int j0 = (8 * dq) & 15;
#pragma unroll
    for (int e = 0; e < 8; ++e) { const float cs = tab[2 * (pos * 16 + j0 + e)], sn = tab[2 * (pos * 16 + j0 + e) + 1]; const float a = lo[e], b = hi[e]; lo[e] = a * cs - b * sn; hi[e] = a * sn + b * cs; }
}
__device__ __forceinline__ void st_tok16(LAS unsigned char* img, int s, int dq, const float (&lo)[8], const float (&hi)[8]) {
    v4u a, b; a.x = pk2(lo[0], lo[1]); a.y = pk2(lo[2], lo[3]); a.z = pk2(lo[4], lo[5]); a.w = pk2(lo[6], lo[7]); b.x = pk2(hi[0], hi[1]); b.y = pk2(hi[2], hi[3]); b.z = pk2(hi[4], hi[5]); b.w = pk2(hi[6], hi[7]);
    *(LAS v4u*)(img + s * LSTR + 16 * dq) = a; *(LAS v4u*)(img + s * LSTR + 64 + 16 * dq) = b; }
__device__ __forceinline__ void st_chn16(LAS unsigned char* img, int s, int dq, const float (&lo)[8], const float (&hi)[8], float scale) {
#pragma unroll
    for (int e = 0; e < 8; ++e) { *(LAS bf16*)(img + (8 * dq + e) * LSTR + 2 * s) = f2bf(lo[e] * scale); *(LAS bf16*)(img + (32 + 8 * dq + e) * LSTR + 2 * s) = f2bf(hi[e] * scale); } }

__device__ __forceinline__ bf16* dz_blob(bf16* DZ, int d, int b, int h, int n) { return DZ + ((size_t)(((d * 4 + b) * 4 + h) * 68 + n)) * 4096; }
__device__ __forceinline__ void ph_ret_pre(Frame& F, const bf16* P, const float* lam, bf16* DZ) {
    const int half = F.tid >> 8, ht = F.tid & 255, s = ht & 63, dq = ht >> 6, wq = F.wave & 3, lane = F.lane;
    LAS unsigned char* hb = F.lds + RING_OFF + half * (3 * IMG);
    LAS unsigned char* KFT = hb, * KBT = hb + IMG, * VT = hb + 2 * IMG;
    for (int it = F.vcu; it < 544; it += F.G) {
        const int item = it * 2 + half, tbi = item >> 2, h = item & 3; const TB tb = tb_of(tbi);
        const float lgf = -lam[h], lgb = -lam[4 + h];
        { float lo[8], hi[8]; const int m = tb.m0 + s;
          load16(P, m, RET_OFF + 256 + h * 64, dq, lo, hi); if (tb.isx) rope16(F, tb.t0 + s, dq, lo, hi);
          st_chn16(KFT, s, dq, lo, hi, 0.125f * __expf((float)(63 - s) * lgf)); st_chn16(KBT, s, dq, lo, hi, 0.125f * __expf((float)s * lgb));
          load16(P, m, RET_OFF + 512 + h * 64, dq, lo, hi); st_chn16(VT, s, dq, lo, hi, 1.f); }
        LDS_BARRIER();
#pragma unroll
        for (int d = 0; d < 2; ++d) { bf16* blob = dz_blob(DZ, d, tb.b, h, chunk_of(tb, d)); const LAS unsigned char* KT = d ? KBT : KFT;
#pragma unroll
            for (int vt = 0; vt < 4; ++vt) { const f32x4 acc = nt_tile64(KT, 16 * wq, VT, 16 * vt, lane, zero4());
                *(unsigned long long*)(blob + (16 * vt + (lane & 15)) * 64 + 16 * wq + 4 * (lane >> 4)) = pack4(acc); } }
        LDS_BARRIER();
    }
}
__device__ __forceinline__ void ph_ret_prefix(Frame& F, const float* lam, bf16* DZ) {
    const int e = F.vcu * NTHR + F.tid;
    if (e >= 32 * 4096) return;
    const int seq = e >> 12, el = e & 4095, d = seq >> 4, h = seq & 3;
    const float gC = __expf(-64.f * lam[d * 4 + h]);
    GAS bf16* base = (GAS bf16*)DZ + (size_t)seq * 68 * 4096 + el; float z = 0.f;
#pragma unroll 1
    for (int n = 0; n < 68; n += 17) { float tmp[17];
#pragma unroll
        for (int u = 0; u < 17; ++u) tmp[u] = bf2f(base[(size_t)(n + u) * 4096]);
#pragma unroll
        for (int u = 0; u < 17; ++u) { base[(size_t)(n + u) * 4096] = f2bf(z); z = gC * z + tmp[u]; } }
}
__device__ __forceinline__ void ph_ret_post(Frame& F, const bf16* P, const float* lam, const bf16* DZ, bf16* MIX) {
    const int half = F.tid >> 8, ht = F.tid & 255, s = ht & 63, dq = ht >> 6, wq = F.wave & 3, lane = F.lane, r = lane & 15, g = lane >> 4;
    LAS unsigned char* hb = F.lds + RING_OFF + half * (4 * IMG);
    LAS unsigned char* Qi = hb, * Ki = hb + IMG, * VT = hb + 2 * IMG, * Wi = hb + 3 * IMG;
    for (int it = F.vcu; it < 544; it += F.G) {
        const int item = it * 2 + half, tbi = item >> 2, h = item & 3; const TB tb = tb_of(tbi);
        const float lgf = -lam[h], lgb = -lam[4 + h];
        { float lo[8], hi[8]; const int m = tb.m0 + s;
          load16(P, m, RET_OFF + h * 64, dq, lo, hi); if (tb.isx) rope16(F, tb.t0 + s, dq, lo, hi); st_tok16(Qi, s, dq, lo, hi);
          load16(P, m, RET_OFF + 256 + h * 64, dq, lo, hi); if (tb.isx) rope16(F, tb.t0 + s, dq, lo, hi);
#pragma unroll
          for (int e = 0; e < 8; ++e) { lo[e] *= 0.125f; hi[e] *= 0.125f; }
          st_tok16(Ki, s, dq, lo, hi);
          load16(P, m, RET_OFF + 512 + h * 64, dq, lo, hi); st_chn16(VT, s, dq, lo, hi, 1.f); }
        LDS_BARRIER();
        const int s0 = 16 * wq, sl = s0 + r;
#pragma unroll
        for (int jt = 0; jt < 4; ++jt) { f32x4 acc = nt_tile64(Ki, 16 * jt, Qi, s0, lane, zero4());
#pragma unroll
            for (int i = 0; i < 4; ++i) { const int j = 16 * jt + 4 * g + i; const float wf = j <= sl ? __expf((float)(sl - j) * lgf) : 0.f, wb = j >= sl ? __expf((float)(j - sl) * lgb) : 0.f; acc[i] *= (wf + wb); }
            *(LAS unsigned long long*)(Wi + sl * LSTR + 2 * (16 * jt + 4 * g)) = pack4(acc); }
        LDS_WAIT();
        const bf16* Zf = dz_blob((bf16*)DZ, 0, tb.b, h, chunk_of(tb, 0)); const bf16* Zb = dz_blob((bf16*)DZ, 1, tb.b, h, chunk_of(tb, 1));
        const float ef = __expf((float)(sl + 1) * lgf), eb = __expf((float)(64 - sl) * lgb);
        f32x4 o[4]; float ssq = 0.f;
#pragma unroll
        for (int vt = 0; vt < 4; ++vt) { f32x4 aw = nt_tile64(VT, 16 * vt, Wi, s0, lane, zero4()), af = zero4(), ab = zero4();
#pragma unroll
            for (int ks = 0; ks < 4; ++ks) { const bf16x4 qf = ldsfrag(Qi, sl, 16 * ks + 4 * g);
                const bf16x4 zf = *(const bf16x4*)(Zf + (16 * vt + r) * 64 + 16 * ks + 4 * g), zb = *(const bf16x4*)(Zb + (16 * vt + r) * 64 + 16 * ks + 4 * g);
                af = MFMA16(zf, qf, af); ab = MFMA16(zb, qf, ab); }
            o[vt] = aw + af * ef + ab * eb; ssq += (o[vt].x * o[vt].x + o[vt].y * o[vt].y) + (o[vt].z * o[vt].z + o[vt].w * o[vt].w); }
        ssq += __shfl_xor(ssq, 16); ssq += __shfl_xor(ssq, 32);
        const float rs = rsqrtf(ssq * (1.f / 64.f) + 1e-6f); const int m = tb.m0 + sl;
#pragma unroll
        for (int vt = 0; vt < 4; ++vt) { const int vd = 16 * vt + 4 * g; const unsigned long long gw = *(const unsigned long long*)(P + (size_t)m * LDP + RET_OFF + 768 + h * 64 + vd);
            f32x4 y; y.x = o[vt].x * rs * siluf_(__uint_as_float((unsigned)(gw & 0xffffull) << 16)); y.y = o[vt].y * rs * siluf_(__uint_as_float((unsigned)((gw >> 16) & 0xffffull) << 16));
            y.z = o[vt].z * rs * siluf_(__uint_as_float((unsigned)((gw >> 32) & 0xffffull) << 16)); y.w = o[vt].w * rs * siluf_(__uint_as_float((unsigned)((gw >> 48) & 0xffffull) << 16));
            *(unsigned long long*)(MIX + (size_t)m * D + 256 + h * 64 + vd) = pack4(y); }
        LDS_BARRIER();
    }
}

constexpr int IT_KP = 0, IT_RP = 8192, IT_BH = 16384, IT_UT = 24576, IT_Y0 = 32768, IT_D0 = 40960, IT_GC = 49152, ITEM_BYTES = 49664;
__device__ __forceinline__ int swz(int r, int c) { return r * 128 + (((c >> 2) ^ (r & 15)) << 3) + (c & 3) * 2; }
__device__ __forceinline__ GAS unsigned char* item_ptr(unsigned char* BL, int seq, int n) { return (GAS unsigned char*)BL + ((size_t)seq * 68 + n) * ITEM_BYTES; }
__device__ __forceinline__ bf16x4 cvt4(f32x4 v) { unsigned long long p = pack4(v); return __builtin_bit_cast(bf16x4, p); }
__device__ __forceinline__ f32x4 up4(unsigned long long w) { f32x4 r; r.x = __uint_as_float((unsigned)(w & 0xffffull) << 16); r.y = __uint_as_float((unsigned)((w >> 16) & 0xffffull) << 16);
    r.z = __uint_as_float((unsigned)((w >> 32) & 0xffffull) << 16); r.w = __uint_as_float((unsigned)((w >> 48) & 0xffffull) << 16); return r; }
constexpr int PI_A0 = 0, PI_A1 = 1, PI_A2 = 2, PI_A3 = 3, PI_KAPT = 4, PI_RHOT = 5, PI_VT = 6, PI_KHT = 7, PI_M1 = 8, PI_M2 = 9, PI_M3 = 10, PI_M4 = 11;
constexpr int PRE_TINV = 12 * IMG;
constexpr int PRE_ARR = PRE_TINV + 4 * 16 * 40;
__device__ __forceinline__ LAS unsigned char* pimg(Frame& F, int i) { return F.lds + RING_OFF + i * IMG; }

template <bool SCALAR>
__device__ __forceinline__ void dplr_core(Frame& F, GAS unsigned char* item) {
    int lane = F.lane; asm volatile("" : "+v"(lane));
    int w = F.wave; asm volatile("" : "+s"(w)); const int r = lane & 15, g = lane >> 4;
    const LAS float* Gs = (const LAS float*)(F.lds + RING_OFF + PRE_ARR); const LAS float* GM1 = Gs + 64; const LAS float* BETA = Gs + 128;
    TSEC_BEGIN(4)
    if (SCALAR) {
#pragma unroll
        for (int q = 0; q < 4; ++q) { const int e = w * 4 + q, which = e >> 4, tj = (e >> 2) & 3, tt = e & 3;
            LAS unsigned char* Ma = pimg(F, which ? PI_M3 : PI_M1); LAS unsigned char* Mb = pimg(F, which ? PI_M4 : PI_M2);
            f32x4 va = zero4(), vb = zero4(); const int t = 16 * tt + r;
            if (tj <= tt) { const f32x4 acc = nt_tile64(pimg(F, PI_A0), 16 * tj, pimg(F, which ? PI_A1 : PI_A0), 16 * tt, lane, zero4());
                const float gt = which ? Gs[t] : GM1[t];
#pragma unroll
                for (int i = 0; i < 4; ++i) { const int j = 16 * tj + 4 * g + i; const bool ok = which ? (j <= t) : (j < t); const float bj = BETA[j];
                    va[i] = ok ? acc[i] * bj * __expf(gt - GM1[j]) : 0.f; vb[i] = ok ? acc[i] * bj * __expf(gt - Gs[j]) : 0.f; } }
            *(LAS unsigned long long*)(Ma + t * LSTR + 2 * (16 * tj + 4 * g)) = pack4(va); *(LAS unsigned long long*)(Mb + t * LSTR + 2 * (16 * tj + 4 * g)) = pack4(vb); }
    } else {
#pragma unroll
        for (int q = 0; q < 8; ++q) { const int e = w * 8 + q, mi = e >> 4, tj = (e >> 2) & 3, tt = e & 3;
            LAS unsigned char* M = pimg(F, PI_M1 + mi); f32x4 va = zero4(); const int t = 16 * tt + r;
            if (tj <= tt) { const f32x4 acc = nt_tile64(pimg(F, (mi & 1) ? PI_A2 : PI_A1), 16 * tj, pimg(F, (mi & 2) ? PI_A3 : PI_A0), 16 * tt, lane, zero4());
#pragma unroll
                for (int i = 0; i < 4; ++i) { const int j = 16 * tj + 4 * g + i; const bool ok = (mi & 2) ? (j <= t) : (j < t); va[i] = ok ? acc[i] : 0.f; } }
            *(LAS unsigned long long*)(M + t * LSTR + 2 * (16 * tj + 4 * g)) = pack4(va); }
    }
    LDS_BARRIER();
    TSEC_END(4)
    TSEC_BEGIN(5)
    if (w == 0) { const int blk = lane >> 4, c = lane & 15; const LAS unsigned char* M1 = pimg(F, PI_M1); float x[16];
#pragma unroll
        for (int rr = 0; rr < 16; ++rr) { float a[16]; const v4u lo = *(const LAS v4u*)(M1 + (16 * blk + rr) * LSTR + 32 * blk), hi = *(const LAS v4u*)(M1 + (16 * blk + rr) * LSTR + 32 * blk + 16);
            { float t8[8]; unpack8(lo, t8);
#pragma unroll
              for (int q = 0; q < 8; ++q) a[q] = t8[q]; unpack8(hi, t8);
#pragma unroll
              for (int q = 0; q < 8; ++q) a[8 + q] = t8[q]; }
            float s = (rr == c) ? 1.f : 0.f;
#pragma unroll
            for (int j = 0; j < rr; ++j) s -= a[j] * x[j];
            x[rr] = s; }
        LAS unsigned char* TI = F.lds + RING_OFF + PRE_TINV + blk * 16 * 40;
#pragma unroll
        for (int rr = 0; rr < 16; ++rr) *(LAS bf16*)(TI + rr * 40 + 2 * c) = f2bf(x[rr]); }
    LDS_BARRIER();
    TSEC_END(5)
    TSEC_BEGIN(6)
    const LAS unsigned char* M1 = pimg(F, PI_M1); const LAS unsigned char* M2 = pimg(F, PI_M2); const LAS unsigned char* M3 = pimg(F, PI_M3); const LAS unsigned char* M4 = pimg(F, PI_M4);
    const LAS unsigned char* VT = pimg(F, PI_VT);
    f32x4 x[4];
    if (w < 4) {
#pragma unroll
        for (int tb = 0; tb < 4; ++tb) { f32x4 acc = zero4();
#pragma unroll
            for (int jb = 0; jb <= tb; ++jb) acc = MFMA16(ldsfrag(M2, 16 * tb + r, 16 * jb + 4 * g), ldsfrag(VT, 16 * w + r, 16 * jb + 4 * g), acc);
            x[tb] = acc; }
    } else { const LAS unsigned char* KAPT = pimg(F, PI_KAPT);
#pragma unroll
        for (int tb = 0; tb < 4; ++tb) x[tb] = up4(*(const LAS unsigned long long*)(KAPT + (16 * (w - 4) + r) * LSTR + 2 * (16 * tb + 4 * g))); }
#pragma unroll
    for (int i = 0; i < 4; ++i) { f32x4 acc = zero4();
#pragma unroll
        for (int j = 0; j < i; ++j) acc = MFMA16(ldsfrag(M1, 16 * i + r, 16 * j + 4 * g), cvt4(x[j]), acc);
        const f32x4 rhs = x[i] - acc;
        const bf16x4 tf = *(const LAS bf16x4*)(F.lds + RING_OFF + PRE_TINV + (i * 16 + r) * 40 + 8 * g);
        x[i] = MFMA16(tf, cvt4(rhs), zero4()); }
    if (w < 4) {
        const int v = 16 * w + r; GAS bf16* UT = (GAS bf16*)(item + IT_UT) + v * 64; GAS bf16* Y0T = (GAS bf16*)(item + IT_Y0) + v * 64; GAS bf16* D0T = (GAS bf16*)(item + IT_D0) + v * 64;
        const LAS unsigned char* KHT = pimg(F, PI_KHT);
#pragma unroll
        for (int tb = 0; tb < 4; ++tb) { *(GAS unsigned long long*)(UT + 16 * tb + 4 * g) = pack4(x[tb]);
            f32x4 a4 = zero4(), a3 = zero4();
#pragma unroll
            for (int jb = 0; jb <= tb; ++jb) { a4 = MFMA16(ldsfrag(M4, 16 * tb + r, 16 * jb + 4 * g), ldsfrag(VT, v, 16 * jb + 4 * g), a4); a3 = MFMA16(ldsfrag(M3, 16 * tb + r, 16 * jb + 4 * g), cvt4(x[jb]), a3); }
            *(GAS unsigned long long*)(Y0T + 16 * tb + 4 * g) = pack4(a4 - a3);
            f32x4 d0 = zero4();
#pragma unroll
            for (int sb = 0; sb < 4; ++sb) d0 = MFMA16(ldsfrag(KHT, 16 * tb + r, 16 * sb + 4 * g), ldsfrag(VT, v, 16 * sb + 4 * g), d0);
            *(GAS unsigned long long*)(D0T + 16 * tb + 4 * g) = pack4(d0); }
    } else {
        const int k = 16 * (w - 4) + r; const LAS unsigned char* RHOT = pimg(F, PI_RHOT); LAS unsigned char* KPi = pimg(F, PI_A2); LAS unsigned char* RPi = pimg(F, PI_A3);
#pragma unroll
        for (int tb = 0; tb < 4; ++tb) { f32x4 a3 = zero4();
#pragma unroll
            for (int jb = 0; jb <= tb; ++jb) a3 = MFMA16(ldsfrag(M3, 16 * tb + r, 16 * jb + 4 * g), cvt4(x[jb]), a3);
            const f32x4 rp = up4(*(const LAS unsigned long long*)(RHOT + k * LSTR + 2 * (16 * tb + 4 * g))) - a3;
#pragma unroll
            for (int i = 0; i < 4; ++i) { const int t = 16 * tb + 4 * g + i; *(LAS bf16*)(KPi + swz(t, k)) = f2bf(x[tb][i]); *(LAS bf16*)(RPi + swz(t, k)) = f2bf(rp[i]); } }
    }
    LDS_BARRIER();
    TSEC_END(6)
    TSEC_BEGIN(7)
    { const v4u a = *(const LAS v4u*)(pimg(F, PI_A2) + F.tid * 16), b = *(const LAS v4u*)(pimg(F, PI_A3) + F.tid * 16);
      *(GAS v4u*)(item + IT_KP + F.tid * 16) = a; *(GAS v4u*)(item + IT_RP + F.tid * 16) = b; }
    LDS_BARRIER();
    TSEC_END(7)
}

__device__ __forceinline__ void gdn_pre_item(Frame& F, const bf16* P, const float* cw, const float* alog, const float* dtb, unsigned char* BL, int tbi, int h, int d) {
    int w = F.wave; asm volatile("" : "+s"(w));
    const TB tb = tb_of(tbi); const int lane = F.lane, L = tb.isx ? SEQ : CTXL;
    LAS float* Gs = (LAS float*)(F.lds + RING_OFF + PRE_ARR); LAS float* GM1 = Gs + 64; LAS float* BETA = Gs + 128; LAS float* LAa = Gs + 192;
    const int seq = (d * 4 + tb.b) * 4 + h; GAS unsigned char* item = item_ptr(BL, seq, chunk_of(tb, d));
    TSEC_BEGIN(1)
    constexpr int GSTR = 400;
    LAS unsigned char* STG = pimg(F, PI_KHT);
    { const GAS bf16* Pg = (const GAS bf16*)P;
#pragma unroll
      for (int q = 0; q < 4; ++q) { const int e0 = F.tid + q * NTHR, e = e0 < 68 * 24 ? e0 : 68 * 24 - 1; const int row = e / 24, ch = e % 24, sg = ch >> 3, part = ch & 7; const int t = tb.t0 - 2 + row;
              const bool ok = t >= 0 && t < L; const int rowc = ok ? row : 2;
              v4u val = *(const GAS v4u*)(Pg + (size_t)(tb.m0 - 2 + rowc) * LDP + GDN_OFF + sg * 256 + h * 64 + part * 8);
              if (!ok) val = (v4u){0u, 0u, 0u, 0u};
              *(LAS v4u*)(STG + row * GSTR + ch * 16) = val; } }
    float qv[8], kv[8], vv[8];
    const float Aexp = __expf(alog[d * 4 + h]), dt = dtb[d * 4 + h];
    float abv[2];
    { const GAS bf16* Pg = (const GAS bf16*)P; const int s = 8 * w + (lane & 7), tau = d ? 63 - s : s; const size_t mo = (size_t)(tb.m0 + tau) * LDP + GDN_OFF;
      abv[0] = bf2f(Pg[mo + 768 + d * 4 + h]); abv[1] = bf2f(Pg[mo + 776 + d * 4 + h]); }
    LDS_BARRIER();
    { float cwv[3][4];
#pragma unroll
      for (int c3 = 0; c3 < 3; ++c3)
#pragma unroll
          for (int j = 0; j < 4; ++j) cwv[c3][j] = cw[j * 768 + c3 * 256 + h * 64 + lane];
#pragma unroll
      for (int u = 0; u < 8; ++u) { const int s = 8 * w + u, tau = d ? 63 - s : s;
          float acc3[3] = {0.f, 0.f, 0.f};
#pragma unroll
          for (int j = 0; j < 4; ++j)
#pragma unroll
              for (int c3 = 0; c3 < 3; ++c3) acc3[c3] += bf2f(*(const LAS bf16*)(STG + (tau + j) * GSTR + (c3 * 64 + lane) * 2)) * cwv[c3][j];
          const float o0 = siluf_(acc3[0]), o1 = siluf_(acc3[1]), o2 = siluf_(acc3[2]);
          const float qs = wave_sum(o0 * o0), ks = wave_sum(o1 * o1);
          qv[u] = o0 * rsqrtf(qs + 1e-6f) * 0.125f; kv[u] = o1 * rsqrtf(ks + 1e-6f); vv[u] = o2;
          const float ar = __int_as_float(__builtin_amdgcn_readlane(__float_as_int(abv[0]), u)), br = __int_as_float(__builtin_amdgcn_readlane(__float_as_int(abv[1]), u));
          const float lav = -Aexp * softplusf_(ar + dt), bev = sigmoidf_(br);
          if (lane == 0) { LAa[s] = lav; BETA[s] = bev; } } }
    TSEC_END(1)
    TSEC_BEGIN(2)
    LDS_BARRIER();
    if (w == 0) { const float la = LAa[lane]; float gsum = la;
#pragma unroll
        for (int o = 1; o < 64; o <<= 1) { const float t = __shfl_up(gsum, o); if (lane >= o) gsum += t; }
        Gs[lane] = gsum; GM1[lane] = gsum - la; }
    LDS_BARRIER();
    TSEC_END(2)
    TSEC_BEGIN(3)
    const float gc = Gs[63];
#pragma unroll
    for (int u = 0; u < 8; ++u) { const int s = 8 * w + u; const float gg = Gs[s], gm = GM1[s], be = BETA[s];
        *(LAS bf16*)(pimg(F, PI_A0) + s * LSTR + 2 * lane) = f2bf(kv[u]); *(LAS bf16*)(pimg(F, PI_A1) + s * LSTR + 2 * lane) = f2bf(qv[u]);
        *(LAS bf16*)(pimg(F, PI_KAPT) + lane * LSTR + 2 * s) = f2bf(kv[u] * __expf(gm)); *(LAS bf16*)(pimg(F, PI_RHOT) + lane * LSTR + 2 * s) = f2bf(qv[u] * __expf(gg));
        *(LAS bf16*)(pimg(F, PI_VT) + lane * LSTR + 2 * s) = f2bf(vv[u]); *(LAS bf16*)(pimg(F, PI_KHT) + lane * LSTR + 2 * s) = f2bf(be * kv[u] * __expf(gc - gg));
        *(GAS bf16*)(item + IT_BH + swz(lane, s)) = f2bf(be * kv[u] * __expf(gc - gm)); }
    if (w == 0) ((GAS float*)(item + IT_GC))[lane] = __expf(gc);
    LDS_BARRIER();
    TSEC_END(3)
    { const int rr_ = RR(28);
#pragma nounroll
      for (int q_ = 0; q_ < rr_; ++q_) dplr_core<true>(F, item); }
}
__device__ __forceinline__ void ph_gdn_pre(Frame& F, const bf16* P, const float* cw, const float* alog, const float* dtb, unsigned char* BL) {
    for (int it = F.vcu; it < 272 * 8; it += F.G) { const int tbi = it >> 3, h = (it >> 1) & 3, d = it & 1; gdn_pre_item(F, P, cw, alog, dtb, BL, tbi, h, d); }
}

constexpr int SLOT_BYTES = 24576;
__device__ __forceinline__ void dplr_scan_seq(Frame& F, const unsigned char* BLgen, int seq, float* YSgen0, float* YSgen1) {
    const GAS unsigned char* BL = (const GAS unsigned char*)BLgen; GAS float* YS = (GAS float*)((seq >> 4) ? YSgen1 : YSgen0);
    const int w = F.wave, lane = F.lane, r = lane & 15, g = lane >> 4;
    const int d = seq >> 4, b = (seq >> 2) & 3, h = seq & 3;
    LAS unsigned char* ring = F.lds + RING_OFF;
    if (w >= 4) {
        const int lw = w - 4;
#define SCAN_ISSUE(n) do { const GAS unsigned char* src = BL + ((size_t)seq * 68 + (n)) * ITEM_BYTES + lw * 6144 + lane * 16; LAS unsigned char* dst = ring + ((n) % 5) * SLOT_BYTES + lw * 6144; \
        _Pragma("unroll") for (int q = 0; q < 6; ++q) __builtin_amdgcn_global_load_lds((const GAS unsigned*)(src + q * 1024), (LAS unsigned*)(dst + q * 1024), 16, 0, 0); } while (0)
        SCAN_ISSUE(0); SCAN_ISSUE(1); SCAN_ISSUE(2); SCAN_ISSUE(3);
        asm volatile("s_waitcnt vmcnt(18)" ::: "memory");
        __builtin_amdgcn_s_barrier(); asm volatile("" ::: "memory");
        for (int n = 0; n < 68; ++n) {
            if (n + 4 < 68) { SCAN_ISSUE(n + 4); asm volatile("s_waitcnt vmcnt(18)" ::: "memory"); }
            else asm volatile("s_waitcnt vmcnt(0)" ::: "memory");
            __builtin_amdgcn_s_barrier(); asm volatile("" ::: "memory");
        }
#undef SCAN_ISSUE
    } else {
        const int v = 16 * w + r;
        f32x4 z[4];
#pragma unroll
        for (int kb = 0; kb < 4; ++kb) z[kb] = zero4();
        struct Strip { unsigned long long ut[4], y0[4], d0[4]; f32x4 gc[4]; };
#define STRIP_LOAD(S, n) do { const GAS unsigned char* it_ = BL + ((size_t)seq * 68 + (n)) * ITEM_BYTES; const GAS bf16* UT_ = (const GAS bf16*)(it_ + IT_UT) + v * 64; const GAS bf16* Y0_ = (const GAS bf16*)(it_ + IT_Y0) + v * 64; \
        const GAS bf16* D0_ = (const GAS bf16*)(it_ + IT_D0) + v * 64; const GAS float* GC_ = (const GAS float*)(it_ + IT_GC); \
        _Pragma("unroll") for (int q = 0; q < 4; ++q) { S.ut[q] = *(const GAS unsigned long long*)(UT_ + 16 * q + 4 * g); S.y0[q] = *(const GAS unsigned long long*)(Y0_ + 16 * q + 4 * g); \
            S.d0[q] = *(const GAS unsigned long long*)(D0_ + 16 * q + 4 * g); S.gc[q] = *(const GAS f32x4*)(GC_ + 16 * q + 4 * g); } } while (0)
#define SCAN_BODY(S, n) do { TSECN_BEGIN(8) const LAS unsigned char* slot = ring + ((n) % 5) * SLOT_BYTES; \
        bf16x4 zb[4]; _Pragma("unroll") for (int kb = 0; kb < 4; ++kb) zb[kb] = cvt4(z[kb]); \
        f32x4 sa[4], y[4]; \
        _Pragma("unroll") for (int tt = 0; tt < 4; ++tt) { f32x4 a = up4(S.ut[tt]), c = up4(S.y0[tt]); const int row = 16 * tt + r; \
            _Pragma("unroll") for (int kb = 0; kb < 4; ++kb) { const int off = row * 128 + (((4 * kb + g) ^ r) << 3); \
                a = MFMA16(*(const LAS bf16x4*)(slot + IT_KP + off), zb[kb], a); c = MFMA16(*(const LAS bf16x4*)(slot + IT_RP + off), zb[kb], c); } \
            sa[tt] = a; y[tt] = c; } \
        bf16x4 sb[4]; _Pragma("unroll") for (int tt = 0; tt < 4; ++tt) sb[tt] = cvt4(sa[tt]); \
        _Pragma("unroll") for (int kb = 0; kb < 4; ++kb) { f32x4 a = zero4(); const int row = 16 * kb + r; \
            _Pragma("unroll") for (int tt = 0; tt < 4; ++tt) a = MFMA16(*(const LAS bf16x4*)(slot + IT_BH + row * 128 + (((4 * tt + g) ^ r) << 3)), sb[tt], a); \
            z[kb] = S.gc[kb] * z[kb] + up4(S.d0[kb]) - a; } \
        { int m0; if ((n) < 4) { const int j = d ? 3 - (n) : (n); m0 = NX + (b * 4 + j) * 64; } else { const int j = d ? 63 - ((n) - 4) : ((n) - 4); m0 = (b * 64 + j) * 64; } \
          GAS float* yb = YS + (size_t)m0 * 256 + h * 64 + v; \
          _Pragma("unroll") for (int tt = 0; tt < 4; ++tt) _Pragma("unroll") for (int i = 0; i < 4; ++i) { const int t = 16 * tt + 4 * g + i, tau = d ? 63 - t : t; yb[(size_t)tau * 256] = y[tt][i]; } } \
        if ((n) + 2 < 68) STRIP_LOAD(S, (n) + 2); \
        TSECN_END(8) TSECN_BEGIN(9) \
        asm volatile("" ::: "memory"); __builtin_amdgcn_s_barrier(); asm volatile("" ::: "memory"); TSECN_END(9) } while (0)
        Strip S0, S1; STRIP_LOAD(S0, 0); STRIP_LOAD(S1, 1);
        __builtin_amdgcn_s_barrier(); asm volatile("" ::: "memory");
        for (int n = 0; n < 68; n += 2) { SCAN_BODY(S0, n); SCAN_BODY(S1, n + 1); }
#undef STRIP_LOAD
#undef SCAN_BODY
    }
}
__device__ __forceinline__ void rwkv_pre_item(Frame& F, const bf16* Pgen, const RwP& wp, int layer, float* VF, float* SV, float* GB, float* BSC, unsigned char* BL, int tbi, int h, int d) {
    int w = F.wave; asm volatile("" : "+s"(w));
    const GAS bf16* P = (const GAS bf16*)Pgen;
    const TB tb = tb_of(tbi); const int lane = F.lane, L = tb.isx ? SEQ : CTXL, c = h * 64 + lane;
    LAS float* WT = (LAS float*)(F.lds + RING_OFF + PRE_ARR);
    const int seq = (d * 4 + tb.b) * 4 + h; GAS unsigned char* item = item_ptr(BL, seq, chunk_of(tb, d));
    const int wacol = lane < 32 ? 768 + d * 32 + lane : 832 + d * 32 + (lane - 32);
    float sr[8], sk[8], sv[8], swa[8], svd[8], svf[8], sgd[8];
    { const float mur = wp.mu[c], muk = wp.mu[256 + c], muv = wp.mu[512 + c], muw = wp.mu[wacol], mug = wp.mu[896 + lane];
#pragma unroll
      for (int u = 0; u < 8; ++u) { const int s = 8 * w + u, tau = d ? 63 - s : s, m = tb.m0 + tau, t = tb.t0 + tau; const GAS bf16* pr = P + (size_t)m * LDP; const bool hp = t > 0, hn = t < L - 1;
#define SHF(col, mu_) ([&]() { const float p_ = bf2f(pr[(col)]); const float pp_ = bf2f(pr[(col) - offp]) * fp; const float pn_ = bf2f(pr[(col) + offn]) * fn; return p_ + (0.5f * (pp_ + pn_) - p_) * (mu_); }())
          const int offp = hp ? LDP : 0, offn = hn ? LDP : 0; const float fp = hp ? 1.f : 0.f, fn = hn ? 1.f : 0.f;
          sr[u] = SHF(c, mur); sk[u] = SHF(256 + c, muk); sv[u] = SHF(512 + c, muv); swa[u] = SHF(wacol, muw);
          svd[u] = (layer && lane < 32) ? bf2f(pr[VRES_OFF + lane]) : 0.f; svf[u] = layer ? VF[(size_t)m * 256 + c] : 0.f;
          if (d == 0) sgd[u] = SHF(896 + lane, mug); else sgd[u] = 0.f;
#undef SHF
      } }
    float rv[8], kn[8], kd[8], bv[8], lwv[8], gl[8]; float run = 0.f;
    {   float w2r[32], a2r[32];
#pragma unroll
        for (int j = 0; j < 32; ++j) { w2r[j] = wp.w2[(d * 32 + j) * 256 + c]; a2r[j] = wp.a2[(d * 32 + j) * 256 + c]; }
        const float w0c = wp.w0[d * 256 + c], a0c = wp.a0[d * 256 + c], kkc = wp.kk[c], kac = wp.ka[c], rkc = wp.rk[c];
#pragma unroll
        for (int u = 0; u < 8; ++u) { const int s = 8 * w + u, tau = d ? 63 - s : s, m = tb.m0 + tau;
            const float wa = lane < 32 ? tanhf_(swa[u]) : swa[u];
            float z = w0c, za = a0c;
#pragma unroll
            for (int j = 0; j < 32; ++j) { z += __int_as_float(__builtin_amdgcn_readlane(__float_as_int(wa), j)) * w2r[j]; za += __int_as_float(__builtin_amdgcn_readlane(__float_as_int(wa), 32 + j)) * a2r[j];
                if ((j & 7) == 7) __builtin_amdgcn_sched_barrier(0); }
            const float lw = -0.6065306597f * sigmoidf_(z), a = sigmoidf_(za);
            const float kkr = sk[u] * kkc; const float kkn = kkr * rsqrtf(wave_sum(kkr * kkr) + 1e-6f);
            const float kdv = sk[u] * (1.f + (a - 1.f) * kac);
            const float bs = wave_sum(sr[u] * kdv * rkc);
            if (lane == 0) BSC[((size_t)d * MT + m) * 4 + h] = bs;
            run += lw; rv[u] = sr[u]; kn[u] = kkn; kd[u] = kdv; bv[u] = kkn * a; lwv[u] = lw; gl[u] = run; }
    }
    if (layer) { float v2r[32]; const float v0c = wp.v0[c];
#pragma unroll
        for (int j = 0; j < 32; ++j) v2r[j] = wp.v2[j * 256 + c];
#pragma unroll
        for (int u = 0; u < 8; ++u) { float zv = v0c;
#pragma unroll
            for (int j = 0; j < 32; ++j) { zv += __int_as_float(__builtin_amdgcn_readlane(__float_as_int(svd[u]), j)) * v2r[j]; if ((j & 7) == 7) __builtin_amdgcn_sched_barrier(0); }
            sv[u] = sv[u] + (svf[u] - sv[u]) * sigmoidf_(zv); } }
    if (d == 0) {
#pragma unroll
        for (int u = 0; u < 8; ++u) { const int m = tb.m0 + 8 * w + u; if (!layer) VF[(size_t)m * 256 + c] = sv[u]; SV[(size_t)m * 256 + c] = sv[u]; } }
    WT[w * 64 + lane] = run;
    LDS_BARRIER();
    float off = 0.f, gc = 0.f;
#pragma unroll
    for (int q = 0; q < 8; ++q) { const float t = WT[q * 64 + lane]; gc += t; if (q < w) off += t; }
#pragma unroll
    for (int u = 0; u < 8; ++u) { const int s = 8 * w + u; const float G = off + gl[u]; const float eg = __expf(G), eng = __expf(-G), egc = __expf(gc - G); const bf16 kap = f2bf(kn[u] * __expf(G - lwv[u])), rho = f2bf(rv[u] * eg);
        *(LAS bf16*)(pimg(F, PI_A0) + s * LSTR + 2 * lane) = kap; *(LAS bf16*)(pimg(F, PI_KAPT) + lane * LSTR + 2 * s) = kap;
        *(LAS bf16*)(pimg(F, PI_A1) + s * LSTR + 2 * lane) = f2bf(bv[u] * eng); *(LAS bf16*)(pimg(F, PI_A2) + s * LSTR + 2 * lane) = f2bf(kd[u] * eng);
        *(LAS bf16*)(pimg(F, PI_A3) + s * LSTR + 2 * lane) = rho; *(LAS bf16*)(pimg(F, PI_RHOT) + lane * LSTR + 2 * s) = rho;
        *(LAS bf16*)(pimg(F, PI_VT) + lane * LSTR + 2 * s) = f2bf(sv[u]); *(LAS bf16*)(pimg(F, PI_KHT) + lane * LSTR + 2 * s) = f2bf(kd[u] * egc);
        *(GAS bf16*)(item + IT_BH + swz(lane, s)) = f2bf(bv[u] * egc); }
    if (w == 0) ((GAS float*)(item + IT_GC))[lane] = __expf(gc);
    if (d == 0) {
        float gs[8];
#pragma unroll
        for (int u = 0; u < 8; ++u) { gs[u] = 0.f; sgd[u] = sigmoidf_(sgd[u]); }
#pragma unroll 8
        for (int j = 0; j < 64; ++j) { const float g2v = wp.g2[j * 256 + c];
#pragma unroll
            for (int u = 0; u < 8; ++u) gs[u] += __int_as_float(__builtin_amdgcn_readlane(__float_as_int(sgd[u]), j)) * g2v; }
#pragma unroll
        for (int u = 0; u < 8; ++u) GB[(size_t)(tb.m0 + 8 * w + u) * 256 + c] = gs[u]; }
    LDS_BARRIER();
    { const int rr_ = RR(27);
#pragma nounroll
      for (int q_ = 0; q_ < rr_; ++q_) dplr_core<false>(F, item); }
}
__device__ __forceinline__ void ph_rwkv_pre(Frame& F, const bf16* P, const RwP& wp, int layer, float* VF, float* SV, float* GB, float* BSC, unsigned char* BL) {
    for (int it = F.vcu; it < 272 * 8; it += F.G) { const int tbi = it >> 3, h = (it >> 1) & 3, d = it & 1; rwkv_pre_item(F, P, wp, layer, VF, SV, GB, BSC, BL, tbi, h, d); }
}
__device__ __forceinline__ void d_rwkv_post2(int m_, int c_, const float* YS, const float* BSC, const float* SV, const float* G, const float* lnw, const float* lnb, bf16* MIX) {
    const int m = m_, c = c_, h = c >> 6;
    const float y = YS[(size_t)m * 256 + c] + YS[((size_t)MT + m) * 256 + c];
    const float mu = wave_sum(y) * (1.f / 64.f); const float dlt = y - mu; const float var = wave_sum(dlt * dlt) * (1.f / 64.f);
    const float yn = dlt * rsqrtf(var + 64e-5f);
    const float bon = (BSC[(size_t)m * 4 + h] + BSC[((size_t)MT + m) * 4 + h]) * SV[(size_t)m * 256 + c];
    MIX[(size_t)m * D + c] = f2bf((yn * lnw[c] + lnb[c] + bon) * G[(size_t)m * 256 + c]);
}

__device__ __forceinline__ void ph_lru_pre(Frame& F, const bf16* Pgen, const LruP& wp, bf16* LLAg, bf16* LBg, float* LSUMg) {
    const GAS bf16* P = (const GAS bf16*)Pgen; GAS bf16* LLA = (GAS bf16*)LLAg; GAS bf16* LB = (GAS bf16*)LBg; GAS float* LSUM = (GAS float*)LSUMg;
    const int w = F.wave, lane = F.lane, r = lane & 15, g = lane >> 4, tid = F.tid;
    LAS unsigned char* XM = F.lds + RING_OFF;
    LAS unsigned char* WA = F.lds + RING_OFF + 1 * IMG;
    LAS unsigned char* WX = F.lds + RING_OFF + 2 * IMG;
    LAS float* LAs = (LAS float*)(F.lds + RING_OFF + 3 * IMG);
    LAS float* BBs = LAs + 4096;
    const int dh = F.vcu & 7, d = dh >> 2, h = dh & 3;
    { const float* wa = wp.wa + (size_t)dh * 4096; const float* wx = wp.wx + (size_t)dh * 4096;
#pragma unroll
      for (int q = 0; q < 8; ++q) { const int e = tid + q * NTHR, i = e >> 6, j = e & 63; *(LAS bf16*)(WA + j * LSTR + 2 * i) = f2bf(wa[e]); *(LAS bf16*)(WX + j * LSTR + 2 * i) = f2bf(wx[e]); } }
    const int cc = tid & 63, sg = tid >> 6, c = h * 64 + cc;
    const float cb = wp.cb[c]; float cwv[4];
#pragma unroll
    for (int j = 0; j < 4; ++j) cwv[j] = wp.cw[j * 256 + c];
    for (int it = F.vcu; it < 272 * 8; it += F.G) {
        const int tbi = it >> 3; const TB tb = tb_of(tbi); const int L = tb.isx ? SEQ : CTXL;
        { const GAS bf16* pc = P + (size_t)tb.m0 * LDP + LRU_OFF + c; float rowv[11];
#pragma unroll
          for (int q = 0; q < 11; ++q) { const int s = 8 * sg - 2 + q, t = tb.t0 + s; const bool ok = t >= 0 && t < L; const int sc = ok ? s : 8 * sg; const float v = bf2f(pc[(ptrdiff_t)sc * LDP]); rowv[q] = ok ? v : 0.f; }
#pragma unroll
          for (int u = 0; u < 8; ++u) { const float xm = cb + rowv[u] * cwv[0] + rowv[u + 1] * cwv[1] + rowv[u + 2] * cwv[2] + rowv[u + 3] * cwv[3];
              *(LAS bf16*)(XM + (8 * sg + u) * LSTR + 2 * cc) = f2bf(xm); } }
        LDS_BARRIER();
        { const int tt = w & 3, jh = w >> 2;
#pragma unroll
          for (int jq = 0; jq < 2; ++jq) { const int jt = 2 * jh + jq;
              const f32x4 ra = nt_tile64(XM, 16 * tt, WA, 16 * jt, lane, zero4()), rx = nt_tile64(XM, 16 * tt, WX, 16 * jt, lane, zero4());
              const int j = 16 * jt + r, cj = h * 64 + j; const float ba = wp.ba[d * 256 + cj], bx = wp.bx[d * 256 + cj], lam8 = -8.f * softplusf_(-wp.lam[d * 256 + cj]);
#pragma unroll
              for (int i = 0; i < 4; ++i) { const int s = 16 * tt + 4 * g + i; const float xm = bf2f(*(const LAS bf16*)(XM + s * LSTR + 2 * j));
                  const float la = lam8 * sigmoidf_(ra[i] + ba); const float bb = __builtin_amdgcn_sqrtf(fmaxf(1.f - __expf(2.f * la), 0.f)) * sigmoidf_(rx[i] + bx) * xm;
                  LAs[s * 64 + j] = la; BBs[s * 64 + j] = bb;
                  const size_t o = ((size_t)d * MT + tb.m0 + s) * 256 + cj; LLA[o] = f2bf(la); LB[o] = f2bf(bb); } } }
        LDS_BARRIER();
        if (w == 0) { float sl = 0.f, hh = 0.f;
#pragma unroll 8
            for (int s = 0; s < 64; ++s) { const int tau = d ? 63 - s : s; const float la = LAs[tau * 64 + lane], bb = BBs[tau * 64 + lane]; sl += la; hh = __expf(la) * hh + bb; }
            LSUM[(((size_t)d * 272 + tbi) * 2 + 0) * 256 + h * 64 + lane] = sl; LSUM[(((size_t)d * 272 + tbi) * 2 + 1) * 256 + h * 64 + lane] = hh; }
        LDS_BARRIER();
    }
}
__device__ __forceinline__ void ph_lru_carry(Frame& F, const float* LSUMg, float* LCINg) {
    if (blockIdx.x >= 4) return;
    const GAS float* LSUM = (const GAS float*)LSUMg; GAS float* LCIN = (GAS float*)LCINg;
    const int e = blockIdx.x * NTHR + F.tid, c = e & 255, bd = e >> 8, d = bd & 1, b = bd >> 1;
    float hh = 0.f;
#pragma unroll 1
    for (int n0 = 0; n0 < 68; n0 += 17) { float sl[17], he[17]; int tb_[17];
#pragma unroll
        for (int u = 0; u < 17; ++u) { const int n = n0 + u; tb_[u] = n < 4 ? 256 + b * 4 + (d ? 3 - n : n) : b * 64 + (d ? 63 - (n - 4) : (n - 4));
            sl[u] = LSUM[(((size_t)d * 272 + tb_[u]) * 2 + 0) * 256 + c]; he[u] = LSUM[(((size_t)d * 272 + tb_[u]) * 2 + 1) * 256 + c]; }
#pragma unroll
        for (int u = 0; u < 17; ++u) { LCIN[((size_t)d * 272 + tb_[u]) * 256 + c] = hh; hh = __expf(sl[u]) * hh + he[u]; } }
}
__device__ __forceinline__ void ph_lru_post(Frame& F, const bf16* P, const bf16* LLA, const bf16* LB, const float* LCIN, bf16* MIX) {
    const int half = F.tid >> 8, c = F.tid & 255;
    for (int it = F.vcu; it < 136; it += F.G) { const int tbi = it * 2 + half; const TB tb = tb_of(tbi);
        float hf[64]; float hh = LCIN[((size_t)0 * 272 + tbi) * 256 + c];
        const GAS bf16* pa = (const GAS bf16*)(LLA + (size_t)tb.m0 * 256 + c); const GAS bf16* pb = (const GAS bf16*)(LB + (size_t)tb.m0 * 256 + c);
#pragma unroll
        for (int s0 = 0; s0 < 64; s0 += 8) { float la[8], bb[8];
            asm volatile("" : "+v"(pa), "+v"(pb));
#pragma unroll
            for (int u = 0; u < 8; ++u) { la[u] = bf2f(pa[u * 256]); bb[u] = bf2f(pb[u * 256]); }
#pragma unroll
            for (int u = 0; u < 8; ++u) { hh = __expf(la[u]) * hh + bb[u]; hf[s0 + u] = hh; }
            pa += 8 * 256; pb += 8 * 256; }
        hh = LCIN[((size_t)1 * 272 + tbi) * 256 + c];
        pa = (const GAS bf16*)(LLA + ((size_t)MT + tb.m0 + 56) * 256 + c); pb = (const GAS bf16*)(LB + ((size_t)MT + tb.m0 + 56) * 256 + c);
        const GAS bf16* pg = (const GAS bf16*)(P + (size_t)(tb.m0 + 56) * LDP + LRU_OFF + 256 + c); GAS bf16* pm = (GAS bf16*)(MIX + (size_t)(tb.m0 + 56) * D + 768 + c);
#pragma unroll
        for (int s0 = 56; s0 >= 0; s0 -= 8) { float la[8], bb[8], gt[8];
            asm volatile("" : "+v"(pa), "+v"(pb), "+v"(pg), "+v"(pm));
#pragma unroll
            for (int u = 0; u < 8; ++u) { la[u] = bf2f(pa[(7 - u) * 256]); bb[u] = bf2f(pb[(7 - u) * 256]); gt[u] = bf2f(pg[(7 - u) * LDP]); }
#pragma unroll
            for (int u = 0; u < 8; ++u) { const int s = s0 + 7 - u; hh = __expf(la[u]) * hh + bb[u];
                const float ge = 0.5f * gt[u] * (1.f + tanhf_(0.7978845608f * (gt[u] + 0.044715f * gt[u] * gt[u] * gt[u])));
                pm[(7 - u) * D] = f2bf((hf[s] + hh) * ge); }
            pa -= 8 * 256; pb -= 8 * 256; pg -= 8 * LDP; pm -= 8 * D; }
    }
}

__device__ __forceinline__ void ph_final_norm(Frame& F, const float* XR, const float* gain, float* out) {
    const int gw = F.vcu * NWAVES + F.wave, NGW = F.G * NWAVES, lane = F.lane;
    for (int m = gw; m < NX; m += NGW) {
        const float* src = XR + (size_t)m * D; f32x4 v[4]; float ss = 0.f;
#pragma unroll
        for (int j = 0; j < 4; ++j) { v[j] = *(const f32x4*)(src + 4 * lane + 256 * j); ss += (v[j].x * v[j].x + v[j].y * v[j].y) + (v[j].z * v[j].z + v[j].w * v[j].w); }
        ss = wave_sum(ss); const float rs = rsqrtf(ss * (1.f / D) + 1e-6f);
#pragma unroll
        for (int j = 0; j < 4; ++j) { const int ci = 4 * lane + 256 * j; *(f32x4*)(out + (size_t)m * D + ci) = v[j] * rs * *(const f32x4*)(gain + ci); }
    }
}

#define INP(i) ([&]() { int ii_ = (i); asm volatile("" : "+s"(ii_)); return (const float*)(const GAS float*)a.in[ii_]; }())
#ifndef PH_MASK
#define PH_MASK 0xfffff
#endif
#define IN(k) ((PH_MASK >> (k)) & 1)
#define SEAM() do { xcd_barrier(bar); if (PROBE_SEC == 100 + F.curk) F.tacc += clock64() - F.tph0; } while (0)
#define MOD ((float*)(GAS float*)(wsb + WS_MOD))
#define XN ((bf16*)(GAS bf16*)(wsb + WS_XN))
#define XR ((float*)(GAS float*)(wsb + WS_XR))
#define P ((bf16*)(GAS bf16*)(wsb + WS_P))
#define WIN_T ((bf16*)(GAS bf16*)(wsb + WS_WIN))
#define WOUT_T ((bf16*)(GAS bf16*)(wsb + WS_WOUT))
#define VF ((float*)(GAS float*)(wsb + WS_VF))
#define BON ((float*)(GAS float*)(wsb + WS_BON))
#define GG ((float*)(GAS float*)(wsb + WS_G))
#define YS ((float*)(GAS float*)(wsb + WS_YS))
#define SV ((float*)(GAS float*)(wsb + WS_SV))
#define SI ((float*)(GAS float*)(wsb + WS_SI))
#define WGU_T ((bf16*)(GAS bf16*)(wsb + WS_WGU))
#define WD_T ((bf16*)(GAS bf16*)(wsb + WS_WD))
#define HACT ((bf16*)(GAS bf16*)(wsb + WS_HACT))
#define Y ((bf16*)(GAS bf16*)(wsb + WS_Y))
#define DZ ((bf16*)(GAS bf16*)(wsb + WS_DZ))
#define BSC ((float*)(GAS float*)(wsb + WS_BSC))
#define YS2A ((float*)(GAS float*)(wsb + WS_BON))
#define YS2B ((float*)(GAS float*)(wsb + WS_YS2B))
#define LLA ((bf16*)(GAS bf16*)(wsb + WS_LLA))
#define LBB ((bf16*)(GAS bf16*)(wsb + WS_LB))
#define LSUM ((float*)(GAS float*)(wsb + WS_LSUM))
#define LCIN ((float*)(GAS float*)(wsb + WS_LCIN))
#define LIST ((unsigned*)(GAS unsigned*)(wsb + WS_LIST))
#define SLOTPOS ((int*)(GAS int*)(wsb + WS_SLOT))
#define SLOTG ((float*)(GAS float*)(wsb + WS_SLOTG))
#define RTW_T ((bf16*)(GAS bf16*)(wsb + WS_RTW))
#define MIX XN
#define PH() do { wsb = (GAS unsigned char*)ws; asm volatile("" : "+s"(wsb)); int t_ = threadIdx.x; asm volatile("" : "+v"(t_)); F.tid = t_; F.lane = t_ & 63; F.wave = __builtin_amdgcn_readfirstlane(t_ >> 6); half = t_ >> 8; c256 = t_ & 255; \
        shh = (LAS float*)(F.lds + RING_OFF + half * 8192); } while (0)

template <int l>
__device__ __forceinline__ void layer_body(Frame& F, const MArgs& a, const XcdBarrier& bar, unsigned char* ws) {
    GAS unsigned char* wsb = (GAS unsigned char*)ws; int half = 0, c256 = 0; LAS float* shh = nullptr;
        const float* MODl = MOD + (size_t)l * 5 * 6144;
        const float* xs = l == 0 ? INP(I_X) : XR; const float* cs = l == 0 ? INP(I_CTX) : XR + (size_t)NX * D;
        const int ntok = l == 0 ? MT : NX;
        if (IN(1) && l == 0) for (int rp_ = 0; rp_ < REPS(1); ++rp_) { PH(); F.curk = 1; if (PROBE_SEC >= 100) F.tph0 = clock64(); ph_norm_mod(F, xs, cs, INP(I_NMIX) + l * D, MODl, 0, XN, MT); SEAM(); }
        if (IN(2)) for (int rp_ = 0; rp_ < REPS(2); ++rp_) { PH(); F.curk = 2; if (PROBE_SEC >= 100) F.tph0 = clock64(); pg8::DenseOrder S; S.init(XN, WIN_T + (size_t)l * LDP * D, MT, LDP, D, F.G, (int)blockIdx.x); pg8::EpiStoreBf16 E{P, LDP};
            pg8::gemm_phase<pg8::EpiStoreBf16, pg8::DenseOrder, true>(F.lds + RING_OFF, D, S, E); SEAM(); }
        float* LA = SI; float* LB = SI + (size_t)2 * MT * 256;
        if (IN(3)) for (int rp_ = 0; rp_ < REPS(3); ++rp_) { PH(); F.curk = 3; if (PROBE_SEC >= 100) F.tph0 = clock64(); const RwP rwp{INP(I_RWMU) + l * 960, INP(I_RWW0) + l * 512, INP(I_RWW2) + l * 2 * 32 * 256, INP(I_RWA0) + l * 512, INP(I_RWA2) + l * 2 * 32 * 256, INP(I_RWG2) + l * 64 * 256, INP(I_RWKK) + l * 256, INP(I_RWKA) + l * 256,
                      INP(I_RWRK) + l * 256, INP(I_RWV0), INP(I_RWV2)};
            ph_rwkv_pre(F, P, rwp, l, VF, SV, GG, BSC, (unsigned char*)SI); SEAM(); }
        if (IN(4)) for (int rp_ = 0; rp_ < REPS(4); ++rp_) { PH(); F.curk = 4; if (PROBE_SEC >= 100) F.tph0 = clock64();
            if (blockIdx.x < 32) dplr_scan_seq(F, (const unsigned char*)SI, (int)blockIdx.x, YS, YS + (size_t)MT * 256);
            else { const int vcu0 = F.vcu, G0 = F.G; F.vcu = (int)blockIdx.x - 32; F.G = G0 - 32;
                { const LruP lrp{INP(I_LCW) + l * 4 * 256, INP(I_LCB) + l * 256, INP(I_LWA) + (size_t)l * 2 * 4 * 64 * 64, INP(I_LBA) + l * 512, INP(I_LWX) + (size_t)l * 2 * 4 * 64 * 64, INP(I_LBX) + l * 512, INP(I_LLAM) + l * 512};
                  ph_lru_pre(F, P, lrp, LLA, LBB, LSUM); }
                __syncthreads(); build_rope(F); __syncthreads(); ph_ret_pre(F, P, INP(I_RETL) + l * 8, DZ);
                F.vcu = vcu0; F.G = G0; }
            SEAM(); }
        if (IN(5)) for (int rp_ = 0; rp_ < REPS(5); ++rp_) { PH(); F.curk = 5; if (PROBE_SEC >= 100) F.tph0 = clock64();
            ph_gdn_pre(F, P, INP(I_GCW) + l * 4 * 768, INP(I_GALOG) + l * 8, INP(I_GDT) + l * 8, (unsigned char*)SI);
            ph_ret_prefix(F, INP(I_RETL) + l * 8, DZ); ph_lru_carry(F, LSUM, LCIN); SEAM(); }
        if (IN(8)) for (int rp_ = 0; rp_ < REPS(8); ++rp_) { PH(); F.curk = 8; if (PROBE_SEC >= 100) F.tph0 = clock64();
            if (blockIdx.x < 32) dplr_scan_seq(F, (const unsigned char*)SI, (int)blockIdx.x, YS2A, YS2B);
            else { const int vcu0 = F.vcu, G0 = F.G; F.vcu = (int)blockIdx.x - 32; F.G = G0 - 32;
                for (int it = F.vcu; it < MT / 2; it += F.G) { const int m = it * 2 + half; d_rwkv_post2(m, c256, YS, BSC, SV, GG, INP(I_RWLNW) + l * 256, INP(I_RWLNB) + l * 256, MIX); }
                build_rope(F); __syncthreads(); ph_ret_post(F, P, INP(I_RETL) + l * 8, DZ, MIX); __syncthreads(); ph_lru_post(F, P, LLA, LBB, LCIN, MIX);
                F.vcu = vcu0; F.G = G0; }
            SEAM(); }
        if (IN(9)) for (int rp_ = 0; rp_ < REPS(9); ++rp_) { PH(); F.curk = 9; if (PROBE_SEC >= 100) F.tph0 = clock64(); for (int it = F.vcu; it < MT / 2; it += F.G) { const int m = it * 2 + half; d_hnorm_post(m, c256, YS2A, YS2B, P, GDN_OFF + 784, INP(I_GNW) + l * 64, MIX, 512); } SEAM(); }
        if (IN(12)) for (int rp_ = 0; rp_ < REPS(12); ++rp_) { PH(); F.curk = 12; if (PROBE_SEC >= 100) F.tph0 = clock64(); pg8::DenseOrder S; S.init(MIX, WOUT_T + (size_t)l * D * D, l == 0 ? MT : NX  , D, D, F.G, (int)blockIdx.x); pg8::EpiResidual E{xs, cs, MODl, XR};
            pg8::gemm_phase<pg8::EpiResidual, pg8::DenseOrder, true>(F.lds + RING_OFF, D, S, E); SEAM(); }
        if (IN(13)) for (int rp_ = 0; rp_ < REPS(13); ++rp_) { PH(); F.curk = 13; if (PROBE_SEC >= 100) F.tph0 = clock64(); ph_route(F, XR, INP(I_NFFN) + l * D, MODl, RTW_T + (size_t)l * 2 * 64 * 1024, INP(I_RTB) + l * NE, XN, l, LIST, SLOTPOS, SLOTG, ntok); __syncthreads();
{ const int rr_ = RR(29);
#pragma nounroll
            for (int q_ = 0; q_ < rr_; ++q_) { ph_convert_experts(F, INP(I_EWG) + (size_t)l * NE * D * EFF, INP(I_EWU) + (size_t)l * NE * D * EFF, INP(I_EWD) + (size_t)l * NE * EFF * D,
                               INP(I_SWG) + (size_t)l * D * EFF, INP(I_SWU) + (size_t)l * D * EFF, INP(I_SWD) + (size_t)l * EFF * D, WGU_T, WD_T); __syncthreads(); } }
            SEAM(); }
        if (IN(14)) for (int rp_ = 0; rp_ < REPS(14); ++rp_) { PH(); F.curk = 14; if (PROBE_SEC >= 100) F.tph0 = clock64(); moe_build_tab(F, l, ntok); MoeTab T = moe_tab(F);
            pg8::MoeOrder1 S{XN, WGU_T, LIST, T, F.G, (int)blockIdx.x, T.ups[65] * 2}; pg8::EpiSwiglu E{HACT};
            pg8::gemm_phase<pg8::EpiSwiglu, pg8::MoeOrder1, true>(F.lds + RING_OFF, D, S, E); SEAM(); }
        if (IN(15)) for (int rp_ = 0; rp_ < REPS(15); ++rp_) { PH(); F.curk = 15; if (PROBE_SEC >= 100) F.tph0 = clock64(); moe_build_tab(F, l, ntok); MoeTab T = moe_tab(F);
            pg8::MoeOrder2 S{HACT, WD_T, T, F.G, (int)blockIdx.x, T.ups[65] * 4}; pg8::EpiDown E{Y, XR, MODl};
            int k2 = EFF; asm volatile("" : "+s"(k2));
            pg8::gemm_phase<pg8::EpiDown, pg8::MoeOrder2, true>(F.lds + RING_OFF, k2, S, E); SEAM(); }
        if (IN(16)) for (int rp_ = 0; rp_ < REPS(16); ++rp_) { PH(); F.curk = 16; if (PROBE_SEC >= 100) F.tph0 = clock64(); moe_build_tab(F, l, ntok);
            if (l == 0) ph_combine_norm<false>(F, Y, SLOTPOS, SLOTG, MODl, XR, ntok, INP(I_NMIX) + D, MOD + (size_t)5 * 6144, XN, nullptr);
            else ph_combine_norm<true>(F, Y, SLOTPOS, SLOTG, MODl, XR, ntok, INP(I_NFIN), nullptr, nullptr, a.out);
            if (l == 0) SEAM(); }
    }

__global__ void __launch_bounds__(NTHR, 2) mega(MArgs a) {
    extern __shared__ __attribute__((aligned(16))) unsigned char lds_raw[];
    Frame F; F.lds = (LAS unsigned char*)lds_raw; F.MISC = (volatile LAS unsigned*)(F.lds + MISC_OFF);
    F.tid = threadIdx.x; F.lane = F.tid & 63; F.wave = __builtin_amdgcn_readfirstlane(F.tid >> 6); F.tacc = 0ull;
    F.G = gridDim.x; { const int bx = blockIdx.x; F.vcu = (F.G % 8 == 0) ? (bx % 8) * (F.G / 8) + bx / 8 : bx; }
    unsigned char* ws = a.ws; F.ctl = (gu32*)ws;
    for (int u = F.tid; u < (LDS_BYTES - LDSCTL_OFF) / 4; u += NTHR) ((LAS unsigned*)(F.lds + LDSCTL_OFF))[u] = 0u;
    __syncthreads();
    XcdBarrier bar = xcd_barrier_post((unsigned*)(F.ctl + CW_BAR) + a.bar_region * XCD_BAR_WORDS, F.MISC + 8);
    GAS unsigned char* wsb = (GAS unsigned char*)ws;
    int half = 0, c256 = 0; LAS float* shh = nullptr;

    if (IN(0)) for (int rp_ = 0; rp_ < REPS(0); ++rp_) { PH(); F.curk = 0; if (PROBE_SEC >= 100) F.tph0 = clock64(); ph_mod(F, INP(I_C), INP(I_CCTX), INP(I_ADAW), INP(I_ADAB), MOD); ph_convert_small(F, INP(I_WIN), INP(I_WVRES), INP(I_WOUT), WIN_T, WOUT_T); ph_convert_router(F, INP(I_RTW), RTW_T); SEAM(); }
    layer_body<0>(F, a, bar, ws);
    layer_body<1>(F, a, bar, ws);
    if (PROBE_SEC >= 0 && blockIdx.x == 0) { const unsigned long long t0_ = clock64(); while (clock64() - t0_ < F.tacc) __builtin_amdgcn_s_sleep(4); }
#undef PH
#undef MOD
#undef XN
#undef XR
#undef P
#undef WIN_T
#undef WOUT_T
#undef VF
#undef BON
#undef GG
#undef YS
#undef SV
#undef SI
#undef WGU_T
#undef WD_T
#undef HACT
#undef Y
#undef DZ
#undef BSC
#undef YS2A
#undef YS2B
#undef LLA
#undef LBB
#undef LSUM
#undef LCIN
#undef LIST
#undef SLOTPOS
#undef SLOTG
#undef RTW_T
#undef MIX
#undef IN
#undef SEAM
}

extern "C" void kernel_launch(void* const* d_in, const int* in_sizes, int n_in, void* d_out, int out_size, void* d_ws, size_t ws_size, hipStream_t stream) {
    static int grid = 0;
    if (grid == 0) {
        if (n_in != I_N || ws_size < WS_END) { fprintf(stderr, "kernel_launch: bad n_in %d or ws %zu\n", n_in, ws_size); grid = -1; return; }
        int dev = 0, cus = 0;
        if (hipGetDevice(&dev) != hipSuccess || hipDeviceGetAttribute(&cus, hipDeviceAttributeMultiprocessorCount, dev) != hipSuccess) { grid = -1; return; }
        if (hipFuncSetAttribute((const void*)mega, hipFuncAttributeMaxDynamicSharedMemorySize, LDS_BYTES) != hipSuccess) { grid = -1; return; }
        int per_cu = 0; (void)hipOccupancyMaxActiveBlocksPerMultiprocessor(&per_cu, (const void*)mega, NTHR, LDS_BYTES); (void)hipGetLastError();
        grid = cus;
    }
    if (grid < 0) return;
    unsigned char* ws = (unsigned char*)d_ws;
    (void)hipMemsetAsync(ws, 0, CTL_ZERO_BYTES, stream);
    MArgs ma{}; for (int i = 0; i < I_N; ++i) ma.in[i] = (const float*)d_in[i]; ma.out = (float*)d_out; ma.ws = ws;
    ma.ph_lo = 0; ma.ph_hi = 18; ma.l_lo = 0; ma.l_hi = 2; ma.bar_region = 0;
    hipLaunchKernelGGL(mega, dim3(grid), dim3(NTHR), LDS_BYTES, stream, ma);
}
```

```cpp
#include <hip/hip_runtime.h>
#include <cstdio>
#include <cstdint>

typedef unsigned short bf16;
#ifndef PROBE_SEC
#define PROBE_SEC -1
#endif
__device__ unsigned long long g_tsec_dummy;
#define TSEC_BEGIN(id) unsigned long long ts0_##id = 0; if ((id) == PROBE_SEC) { asm volatile("s_waitcnt vmcnt(0) lgkmcnt(0)" ::: "memory"); ts0_##id = clock64(); }
#define TSECN_BEGIN(id) unsigned long long tn0_##id = 0; if ((id) == PROBE_SEC) { tn0_##id = clock64(); }
#define TSECN_END(id) if ((id) == PROBE_SEC) { F.tacc += clock64() - tn0_##id; }
#define TSEC_END(id) if ((id) == PROBE_SEC) { asm volatile("s_waitcnt vmcnt(0) lgkmcnt(0)" ::: "memory"); F.tacc += clock64() - ts0_##id; }
#ifndef PROBE_MASK
#define PROBE_MASK 0
#endif
#define REPS(k) (((PROBE_MASK >> (k)) & 1) ? 2 : 1)
#define RR(k) ([]() { int r_ = REPS(k); asm volatile("" : "+s"(r_)); return r_; }())
__device__ __forceinline__ float bf2f(bf16 v) { return __uint_as_float(((unsigned)v) << 16); }
typedef float f32x2_ __attribute__((ext_vector_type(2)));
typedef __bf16 bf16x2_ __attribute__((ext_vector_type(2)));
__device__ __forceinline__ unsigned cvtpk_bf16(float lo, float hi) { f32x2_ v = {lo, hi}; bf16x2_ b = __builtin_convertvector(v, bf16x2_); return __builtin_bit_cast(unsigned, b); }
__device__ __forceinline__ bf16 f2bf(float f) { return (bf16)(cvtpk_bf16(f, f) & 0xffffu); }

constexpr int D = 1024, NB = 4, SEQ = 4096, CTXL = 256;
constexpr int NX = NB * SEQ;
constexpr int NC = NB * CTXL;
constexpr int MT = NX + NC;
constexpr int NIN = 3536, NINV = 3568, LDP = 3584;
constexpr int RW_OFF = 0, RET_OFF = 960, GDN_OFF = 1984, LRU_OFF = 3024, VRES_OFF = 3536;
constexpr int NE = 64, TOPK = 8, EFF = 256;
constexpr int NSTEP = CTXL + SEQ;

constexpr size_t MiB = 1u << 20;
constexpr size_t WS_MOD = 1 * MiB;
constexpr size_t WS_XN = 2 * MiB;
constexpr size_t WS_XR = 36 * MiB;
constexpr size_t WS_VF = 104 * MiB;
constexpr size_t WS_LIST = 121 * MiB;
constexpr size_t WS_SLOTG = 126 * MiB;
constexpr size_t WS_RTW = 127 * MiB;
constexpr size_t WS_RWT = 128 * MiB;
constexpr size_t WS_SLOT = 130 * MiB;
constexpr size_t WS_WIN = 131 * MiB;
constexpr size_t WS_WOUT = 145 * MiB;
constexpr size_t WS_SI = 149 * MiB;
constexpr size_t WS_LLA = 253 * MiB;
constexpr size_t WS_LB = 270 * MiB;
constexpr size_t WS_LSUM = 287 * MiB;
constexpr size_t WS_LCIN = 289 * MiB;
constexpr size_t WS_BSC = 290 * MiB;
constexpr size_t WS_YS2B = 291 * MiB;
constexpr size_t WS_P = 319 * MiB;
constexpr size_t WS_BON = 438 * MiB;
constexpr size_t WS_G = 455 * MiB;
constexpr size_t WS_YS = 472 * MiB;
constexpr size_t WS_SV = 506 * MiB;
constexpr size_t WS_DZ = 523 * MiB;
constexpr size_t WS_WD = 149 * MiB;
constexpr size_t WS_HACT = 182 * MiB;
constexpr size_t WS_Y = 267 * MiB;
constexpr size_t WS_WGU = 267 * MiB;
constexpr size_t WS_END = 540 * MiB;

struct Row { int b, t, L, isx; };
__device__ __forceinline__ Row row_of(int m) { Row r; if (m < NX) { r.b = m >> 12; r.t = m & 4095; r.L = SEQ; r.isx = 1; } else { int q = m - NX; r.b = q >> 8; r.t = q & 255; r.L = CTXL; r.isx = 0; } return r; }
__device__ __forceinline__ float frcp_(float x) { return __builtin_amdgcn_rcpf(x); }
__device__ __forceinline__ float sigmoidf_(float x) { return frcp_(1.f + __expf(-x)); }
__device__ __forceinline__ float softplusf_(float x) { return x > 20.f ? x : __logf(1.f + __expf(x)); }
__device__ __forceinline__ float siluf_(float x) { return x * frcp_(1.f + __expf(-x)); }
__device__ __forceinline__ float tanhf_(float x) { const float xc = fminf(fmaxf(x, -15.f), 15.f); return 1.f - 2.f * frcp_(1.f + __expf(2.f * xc)); }
__device__ __forceinline__ float dpp_f(float v, const int ctrl) { return v; }
#define DPPF(v, ctrl) __int_as_float(__builtin_amdgcn_update_dpp(0, __float_as_int(v), (ctrl), 0xf, 0xf, true))
__device__ __forceinline__ float wave_sum(float v) {
    v += DPPF(v, 0xB1); v += DPPF(v, 0x4E); v += DPPF(v, 0x141); v += DPPF(v, 0x140);
    return (__int_as_float(__builtin_amdgcn_readlane(__float_as_int(v), 0)) + __int_as_float(__builtin_amdgcn_readlane(__float_as_int(v), 16))) +
           (__int_as_float(__builtin_amdgcn_readlane(__float_as_int(v), 32)) + __int_as_float(__builtin_amdgcn_readlane(__float_as_int(v), 48)));
}

struct EpiP { bf16* P; __device__ void operator()(int m, int n, float v) const { P[(size_t)m * LDP + n] = f2bf(v); } };
struct EpiRes { const float* xs; const float* cs; const float* MODl; float* XR; __device__ void operator()(int m, int n, float v) const {
    const float xin = m < NX ? xs[(size_t)m * D + n] : cs[(size_t)(m - NX) * D + n]; const int rb = m < NX ? (m >> 12) : 4;
    XR[(size_t)m * D + n] = xin + MODl[(size_t)rb * 6144 + 2 * 1024 + n] * v; } };

__device__ __forceinline__ float* si_ptr(float* SI, int d, int m, int h, int vec) { return SI + ((((size_t)d * MT + m) * 4 + h) * 5 + vec) * 64; }

struct RwP { const float *mu, *w0, *w2, *a0, *a2, *g2, *kk, *ka, *rk, *v0, *v2; };

__device__ __forceinline__ int step_row(int b, int d, int s) { if (s < CTXL) { const int tc = d ? CTXL - 1 - s : s; return NX + b * CTXL + tc; } const int tx = d ? SEQ - 1 - (s - CTXL) : (s - CTXL); return b * SEQ + tx; }
struct LruP { const float *cw, *cb, *wa, *ba, *wx, *bx, *lam; };

struct MoeW { const float *wg, *wu, *wd, *sg, *su, *sd; };

enum { I_X = 0, I_C, I_CTX, I_CCTX, I_ADAW, I_ADAB, I_NMIX, I_NFFN, I_NFIN, I_WIN, I_WVRES, I_WOUT, I_RWMU, I_RWW0, I_RWW2, I_RWA0, I_RWA2, I_RWG2, I_RWKK, I_RWKA, I_RWRK, I_RWLNW, I_RWLNB, I_RWV0, I_RWV2,
       I_RETL, I_GCW, I_GALOG, I_GDT, I_GNW, I_LCW, I_LCB, I_LWA, I_LBA, I_LWX, I_LBX, I_LLAM, I_RTW, I_RTB, I_EWG, I_EWU, I_EWD, I_SWG, I_SWU, I_SWD, I_N };
#define GAS __attribute__((address_space(1)))
#define LAS __attribute__((address_space(3)))
typedef unsigned v4u __attribute__((ext_vector_type(4)));
typedef float f32x4 __attribute__((ext_vector_type(4)));
typedef short bf16x8 __attribute__((ext_vector_type(8)));
typedef GAS unsigned gu32;
#define RLX_AGENT __ATOMIC_RELAXED, __HIP_MEMORY_SCOPE_AGENT
#define LDS_WAIT() asm volatile("s_waitcnt lgkmcnt(0)" ::: "memory")
#define VM_WAIT() asm volatile("s_waitcnt vmcnt(0)" ::: "memory")
#define LDS_BARRIER() do { asm volatile("s_waitcnt lgkmcnt(0)" ::: "memory"); __builtin_amdgcn_s_barrier(); asm volatile("" ::: "memory"); } while (0)
__device__ __forceinline__ unsigned pk2(float lo, float hi) { return cvtpk_bf16(lo, hi); }
__device__ __forceinline__ unsigned long long pack4(f32x4 v) { return (unsigned long long)pk2(v.x, v.y) | ((unsigned long long)pk2(v.z, v.w) << 32); }

namespace pg8 {
#define PG8_LAS __attribute__((address_space(3)))
typedef unsigned short bf16_t;
typedef unsigned u32x4 __attribute__((ext_vector_type(4)));
constexpr int BM = 256, BK = 64, HALF = 128, HTB = HALF * BK * 2, STAGE_BYTES = 8 * HTB, NXCD = 8, WGM = 8;
__host__ __device__ __forceinline__ int lds_byte(int r, int c) { const int st = (r >> 4) * 2 + (c >> 5), rr = r & 15, cc = c & 31, ob = rr * 64 + cc * 2; return st * 1024 + (ob ^ (((ob >> 9) & 1) << 5)); }
__host__ __device__ __forceinline__ void stage_rc(int b, int& R, int& C) { const int st = b / 1024, sb = b % 1024, swz = sb ^ (((sb >> 9) & 1) << 5); R = (st >> 1) * 16 + swz / 64; C = (st & 1) * 32 + (swz % 64) / 2; }
__host__ __device__ __forceinline__ int perm32(int rho) { const int n = rho >> 4, i = rho & 15; return 8 * (i >> 2) + 4 * n + (i & 3); }
__device__ __forceinline__ unsigned cvt_pk_bf16(float lo, float hi) { unsigned r; asm volatile("v_cvt_pk_bf16_f32 %0, %1, %2" : "=v"(r) : "v"(lo), "v"(hi)); return r; }

struct Unit { const char* A; const char* B; int pm, pn, e, nrows, rb; };

struct DenseOrder {
    static constexpr bool GATHER = false;
    const bf16_t* A; const bf16_t* Bt; int K, nM, nN, nwg, G, c;
    __device__ void init(const bf16_t* A_, const bf16_t* Bt_, int M, int N, int K_, int G_, int c_) { A = A_; Bt = Bt_; K = K_; nM = M / BM; nN = N / BM; nwg = nM * nN; G = G_; c = c_; }
    __device__ bool next(int i, Unit& u) const {
        const long L = (long)i * G + c; if (L >= nwg) return false;
        int wgid = (int)L; { const int q = nwg / NXCD, r = nwg % NXCD, xcd = wgid % NXCD, off = wgid / NXCD; wgid = (xcd < r ? xcd * (q + 1) : r * (q + 1) + (xcd - r) * q) + off; }
        const int nig = WGM * nN, gid = wgid / nig, fm = gid * WGM, gsz = (nM - fm) < WGM ? (nM - fm) : WGM;
        u.pm = fm + ((wgid % nig) % gsz); u.pn = (wgid % nig) / gsz; u.e = 0; u.nrows = BM; u.rb = 0;
        u.A = (const char*)A + (size_t)u.pm * BM * K * 2; u.B = (const char*)Bt + (size_t)u.pn * BM * K * 2; return true;
    }
    __device__ __forceinline__ unsigned a_off(const Unit&, int h, int R, int C) const { return (unsigned)((h * HALF + R) * K + C) * 2u; }
};

template <class Epi, class Sched, bool ALIGN_EPI = false>
__device__ __forceinline__ void gemm_phase(PG8_LAS unsigned char* lds, const int K, const Sched& S, const Epi& E) {
    int tid = threadIdx.x; asm volatile("" : "+v"(tid));
    const int wid = __builtin_amdgcn_readfirstlane(tid >> 6), lane = tid & 63, wr = wid >> 2, wc = wid & 3, fr = lane & 15, fq = lane >> 4;
    const int nt = K / BK;
    unsigned voffB[2];
#pragma unroll
    for (int i = 0; i < 2; ++i) { int R, C; stage_rc(tid * 16 + i * 8192, R, C); const int Rb = Epi::PERM ? ((R & ~31) + perm32(R & 31)) : R; voffB[i] = (unsigned)(Rb * K + C) * 2u; }
    const size_t kstep = (size_t)(BK * 2);
    const size_t hstep = (size_t)HALF * K * 2;
    const unsigned ldsw = (unsigned)wid * 1024u;
    const int aoff = lds_byte(wr * 64 + fr, fq * 8), boff = lds_byte(wc * 32 + fr, fq * 8);
#define PG8_SA(b, h) (((b) * 2 + (h)) * HTB)
#define PG8_SB(b, h) ((4 + (b) * 2 + (h)) * HTB)
#define PG8_STAGE(bufoff, gbase, voff) do { _Pragma("unroll") for (int _i = 0; _i < 2; ++_i) \
        __builtin_amdgcn_global_load_lds((const unsigned*)((const char*)(gbase) + (voff)[_i]), (PG8_LAS unsigned*)(lds + (bufoff) + ldsw + _i * 8192), 16, 0, 0); } while (0)
#define PG8_LDA(dst, b, h) do { _Pragma("unroll") for (int m = 0; m < 4; ++m) _Pragma("unroll") for (int k = 0; k < 2; ++k) dst[m][k] = *(const PG8_LAS bf16x8*)(lds + PG8_SA(b, h) + aoff + m * 2048 + k * 1024); } while (0)
#define PG8_LDB(dst, b, h) do { _Pragma("unroll") for (int n = 0; n < 2; ++n) _Pragma("unroll") for (int k = 0; k < 2; ++k) dst[n][k] = *(const PG8_LAS bf16x8*)(lds + PG8_SB(b, h) + boff + n * 2048 + k * 1024); } while (0)
#define PG8_MMA(ai, bj, At, Bt) do { __builtin_amdgcn_s_setprio(1); _Pragma("unroll") for (int m = 0; m < 4; ++m) _Pragma("unroll") for (int n = 0; n < 2; ++n) _Pragma("unroll") for (int k = 0; k < 2; ++k) \
        acc[ai][bj][m][n] = __builtin_amdgcn_mfma_f32_16x16x32_bf16(Bt[n][k], At[m][k], acc[ai][bj][m][n], 0, 0, 0); __builtin_amdgcn_s_setprio(0); } while (0)
#define PG8_WAIT_V(n) asm volatile("s_waitcnt vmcnt(" #n ")" ::: "memory")
#define PG8_WAIT_L(n) asm volatile("s_waitcnt lgkmcnt(" #n ")" ::: "memory")
#define PG8_BAR __builtin_amdgcn_s_barrier()
#define PG8_SCHED __builtin_amdgcn_sched_barrier(0)
    Unit cur, nxt; int ui = 0;
    if (!S.next(0, cur)) return;
    f32x4 acc[2][2][4][2];
#pragma unroll
    for (int a = 0; a < 2; ++a)
#pragma unroll
        for (int b = 0; b < 2; ++b)
#pragma unroll
            for (int m = 0; m < 4; ++m)
#pragma unroll
                for (int n = 0; n < 2; ++n) acc[a][b][m][n] = (f32x4){0.f, 0.f, 0.f, 0.f};
    bf16x8 At[4][2], B0[2][2], B1[2][2];
    unsigned cv0[2], cv1[2], nv0[2], nv1[2];
#pragma unroll
    for (int i = 0; i < 2; ++i) { int R, C; stage_rc(tid * 16 + i * 8192, R, C); cv0[i] = S.a_off(cur, 0, R, C); cv1[i] = S.a_off(cur, 1, R, C); nv0[i] = cv0[i]; nv1[i] = cv1[i]; }
    const char* cA = cur.A; const char* cB = cur.B;
    PG8_STAGE(PG8_SB(0, 0), cB, voffB); PG8_STAGE(PG8_SB(0, 1), cB + hstep, voffB); PG8_STAGE(PG8_SA(0, 0), cA, cv0); PG8_STAGE(PG8_SA(0, 1), cA, cv1);
    if (wr == 1) PG8_BAR;
    PG8_WAIT_V(2); PG8_BAR;
    PG8_STAGE(PG8_SB(1, 0), cB + kstep, voffB); PG8_STAGE(PG8_SA(1, 0), cA + kstep, cv0); PG8_STAGE(PG8_SB(1, 1), cB + hstep + kstep, voffB);
    PG8_WAIT_V(6); PG8_BAR;
    for (;;) {
        const bool has_next = S.next(ui + 1, nxt);
        const char* nA = has_next ? nxt.A : cA; const char* nB = has_next ? nxt.B : cB;
        if constexpr (Sched::GATHER) {
        if (has_next) {
#pragma unroll
            for (int i = 0; i < 2; ++i) { int tt = threadIdx.x; asm volatile("" : "+v"(tt)); int R, C; stage_rc(tt * 16 + i * 8192, R, C); nv0[i] = S.a_off(nxt, 0, R, C); nv1[i] = S.a_off(nxt, 1, R, C); } }
        else {
#pragma unroll
            for (int i = 0; i < 2; ++i) { nv0[i] = cv0[i]; nv1[i] = cv1[i]; } } }
        for (int t = 0; t < nt; t += 2) {
            const bool last = (t == nt - 2);
            const char* a1 = cA + (size_t)(t + 1) * kstep;
            const char* a2 = last ? nA : cA + (size_t)(t + 2) * kstep; const char* b2 = last ? nB : cB + (size_t)(t + 2) * kstep;
            const char* a3 = a2 + kstep; const char* b3 = b2 + kstep;
            unsigned x0[2], x1[2];
#pragma unroll
            for (int i = 0; i < 2; ++i) { if constexpr (Sched::GATHER) { x0[i] = last ? nv0[i] : cv0[i]; x1[i] = last ? nv1[i] : cv1[i]; } else { x0[i] = cv0[i]; x1[i] = cv1[i]; } }
            PG8_LDB(B0, 0, 0); PG8_LDB(B1, 0, 1); PG8_SCHED; PG8_LDA(At, 0, 0); PG8_STAGE(PG8_SA(1, 1), a1, cv1);
            PG8_WAIT_V(8); PG8_WAIT_L(0); PG8_BAR; PG8_MMA(0, 0, At, B0); PG8_MMA(0, 1, At, B1); PG8_BAR; PG8_SCHED;
            PG8_LDA(At, 0, 1); PG8_STAGE(PG8_SB(0, 0), b2, voffB); PG8_STAGE(PG8_SB(0, 1), b2 + hstep, voffB); PG8_STAGE(PG8_SA(0, 0), a2, x0);
            PG8_WAIT_V(8); PG8_WAIT_L(0); PG8_BAR; PG8_MMA(1, 0, At, B0); PG8_MMA(1, 1, At, B1); PG8_BAR; PG8_SCHED;
            PG8_LDB(B0, 1, 0); PG8_LDB(B1, 1, 1); PG8_SCHED; PG8_LDA(At, 1, 0); PG8_STAGE(PG8_SA(0, 1), a2, x1);
            PG8_WAIT_V(8); PG8_WAIT_L(0); PG8_BAR; PG8_MMA(0, 0, At, B0); PG8_MMA(0, 1, At, B1); PG8_BAR; PG8_SCHED;
            PG8_LDA(At, 1, 1); PG8_STAGE(PG8_SB(1, 0), b3, voffB); PG8_STAGE(PG8_SB(1, 1), b3 + hstep, voffB); PG8_STAGE(PG8_SA(1, 0), a3, x0);
            PG8_WAIT_V(8); PG8_WAIT_L(0); PG8_BAR; PG8_MMA(1, 0, At, B0); PG8_MMA(1, 1, At, B1); PG8_BAR; PG8_SCHED;
        }
        if constexpr (ALIGN_EPI) { if (wr == 0) PG8_BAR; }
        E(acc, cur, wr, wc, fr, fq);
        if (!has_next) break;
#pragma unroll
        for (int a = 0; a < 2; ++a)
#pragma unroll
            for (int b = 0; b < 2; ++b)
#pragma unroll
                for (int m = 0; m < 4; ++m)
#pragma unroll
                    for (int n = 0; n < 2; ++n) acc[a][b][m][n] = (f32x4){0.f, 0.f, 0.f, 0.f};
        cur = nxt; cA = nA; cB = nB; ++ui;
        if constexpr (Sched::GATHER) {
#pragma unroll
            for (int i = 0; i < 2; ++i) { cv0[i] = nv0[i]; cv1[i] = nv1[i]; } }
        if constexpr (ALIGN_EPI) { if (wr == 1) PG8_BAR; }
    }
    PG8_WAIT_V(0);
    if constexpr (!ALIGN_EPI) { if (wr == 0) PG8_BAR; }
    PG8_BAR;
#undef PG8_SA
#undef PG8_SB
#undef PG8_STAGE
#undef PG8_LDA
#undef PG8_LDB
#undef PG8_MMA
#undef PG8_WAIT_V
#undef PG8_WAIT_L
#undef PG8_BAR
#undef PG8_SCHED
}

struct EpiStoreBf16 {
    static constexpr bool PERM = true;
    bf16_t* O; int ldc;
    __device__ __forceinline__ void operator()(const f32x4 (&acc)[2][2][4][2], const Unit& u, int wr, int wc, int fr, int fq) const {
        asm volatile("" : "+v"(fr), "+v"(fq));
        const int row0 = u.pm * BM + wr * 64 + fr, col0 = u.pn * BM + wc * 32 + 8 * fq;
#pragma unroll
        for (int ai = 0; ai < 2; ++ai)
#pragma unroll
            for (int m = 0; m < 4; ++m) { bf16_t* rowp = O + (size_t)(row0 + ai * HALF + m * 16) * ldc + col0;
#pragma unroll
                for (int bj = 0; bj < 2; ++bj) { const f32x4 v0 = acc[ai][bj][m][0], v1 = acc[ai][bj][m][1];
                    u32x4 w; w.x = cvt_pk_bf16(v0[0], v0[1]); w.y = cvt_pk_bf16(v0[2], v0[3]); w.z = cvt_pk_bf16(v1[0], v1[1]); w.w = cvt_pk_bf16(v1[2], v1[3]);
                    *(u32x4*)(rowp + bj * HALF) = w; } }
    }
};
struct EpiResidual {
    static constexpr bool PERM = false;
    const float* xs; const float* cs; const float* MODl; float* XR;
    __device__ __forceinline__ void operator()(const f32x4 (&acc)[2][2][4][2], const Unit& u, int wr, int wc, int fr, int fq) const {
        asm volatile("" : "+v"(fr), "+v"(fq));
        const int row0 = u.pm * BM + wr * 64 + fr, col0 = u.pn * BM + wc * 32 + 4 * fq;
#pragma unroll
        for (int ai = 0; ai < 2; ++ai)
#pragma unroll
            for (int m = 0; m < 4; ++m) { const int row = row0 + ai * HALF + m * 16;
                const float* xin = row < NX ? xs + (size_t)row * D : cs + (size_t)(row - NX) * D; const int rb = row < NX ? (row >> 12) : 4;
                const float* md = MODl + (size_t)rb * 6144 + 2 * 1024; float* o = XR + (size_t)row * D;
#pragma unroll
                for (int bj = 0; bj < 2; ++bj)
#pragma unroll
                    for (int n = 0; n < 2; ++n) { const int c = col0 + bj * HALF + n * 16; const f32x4 xi = *(const f32x4*)(xin + c), mm = *(const f32x4*)(md + c); *(f32x4*)(o + c) = xi + mm * acc[ai][bj][m][n]; } }
    }
};
}

#define XB_TMO      128
#define XB_XCNT(j)  (256  + 64 * (j))
#define XB_XSUB(j)  (1280 + 64 * (j))
#define XB_XGEN(j)  (2304 + 64 * (j))
#define XB_TOP      3328
#define XB_TOPGEN   3392
#define XCD_BAR_WORDS 3456
#define XB_SPIN_CAP (1u << 22)
__device__ __forceinline__ unsigned xb_ld(unsigned* p)              { return __hip_atomic_load(p, __ATOMIC_RELAXED, __HIP_MEMORY_SCOPE_AGENT); }
__device__ __forceinline__ unsigned xb_add(unsigned* p, unsigned v) { return __hip_atomic_fetch_add(p, v, __ATOMIC_RELAXED, __HIP_MEMORY_SCOPE_AGENT); }
__device__ __forceinline__ unsigned xb_xcc_id() { return (unsigned)__builtin_amdgcn_s_getreg((3 << 11) | 20) & 0xFu; }
#define XB_SPIN(cond, bar) do { unsigned _sp = 0; while (cond) { __builtin_amdgcn_s_sleep(1); \
    if ((++_sp & 255u) == 0u) { if (xb_ld(&(bar)[XB_TMO])) break; if (_sp > XB_SPIN_CAP) { atomicAdd(&(bar)[XB_TMO], 1u); break; } } } } while (0)
struct XcdBarrier { unsigned* bar; unsigned x; volatile LAS unsigned* st; };
__device__ __forceinline__ XcdBarrier xcd_barrier_post(unsigned* bar, volatile LAS unsigned* st) {
    XcdBarrier b; b.bar = bar; b.x = (unsigned)__builtin_amdgcn_readfirstlane((int)xb_xcc_id()); b.st = st;
    if (threadIdx.x == 0) (void)xb_add(&bar[XB_XCNT(b.x)], 1u);
    return b;
}
__device__ __forceinline__ void xcd_barrier_complete(unsigned* bar, unsigned x, unsigned& nloc, unsigned& nx) {
    const unsigned G = gridDim.x * gridDim.y * gridDim.z;
    unsigned sum, cnt, mine, sp = 0u;
    for (;;) {
        sum = 0u; cnt = 0u; mine = 0u;
#pragma unroll
        for (unsigned j = 0; j < 16; ++j) { const unsigned c = xb_ld(&bar[XB_XCNT(j)]); sum += c; cnt += (c > 0u) ? 1u : 0u; mine = (j == x) ? c : mine; }
        if (sum == G) break;
        __builtin_amdgcn_s_sleep(1);
        if ((++sp & 255u) == 0u) { if (xb_ld(&bar[XB_TMO])) break; if (sp > XB_SPIN_CAP) { atomicAdd(&bar[XB_TMO], 1u); break; } }
    }
    nloc = mine > 0u ? mine : 1u; nx = cnt > 0u ? cnt : 1u;
}
__device__ __forceinline__ void xcd_barrier(const XcdBarrier& b) {
    asm volatile("s_waitcnt vmcnt(0)" ::: "memory");
    __syncthreads();
    if (threadIdx.x == 0) {
        unsigned* bar = b.bar; const unsigned bx = (unsigned)__builtin_amdgcn_readfirstlane((int)xb_xcc_id());
        __builtin_amdgcn_s_waitcnt(0);
        unsigned nloc = b.st[0], nx = b.st[1];
        if (nloc == 0u) { xcd_barrier_complete(bar, bx, nloc, nx); b.st[0] = nloc; b.st[1] = nx; }
        const unsigned old = xb_add(&bar[XB_XSUB(bx)], 1u);
        const unsigned gen = old / nloc;
        if (old + 1u == (gen + 1u) * nloc) {
            __builtin_amdgcn_fence(__ATOMIC_RELEASE, "agent");
            asm volatile("s_waitcnt vmcnt(0)" ::: "memory");
            const unsigned og = xb_add(&bar[XB_TOP], 1u);
            const unsigned tg = og / nx;
            if (og + 1u == (tg + 1u) * nx) xb_add(&bar[XB_TOPGEN], 1u);
            else XB_SPIN(xb_ld(&bar[XB_TOPGEN]) == tg, bar);
            __builtin_amdgcn_fence(__ATOMIC_ACQUIRE, "agent");
            xb_add(&bar[XB_XGEN(bx)], 1u);
            asm volatile("s_waitcnt vmcnt(0)" ::: "memory");
        } else {
            XB_SPIN(xb_ld(&bar[XB_XGEN(bx)]) == gen, bar);
            __builtin_amdgcn_fence(__ATOMIC_ACQUIRE, "agent");
            asm volatile("s_waitcnt vmcnt(0)" ::: "memory");
        }
    }
    __syncthreads();
}

constexpr int NWAVES = 8, NTHR = 512;
constexpr int RING_OFF = 0, RING_BYTES = 131072;
constexpr int LDSCTL_OFF = RING_BYTES, MISC_OFF = LDSCTL_OFF + 320;
constexpr int LDS_BYTES = 147456;
constexpr int CW_BAR = 4096;
constexpr size_t CTL_ZERO_BYTES = 1 * MiB;

struct MArgs {
    const float* in[45]; float* out; unsigned char* ws; int ph_lo, ph_hi, l_lo, l_hi, bar_region, pad;
};
struct Frame { LAS unsigned char* lds; volatile LAS unsigned* MISC; gu32* ctl; int tid, lane, wave, vcu, G; unsigned long long tacc, tph0; int curk; };

__device__ __forceinline__ void transpose_item(const float* W, int ldw, int N, int k0, int n0, bf16* WT, int ldt, int drow0, LAS float* scr, int lane) {
    const int nn = n0 + (lane & 31); const bool okn = nn < N;
#pragma unroll 8
    for (int i = 0; i < 32; ++i) { const int kk = 2 * i + (lane >> 5); scr[kk * 33 + (lane & 31)] = okn ? W[(size_t)(k0 + kk) * ldw + nn] : 0.f; }
    LDS_WAIT(); asm volatile("" ::: "memory");
    const int c = lane & 7;
#pragma unroll
    for (int j = 0; j < 4; ++j) { const int n = (lane >> 3) + 8 * j; const LAS float* s = scr + (8 * c) * 33 + n;
        v4u o; o.x = pk2(s[0 * 33], s[1 * 33]); o.y = pk2(s[2 * 33], s[3 * 33]); o.z = pk2(s[4 * 33], s[5 * 33]); o.w = pk2(s[6 * 33], s[7 * 33]);
        if (n0 + n < N) *(GAS v4u*)(WT + (size_t)(drow0 + n) * ldt + k0 + 8 * c) = o; }
    LDS_WAIT(); asm volatile("" ::: "memory");
}

__device__ __forceinline__ void ph_mod(Frame& F, const float* c, const float* cctx, const float* ada_w, const float* ada_b, float* MOD) {
    LAS float* s = (LAS float*)(F.lds + RING_OFF);
    LAS float* red = s + 5 * 1024;
    for (int i = F.tid; i < 5 * 1024; i += NTHR) { const int r = i >> 10, k = i & 1023; const float v = r < 4 ? c[r * 1024 + k] : cctx[k]; s[i] = siluf_(v); }
    __syncthreads();
    for (int u = F.vcu; u < 192; u += F.G) {
        const int l = u / 96, j0 = (u % 96) * 64, cl = F.tid & 63, kp = F.tid >> 6;
        const float* W = ada_w + (size_t)l * 1024 * 6144 + j0 + cl;
        float acc[5] = {0.f, 0.f, 0.f, 0.f, 0.f};
        for (int k = kp * 128; k < kp * 128 + 128; ++k) { const float w = W[(size_t)k * 6144];
#pragma unroll
            for (int r = 0; r < 5; ++r) acc[r] += s[r * 1024 + k] * w; }
#pragma unroll
        for (int r = 0; r < 5; ++r) red[(kp * 5 + r) * 64 + cl] = acc[r];
        __syncthreads();
        if (F.tid < 320) { const int r = F.tid >> 6; float a = ada_b[l * 6144 + j0 + cl];
#pragma unroll
            for (int q = 0; q < 8; ++q) a += red[(q * 5 + r) * 64 + cl];
            MOD[((size_t)l * 5 + r) * 6144 + j0 + cl] = a; }
        __syncthreads();
    }
}
__device__ __forceinline__ void ph_convert_small(Frame& F, const float* w_in, const float* w_vres, const float* w_out, bf16* WIN_T  , bf16* WOUT_T  ) {
    LAS float* scr = (LAS float*)(F.lds + RING_OFF + 32768 + F.wave * 16384 / 2);
    scr = (LAS float*)(F.lds + RING_OFF + 32768 + F.wave * 9216);
    const int gw = F.vcu * NWAVES + F.wave, NGW = F.G * NWAVES;
    constexpr int NB_IN = (NIN + 31) / 32;
    constexpr int I_IN = 16 * NB_IN, I_VR = 16 * 1, I_OUT = 16 * 32;
    constexpr int PER_L = I_IN + I_VR + I_OUT;
    for (int it = gw; it < 2 * PER_L; it += NGW) {
        const int l = it / PER_L; int r = it % PER_L;
        if (r < I_IN) { const int kb = r / NB_IN, nb = r % NB_IN; transpose_item(w_in + (size_t)l * D * NIN, NIN, NIN, kb * 64, nb * 32, WIN_T + (size_t)l * LDP * D, D, nb * 32, scr, F.lane); continue; } r -= I_IN;
        if (r < I_VR) { if (l == 1) transpose_item(w_vres, 32, 32, r * 64, 0, WIN_T + (size_t)LDP * D, D, NIN, scr, F.lane); continue; } r -= I_VR;
        { const int kb = r / 32, nb = r % 32; transpose_item(w_out + (size_t)l * D * D, D, D, kb * 64, nb * 32, WOUT_T + (size_t)l * D * D, D, nb * 32, scr, F.lane); }
    }
}
__device__ __forceinline__ void ph_norm_mod(Frame& F, const float* xs, const float* cs, const float* gain, const float* MODl, int si, bf16* XN, int nrows) {
    const int gw = F.vcu * NWAVES + F.wave, NGW = F.G * NWAVES, lane = F.lane;
    for (int m0 = gw; m0 < nrows; m0 += 2 * NGW) {
        const int m1 = m0 + NGW < nrows ? m0 + NGW : m0;
        const float* s0 = m0 < NX ? xs + (size_t)m0 * D : cs + (size_t)(m0 - NX) * D; const float* s1 = m1 < NX ? xs + (size_t)m1 * D : cs + (size_t)(m1 - NX) * D;
        f32x4 v0[4], v1[4]; float q0 = 0.f, q1 = 0.f;
#pragma unroll
        for (int j = 0; j < 4; ++j) { v0[j] = *(const f32x4*)(s0 + 4 * lane + 256 * j); v1[j] = *(const f32x4*)(s1 + 4 * lane + 256 * j); }
#pragma unroll
        for (int j = 0; j < 4; ++j) { q0 += (v0[j].x * v0[j].x + v0[j].y * v0[j].y) + (v0[j].z * v0[j].z + v0[j].w * v0[j].w); q1 += (v1[j].x * v1[j].x + v1[j].y * v1[j].y) + (v1[j].z * v1[j].z + v1[j].w * v1[j].w); }
        q0 = wave_sum(q0); q1 = wave_sum(q1); const float r0 = rsqrtf(q0 * (1.f / D) + 1e-6f), r1 = rsqrtf(q1 * (1.f / D) + 1e-6f);
        const float* md0 = MODl + (size_t)(m0 < NX ? (m0 >> 12) : 4) * 6144; const float* md1 = MODl + (size_t)(m1 < NX ? (m1 >> 12) : 4) * 6144;
#pragma unroll
        for (int j = 0; j < 4; ++j) { const int ci = 4 * lane + 256 * j; const f32x4 g = *(const f32x4*)(gain + ci);
            const f32x4 y0 = v0[j] * r0 * g * (*(const f32x4*)(md0 + (si + 1) * 1024 + ci) + 1.f) + *(const f32x4*)(md0 + si * 1024 + ci);
            const f32x4 y1 = v1[j] * r1 * g * (*(const f32x4*)(md1 + (si + 1) * 1024 + ci) + 1.f) + *(const f32x4*)(md1 + si * 1024 + ci);
            *(unsigned long long*)(XN + (size_t)m0 * D + ci) = pack4(y0); *(unsigned long long*)(XN + (size_t)m1 * D + ci) = pack4(y1); }
    }
}

typedef short bf16x4 __attribute__((ext_vector_type(4)));
constexpr int CW_CNT = 16384;
constexpr int TAB_OFF = LDSCTL_OFF + 1024;
struct MoeTab { LAS int* cnt; LAS int* ups; LAS int* ro; };
__device__ __forceinline__ MoeTab moe_tab(Frame& F) { MoeTab t; t.cnt = (LAS int*)(F.lds + TAB_OFF); t.ups = t.cnt + 80; t.ro = t.ups + 80; return t; }
__device__ __forceinline__ void moe_build_tab(Frame& F, int layer, int ntok) {
    MoeTab T = moe_tab(F);
    if (F.tid < 64) T.cnt[F.tid] = (int)__hip_atomic_load(F.ctl + CW_CNT + (layer * 64 + F.tid) * 64, RLX_AGENT);
    if (F.tid == 64) T.cnt[64] = ntok;
    __syncthreads();
    if (F.tid == 0) { int u = 0, r = 0; for (int e = 0; e < 65; ++e) { T.ups[e] = u; T.ro[e] = r; u += (T.cnt[e] + 255) >> 8; r += T.cnt[e]; } T.ups[65] = u; T.ro[65] = r; }
    __syncthreads();
}
__device__ __forceinline__ int uni(int v) { return __builtin_amdgcn_readfirstlane(v); }
__device__ __forceinline__ const char* uni_ptr(const char* p) { unsigned long long v = (unsigned long long)p; unsigned lo = __builtin_amdgcn_readfirstlane((unsigned)v), hi = __builtin_amdgcn_readfirstlane((unsigned)(v >> 32)); return (const char*)(((unsigned long long)hi << 32) | lo); }

__device__ __forceinline__ void ph_convert_router(Frame& F, const float* rtw, bf16* RT) {
    for (int i = F.vcu * NTHR + F.tid; i < 2 * 64 * 1024; i += F.G * NTHR) { const int l = i >> 16, e = (i >> 10) & 63, k = i & 1023;
        const float x = rtw[((size_t)l * 1024 + k) * 64 + e]; const bf16 hi = f2bf(x); const bf16 lo = f2bf(x - bf2f(hi));
        RT[(((size_t)l * 2 + 0) * 64 + e) * 1024 + k] = hi; RT[(((size_t)l * 2 + 1) * 64 + e) * 1024 + k] = lo; }
}
__device__ __forceinline__ void ph_route(Frame& F, const float* XR, const float* gain, const float* MODl, const bf16* RTl  , const float* rbias, bf16* XN, int layer,
                                         unsigned* LIST, int* SLOTPOS, float* SLOTG, int ntok) {
    constexpr int HSTR = 2064;
    LAS unsigned char* HH = F.lds + RING_OFF;
    LAS unsigned char* HL = F.lds + RING_OFF + 16 * HSTR;
    LAS float* part = (LAS float*)(F.lds + RING_OFF + 32 * HSTR);
    LAS float* sc = (LAS float*)(F.lds + RING_OFF + 32 * HSTR + 32768);
    LAS int* lcnt = (LAS int*)(F.lds + RING_OFF + 32 * HSTR + 32768 + 4096);
    LAS int* lbase = lcnt + 64;
    if (F.tid < 64) lcnt[F.tid] = 0;
    const int lane = F.lane, wv = F.wave, tid = F.tid, r = lane & 15, g = lane >> 4;
    const int ngrp = ntok / 16;
    bf16x4 BH[4][8], BL[4][8];
    { const GAS bf16* R = (const GAS bf16*)RTl;
#pragma unroll
      for (int nt = 0; nt < 4; ++nt)
#pragma unroll
          for (int ks = 0; ks < 8; ++ks) { const size_t o = (size_t)(16 * nt + r) * 1024 + 128 * wv + 16 * ks + 4 * g; BH[nt][ks] = *(const GAS bf16x4*)(R + o); BL[nt][ks] = *(const GAS bf16x4*)(R + 65536 + o); } }
    f32x4 vq[2][4];
    { const int m0 = (F.vcu < ngrp ? F.vcu : 0) * 16 + 2 * wv;
#pragma unroll
      for (int tt = 0; tt < 2; ++tt)
#pragma unroll
          for (int j = 0; j < 4; ++j) vq[tt][j] = *(const GAS f32x4*)((const GAS float*)XR + (size_t)(m0 + tt) * D + 4 * lane + 256 * j); }
    for (int gi = F.vcu; gi < ngrp; gi += F.G) {
        TSEC_BEGIN(20)
#pragma unroll
        for (int tt = 0; tt < 2; ++tt) {
            const int tl = 2 * wv + tt, m = gi * 16 + tl;
            const int rb = m < NX ? (m >> 12) : 4; const float* md = MODl + (size_t)rb * 6144;
            float ss = 0.f;
#pragma unroll
            for (int j = 0; j < 4; ++j) { const f32x4 x = vq[tt][j]; ss += (x.x * x.x + x.y * x.y) + (x.z * x.z + x.w * x.w); }
            ss = wave_sum(ss); const float rs = rsqrtf(ss * (1.f / D) + 1e-6f);
#pragma unroll
            for (int j = 0; j < 4; ++j) { const int ci = 4 * lane + 256 * j; const f32x4 gg = *(const f32x4*)(gain + ci), sh = *(const f32x4*)(md + 3 * 1024 + ci), scl = *(const f32x4*)(md + 4 * 1024 + ci);
                const f32x4 y = vq[tt][j] * rs * gg * (scl + 1.f) + sh;
                const unsigned h0 = pk2(y.x, y.y), h1 = pk2(y.z, y.w);
                const f32x4 yl = (f32x4){y.x - __uint_as_float(h0 << 16), y.y - __uint_as_float(h0 & 0xffff0000u), y.z - __uint_as_float(h1 << 16), y.w - __uint_as_float(h1 & 0xffff0000u)};
                const unsigned long long hw = (unsigned long long)h0 | ((unsigned long long)h1 << 32);
                *(LAS unsigned long long*)(HH + tl * HSTR + ci * 2) = hw; *(LAS unsigned long long*)(HL + tl * HSTR + ci * 2) = pack4(yl);
                *(unsigned long long*)(XN + (size_t)m * D + ci) = hw; }
        }
        { const int gn = gi + F.G < ngrp ? gi + F.G : gi; const int m0 = gn * 16 + 2 * wv;
#pragma unroll
          for (int tt = 0; tt < 2; ++tt)
#pragma unroll
              for (int j = 0; j < 4; ++j) vq[tt][j] = *(const GAS f32x4*)((const GAS float*)XR + (size_t)(m0 + tt) * D + 4 * lane + 256 * j); }
        LDS_BARRIER();
        TSEC_END(20)
        TSEC_BEGIN(21)
        { f32x4 acc[4];
#pragma unroll
          for (int nt = 0; nt < 4; ++nt) acc[nt] = (f32x4){0.f, 0.f, 0.f, 0.f};
#pragma unroll
          for (int ks = 0; ks < 8; ++ks) { const int ko = (128 * wv + 16 * ks + 4 * g) * 2; const bf16x4 ah = *(const LAS bf16x4*)(HH + r * HSTR + ko), al = *(const LAS bf16x4*)(HL + r * HSTR + ko);
#pragma unroll
              for (int nt = 0; nt < 4; ++nt) { acc[nt] = __builtin_amdgcn_mfma_f32_16x16x16bf16_1k(ah, BH[nt][ks], acc[nt], 0, 0, 0); acc[nt] = __builtin_amdgcn_mfma_f32_16x16x16bf16_1k(al, BH[nt][ks], acc[nt], 0, 0, 0);
                  acc[nt] = __builtin_amdgcn_mfma_f32_16x16x16bf16_1k(ah, BL[nt][ks], acc[nt], 0, 0, 0); } }
#pragma unroll
          for (int nt = 0; nt < 4; ++nt)
#pragma unroll
              for (int i = 0; i < 4; ++i) part[(wv * 16 + 4 * g + i) * 64 + 16 * nt + r] = acc[nt][i]; }
        LDS_BARRIER();
#pragma unroll
        for (int q = 0; q < 2; ++q) { const int t = (tid >> 6) + 8 * q, e = tid & 63; float a = 0.f;
#pragma unroll
            for (int kp = 0; kp < 8; ++kp) a += part[(kp * 16 + t) * 64 + e];
            sc[t * 64 + e] = sigmoidf_(a); }
        LDS_BARRIER();
        TSEC_END(21)
        TSEC_BEGIN(22)
#pragma unroll
        for (int tt = 0; tt < 2; ++tt) {
            const int tl = 2 * wv + tt, m = gi * 16 + tl;
            const float s = sc[tl * 64 + lane]; const float sel = s + rbias[lane]; int rank8 = 0;
#pragma unroll 16
            for (int j = 0; j < 64; ++j) { const float oj = __int_as_float(__builtin_amdgcn_readlane(__float_as_int(sel), j)); rank8 += (oj > sel || (oj == sel && j < lane)) ? 1 : 0; }
            const int myk = rank8 < 8 ? rank8 : -1;
            const float ssum = wave_sum(myk >= 0 ? s : 0.f);
            if (myk >= 0) { const int lr = __hip_atomic_fetch_add(lcnt + lane, 1, __ATOMIC_RELAXED, __HIP_MEMORY_SCOPE_WORKGROUP);
                SLOTPOS[(size_t)m * 8 + myk] = (lane << 16) | lr; SLOTG[(size_t)m * 8 + myk] = 2.5f * s * __builtin_amdgcn_rcpf(ssum); }
        }
        LDS_BARRIER();
        TSEC_END(22)
    }
    asm volatile("s_waitcnt vmcnt(0)" ::: "memory"); __syncthreads();
    if (F.tid < 64) { const int n = lcnt[F.tid]; lbase[F.tid] = n > 0 ? (int)__hip_atomic_fetch_add(F.ctl + CW_CNT + (layer * 64 + F.tid) * 64, (unsigned)n, RLX_AGENT) : 0; }
    __syncthreads();
    for (int gi = F.vcu; gi < ngrp; gi += F.G) {
        if (tid < 128) { const int m = gi * 16 + (tid >> 3), k = tid & 7; const int sp = (int)__hip_atomic_load((unsigned*)SLOTPOS + (size_t)m * 8 + k, RLX_AGENT); const int e = sp >> 16, rk = lbase[e] + (sp & 0xffff);
            SLOTPOS[(size_t)m * 8 + k] = (e << 16) | rk; LIST[(size_t)e * MT + rk] = (unsigned)m; } }
}
__device__ __forceinline__ void ph_convert_experts(Frame& F, const float* wg, const float* wu, const float* wd, const float* sg, const float* su, const float* sd, bf16* WGU_T, bf16* WD_T) {
    LAS float* scr = (LAS float*)(F.lds + RING_OFF + F.wave * 9216);
    const int gw = F.vcu * NWAVES + F.wave, NGW = F.G * NWAVES;
    for (int it = gw; it < 65 * 384; it += NGW) {
        const int e = it / 384; int r = it % 384;
        const float* Wg = e < 64 ? wg + (size_t)e * D * EFF : sg; const float* Wu = e < 64 ? wu + (size_t)e * D * EFF : su; const float* Wd = e < 64 ? wd + (size_t)e * EFF * D : sd;
        if (r < 256) { const float* W = r < 128 ? Wg : Wu; const int up = r >= 128; r &= 127; const int kb = r >> 3, nb = r & 7, n0 = nb * 32;
            transpose_item(W, EFF, EFF, kb * 64, n0, WGU_T + (size_t)e * 512 * D, D, (n0 >> 7) * 256 + (n0 & 127) + up * 128, scr, F.lane); }
        else { r -= 256; const int kb = r >> 5, nb = r & 31; transpose_item(Wd, D, D, kb * 64, nb * 32, WD_T + (size_t)e * D * EFF, EFF, nb * 32, scr, F.lane); }
    }
}
namespace pg8 {
struct MoeOrder1 {          static constexpr bool GATHER = true;
    const bf16_t* XN; const bf16_t* WGU; const unsigned* LIST; MoeTab T; int G, c, total;
    __device__ bool next(int i, Unit& u) const {
        const int L = i * G + c; if (L >= total) return false;
        const int pn = L & 1, ru = L >> 1; int lo = 0, hi = 64;
        while (lo < hi) { const int mid = (lo + hi + 1) >> 1; if (T.ups[mid] <= ru) lo = mid; else hi = mid - 1; }
        const int e = uni(lo), j = uni(ru - T.ups[lo]);
        u.e = e; u.pm = j; u.pn = pn; u.nrows = uni(min(256, T.cnt[e] - j * 256)); u.rb = uni(T.ro[e] + j * 256);
        u.A = (const char*)XN; u.B = uni_ptr((const char*)WGU + ((size_t)e * 512 + (size_t)pn * 256) * D * 2); return true;
    }
    __device__ __forceinline__ unsigned a_off(const Unit& u, int h, int R, int C) const {
        const int idx = h * HALF + R; int tok = 0;
        if (idx < u.nrows) tok = u.e < 64 ? (int)LIST[(size_t)u.e * MT + u.pm * 256 + idx] : u.pm * 256 + idx;
        return (unsigned)(tok * D + C) * 2u;
    }
};
struct MoeOrder2 {          static constexpr bool GATHER = false;
    const bf16_t* HACT; const bf16_t* WD; MoeTab T; int G, c, total;
    __device__ bool next(int i, Unit& u) const {
        const int L = i * G + c; if (L >= total) return false;
        const int pn = L & 3, ru = L >> 2; int lo = 0, hi = 64;
        while (lo < hi) { const int mid = (lo + hi + 1) >> 1; if (T.ups[mid] <= ru) lo = mid; else hi = mid - 1; }
        const int e = uni(lo), j = uni(ru - T.ups[lo]);
        u.e = e; u.pm = j; u.pn = pn; u.nrows = uni(min(256, T.cnt[e] - j * 256)); u.rb = uni(T.ro[e] + j * 256);
        u.A = uni_ptr((const char*)HACT + (size_t)u.rb * EFF * 2); u.B = uni_ptr((const char*)WD + ((size_t)e * D + (size_t)pn * 256) * EFF * 2); return true;
    }
    __device__ __forceinline__ unsigned a_off(const Unit&, int h, int R, int C) const { return (unsigned)((h * HALF + R) * EFF + C) * 2u; }
};
struct EpiSwiglu {
    static constexpr bool PERM = true;
    bf16_t* HACT;
    __device__ __forceinline__ void operator()(const f32x4 (&acc)[2][2][4][2], const Unit& u, int wr, int wc, int fr, int fq) const {
        asm volatile("" : "+v"(fr), "+v"(fq));
#pragma unroll
        for (int ai = 0; ai < 2; ++ai)
#pragma unroll
            for (int m = 0; m < 4; ++m) { const int r = ai * HALF + wr * 64 + m * 16 + fr;
                if (r < u.nrows) { const f32x4 g0 = acc[ai][0][m][0], g1 = acc[ai][0][m][1], u0 = acc[ai][1][m][0], u1 = acc[ai][1][m][1];
                    float o[8];
#pragma unroll
                    for (int q = 0; q < 4; ++q) { o[q] = g0[q] * __builtin_amdgcn_rcpf(1.f + __expf(-g0[q])) * u0[q]; o[4 + q] = g1[q] * __builtin_amdgcn_rcpf(1.f + __expf(-g1[q])) * u1[q]; }
                    u32x4 w; w.x = cvt_pk_bf16(o[0], o[1]); w.y = cvt_pk_bf16(o[2], o[3]); w.z = cvt_pk_bf16(o[4], o[5]); w.w = cvt_pk_bf16(o[6], o[7]);
                    *(u32x4*)(HACT + (size_t)(u.rb + r) * EFF + u.pn * 128 + wc * 32 + 8 * fq) = w; } }
    }
};
struct EpiDown {
    static constexpr bool PERM = true;
    bf16_t* Y; float* XR; const float* MODl;
    __device__ __forceinline__ void operator()(const f32x4 (&acc)[2][2][4][2], const Unit& u, int wr, int wc, int fr, int fq) const {
        asm volatile("" : "+v"(fr), "+v"(fq));
        const unsigned lcol = (unsigned)(wc * 32 + 8 * fq);
        if (u.e < 64) {
            GAS char* ybase = (GAS char*)uni_ptr((const char*)(Y + (size_t)u.rb * D + u.pn * BM));
#pragma unroll
            for (int ai = 0; ai < 2; ++ai)
#pragma unroll
                for (int m = 0; m < 4; ++m) { const int r = ai * HALF + wr * 64 + m * 16 + fr;
                    if (r < u.nrows) { const unsigned off = ((unsigned)r * D + lcol) * 2u;
#pragma unroll
                        for (int bj = 0; bj < 2; ++bj) { const f32x4 v0 = acc[ai][bj][m][0], v1 = acc[ai][bj][m][1];
                            u32x4 w; w.x = cvt_pk_bf16(v0[0], v0[1]); w.y = cvt_pk_bf16(v0[2], v0[3]); w.z = cvt_pk_bf16(v1[0], v1[1]); w.w = cvt_pk_bf16(v1[2], v1[3]);
                            *(GAS u32x4*)(ybase + off + bj * HALF * 2) = w; } } }
        } else {
            const int m0 = u.pm * 256; const int rb = m0 < NX ? (m0 >> 12) : 4;
            const GAS char* mdb = (const GAS char*)uni_ptr((const char*)(MODl + (size_t)rb * 6144 + 5 * 1024 + u.pn * BM)); GAS char* xb = (GAS char*)uni_ptr((const char*)(XR + (size_t)m0 * D + u.pn * BM));
#pragma unroll
            for (int ai = 0; ai < 2; ++ai)
#pragma unroll
                for (int m = 0; m < 4; ++m) { const int r = ai * HALF + wr * 64 + m * 16 + fr;
                    if (r < u.nrows) {
#pragma unroll
                        for (int bj = 0; bj < 2; ++bj)
#pragma unroll
                            for (int n = 0; n < 2; ++n) { const unsigned c = (unsigned)(bj * HALF) + lcol + 4u * n; const unsigned off = ((unsigned)r * D + c) * 4u;
                                const f32x4 xi = *(const GAS f32x4*)(xb + off), mm = *(const GAS f32x4*)(mdb + c * 4u); *(GAS f32x4*)(xb + off) = xi + mm * acc[ai][bj][m][n]; } }
                    asm volatile("" ::: "memory"); }
        }
    }
};
}
template <bool FINAL>
__device__ __forceinline__ void ph_combine_norm(Frame& F, const bf16* Y, const int* SLOTPOS, const float* SLOTG, const float* MODl, float* XR, int ntok, const float* gainN, const float* MODn, bf16* XN, float* out) {
    MoeTab T = moe_tab(F);
    const int gw = F.vcu * NWAVES + F.wave, NGW = F.G * NWAVES, lane = F.lane;
    for (int m = gw; m < ntok; m += NGW) {
        const int rb = m < NX ? (m >> 12) : 4; const float* md = MODl + (size_t)rb * 6144 + 5 * 1024;
        float acc[16];
#pragma unroll
        for (int q = 0; q < 16; ++q) acc[q] = 0.f;
#pragma unroll
        for (int s = 0; s < 8; ++s) { const int sp = SLOTPOS[(size_t)m * 8 + s]; const int row = T.ro[sp >> 16] + (sp & 0xffff); const float gs = SLOTG[(size_t)m * 8 + s];
            const bf16* yr = Y + (size_t)row * D;
#pragma unroll
            for (int j = 0; j < 4; ++j) { const unsigned long long w = *(const unsigned long long*)(yr + 4 * lane + 256 * j);
                acc[4 * j + 0] += gs * __uint_as_float((unsigned)(w & 0xffffull) << 16); acc[4 * j + 1] += gs * __uint_as_float((unsigned)((w >> 16) & 0xffffull) << 16);
                acc[4 * j + 2] += gs * __uint_as_float((unsigned)((w >> 32) & 0xffffull) << 16); acc[4 * j + 3] += gs * __uint_as_float((unsigned)((w >> 48) & 0xffffull) << 16); } }
        f32x4 x[4]; float ss = 0.f;
#pragma unroll
        for (int j = 0; j < 4; ++j) { const int ci = 4 * lane + 256 * j; float* o = XR + (size_t)m * D + ci; const f32x4 xi = *(const f32x4*)o, mm = *(const f32x4*)(md + ci);
            x[j] = xi + mm * (f32x4){acc[4 * j], acc[4 * j + 1], acc[4 * j + 2], acc[4 * j + 3]};
            if (!FINAL) *(f32x4*)o = x[j];
            ss += (x[j].x * x[j].x + x[j].y * x[j].y) + (x[j].z * x[j].z + x[j].w * x[j].w); }
        ss = wave_sum(ss); const float rs = rsqrtf(ss * (1.f / D) + 1e-6f);
        const float* mdn = FINAL ? nullptr : MODn + (size_t)rb * 6144;
#pragma unroll
        for (int j = 0; j < 4; ++j) { const int ci = 4 * lane + 256 * j; const f32x4 g = *(const f32x4*)(gainN + ci);
            if (FINAL) *(f32x4*)(out + (size_t)m * D + ci) = x[j] * rs * g;
            else { const f32x4 y = x[j] * rs * g * (*(const f32x4*)(mdn + 1024 + ci) + 1.f) + *(const f32x4*)(mdn + ci); *(unsigned long long*)(XN + (size_t)m * D + ci) = pack4(y); } }
    }
}

__device__ __forceinline__ void d_rwkv_prep(int m_, int c_, LAS float* shm_, const bf16* P, RwP w, int layer, float* VF, float* SI, float* SV, float* BON, float* G) {
    LAS float* sp = shm_; LAS float* vd = shm_ + 960;
    const int m = m_, c = c_, h = c >> 6; const Row rw = row_of(m);
    const bf16* pr = P + (size_t)m * LDP;
    for (int j = c; j < 960; j += 256) { const float p = bf2f(pr[j]); const float pp = rw.t > 0 ? bf2f(pr[j - LDP]) : 0.f; const float pn = rw.t < rw.L - 1 ? bf2f(pr[j + LDP]) : 0.f;
        sp[j] = p + (0.5f * (pp + pn) - p) * w.mu[j]; }
    if (c < 32) vd[c] = bf2f(pr[VRES_OFF + c]);
    __syncthreads();
    const float r = sp[c], kv = sp[256 + c]; float v = sp[512 + c];
    float g = 0.f;
#pragma unroll 4
    for (int j = 0; j < 64; ++j) g += sigmoidf_(sp[896 + j]) * w.g2[j * 256 + c];
    const float kkr = kv * w.kk[c]; const float ss = wave_sum(kkr * kkr); const float kkn = kkr * rsqrtf(ss + 1e-6f);
    if (layer == 0) VF[(size_t)m * 256 + c] = v;
    else { float z = w.v0[c];
#pragma unroll 4
        for (int j = 0; j < 32; ++j) z += vd[j] * w.v2[j * 256 + c]; v = v + (VF[(size_t)m * 256 + c] - v) * sigmoidf_(z); }
    float bsum = 0.f;
#pragma nounroll
    for (int d = 0; d < 2; ++d) {
        float z = w.w0[d * 256 + c];
#pragma unroll 4
        for (int j = 0; j < 32; ++j) z += tanhf(sp[768 + d * 32 + j]) * w.w2[(d * 32 + j) * 256 + c];
        const float lw = -0.6065306597f * sigmoidf_(z);
        float za = w.a0[d * 256 + c];
#pragma unroll 4
        for (int j = 0; j < 32; ++j) za += sp[832 + d * 32 + j] * w.a2[(d * 32 + j) * 256 + c];
        const float a = sigmoidf_(za);
        const float kd = kv * (1.f + (a - 1.f) * w.ka[c]);
        const float bs = wave_sum(r * kd * w.rk[c]);
        bsum += bs * v;
        const int k = c & 63;
        si_ptr(SI, d, m, h, 0)[k] = __expf(lw); si_ptr(SI, d, m, h, 1)[k] = kkn; si_ptr(SI, d, m, h, 2)[k] = kkn * a; si_ptr(SI, d, m, h, 3)[k] = kd; si_ptr(SI, d, m, h, 4)[k] = r;
    }
    SV[(size_t)m * 256 + c] = v; BON[(size_t)m * 256 + c] = bsum; G[(size_t)m * 256 + c] = g;
}

__device__ __forceinline__ void d_rwkv_post(int m_, int c_, const float* YS, const float* BON, const float* G, const float* lnw, const float* lnb, bf16* MIX) {
    const int m = m_, c = c_;
    const float y = YS[(size_t)m * 256 + c] + YS[((size_t)MT + m) * 256 + c];
    const float mu = wave_sum(y) * (1.f / 64.f); const float dlt = y - mu; const float var = wave_sum(dlt * dlt) * (1.f / 64.f);
    const float yn = dlt * rsqrtf(var + 64e-5f);
    MIX[(size_t)m * D + c] = f2bf((yn * lnw[c] + lnb[c] + BON[(size_t)m * 256 + c]) * G[(size_t)m * 256 + c]);
}

__device__ __forceinline__ void d_ret_prep(int m_, int c_, LAS float* shm_, const bf16* P, const float* lam  , float* SI, float* SV) {
    LAS float* sq = shm_; LAS float* sk = shm_ + 256;
    const int m = m_, c = c_, h = c >> 6, i = c & 63; const Row rw = row_of(m);
    const bf16* pr = P + (size_t)m * LDP + RET_OFF;
    float q = bf2f(pr[c]), k = bf2f(pr[256 + c]); const float v = bf2f(pr[512 + c]);
    sq[c] = q; sk[c] = k; __syncthreads();
    if (rw.isx) {
        const int j = i & 31, jj = j & 15; const float pos = j < 16 ? (float)(rw.t >> 6) : (float)(rw.t & 63);
        const float inv = powf(10000.f, -(float)jj / 16.f); const float ang = pos * inv; const float cs = cosf(ang), sn = sinf(ang);
        const int pc = i < 32 ? c + 32 : c - 32;
        const float q1 = i < 32 ? q : sq[pc], q2 = i < 32 ? sq[pc] : q, k1 = i < 32 ? k : sk[pc], k2 = i < 32 ? sk[pc] : k;
        q = i < 32 ? q1 * cs - q2 * sn : q1 * sn + q2 * cs; k = i < 32 ? k1 * cs - k2 * sn : k1 * sn + k2 * cs;
    }
    k *= 0.125f;
    for (int d = 0; d < 2; ++d) { const float gm = __expf(-lam[d * 4 + h]);
        si_ptr(SI, d, m, h, 0)[i] = gm; si_ptr(SI, d, m, h, 1)[i] = 0.f; si_ptr(SI, d, m, h, 2)[i] = 0.f; si_ptr(SI, d, m, h, 3)[i] = k; si_ptr(SI, d, m, h, 4)[i] = q; }
    SV[(size_t)m * 256 + c] = v;
}

__device__ __forceinline__ void d_hnorm_post(int m_, int c_, const float* YSa, const float* YSb, const bf16* P, int gate_off, const float* nw, bf16* MIX, int mix_off) {
    const int m = m_, c = c_;
    const float o = YSa[(size_t)m * 256 + c] + YSb[(size_t)m * 256 + c];
    const float ms = wave_sum(o * o) * (1.f / 64.f);
    const float g = bf2f(P[(size_t)m * LDP + gate_off + c]);
    float y = o * rsqrtf(ms + 1e-6f) * siluf_(g); if (nw) y *= nw[c & 63];
    MIX[(size_t)m * D + mix_off + c] = f2bf(y);
}

__device__ __forceinline__ void d_gdn_prep(int m_, int c_, const bf16* P, const float* cw  , const float* alog, const float* dtb, float* SI, float* SV) {
    const int m = m_, c = c_, h = c >> 6, i = c & 63; const Row rw = row_of(m);
    const bf16* pr = P + (size_t)m * LDP + GDN_OFF;
    float o[3];
#pragma unroll
    for (int s = 0; s < 3; ++s) { const int ch = s * 256 + c; float a = 0.f;
#pragma unroll
        for (int j = 0; j < 4; ++j) { const int tt = rw.t + j - 2; if (tt >= 0 && tt < rw.L) a += bf2f(pr[(ptrdiff_t)(j - 2) * LDP + ch]) * cw[j * 768 + ch]; }
        o[s] = siluf_(a); }
    const float qs = wave_sum(o[0] * o[0]), ks = wave_sum(o[1] * o[1]);
    const float q = o[0] * rsqrtf(qs + 1e-6f) * 0.125f, k = o[1] * rsqrtf(ks + 1e-6f);
    for (int d = 0; d < 2; ++d) {
        const float a = bf2f(pr[768 + d * 4 + h]), b = bf2f(pr[776 + d * 4 + h]);
        const float al = __expf(-__expf(alog[d * 4 + h]) * softplusf_(a + dtb[d * 4 + h])), be = sigmoidf_(b);
        si_ptr(SI, d, m, h, 0)[i] = al; si_ptr(SI, d, m, h, 1)[i] = k; si_ptr(SI, d, m, h, 2)[i] = al * be * k; si_ptr(SI, d, m, h, 3)[i] = be * k; si_ptr(SI, d, m, h, 4)[i] = q; }
    SV[(size_t)m * 256 + c] = o[2];
}

__device__ __forceinline__ void d_rowscan(int seq_, int v_, LAS float* shm_, const float* SI, const float* SV, float* YS) {
    LAS float (*sh)[5][64] = (LAS float (*)[5][64])shm_;
    const int seq = seq_, d = seq & 1, h = (seq >> 1) & 3, b = seq >> 3, v = v_;
    float s[64];
#pragma unroll
    for (int k = 0; k < 64; ++k) s[k] = 0.f;
    float nx[5], nv; { const int m = step_row(b, d, 0); const float* p = SI + (((size_t)d * MT + m) * 4 + h) * 320;
#pragma unroll
        for (int j = 0; j < 5; ++j) nx[j] = p[j * 64 + v]; nv = SV[(size_t)m * 256 + h * 64 + v]; }
    for (int st = 0; st < NSTEP; ++st) {
        const int buf = st & 1; const int m = step_row(b, d, st);
#pragma unroll
        for (int j = 0; j < 5; ++j) sh[buf][j][v] = nx[j];
        const float vv = nv;
        __syncthreads();
        if (st + 1 < NSTEP) { const int m2 = step_row(b, d, st + 1); const float* p = SI + (((size_t)d * MT + m2) * 4 + h) * 320;
#pragma unroll
            for (int j = 0; j < 5; ++j) nx[j] = p[j * 64 + v]; nv = SV[(size_t)m2 * 256 + h * 64 + v]; }
        float sa = 0.f;
#pragma unroll
        for (int k = 0; k < 64; ++k) sa += s[k] * sh[buf][1][k];
        float y = 0.f;
#pragma unroll
        for (int k = 0; k < 64; ++k) { s[k] = s[k] * sh[buf][0][k] - sa * sh[buf][2][k] + vv * sh[buf][3][k]; y += s[k] * sh[buf][4][k]; }
        YS[((size_t)d * MT + m) * 256 + h * 64 + v] = y;
    }
}

__device__ __forceinline__ void d_lru_prep(int m_, int c_, LAS float* shm_, const bf16* P, LruP w, float* LA, float* LB) {
    LAS float* xs = shm_;
    const int m = m_, c = c_, h = c >> 6, i = c & 63; const Row rw = row_of(m);
    const bf16* pr = P + (size_t)m * LDP + LRU_OFF;
    float xm = w.cb[c];
#pragma unroll
    for (int j = 0; j < 4; ++j) { const int tt = rw.t + j - 2; if (tt >= 0 && tt < rw.L) xm += bf2f(pr[(ptrdiff_t)(j - 2) * LDP + c]) * w.cw[j * 256 + c]; }
    xs[c] = xm; __syncthreads();
#pragma nounroll
    for (int d = 0; d < 2; ++d) {
        float ra = w.ba[d * 256 + c], rx = w.bx[d * 256 + c];
        const float* wa = w.wa + ((size_t)(d * 4 + h) * 64) * 64 + i; const float* wx = w.wx + ((size_t)(d * 4 + h) * 64) * 64 + i;
#pragma unroll 4
        for (int j = 0; j < 64; ++j) { const float xv = xs[h * 64 + j]; ra += xv * wa[j * 64]; rx += xv * wx[j * 64]; }
        const float r = sigmoidf_(ra), ig = sigmoidf_(rx);
        const float la = -8.f * softplusf_(-w.lam[d * 256 + c]) * r;
        LA[((size_t)d * MT + m) * 256 + c] = __expf(la); LB[((size_t)d * MT + m) * 256 + c] = sqrtf(-expm1f(2.f * la)) * ig * xm;
    }
}

__device__ __forceinline__ void d_lru_scan(int bd_, int c_, const float* LA, const float* LB, float* YS) {
    const int d = bd_ & 1, b = bd_ >> 1, c = c_;
    float hst = 0.f;
    for (int st = 0; st < NSTEP; st += 8) { float a[8], bb[8]; int mm[8];
#pragma unroll
        for (int u = 0; u < 8; ++u) { mm[u] = step_row(b, d, st + u); a[u] = LA[((size_t)d * MT + mm[u]) * 256 + c]; bb[u] = LB[((size_t)d * MT + mm[u]) * 256 + c]; }
#pragma unroll
        for (int u = 0; u < 8; ++u) { hst = a[u] * hst + bb[u]; YS[((size_t)d * MT + mm[u]) * 256 + c] = hst; } }
}

__device__ __forceinline__ void d_lru_post(int m_, int c_, const float* YS, const bf16* P, bf16* MIX) {
    const int m = m_, c = c_;
    const float hs = YS[(size_t)m * 256 + c] + YS[((size_t)MT + m) * 256 + c];
    const float g = bf2f(P[(size_t)m * LDP + LRU_OFF + 256 + c]);
    const float ge = 0.5f * g * (1.f + tanhf(0.7978845608f * (g + 0.044715f * g * g * g)));
    MIX[(size_t)m * D + 768 + c] = f2bf(hs * ge);
}

#define MFMA16(a, b, c) __builtin_amdgcn_mfma_f32_16x16x16bf16_1k((a), (b), (c), 0, 0, 0)
constexpr int LSTR = 144;
constexpr int IMG = 64 * LSTR;
constexpr int ROPE_OFF = 120 * 1024;
__device__ __forceinline__ bf16x4 ldsfrag(const LAS unsigned char* img, int row, int k0) { return *(const LAS bf16x4*)(img + row * LSTR + k0 * 2); }
__device__ __forceinline__ f32x4 zero4() { return (f32x4){0.f, 0.f, 0.f, 0.f}; }
__device__ __forceinline__ f32x4 nt_tile64(const LAS unsigned char* A, int m0, const LAS unsigned char* B, int n0, int lane, f32x4 acc) {
    const int r = lane & 15, g = lane >> 4;
#pragma unroll
    for (int s = 0; s < 4; ++s) acc = MFMA16(ldsfrag(A, m0 + r, 16 * s + 4 * g), ldsfrag(B, n0 + r, 16 * s + 4 * g), acc);
    return acc;
}
__device__ __forceinline__ void unpack8(v4u w, float (&o)[8]) {
    o[0] = __uint_as_float(w.x << 16); o[1] = __uint_as_float(w.x & 0xffff0000u); o[2] = __uint_as_float(w.y << 16); o[3] = __uint_as_float(w.y & 0xffff0000u);
    o[4] = __uint_as_float(w.z << 16); o[5] = __uint_as_float(w.z & 0xffff0000u); o[6] = __uint_as_float(w.w << 16); o[7] = __uint_as_float(w.w & 0xffff0000u); }
struct TB { int m0, b, j, isx, t0; };
__device__ __forceinline__ TB tb_of(int tb) { TB r; if (tb < 256) { r.b = tb >> 6; r.j = tb & 63; r.isx = 1; r.m0 = tb * 64; r.t0 = r.j * 64; } else { const int q = tb - 256; r.b = q >> 2; r.j = q & 3; r.isx = 0; r.m0 = NX + q * 64; r.t0 = r.j * 64; } return r; }
__device__ __forceinline__ int chunk_of(const TB& t, int d) { return t.isx ? 4 + (d ? 63 - t.j : t.j) : (d ? 3 - t.j : t.j); }
__device__ __forceinline__ void build_rope(Frame& F) {
    LAS float* tab = (LAS float*)(F.lds + ROPE_OFF);
    for (int i = F.tid; i < 1024; i += NTHR) { const int pos = i >> 4, jj = i & 15; const float inv = __powf(10000.f, -(float)jj * (1.f / 16.f)); float sn, cs; sincosf((float)pos * inv, &sn, &cs); tab[2 * i] = cs; tab[2 * i + 1] = sn; }
}
__device__ __forceinline__ void load16(const bf16* P, int m, int col0, int dq, float (&lo)[8], float (&hi)[8]) {
    const v4u a = *(const v4u*)(P + (size_t)m * LDP + col0 + 8 * dq), b = *(const v4u*)(P + (size_t)m * LDP + col0 + 32 + 8 * dq); unpack8(a, lo); unpack8(b, hi); }
__device__ __forceinline__ void rope16(Frame& F, int t, int dq, float (&lo)[8], float (&hi)[8]) {
    const LAS float* tab = (const LAS float*)(F.lds + ROPE_OFF); const int pos = dq < 2 ? (t >> 6) : (t & 63); const int j0 = (8 * dq) & 15;
#pragma unroll
    for (int e = 0; e < 8; ++e) { const float cs = tab[2 * (pos * 16 + j0 + e)], sn = tab[2 * (pos * 16 + j0 + e) + 1]; const float a = lo[e], b = hi[e]; lo[e] = a * cs - b * sn; hi[e] = a * sn + b * cs; }
}
__device__ __forceinline__ void st_tok16(LAS unsigned char* img, int s, int dq, const float (&lo)[8], const float (&hi)[8]) {
    v4u a, b; a.x = pk2(lo[0], lo[1]); a.y = pk2(lo[2], lo[3]); a.z = pk2(lo[4], lo[5]); a.w = pk2(lo[6], lo[7]); b.x = pk2(hi[0], hi[1]); b.y = pk2(hi[2], hi[3]); b.z = pk2(hi[4], hi[5]); b.w = pk2(hi[6], hi[7]);
    *(LAS v4u*)(img + s * LSTR + 16 * dq) = a; *(LAS v4u*)(img + s * LSTR + 64 + 16 * dq) = b; }
__device__ __forceinline__ void st_chn16(LAS unsigned char* img, int s, int dq, const float (&lo)[8], const float (&hi)[8], float scale) {
#pragma unroll
    for (int e = 0; e < 8; ++e) { *(LAS bf16*)(img + (8 * dq + e) * LSTR + 2 * s) = f2bf(lo[e] * scale); *(LAS bf16*)(img + (32 + 8 * dq + e) * LSTR + 2 * s) = f2bf(hi[e] * scale); } }

__device__ __forceinline__ bf16* dz_blob(bf16* DZ, int d, int b, int h, int n) { return DZ + ((size_t)(((d * 4 + b) * 4 + h) * 68 + n)) * 4096; }
__device__ __forceinline__ void ph_ret_pre(Frame& F, const bf16* P, const float* lam, bf16* DZ) {
    const int half = F.tid >> 8, ht = F.tid & 255, s = ht & 63, dq = ht >> 6, wq = F.wave & 3, lane = F.lane;
    LAS unsigned char* hb = F.lds + RING_OFF + half * (3 * IMG);
    LAS unsigned char* KFT = hb, * KBT = hb + IMG, * VT = hb + 2 * IMG;
    for (int it = F.vcu; it < 544; it += F.G) {
        const int item = it * 2 + half, tbi = item >> 2, h = item & 3; const TB tb = tb_of(tbi);
        const float lgf = -lam[h], lgb = -lam[4 + h];
        { float lo[8], hi[8]; const int m = tb.m0 + s;
          load16(P, m, RET_OFF + 256 + h * 64, dq, lo, hi); if (tb.isx) rope16(F, tb.t0 + s, dq, lo, hi);
          st_chn16(KFT, s, dq, lo, hi, 0.125f * __expf((float)(63 - s) * lgf)); st_chn16(KBT, s, dq, lo, hi, 0.125f * __expf((float)s * lgb));
          load16(P, m, RET_OFF + 512 + h * 64, dq, lo, hi); st_chn16(VT, s, dq, lo, hi, 1.f); }
        LDS_BARRIER();
#pragma unroll
        for (int d = 0; d < 2; ++d) { bf16* blob = dz_blob(DZ, d, tb.b, h, chunk_of(tb, d)); const LAS unsigned char* KT = d ? KBT : KFT;
#pragma unroll
            for (int vt = 0; vt < 4; ++vt) { const f32x4 acc = nt_tile64(KT, 16 * wq, VT, 16 * vt, lane, zero4());
                *(unsigned long long*)(blob + (16 * vt + (lane & 15)) * 64 + 16 * wq + 4 * (lane >> 4)) = pack4(acc); } }
        LDS_BARRIER();
    }
}
__device__ __forceinline__ void ph_ret_prefix(Frame& F, const float* lam, bf16* DZ) {
    const int e = F.vcu * NTHR + F.tid;
    if (e >= 32 * 4096) return;
    const int seq = e >> 12, el = e & 4095, d = seq >> 4, h = seq & 3;
    const float gC = __expf(-64.f * lam[d * 4 + h]);
    GAS bf16* base = (GAS bf16*)DZ + (size_t)seq * 68 * 4096 + el; float z = 0.f;
#pragma unroll 1
    for (int n = 0; n < 68; n += 17) { float tmp[17];
#pragma unroll
        for (int u = 0; u < 17; ++u) tmp[u] = bf2f(base[(size_t)(n + u) * 4096]);
#pragma unroll
        for (int u = 0; u < 17; ++u) { base[(size_t)(n + u) * 4096] = f2bf(z); z = gC * z + tmp[u]; } }
}
__device__ __forceinline__ void ph_ret_post(Frame& F, const bf16* P, const float* lam, const bf16* DZ, bf16* MIX) {
    const int half = F.tid >> 8, ht = F.tid & 255, s = ht & 63, dq = ht >> 6, wq = F.wave & 3, lane = F.lane, r = lane & 15, g = lane >> 4;
    LAS unsigned char* hb = F.lds + RING_OFF + half * (4 * IMG);
    LAS unsigned char* Qi = hb, * Ki = hb + IMG, * VT = hb + 2 * IMG, * Wi = hb + 3 * IMG;
    for (int it = F.vcu; it < 544; it += F.G) {
        const int item = it * 2 + half, tbi = item >> 2, h = item & 3; const TB tb = tb_of(tbi);
        const float lgf = -lam[h], lgb = -lam[4 + h];
        { float lo[8], hi[8]; const int m = tb.m0 + s;
          load16(P, m, RET_OFF + h * 64, dq, lo, hi); if (tb.isx) rope16(F, tb.t0 + s, dq, lo, hi); st_tok16(Qi, s, dq, lo, hi);
          load16(P, m, RET_OFF + 256 + h * 64, dq, lo, hi); if (tb.isx) rope16(F, tb.t0 + s, dq, lo, hi);
#pragma unroll
          for (int e = 0; e < 8; ++e) { lo[e] *= 0.125f; hi[e] *= 0.125f; }
          st_tok16(Ki, s, dq, lo, hi);
          load16(P, m, RET_OFF + 512 + h * 64, dq, lo, hi); st_chn16(VT, s, dq, lo, hi, 1.f); }
        LDS_BARRIER();
        const int s0 = 16 * wq, sl = s0 + r;
#pragma unroll
        for (int jt = 0; jt < 4; ++jt) { f32x4 acc = nt_tile64(Ki, 16 * jt, Qi, s0, lane, zero4());
#pragma unroll
            for (int i = 0; i < 4; ++i) { const int j = 16 * jt + 4 * g + i; const float wf = j <= sl ? __expf((float)(sl - j) * lgf) : 0.f, wb = j >= sl ? __expf((float)(j - sl) * lgb) : 0.f; acc[i] *= (wf + wb); }
            *(LAS unsigned long long*)(Wi + sl * LSTR + 2 * (16 * jt + 4 * g)) = pack4(acc); }
        LDS_WAIT();
        const bf16* Zf = dz_blob((bf16*)DZ, 0, tb.b, h, chunk_of(tb, 0)); const bf16* Zb = dz_blob((bf16*)DZ, 1, tb.b, h, chunk_of(tb, 1));
        const float ef = __expf((float)(sl + 1) * lgf), eb = __expf((float)(64 - sl) * lgb);
        f32x4 o[4]; float ssq = 0.f;
#pragma unroll
        for (int vt = 0; vt < 4; ++vt) { f32x4 aw = nt_tile64(VT, 16 * vt, Wi, s0, lane, zero4()), af = zero4(), ab = zero4();
#pragma unroll
            for (int ks = 0; ks < 4; ++ks) { const bf16x4 qf = ldsfrag(Qi, sl, 16 * ks + 4 * g);
                const bf16x4 zf = *(const bf16x4*)(Zf + (16 * vt + r) * 64 + 16 * ks + 4 * g), zb = *(const bf16x4*)(Zb + (16 * vt + r) * 64 + 16 * ks + 4 * g);
                af = MFMA16(zf, qf, af); ab = MFMA16(zb, qf, ab); }
            o[vt] = aw + af * ef + ab * eb; ssq += (o[vt].x * o[vt].x + o[vt].y * o[vt].y) + (o[vt].z * o[vt].z + o[vt].w * o[vt].w); }
        ssq += __shfl_xor(ssq, 16); ssq += __shfl_xor(ssq, 32);
        const float rs = rsqrtf(ssq * (1.f / 64.f) + 1e-6f); const int m = tb.m0 + sl;
#pragma unroll
        for (int vt = 0; vt < 4; ++vt) { const int vd = 16 * vt + 4 * g; const unsigned long long gw = *(const unsigned long long*)(P + (size_t)m * LDP + RET_OFF + 768 + h * 64 + vd);
            f32x4 y; y.x = o[vt].x * rs * siluf_(__uint_as_float((unsigned)(gw & 0xffffull) << 16)); y.y = o[vt].y * rs * siluf_(__uint_as_float((unsigned)((gw >> 16) & 0xffffull) << 16));
            y.z = o[vt].z * rs * siluf_(__uint_as_float((unsigned)((gw >> 32) & 0xffffull) << 16)); y.w = o[vt].w * rs * siluf_(__uint_as_float((unsigned)((gw >> 48) & 0xffffull) << 16));
            *(unsigned long long*)(MIX + (size_t)m * D + 256 + h * 64 + vd) = pack4(y); }
        LDS_BARRIER();
    }
}

constexpr int IT_KP = 0, IT_RP = 8192, IT_BH = 16384, IT_UT = 24576, IT_Y0 = 32768, IT_D0 = 40960, IT_GC = 49152, ITEM_BYTES = 49664;
__device__ __forceinline__ int swz(int r, int c) { return r * 128 + (((c >> 2) ^ (r & 15)) << 3) + (c & 3) * 2; }
__device__ __forceinline__ GAS unsigned char* item_ptr(unsigned char* BL, int seq, int n) { return (GAS unsigned char*)BL + ((size_t)seq * 68 + n) * ITEM_BYTES; }
__device__ __forceinline__ bf16x4 cvt4(f32x4 v) { unsigned long long p = pack4(v); return __builtin_bit_cast(bf16x4, p); }
__device__ __forceinline__ f32x4 up4(unsigned long long w) { f32x4 r; r.x = __uint_as_float((unsigned)(w & 0xffffull) << 16); r.y = __uint_as_float((unsigned)((w >> 16) & 0xffffull) << 16);
    r.z = __uint_as_float((unsigned)((w >> 32) & 0xffffull) << 16); r.w = __uint_as_float((unsigned)((w >> 48) & 0xffffull) << 16); return r; }
constexpr int PI_A0 = 0, PI_A1 = 1, PI_A2 = 2, PI_A3 = 3, PI_KAPT = 4, PI_RHOT = 5, PI_VT = 6, PI_KHT = 7, PI_M1 = 8, PI_M2 = 9, PI_M3 = 10, PI_M4 = 11;
constexpr int PRE_TINV = 12 * IMG;
constexpr int PRE_ARR = PRE_TINV + 4 * 16 * 40;
__device__ __forceinline__ LAS unsigned char* pimg(Frame& F, int i) { return F.lds + RING_OFF + i * IMG; }

template <bool SCALAR>
__device__ __forceinline__ void dplr_core(Frame& F, GAS unsigned char* item) {
    int lane = F.lane; asm volatile("" : "+v"(lane));
    int w = F.wave; asm volatile("" : "+s"(w)); const int r = lane & 15, g = lane >> 4;
    const LAS float* Gs = (const LAS float*)(F.lds + RING_OFF + PRE_ARR); const LAS float* GM1 = Gs + 64; const LAS float* BETA = Gs + 128;
    TSEC_BEGIN(4)
    if (SCALAR) {
#pragma unroll
        for (int q = 0; q < 4; ++q) { const int e = w * 4 + q, which = e >> 4, tj = (e >> 2) & 3, tt = e & 3;
            LAS unsigned char* Ma = pimg(F, which ? PI_M3 : PI_M1); LAS unsigned char* Mb = pimg(F, which ? PI_M4 : PI_M2);
            f32x4 va = zero4(), vb = zero4(); const int t = 16 * tt + r;
            if (tj <= tt) { const f32x4 acc = nt_tile64(pimg(F, PI_A0), 16 * tj, pimg(F, which ? PI_A1 : PI_A0), 16 * tt, lane, zero4());
                const float gt = which ? Gs[t] : GM1[t];
#pragma unroll
                for (int i = 0; i < 4; ++i) { const int j = 16 * tj + 4 * g + i; const bool ok = which ? (j <= t) : (j < t); const float bj = BETA[j];
                    va[i] = ok ? acc[i] * bj * __expf(gt - GM1[j]) : 0.f; vb[i] = ok ? acc[i] * bj * __expf(gt - Gs[j]) : 0.f; } }
            *(LAS unsigned long long*)(Ma + t * LSTR + 2 * (16 * tj + 4 * g)) = pack4(va); *(LAS unsigned long long*)(Mb + t * LSTR + 2 * (16 * tj + 4 * g)) = pack4(vb); }
    } else {
#pragma unroll
        for (int q = 0; q < 8; ++q) { const int e = w * 8 + q, mi = e >> 4, tj = (e >> 2) & 3, tt = e & 3;
            LAS unsigned char* M = pimg(F, PI_M1 + mi); f32x4 va = zero4(); const int t = 16 * tt + r;
            if (tj <= tt) { const f32x4 acc = nt_tile64(pimg(F, (mi & 1) ? PI_A2 : PI_A1), 16 * tj, pimg(F, (mi & 2) ? PI_A3 : PI_A0), 16 * tt, lane, zero4());
#pragma unroll
                for (int i = 0; i < 4; ++i) { const int j = 16 * tj + 4 * g + i; const bool ok = (mi & 2) ? (j <= t) : (j < t); va[i] = ok ? acc[i] : 0.f; } }
            *(LAS unsigned long long*)(M + t * LSTR + 2 * (16 * tj + 4 * g)) = pack4(va); }
    }
    LDS_BARRIER();
    TSEC_END(4)
    TSEC_BEGIN(5)
    if (w == 0) { const int blk = lane >> 4, c = lane & 15; const LAS unsigned char* M1 = pimg(F, PI_M1); float x[16];
#pragma unroll
        for (int rr = 0; rr < 16; ++rr) { float a[16]; const v4u lo = *(const LAS v4u*)(M1 + (16 * blk + rr) * LSTR + 32 * blk), hi = *(const LAS v4u*)(M1 + (16 * blk + rr) * LSTR + 32 * blk + 16);
            { float t8[8]; unpack8(lo, t8);
#pragma unroll
              for (int q = 0; q < 8; ++q) a[q] = t8[q]; unpack8(hi, t8);
#pragma unroll
              for (int q = 0; q < 8; ++q) a[8 + q] = t8[q]; }
            float s = (rr == c) ? 1.f : 0.f;
#pragma unroll
            for (int j = 0; j < rr; ++j) s -= a[j] * x[j];
            x[rr] = s; }
        LAS unsigned char* TI = F.lds + RING_OFF + PRE_TINV + blk * 16 * 40;
#pragma unroll
        for (int rr = 0; rr < 16; ++rr) *(LAS bf16*)(TI + rr * 40 + 2 * c) = f2bf(x[rr]); }
    LDS_BARRIER();
    TSEC_END(5)
    TSEC_BEGIN(6)
    const LAS unsigned char* M1 = pimg(F, PI_M1); const LAS unsigned char* M2 = pimg(F, PI_M2); const LAS unsigned char* M3 = pimg(F, PI_M3); const LAS unsigned char* M4 = pimg(F, PI_M4);
    const LAS unsigned char* VT = pimg(F, PI_VT);
    f32x4 x[4];
    if (w < 4) {
#pragma unroll
        for (int tb = 0; tb < 4; ++tb) { f32x4 acc = zero4();
#pragma unroll
            for (int jb = 0; jb <= tb; ++jb) acc = MFMA16(ldsfrag(M2, 16 * tb + r, 16 * jb + 4 * g), ldsfrag(VT, 16 * w + r, 16 * jb + 4 * g), acc);
            x[tb] = acc; }
    } else { const LAS unsigned char* KAPT = pimg(F, PI_KAPT);
#pragma unroll
        for (int tb = 0; tb < 4; ++tb) x[tb] = up4(*(const LAS unsigned long long*)(KAPT + (16 * (w - 4) + r) * LSTR + 2 * (16 * tb + 4 * g))); }
#pragma unroll
    for (int i = 0; i < 4; ++i) { f32x4 acc = zero4();
#pragma unroll
        for (int j = 0; j < i; ++j) acc = MFMA16(ldsfrag(M1, 16 * i + r, 16 * j + 4 * g), cvt4(x[j]), acc);
        const f32x4 rhs = x[i] - acc;
        const bf16x4 tf = *(const LAS bf16x4*)(F.lds + RING_OFF + PRE_TINV + (i * 16 + r) * 40 + 8 * g);
        x[i] = MFMA16(tf, cvt4(rhs), zero4()); }
    if (w < 4) {
        const int v = 16 * w + r; GAS bf16* UT = (GAS bf16*)(item + IT_UT) + v * 64; GAS bf16* Y0T = (GAS bf16*)(item + IT_Y0) + v * 64; GAS bf16* D0T = (GAS bf16*)(item + IT_D0) + v * 64;
        const LAS unsigned char* KHT = pimg(F, PI_KHT);
#pragma unroll
        for (int tb = 0; tb < 4; ++tb) { *(GAS unsigned long long*)(UT + 16 * tb + 4 * g) = pack4(x[tb]);
            f32x4 a4 = zero4(), a3 = zero4();
#pragma unroll
            for (int jb = 0; jb <= tb; ++jb) { a4 = MFMA16(ldsfrag(M4, 16 * tb + r, 16 * jb + 4 * g), ldsfrag(VT, v, 16 * jb + 4 * g), a4); a3 = MFMA16(ldsfrag(M3, 16 * tb + r, 16 * jb + 4 * g), cvt4(x[jb]), a3); }
            *(GAS unsigned long long*)(Y0T + 16 * tb + 4 * g) = pack4(a4 - a3);
            f32x4 d0 = zero4();
#pragma unroll
            for (int sb = 0; sb < 4; ++sb) d0 = MFMA16(ldsfrag(KHT, 16 * tb + r, 16 * sb + 4 * g), ldsfrag(VT, v, 16 * sb + 4 * g), d0);
            *(GAS unsigned long long*)(D0T + 16 * tb + 4 * g) = pack4(d0); }
    } else {
        const int k = 16 * (w - 4) + r; const LAS unsigned char* RHOT = pimg(F, PI_RHOT); LAS unsigned char* KPi = pimg(F, PI_A2); LAS unsigned char* RPi = pimg(F, PI_A3);
#pragma unroll
        for (int tb = 0; tb < 4; ++tb) { f32x4 a3 = zero4();
#pragma unroll
            for (int jb = 0; jb <= tb; ++jb) a3 = MFMA16(ldsfrag(M3, 16 * tb + r, 16 * jb + 4 * g), cvt4(x[jb]), a3);
            const f32x4 rp = up4(*(const LAS unsigned long long*)(RHOT + k * LSTR + 2 * (16 * tb + 4 * g))) - a3;
#pragma unroll
            for (int i = 0; i < 4; ++i) { const int t = 16 * tb + 4 * g + i; *(LAS bf16*)(KPi + swz(t, k)) = f2bf(x[tb][i]); *(LAS bf16*)(RPi + swz(t, k)) = f2bf(rp[i]); } }
    }
    LDS_BARRIER();
    TSEC_END(6)
    TSEC_BEGIN(7)
    { const v4u a = *(const LAS v4u*)(pimg(F, PI_A2) + F.tid * 16), b = *(const LAS v4u*)(pimg(F, PI_A3) + F.tid * 16);
      *(GAS v4u*)(item + IT_KP + F.tid * 16) = a; *(GAS v4u*)(item + IT_RP + F.tid * 16) = b; }
    LDS_BARRIER();
    TSEC_END(7)
}

__device__ __forceinline__ void gdn_pre_item(Frame& F, const bf16* P, const float* cw, const float* alog, const float* dtb, unsigned char* BL, int tbi, int h, int d) {
    int w = F.wave; asm volatile("" : "+s"(w));
    const TB tb = tb_of(tbi); const int lane = F.lane, L = tb.isx ? SEQ : CTXL;
    LAS float* Gs = (LAS float*)(F.lds + RING_OFF + PRE_ARR); LAS float* GM1 = Gs + 64; LAS float* BETA = Gs + 128; LAS float* LAa = Gs + 192;
    const int seq = (d * 4 + tb.b) * 4 + h; GAS unsigned char* item = item_ptr(BL, seq, chunk_of(tb, d));
    TSEC_BEGIN(1)
    constexpr int GSTR = 400;
    LAS unsigned char* STG = pimg(F, PI_KHT);
    { const GAS bf16* Pg = (const GAS bf16*)P;
#pragma unroll
      for (int q = 0; q < 4; ++q) { const int e0 = F.tid + q * NTHR, e = e0 < 68 * 24 ? e0 : 68 * 24 - 1; const int row = e / 24, ch = e % 24, sg = ch >> 3, part = ch & 7; const int t = tb.t0 - 2 + row;
              const bool ok = t >= 0 && t < L; const int rowc = ok ? row : 2;
              v4u val = *(const GAS v4u*)(Pg + (size_t)(tb.m0 - 2 + rowc) * LDP + GDN_OFF + sg * 256 + h * 64 + part * 8);
              if (!ok) val = (v4u){0u, 0u, 0u, 0u};
              *(LAS v4u*)(STG + row * GSTR + ch * 16) = val; } }
    float qv[8], kv[8], vv[8];
    const float Aexp = __expf(alog[d * 4 + h]), dt = dtb[d * 4 + h];
    float abv[2];
    { const GAS bf16* Pg = (const GAS bf16*)P; const int s = 8 * w + (lane & 7), tau = d ? 63 - s : s; const size_t mo = (size_t)(tb.m0 + tau) * LDP + GDN_OFF;
      abv[0] = bf2f(Pg[mo + 768 + d * 4 + h]); abv[1] = bf2f(Pg[mo + 776 + d * 4 + h]); }
    LDS_BARRIER();
    { float cwv[3][4];
#pragma unroll
      for (int c3 = 0; c3 < 3; ++c3)
#pragma unroll
          for (int j = 0; j < 4; ++j) cwv[c3][j] = cw[j * 768 + c3 * 256 + h * 64 + lane];
#pragma unroll
      for (int u = 0; u < 8; ++u) { const int s = 8 * w + u, tau = d ? 63 - s : s;
          float acc3[3] = {0.f, 0.f, 0.f};
#pragma unroll
          for (int j = 0; j < 4; ++j)
#pragma unroll
              for (int c3 = 0; c3 < 3; ++c3) acc3[c3] += bf2f(*(const LAS bf16*)(STG + (tau + j) * GSTR + (c3 * 64 + lane) * 2)) * cwv[c3][j];
          const float o0 = siluf_(acc3[0]), o1 = siluf_(acc3[1]), o2 = siluf_(acc3[2]);
          const float qs = wave_sum(o0 * o0), ks = wave_sum(o1 * o1);
          qv[u] = o0 * rsqrtf(qs + 1e-6f) * 0.125f; kv[u] = o1 * rsqrtf(ks + 1e-6f); vv[u] = o2;
          const float ar = __int_as_float(__builtin_amdgcn_readlane(__float_as_int(abv[0]), u)), br = __int_as_float(__builtin_amdgcn_readlane(__float_as_int(abv[1]), u));
          const float lav = -Aexp * softplusf_(ar + dt), bev = sigmoidf_(br);
          if (lane == 0) { LAa[s] = lav; BETA[s] = bev; } } }
    TSEC_END(1)
    TSEC_BEGIN(2)
    LDS_BARRIER();
    if (w == 0) { const float la = LAa[lane]; float gsum = la;
#pragma unroll
        for (int o = 1; o < 64; o <<= 1) { const float t = __shfl_up(gsum, o); if (lane >= o) gsum += t; }
        Gs[lane] = gsum; GM1[lane] = gsum - la; }
    LDS_BARRIER();
    TSEC_END(2)
    TSEC_BEGIN(3)
    const float gc = Gs[63];
#pragma unroll
    for (int u = 0; u < 8; ++u) { const int s = 8 * w + u; const float gg = Gs[s], gm = GM1[s], be = BETA[s];
        *(LAS bf16*)(pimg(F, PI_A0) + s * LSTR + 2 * lane) = f2bf(kv[u]); *(LAS bf16*)(pimg(F, PI_A1) + s * LSTR + 2 * lane) = f2bf(qv[u]);
        *(LAS bf16*)(pimg(F, PI_KAPT) + lane * LSTR + 2 * s) = f2bf(kv[u] * __expf(gm)); *(LAS bf16*)(pimg(F, PI_RHOT) + lane * LSTR + 2 * s) = f2bf(qv[u] * __expf(gg));
        *(LAS bf16*)(pimg(F, PI_VT) + lane * LSTR + 2 * s) = f2bf(vv[u]); *(LAS bf16*)(pimg(F, PI_KHT) + lane * LSTR + 2 * s) = f2bf(be * kv[u] * __expf(gc - gg));
        *(GAS bf16*)(item + IT_BH + swz(lane, s)) = f2bf(be * kv[u] * __expf(gc - gm)); }
    if (w == 0) ((GAS float*)(item + IT_GC))[lane] = __expf(gc);
    LDS_BARRIER();
    TSEC_END(3)
    { const int rr_ = RR(28);
#pragma nounroll
      for (int q_ = 0; q_ < rr_; ++q_) dplr_core<true>(F, item); }
}
__device__ __forceinline__ void ph_gdn_pre(Frame& F, const bf16* P, const float* cw, const float* alog, const float* dtb, unsigned char* BL) {
    for (int it = F.vcu; it < 272 * 8; it += F.G) { const int tbi = it >> 3, h = (it >> 1) & 3, d = it & 1; gdn_pre_item(F, P, cw, alog, dtb, BL, tbi, h, d); }
}

constexpr int SLOT_BYTES = 24576;
__device__ __forceinline__ void dplr_scan_seq(Frame& F, const unsigned char* BLgen, int seq, float* YSgen0, float* YSgen1) {
    const GAS unsigned char* BL = (const GAS unsigned char*)BLgen; GAS float* YS = (GAS float*)((seq >> 4) ? YSgen1 : YSgen0);
    const int w = F.wave, lane = F.lane, r = lane & 15, g = lane >> 4;
    const int d = seq >> 4, b = (seq >> 2) & 3, h = seq & 3;
    LAS unsigned char* ring = F.lds + RING_OFF;
    if (w >= 4) {
        const int lw = w - 4;
#define SCAN_ISSUE(n) do { const GAS unsigned char* src = BL + ((size_t)seq * 68 + (n)) * ITEM_BYTES + lw * 6144 + lane * 16; LAS unsigned char* dst = ring + ((n) % 5) * SLOT_BYTES + lw * 6144; \
        _Pragma("unroll") for (int q = 0; q < 6; ++q) __builtin_amdgcn_global_load_lds((const GAS unsigned*)(src + q * 1024), (LAS unsigned*)(dst + q * 1024), 16, 0, 0); } while (0)
        SCAN_ISSUE(0); SCAN_ISSUE(1); SCAN_ISSUE(2); SCAN_ISSUE(3);
        asm volatile("s_waitcnt vmcnt(18)" ::: "memory");
        __builtin_amdgcn_s_barrier(); asm volatile("" ::: "memory");
        for (int n = 0; n < 68; ++n) {
            if (n + 4 < 68) { SCAN_ISSUE(n + 4); asm volatile("s_waitcnt vmcnt(18)" ::: "memory"); }
            else asm volatile("s_waitcnt vmcnt(0)" ::: "memory");
            __builtin_amdgcn_s_barrier(); asm volatile("" ::: "memory");
        }
#undef SCAN_ISSUE
    } else {
        const int v = 16 * w + r;
        f32x4 z[4];
#pragma unroll
        for (int kb = 0; kb < 4; ++kb) z[kb] = zero4();
        struct Strip { unsigned long long ut[4], y0[4], d0[4]; f32x4 gc[4]; };
#define STRIP_LOAD(S, n) do { const GAS unsigned char* it_ = BL + ((size_t)seq * 68 + (n)) * ITEM_BYTES; const GAS bf16* UT_ = (const GAS bf16*)(it_ + IT_UT) + v * 64; const GAS bf16* Y0_ = (const GAS bf16*)(it_ + IT_Y0) + v * 64; \
        const GAS bf16* D0_ = (const GAS bf16*)(it_ + IT_D0) + v * 64; const GAS float* GC_ = (const GAS float*)(it_ + IT_GC); \
        _Pragma("unroll") for (int q = 0; q < 4; ++q) { S.ut[q] = *(const GAS unsigned long long*)(UT_ + 16 * q + 4 * g); S.y0[q] = *(const GAS unsigned long long*)(Y0_ + 16 * q + 4 * g); \
            S.d0[q] = *(const GAS unsigned long long*)(D0_ + 16 * q + 4 * g); S.gc[q] = *(const GAS f32x4*)(GC_ + 16 * q + 4 * g); } } while (0)
#define SCAN_BODY(S, n, SL) do { TSECN_BEGIN(8) const LAS unsigned char* slot = ring + (SL) * SLOT_BYTES; const LAS unsigned char* sx0 = slot + xo[0]; const LAS unsigned char* sx1 = slot + xo[1]; const LAS unsigned char* sx2 = slot + xo[2]; const LAS unsigned char* sx3 = slot + xo[3]; \
        bf16x4 zb[4]; _Pragma("unroll") for (int kb = 0; kb < 4; ++kb) zb[kb] = cvt4(z[kb]); \
        f32x4 sa[4], y[4]; \
        _Pragma("unroll") for (int tt = 0; tt < 4; ++tt) { sa[tt] = up4(S.ut[tt]); y[tt] = up4(S.y0[tt]); } \
        _Pragma("unroll") for (int kb = 0; kb < 4; ++kb) { const LAS unsigned char* sx = kb == 0 ? sx0 : kb == 1 ? sx1 : kb == 2 ? sx2 : sx3;     \
            _Pragma("unroll") for (int tt = 0; tt < 4; ++tt) { sa[tt] = MFMA16(*(const LAS bf16x4*)(sx + IT_KP + tt * 2048), zb[kb], sa[tt]); y[tt] = MFMA16(*(const LAS bf16x4*)(sx + IT_RP + tt * 2048), zb[kb], y[tt]); } } \
        bf16x4 sb[4]; _Pragma("unroll") for (int tt = 0; tt < 4; ++tt) sb[tt] = cvt4(sa[tt]); \
        f32x4 zu[4]; _Pragma("unroll") for (int kb = 0; kb < 4; ++kb) zu[kb] = zero4(); \
        _Pragma("unroll") for (int tt = 0; tt < 4; ++tt) { const LAS unsigned char* sx = tt == 0 ? sx0 : tt == 1 ? sx1 : tt == 2 ? sx2 : sx3; \
            _Pragma("unroll") for (int kb = 0; kb < 4; ++kb) zu[kb] = MFMA16(*(const LAS bf16x4*)(sx + IT_BH + kb * 2048), sb[tt], zu[kb]); } \
        _Pragma("unroll") for (int kb = 0; kb < 4; ++kb) z[kb] = S.gc[kb] * z[kb] + up4(S.d0[kb]) - zu[kb]; \
        { int m0; if ((n) < 4) { const int j = d ? 3 - (n) : (n); m0 = NX + (b * 4 + j) * 64; } else { const int j = d ? 63 - ((n) - 4) : ((n) - 4); m0 = (b * 64 + j) * 64; } \
          GAS float* yb = YS + (size_t)m0 * 256 + h * 64 + v; \
          _Pragma("unroll") for (int tt = 0; tt < 4; ++tt) _Pragma("unroll") for (int i = 0; i < 4; ++i) { const int t = 16 * tt + 4 * g + i, tau = d ? 63 - t : t; yb[(size_t)tau * 256] = y[tt][i]; } } \
        if ((n) + 2 < 68) STRIP_LOAD(S, (n) + 2); \
        TSECN_END(8) TSECN_BEGIN(9) \
        asm volatile("" ::: "memory"); __builtin_amdgcn_s_barrier(); asm volatile("" ::: "memory"); TSECN_END(9) } while (0)
        int xo[4];
#pragma unroll
        for (int q = 0; q < 4; ++q) xo[q] = r * 128 + (((4 * q + g) ^ r) << 3);
        Strip S0, S1; STRIP_LOAD(S0, 0); STRIP_LOAD(S1, 1);
        __builtin_amdgcn_s_barrier(); asm volatile("" ::: "memory");
        for (int n = 0; n < 68; n += 2) { SCAN_BODY(S0, n, (n % 5)); SCAN_BODY(S1, n + 1, ((n + 1) % 5)); }
#undef STRIP_LOAD
#undef SCAN_BODY
    }
}
constexpr int RWT_A2 = 2 * 2 * 256 * 32, RWT_V2 = 2 * RWT_A2, RWT_G2 = RWT_V2 + 256 * 32, RWT_TOTAL = RWT_G2 + 2 * 256 * 64;
__device__ __forceinline__ void ph_convert_rwkv(Frame& F, const float* w2, const float* a2, const float* v2, const float* g2, bf16* RWTp) {
    for (int i = F.vcu * NTHR + F.tid; i < RWT_TOTAL; i += F.G * NTHR) {
        float x;
        if (i < RWT_V2) { const int which = i >= RWT_A2, r = i - which * RWT_A2, ld = r >> 13, c = (r >> 5) & 255, j = r & 31; x = (which ? a2 : w2)[((size_t)ld * 32 + j) * 256 + c]; }
        else if (i < RWT_G2) { const int r = i - RWT_V2, c = r >> 5, j = r & 31; x = v2[j * 256 + c]; }
        else { const int r = i - RWT_G2, l = r >> 14, c = (r >> 6) & 255, j = r & 63; x = g2[((size_t)l * 64 + j) * 256 + c]; }
        RWTp[i] = f2bf(x); }
}
constexpr int RW_RSTR = 720;
constexpr int RW_RAW = 0, RW_TW = 55296, RW_AD = RW_TW + 64 * 80, RW_VD = RW_AD + 64 * 80, RW_GD = RW_VD + 64 * 80, RW_ZZ = RW_GD + 64 * 144, RW_ZA = RW_ZZ + 16384, RW_ZV = RW_ZA + 16384, RW_ZG = RW_ZV + IMG;
static_assert(RW_ZG + IMG <= RING_BYTES && 66 * RW_RSTR <= RW_TW, "RWKV prep LDS map");
constexpr int RW_WT = LDSCTL_OFF + 4096;
__device__ __forceinline__ void rwkv_pre_item(Frame& F, const bf16* Pgen, const RwP& wp, const bf16* RWTg, int layer, float* VF, float* SV, float* GB, float* BSC, unsigned char* BL, int tbi, int h, int d) {
    int w = F.wave; asm volatile("" : "+s"(w));
    const GAS bf16* P = (const GAS bf16*)Pgen; const GAS bf16* RWTp = (const GAS bf16*)RWTg;
    const TB tb = tb_of(tbi); const int lane = F.lane, tid = F.tid, L = tb.isx ? SEQ : CTXL, c = h * 64 + lane, r = lane & 15, g = lane >> 4;
    LAS unsigned char* lds = F.lds + RING_OFF; LAS float* WT = (LAS float*)(F.lds + RW_WT);
    const int seq = (d * 4 + tb.b) * 4 + h; GAS unsigned char* item = item_ptr(BL, seq, chunk_of(tb, d));
#pragma unroll
    for (int q = 0; q < 6; ++q) { const int e0 = tid + q * NTHR, e = e0 < 66 * 44 ? e0 : 66 * 44 - 1; const int row = e / 44, ch = e % 44; const int t = tb.t0 - 1 + row; const bool ok = t >= 0 && t < L; const int rowc = ok ? row : 1;
        const int pcol = ch < 24 ? (ch >> 3) * 256 + h * 64 + (ch & 7) * 8 : ch < 28 ? 768 + d * 32 + (ch - 24) * 8 : ch < 32 ? 832 + d * 32 + (ch - 28) * 8 : ch < 40 ? 896 + (ch - 32) * 8 : VRES_OFF + (ch - 40) * 8;
        v4u val = *(const GAS v4u*)(P + (size_t)(tb.m0 - 1 + rowc) * LDP + pcol); if (!ok) val = (v4u){0u, 0u, 0u, 0u};
        *(LAS v4u*)(lds + RW_RAW + row * RW_RSTR + ch * 16) = val; }
    float svf[8];
#pragma unroll
    for (int u = 0; u < 8; ++u) { const int s = 8 * w + u, tau = d ? 63 - s : s; svf[u] = layer ? VF[(size_t)(tb.m0 + tau) * 256 + c] : 0.f; }
    LDS_BARRIER();
#define RAWV(row, col) bf2f(*(const LAS bf16*)(lds + RW_RAW + (row) * RW_RSTR + (col) * 2))
#define RSHF(tau_, col, mu_) ([&]() { const float p_ = RAWV((tau_) + 1, col); return p_ + (0.5f * (RAWV((tau_), col) + RAWV((tau_) + 2, col)) - p_) * (mu_); }())
    { const int tau = tid & 63, cg = tid >> 6;
#pragma unroll 4
      for (int q = 0; q < 20; ++q) { const int j = cg * 20 + q;
          if (j < 32) { const float x = RSHF(tau, 192 + j, wp.mu[768 + d * 32 + j]); *(LAS bf16*)(lds + RW_TW + tau * 80 + 2 * j) = f2bf(tanhf_(x)); }
          else if (j < 64) { const float x = RSHF(tau, 224 + (j - 32), wp.mu[832 + d * 32 + (j - 32)]); *(LAS bf16*)(lds + RW_AD + tau * 80 + 2 * (j - 32)) = f2bf(x); }
          else if (j < 128) { const float x = RSHF(tau, 256 + (j - 64), wp.mu[896 + (j - 64)]); *(LAS bf16*)(lds + RW_GD + tau * 144 + 2 * (j - 64)) = f2bf(sigmoidf_(x)); }
          else { *(LAS bf16*)(lds + RW_VD + tau * 80 + 2 * (j - 128)) = *(const LAS bf16*)(lds + RW_RAW + (tau + 1) * RW_RSTR + (320 + (j - 128)) * 2); } } }
    LDS_BARRIER();
    { const int p = w >> 1; const bool live = p < 2 || (p == 2 && layer) || (p == 3 && d == 0);
      if (live) { const int ksteps = p == 3 ? 4 : 2, astr = p == 3 ? 144 : 80; const LAS unsigned char* A = lds + (p == 0 ? RW_TW : p == 1 ? RW_AD : p == 2 ? RW_VD : RW_GD);
          const GAS bf16* Bw = p == 0 ? RWTp + ((size_t)(layer * 2 + d) * 256 + h * 64) * 32 : p == 1 ? RWTp + RWT_A2 + ((size_t)(layer * 2 + d) * 256 + h * 64) * 32 : p == 2 ? RWTp + RWT_V2 + (size_t)(h * 64) * 32 : RWTp + RWT_G2 + ((size_t)layer * 256 + h * 64) * 64;
          const int bstr = p == 3 ? 64 : 32;
#pragma unroll
          for (int sq = 0; sq < 2; ++sq) { const int st = 2 * (w & 1) + sq;
#pragma unroll
              for (int ct = 0; ct < 4; ++ct) { f32x4 acc = zero4();
                  for (int ks = 0; ks < ksteps; ++ks) { const bf16x4 af = *(const LAS bf16x4*)(A + (16 * st + r) * astr + (16 * ks + 4 * g) * 2); const bf16x4 bfr = *(const GAS bf16x4*)(Bw + (size_t)(16 * ct + r) * bstr + 16 * ks + 4 * g); acc = MFMA16(af, bfr, acc); }
#pragma unroll
                  for (int i = 0; i < 4; ++i) { const int tau = 16 * st + 4 * g + i, cc = 16 * ct + r;
                      if (p == 0) *(LAS float*)(lds + RW_ZZ + (tau * 64 + cc) * 4) = acc[i]; else if (p == 1) *(LAS float*)(lds + RW_ZA + (tau * 64 + cc) * 4) = acc[i];
                      else if (p == 2) *(LAS bf16*)(lds + RW_ZV + tau * LSTR + 2 * cc) = f2bf(acc[i]); else *(LAS bf16*)(lds + RW_ZG + tau * LSTR + 2 * cc) = f2bf(acc[i]); } } } } }
    LDS_BARRIER();
    float rv[8], kn[8], kd[8], bv[8], sv[8], lwv[8], gl[8]; float run = 0.f;
    { const float w0c = wp.w0[d * 256 + c], a0c = wp.a0[d * 256 + c], kkc = wp.kk[c], kac = wp.ka[c], rkc = wp.rk[c], v0c = layer ? wp.v0[c] : 0.f;
      const float mur = wp.mu[c], muk = wp.mu[256 + c], muv = wp.mu[512 + c];
#pragma unroll
      for (int u = 0; u < 8; ++u) { const int s = 8 * w + u, tau = d ? 63 - s : s, m = tb.m0 + tau;
          const float rr = RSHF(tau, lane, mur), kraw = RSHF(tau, 64 + lane, muk); float v = RSHF(tau, 128 + lane, muv);
          const float z = w0c + *(const LAS float*)(lds + RW_ZZ + (tau * 64 + lane) * 4), za = a0c + *(const LAS float*)(lds + RW_ZA + (tau * 64 + lane) * 4);
          const float lw = -0.6065306597f * sigmoidf_(z), a = sigmoidf_(za);
          const float kkr = kraw * kkc; const float kkn = kkr * rsqrtf(wave_sum(kkr * kkr) + 1e-6f);
          const float kdv = kraw * (1.f + (a - 1.f) * kac);
          const float bs = wave_sum(rr * kdv * rkc);
          if (lane == 0) BSC[((size_t)d * MT + m) * 4 + h] = bs;
          if (layer) { const float zv = v0c + bf2f(*(const LAS bf16*)(lds + RW_ZV + tau * LSTR + 2 * lane)); v = v + (svf[u] - v) * sigmoidf_(zv); }
          if (d == 0) { if (!layer) VF[(size_t)m * 256 + c] = v; SV[(size_t)m * 256 + c] = v; GB[(size_t)m * 256 + c] = bf2f(*(const LAS bf16*)(lds + RW_ZG + tau * LSTR + 2 * lane)); }
          run += lw; rv[u] = rr; kn[u] = kkn; kd[u] = kdv; bv[u] = kkn * a; sv[u] = v; lwv[u] = lw; gl[u] = run; } }
#undef RSHF
#undef RAWV
    WT[w * 64 + lane] = run;
    LDS_BARRIER();
    float off = 0.f, gc = 0.f;
#pragma unroll
    for (int q = 0; q < 8; ++q) { const float t = WT[q * 64 + lane]; gc += t; if (q < w) off += t; }
#pragma unroll
    for (int u = 0; u < 8; ++u) { const int s = 8 * w + u; const float G = off + gl[u]; const float eg = __expf(G), eng = __expf(-G), egc = __expf(gc - G); const bf16 kap = f2bf(kn[u] * __expf(G - lwv[u])), rho = f2bf(rv[u] * eg);
        *(LAS bf16*)(pimg(F, PI_A0) + s * LSTR + 2 * lane) = kap; *(LAS bf16*)(pimg(F, PI_KAPT) + lane * LSTR + 2 * s) = kap;
        *(LAS bf16*)(pimg(F, PI_A1) + s * LSTR + 2 * lane) = f2bf(bv[u] * eng); *(LAS bf16*)(pimg(F, PI_A2) + s * LSTR + 2 * lane) = f2bf(kd[u] * eng);
        *(LAS bf16*)(pimg(F, PI_A3) + s * LSTR + 2 * lane) = rho; *(LAS bf16*)(pimg(F, PI_RHOT) + lane * LSTR + 2 * s) = rho;
        *(LAS bf16*)(pimg(F, PI_VT) + lane * LSTR + 2 * s) = f2bf(sv[u]); *(LAS bf16*)(pimg(F, PI_KHT) + lane * LSTR + 2 * s) = f2bf(kd[u] * egc);
        *(GAS bf16*)(item + IT_BH + swz(lane, s)) = f2bf(bv[u] * egc); }
    if (w == 0) ((GAS float*)(item + IT_GC))[lane] = __expf(gc);
    LDS_BARRIER();
    dplr_core<false>(F, item);
}
__device__ __forceinline__ void ph_rwkv_pre(Frame& F, const bf16* P, const RwP& wp, const bf16* RWTg, int layer, float* VF, float* SV, float* GB, float* BSC, unsigned char* BL) {
    for (int it = F.vcu; it < 272 * 8; it += F.G) { const int tbi = it >> 3, h = (it >> 1) & 3, d = it & 1; rwkv_pre_item(F, P, wp, RWTg, layer, VF, SV, GB, BSC, BL, tbi, h, d); }
}
__device__ __forceinline__ void d_rwkv_post2(int m_, int c_, const float* YS, const float* BSC, const float* SV, const float* G, const float* lnw, const float* lnb, bf16* MIX) {
    const int m = m_, c = c_, h = c >> 6;
    const float y = YS[(size_t)m * 256 + c] + YS[((size_t)MT + m) * 256 + c];
    const float mu = wave_sum(y) * (1.f / 64.f); const float dlt = y - mu; const float var = wave_sum(dlt * dlt) * (1.f / 64.f);
    const float yn = dlt * rsqrtf(var + 64e-5f);
    const float bon = (BSC[(size_t)m * 4 + h] + BSC[((size_t)MT + m) * 4 + h]) * SV[(size_t)m * 256 + c];
    MIX[(size_t)m * D + c] = f2bf((yn * lnw[c] + lnb[c] + bon) * G[(size_t)m * 256 + c]);
}

constexpr int S8_RING = 4, S8_XZ = S8_RING * 24576, S8_XS = S8_XZ + 8192;
__device__ __forceinline__ void dplr_scan_seq8(Frame& F, const unsigned char* BLgen, int seq, float* YSgen0, float* YSgen1) {
    const GAS unsigned char* BL = (const GAS unsigned char*)BLgen; GAS float* YS = (GAS float*)((seq >> 4) ? YSgen1 : YSgen0);
    const int w = F.wave, lane = F.lane, r = lane & 15, g = lane >> 4, vs = w & 3, hh = w >> 2;
    const int d = seq >> 4, b = (seq >> 2) & 3, h = seq & 3, v = 16 * vs + r;
    LAS unsigned char* ring = F.lds + RING_OFF;
    LAS unsigned char* XZ = ring + S8_XZ + vs * 2048 + lane * 8; LAS unsigned char* XS = ring + S8_XS + vs * 2048 + lane * 8;
    int xo[4];
#pragma unroll
    for (int q = 0; q < 4; ++q) xo[q] = r * 128 + (((4 * q + g) ^ r) << 3);
#define S8_ISSUE(n) do { const GAS unsigned char* src_ = BL + ((size_t)seq * 68 + (n)) * ITEM_BYTES + w * 3072 + lane * 16; LAS unsigned char* dst_ = ring + ((n) & 3) * 24576 + w * 3072; \
        _Pragma("unroll") for (int q = 0; q < 3; ++q) __builtin_amdgcn_global_load_lds((const GAS unsigned*)(src_ + q * 1024), (LAS unsigned*)(dst_ + q * 1024), 16, 0, 0); } while (0)
    struct Strip8 { unsigned long long ut[2], y0[2], d0[2]; f32x4 gc[2]; };
#define S8_LOAD(S, n) do { const GAS unsigned char* it_ = BL + ((size_t)seq * 68 + (n)) * ITEM_BYTES; \
        _Pragma("unroll") for (int q = 0; q < 2; ++q) { const int tq = 2 * hh + q; S.ut[q] = *(const GAS unsigned long long*)((const GAS bf16*)(it_ + IT_UT) + v * 64 + 16 * tq + 4 * g); S.y0[q] = *(const GAS unsigned long long*)((const GAS bf16*)(it_ + IT_Y0) + v * 64 + 16 * tq + 4 * g); \
            S.d0[q] = *(const GAS unsigned long long*)((const GAS bf16*)(it_ + IT_D0) + v * 64 + 16 * tq + 4 * g); S.gc[q] = *(const GAS f32x4*)((const GAS float*)(it_ + IT_GC) + 16 * tq + 4 * g); } } while (0)
    f32x4 z[2] = {zero4(), zero4()};
    Strip8 S0, S1;
    S8_ISSUE(0); S8_LOAD(S0, 0); S8_ISSUE(1); S8_LOAD(S1, 1); S8_ISSUE(2);
    asm volatile("s_waitcnt vmcnt(0)" ::: "memory"); __builtin_amdgcn_s_barrier(); asm volatile("" ::: "memory");
#define S8_BODY(S, n) do { const LAS unsigned char* slot = ring + ((n) & 3) * 24576; \
          \
        _Pragma("unroll") for (int q = 0; q < 2; ++q) *(LAS unsigned long long*)(XZ + (2 * hh + q) * 512) = pack4(z[q]); \
        asm volatile("s_waitcnt lgkmcnt(0)" ::: "memory"); __builtin_amdgcn_s_barrier(); asm volatile("" ::: "memory"); \
        if ((n) + 3 < 68) S8_ISSUE((n) + 3);     \
        bf16x4 zb[4]; _Pragma("unroll") for (int kb = 0; kb < 4; ++kb) zb[kb] = *(const LAS bf16x4*)(XZ + kb * 512); \
          \
        f32x4 sa[2], y[2]; \
        _Pragma("unroll") for (int q = 0; q < 2; ++q) { const int tt = 2 * hh + q; f32x4 a = up4(S.ut[q]), c = up4(S.y0[q]); \
            _Pragma("unroll") for (int kb = 0; kb < 4; ++kb) { a = MFMA16(*(const LAS bf16x4*)(slot + IT_KP + tt * 2048 + xo[kb]), zb[kb], a); c = MFMA16(*(const LAS bf16x4*)(slot + IT_RP + tt * 2048 + xo[kb]), zb[kb], c); } \
            sa[q] = a; y[q] = c; } \
        _Pragma("unroll") for (int q = 0; q < 2; ++q) *(LAS unsigned long long*)(XS + (2 * hh + q) * 512) = pack4(sa[q]); \
        { int m0; if ((n) < 4) { const int j = d ? 3 - (n) : (n); m0 = NX + (b * 4 + j) * 64; } else { const int j = d ? 63 - ((n) - 4) : ((n) - 4); m0 = (b * 64 + j) * 64; } \
          GAS float* yb = YS + (size_t)m0 * 256 + h * 64 + v; \
          _Pragma("unroll") for (int q = 0; q < 2; ++q) _Pragma("unroll") for (int i = 0; i < 4; ++i) { const int t = 16 * (2 * hh + q) + 4 * g + i, tau = d ? 63 - t : t; yb[(size_t)tau * 256] = y[q][i]; } } \
        asm volatile("s_waitcnt lgkmcnt(0)" ::: "memory"); __builtin_amdgcn_s_barrier(); asm volatile("" ::: "memory"); \
          \
        bf16x4 sb[4]; _Pragma("unroll") for (int tt = 0; tt < 4; ++tt) sb[tt] = *(const LAS bf16x4*)(XS + tt * 512); \
        _Pragma("unroll") for (int q = 0; q < 2; ++q) { const int kb = 2 * hh + q; f32x4 a = zero4(); \
            _Pragma("unroll") for (int tt = 0; tt < 4; ++tt) a = MFMA16(*(const LAS bf16x4*)(slot + IT_BH + kb * 2048 + xo[tt]), sb[tt], a); \
            z[q] = S.gc[q] * z[q] + up4(S.d0[q]) - a; } \
        if ((n) + 2 < 68) S8_LOAD(S, (n) + 2); } while (0)
    for (int n = 0; n < 68; n += 2) { S8_BODY(S0, n); S8_BODY(S1, n + 1); }
    asm volatile("s_waitcnt vmcnt(0) lgkmcnt(0)" ::: "memory"); __builtin_amdgcn_s_barrier(); asm volatile("" ::: "memory");
#undef S8_ISSUE
#undef S8_LOAD
#undef S8_BODY
}
__device__ __forceinline__ void ph_rwkv_post(Frame& F, const float* YSg, const float* BSCg, const float* SVg, const float* Gg, const float* lnw, const float* lnb, bf16* MIXg) {
    const GAS float* YS = (const GAS float*)YSg; const GAS float* BSC = (const GAS float*)BSCg; const GAS float* SV = (const GAS float*)SVg; const GAS float* G = (const GAS float*)Gg; GAS bf16* MIX = (GAS bf16*)MIXg;
    const int gw = F.vcu * NWAVES + F.wave, NGW = F.G * NWAVES, lane = F.lane;
    for (int i0 = gw; i0 < MT * 4; i0 += 4 * NGW) {
        float y[4], bon[4], gg[4]; int mm[4], cc[4]; bool ok[4];
#pragma unroll
        for (int q = 0; q < 4; ++q) { const int it = i0 + q * NGW; ok[q] = it < MT * 4; const int itc = ok[q] ? it : i0; const int m = itc >> 2, h = itc & 3, c = h * 64 + lane; mm[q] = m; cc[q] = c;
            y[q] = YS[(size_t)m * 256 + c] + YS[((size_t)MT + m) * 256 + c]; bon[q] = (BSC[(size_t)m * 4 + h] + BSC[((size_t)MT + m) * 4 + h]) * SV[(size_t)m * 256 + c]; gg[q] = G[(size_t)m * 256 + c]; }
#pragma unroll
        for (int q = 0; q < 4; ++q) { const float mu = wave_sum(y[q]) * (1.f / 64.f); const float dlt = y[q] - mu; const float var = wave_sum(dlt * dlt) * (1.f / 64.f);
            const float yn = dlt * rsqrtf(var + 64e-5f); const float o = (yn * lnw[cc[q]] + lnb[cc[q]] + bon[q]) * gg[q];
            if (ok[q]) MIX[(size_t)mm[q] * D + cc[q]] = f2bf(o); }
    }
}
__device__ __forceinline__ void ph_hnorm_post(Frame& F, const float* YSag, const float* YSbg, const bf16* Pg, int gate_off, const float* nw, bf16* MIXg, int mix_off) {
    const GAS float* YSa = (const GAS float*)YSag; const GAS float* YSb = (const GAS float*)YSbg; const GAS bf16* P = (const GAS bf16*)Pg; GAS bf16* MIX = (GAS bf16*)MIXg;
    const int gw = F.vcu * NWAVES + F.wave, NGW = F.G * NWAVES, lane = F.lane; const float nwv = nw[lane];
    for (int i0 = gw; i0 < MT * 4; i0 += 4 * NGW) {
        float o[4], g[4]; int mm[4], cc[4]; bool ok[4];
#pragma unroll
        for (int q = 0; q < 4; ++q) { const int it = i0 + q * NGW; ok[q] = it < MT * 4; const int itc = ok[q] ? it : i0; const int m = itc >> 2, c = (itc & 3) * 64 + lane; mm[q] = m; cc[q] = c;
            o[q] = YSa[(size_t)m * 256 + c] + YSb[(size_t)m * 256 + c]; g[q] = bf2f(P[(size_t)m * LDP + gate_off + c]); }
#pragma unroll
        for (int q = 0; q < 4; ++q) { const float ms = wave_sum(o[q] * o[q]) * (1.f / 64.f); const float y = o[q] * rsqrtf(ms + 1e-6f) * siluf_(g[q]) * nwv;
            if (ok[q]) MIX[(size_t)mm[q] * D + mix_off + cc[q]] = f2bf(y); }
    }
}
__device__ __forceinline__ void ph_lru_pre(Frame& F, const bf16* Pgen, const LruP& wp, bf16* LLAg, bf16* LBg, float* LSUMg) {
    const GAS bf16* P = (const GAS bf16*)Pgen; GAS bf16* LLA = (GAS bf16*)LLAg; GAS bf16* LB = (GAS bf16*)LBg; GAS float* LSUM = (GAS float*)LSUMg;
    const int w = F.wave, lane = F.lane, r = lane & 15, g = lane >> 4, tid = F.tid;
    LAS unsigned char* XM = F.lds + RING_OFF;
    LAS unsigned char* WA = F.lds + RING_OFF + 1 * IMG;
    LAS unsigned char* WX = F.lds + RING_OFF + 2 * IMG;
    LAS float* LAs = (LAS float*)(F.lds + RING_OFF + 3 * IMG);
    LAS float* BBs = LAs + 4096;
    const int dh = F.vcu & 7, d = dh >> 2, h = dh & 3;
    { const float* wa = wp.wa + (size_t)dh * 4096; const float* wx = wp.wx + (size_t)dh * 4096;
#pragma unroll
      for (int q = 0; q < 8; ++q) { const int e = tid + q * NTHR, i = e >> 6, j = e & 63; *(LAS bf16*)(WA + j * LSTR + 2 * i) = f2bf(wa[e]); *(LAS bf16*)(WX + j * LSTR + 2 * i) = f2bf(wx[e]); } }
    const int cc = tid & 63, sg = tid >> 6, c = h * 64 + cc;
    const float cb = wp.cb[c]; float cwv[4];
#pragma unroll
    for (int j = 0; j < 4; ++j) cwv[j] = wp.cw[j * 256 + c];
    for (int it = F.vcu; it < 272 * 8; it += F.G) {
        const int tbi = it >> 3; const TB tb = tb_of(tbi); const int L = tb.isx ? SEQ : CTXL;
        { const GAS bf16* pc = P + (size_t)tb.m0 * LDP + LRU_OFF + c; float rowv[11];
#pragma unroll
          for (int q = 0; q < 11; ++q) { const int s = 8 * sg - 2 + q, t = tb.t0 + s; const bool ok = t >= 0 && t < L; const int sc = ok ? s : 8 * sg; const float v = bf2f(pc[(ptrdiff_t)sc * LDP]); rowv[q] = ok ? v : 0.f; }
#pragma unroll
          for (int u = 0; u < 8; ++u) { const float xm = cb + rowv[u] * cwv[0] + rowv[u + 1] * cwv[1] + rowv[u + 2] * cwv[2] + rowv[u + 3] * cwv[3];
              *(LAS bf16*)(XM + (8 * sg + u) * LSTR + 2 * cc) = f2bf(xm); } }
        LDS_BARRIER();
        { const int tt = w & 3, jh = w >> 2;
#pragma unroll
          for (int jq = 0; jq < 2; ++jq) { const int jt = 2 * jh + jq;
              const f32x4 ra = nt_tile64(XM, 16 * tt, WA, 16 * jt, lane, zero4()), rx = nt_tile64(XM, 16 * tt, WX, 16 * jt, lane, zero4());
              const int j = 16 * jt + r, cj = h * 64 + j; const float ba = wp.ba[d * 256 + cj], bx = wp.bx[d * 256 + cj], lam8 = -8.f * softplusf_(-wp.lam[d * 256 + cj]);
#pragma unroll
              for (int i = 0; i < 4; ++i) { const int s = 16 * tt + 4 * g + i; const float xm = bf2f(*(const LAS bf16*)(XM + s * LSTR + 2 * j));
                  const float la = lam8 * sigmoidf_(ra[i] + ba); const float bb = __builtin_amdgcn_sqrtf(fmaxf(1.f - __expf(2.f * la), 0.f)) * sigmoidf_(rx[i] + bx) * xm;
                  LAs[s * 64 + j] = la; BBs[s * 64 + j] = bb;
                  const size_t o = ((size_t)d * MT + tb.m0 + s) * 256 + cj; LLA[o] = f2bf(la); LB[o] = f2bf(bb); } } }
        LDS_BARRIER();
        if (w == 0) { float sl = 0.f, hh = 0.f;
#pragma unroll 8
            for (int s = 0; s < 64; ++s) { const int tau = d ? 63 - s : s; const float la = LAs[tau * 64 + lane], bb = BBs[tau * 64 + lane]; sl += la; hh = __expf(la) * hh + bb; }
            LSUM[(((size_t)d * 272 + tbi) * 2 + 0) * 256 + h * 64 + lane] = sl; LSUM[(((size_t)d * 272 + tbi) * 2 + 1) * 256 + h * 64 + lane] = hh; }
        LDS_BARRIER();
    }
}
__device__ __forceinline__ void ph_lru_carry(Frame& F, const float* LSUMg, float* LCINg) {
    if (blockIdx.x >= 4) return;
    const GAS float* LSUM = (const GAS float*)LSUMg; GAS float* LCIN = (GAS float*)LCINg;
    const int e = blockIdx.x * NTHR + F.tid, c = e & 255, bd = e >> 8, d = bd & 1, b = bd >> 1;
    float hh = 0.f;
#pragma unroll 1
    for (int n0 = 0; n0 < 68; n0 += 17) { float sl[17], he[17]; int tb_[17];
#pragma unroll
        for (int u = 0; u < 17; ++u) { const int n = n0 + u; tb_[u] = n < 4 ? 256 + b * 4 + (d ? 3 - n : n) : b * 64 + (d ? 63 - (n - 4) : (n - 4));
            sl[u] = LSUM[(((size_t)d * 272 + tb_[u]) * 2 + 0) * 256 + c]; he[u] = LSUM[(((size_t)d * 272 + tb_[u]) * 2 + 1) * 256 + c]; }
#pragma unroll
        for (int u = 0; u < 17; ++u) { LCIN[((size_t)d * 272 + tb_[u]) * 256 + c] = hh; hh = __expf(sl[u]) * hh + he[u]; } }
}
__device__ __forceinline__ void ph_lru_post(Frame& F, const bf16* P, const bf16* LLA, const bf16* LB, const float* LCIN, bf16* MIX) {
    const int half = F.tid >> 8, c = F.tid & 255;
    for (int it = F.vcu; it < 136; it += F.G) { const int tbi = it * 2 + half; const TB tb = tb_of(tbi);
        float hf[64]; float hh = LCIN[((size_t)0 * 272 + tbi) * 256 + c];
        const GAS bf16* pa = (const GAS bf16*)(LLA + (size_t)tb.m0 * 256 + c); const GAS bf16* pb = (const GAS bf16*)(LB + (size_t)tb.m0 * 256 + c);
#pragma unroll
        for (int s0 = 0; s0 < 64; s0 += 8) { float la[8], bb[8];
            asm volatile("" : "+v"(pa), "+v"(pb));
#pragma unroll
            for (int u = 0; u < 8; ++u) { la[u] = bf2f(pa[u * 256]); bb[u] = bf2f(pb[u * 256]); }
#pragma unroll
            for (int u = 0; u < 8; ++u) { hh = __expf(la[u]) * hh + bb[u]; hf[s0 + u] = hh; }
            pa += 8 * 256; pb += 8 * 256; }
        hh = LCIN[((size_t)1 * 272 + tbi) * 256 + c];
        pa = (const GAS bf16*)(LLA + ((size_t)MT + tb.m0 + 56) * 256 + c); pb = (const GAS bf16*)(LB + ((size_t)MT + tb.m0 + 56) * 256 + c);
        const GAS bf16* pg = (const GAS bf16*)(P + (size_t)(tb.m0 + 56) * LDP + LRU_OFF + 256 + c); GAS bf16* pm = (GAS bf16*)(MIX + (size_t)(tb.m0 + 56) * D + 768 + c);
#pragma unroll
        for (int s0 = 56; s0 >= 0; s0 -= 8) { float la[8], bb[8], gt[8];
            asm volatile("" : "+v"(pa), "+v"(pb), "+v"(pg), "+v"(pm));
#pragma unroll
            for (int u = 0; u < 8; ++u) { la[u] = bf2f(pa[(7 - u) * 256]); bb[u] = bf2f(pb[(7 - u) * 256]); gt[u] = bf2f(pg[(7 - u) * LDP]); }
#pragma unroll
            for (int u = 0; u < 8; ++u) { const int s = s0 + 7 - u; hh = __expf(la[u]) * hh + bb[u];
                const float ge = 0.5f * gt[u] * (1.f + tanhf_(0.7978845608f * (gt[u] + 0.044715f * gt[u] * gt[u] * gt[u])));
                pm[(7 - u) * D] = f2bf((hf[s] + hh) * ge); }
            pa -= 8 * 256; pb -= 8 * 256; pg -= 8 * LDP; pm -= 8 * D; }
    }
}

__device__ __forceinline__ void ph_final_norm(Frame& F, const float* XR, const float* gain, float* out) {
    const int gw = F.vcu * NWAVES + F.wave, NGW = F.G * NWAVES, lane = F.lane;
    for (int m = gw; m < NX; m += NGW) {
        const float* src = XR + (size_t)m * D; f32x4 v[4]; float ss = 0.f;
#pragma unroll
        for (int j = 0; j < 4; ++j) { v[j] = *(const f32x4*)(src + 4 * lane + 256 * j); ss += (v[j].x * v[j].x + v[j].y * v[j].y) + (v[j].z * v[j].z + v[j].w * v[j].w); }
        ss = wave_sum(ss); const float rs = rsqrtf(ss * (1.f / D) + 1e-6f);
#pragma unroll
        for (int j = 0; j < 4; ++j) { const int ci = 4 * lane + 256 * j; *(f32x4*)(out + (size_t)m * D + ci) = v[j] * rs * *(const f32x4*)(gain + ci); }
    }
}

#define INP(i) ([&]() { int ii_ = (i); asm volatile("" : "+s"(ii_)); return (const float*)(const GAS float*)a.in[ii_]; }())
#ifndef PH_MASK
#define PH_MASK 0xfffff
#endif
#define IN(k) ((PH_MASK >> (k)) & 1)
#define SEAM() do { xcd_barrier(bar); if (PROBE_SEC == 100 + F.curk) F.tacc += clock64() - F.tph0; } while (0)
#define MOD ((float*)(GAS float*)(wsb + WS_MOD))
#define XN ((bf16*)(GAS bf16*)(wsb + WS_XN))
#define XR ((float*)(GAS float*)(wsb + WS_XR))
#define P ((bf16*)(GAS bf16*)(wsb + WS_P))
#define WIN_T ((bf16*)(GAS bf16*)(wsb + WS_WIN))
#define WOUT_T ((bf16*)(GAS bf16*)(wsb + WS_WOUT))
#define VF ((float*)(GAS float*)(wsb + WS_VF))
#define BON ((float*)(GAS float*)(wsb + WS_BON))
#define GG ((float*)(GAS float*)(wsb + WS_G))
#define YS ((float*)(GAS float*)(wsb + WS_YS))
#define SV ((float*)(GAS float*)(wsb + WS_SV))
#define SI ((float*)(GAS float*)(wsb + WS_SI))
#define WGU_T ((bf16*)(GAS bf16*)(wsb + WS_WGU))
#define WD_T ((bf16*)(GAS bf16*)(wsb + WS_WD))
#define HACT ((bf16*)(GAS bf16*)(wsb + WS_HACT))
#define Y ((bf16*)(GAS bf16*)(wsb + WS_Y))
#define DZ ((bf16*)(GAS bf16*)(wsb + WS_DZ))
#define BSC ((float*)(GAS float*)(wsb + WS_BSC))
#define YS2A ((float*)(GAS float*)(wsb + WS_BON))
#define YS2B ((float*)(GAS float*)(wsb + WS_YS2B))
#define LLA ((bf16*)(GAS bf16*)(wsb + WS_LLA))
#define LBB ((bf16*)(GAS bf16*)(wsb + WS_LB))
#define LSUM ((float*)(GAS float*)(wsb + WS_LSUM))
#define LCIN ((float*)(GAS float*)(wsb + WS_LCIN))
#define LIST ((unsigned*)(GAS unsigned*)(wsb + WS_LIST))
#define SLOTPOS ((int*)(GAS int*)(wsb + WS_SLOT))
#define SLOTG ((float*)(GAS float*)(wsb + WS_SLOTG))
#define RTW_T ((bf16*)(GAS bf16*)(wsb + WS_RTW))
#define RWT ((bf16*)(GAS bf16*)(wsb + WS_RWT))
#define MIX XN
#define PH() do { wsb = (GAS unsigned char*)ws; asm volatile("" : "+s"(wsb)); int t_ = threadIdx.x; asm volatile("" : "+v"(t_)); F.tid = t_; F.lane = t_ & 63; F.wave = __builtin_amdgcn_readfirstlane(t_ >> 6); half = t_ >> 8; c256 = t_ & 255; \
        shh = (LAS float*)(F.lds + RING_OFF + half * 8192); } while (0)

template <int l>
__device__ __forceinline__ void layer_body(Frame& F, const MArgs& a, const XcdBarrier& bar, unsigned char* ws) {
    GAS unsigned char* wsb = (GAS unsigned char*)ws; int half = 0, c256 = 0; LAS float* shh = nullptr;
        const float* MODl = MOD + (size_t)l * 5 * 6144;
        const float* xs = l == 0 ? INP(I_X) : XR; const float* cs = l == 0 ? INP(I_CTX) : XR + (size_t)NX * D;
        const int ntok = l == 0 ? MT : NX;
        if (IN(1) && l == 0) for (int rp_ = 0; rp_ < REPS(1); ++rp_) { PH(); F.curk = 1; if (PROBE_SEC >= 100) F.tph0 = clock64(); ph_norm_mod(F, xs, cs, INP(I_NMIX) + l * D, MODl, 0, XN, MT); SEAM(); }
        if (IN(2)) for (int rp_ = 0; rp_ < REPS(2); ++rp_) { PH(); F.curk = 2; if (PROBE_SEC >= 100) F.tph0 = clock64(); pg8::DenseOrder S; S.init(XN, WIN_T + (size_t)l * LDP * D, MT, LDP, D, F.G, (int)blockIdx.x); pg8::EpiStoreBf16 E{P, LDP};
            pg8::gemm_phase<pg8::EpiStoreBf16, pg8::DenseOrder, true>(F.lds + RING_OFF, D, S, E); SEAM(); }
        float* LA = SI; float* LB = SI + (size_t)2 * MT * 256;
        if (IN(3)) for (int rp_ = 0; rp_ < REPS(3); ++rp_) { PH(); F.curk = 3; if (PROBE_SEC >= 100) F.tph0 = clock64(); const RwP rwp{INP(I_RWMU) + l * 960, INP(I_RWW0) + l * 512, INP(I_RWW2) + l * 2 * 32 * 256, INP(I_RWA0) + l * 512, INP(I_RWA2) + l * 2 * 32 * 256, INP(I_RWG2) + l * 64 * 256, INP(I_RWKK) + l * 256, INP(I_RWKA) + l * 256,
                      INP(I_RWRK) + l * 256, INP(I_RWV0), INP(I_RWV2)};
            ph_rwkv_pre(F, P, rwp, RWT, l, VF, SV, GG, BSC, (unsigned char*)SI); SEAM(); }
        if (IN(4)) for (int rp_ = 0; rp_ < REPS(4); ++rp_) { PH(); F.curk = 4; if (PROBE_SEC >= 100) F.tph0 = clock64();
            if (blockIdx.x < 32) { TSECN_BEGIN(30) dplr_scan_seq(F, (const unsigned char*)SI, (int)blockIdx.x, YS, YS + (size_t)MT * 256); TSECN_END(30) }
            else { TSECN_BEGIN(31) const int vcu0 = F.vcu, G0 = F.G; F.vcu = (int)blockIdx.x - 32; F.G = G0 - 32;
                { const LruP lrp{INP(I_LCW) + l * 4 * 256, INP(I_LCB) + l * 256, INP(I_LWA) + (size_t)l * 2 * 4 * 64 * 64, INP(I_LBA) + l * 512, INP(I_LWX) + (size_t)l * 2 * 4 * 64 * 64, INP(I_LBX) + l * 512, INP(I_LLAM) + l * 512};
                  ph_lru_pre(F, P, lrp, LLA, LBB, LSUM); }
                __syncthreads(); build_rope(F); __syncthreads(); ph_ret_pre(F, P, INP(I_RETL) + l * 8, DZ);
                F.vcu = vcu0; F.G = G0; TSECN_END(31) }
            SEAM(); }
        if (IN(5)) for (int rp_ = 0; rp_ < REPS(5); ++rp_) { PH(); F.curk = 5; if (PROBE_SEC >= 100) F.tph0 = clock64();
            ph_gdn_pre(F, P, INP(I_GCW) + l * 4 * 768, INP(I_GALOG) + l * 8, INP(I_GDT) + l * 8, (unsigned char*)SI);
            ph_ret_prefix(F, INP(I_RETL) + l * 8, DZ); ph_lru_carry(F, LSUM, LCIN); SEAM(); }
        if (IN(8)) for (int rp_ = 0; rp_ < REPS(8); ++rp_) { PH(); F.curk = 8; if (PROBE_SEC >= 100) F.tph0 = clock64();
            if (blockIdx.x < 32) { TSECN_BEGIN(30) dplr_scan_seq(F, (const unsigned char*)SI, (int)blockIdx.x, YS2A, YS2B); TSECN_END(30) }
            else { TSECN_BEGIN(32) const int vcu0 = F.vcu, G0 = F.G; F.vcu = (int)blockIdx.x - 32; F.G = G0 - 32;
                ph_rwkv_post(F, YS, BSC, SV, GG, INP(I_RWLNW) + l * 256, INP(I_RWLNB) + l * 256, MIX);
                build_rope(F); __syncthreads(); ph_ret_post(F, P, INP(I_RETL) + l * 8, DZ, MIX); __syncthreads(); ph_lru_post(F, P, LLA, LBB, LCIN, MIX);
                F.vcu = vcu0; F.G = G0; TSECN_END(32) }
            SEAM(); }
        if (IN(9)) for (int rp_ = 0; rp_ < REPS(9); ++rp_) { PH(); F.curk = 9; if (PROBE_SEC >= 100) F.tph0 = clock64(); ph_hnorm_post(F, YS2A, YS2B, P, GDN_OFF + 784, INP(I_GNW) + l * 64, MIX, 512); SEAM(); }
        if (IN(12)) for (int rp_ = 0; rp_ < REPS(12); ++rp_) { PH(); F.curk = 12; if (PROBE_SEC >= 100) F.tph0 = clock64(); pg8::DenseOrder S; S.init(MIX, WOUT_T + (size_t)l * D * D, l == 0 ? MT : NX  , D, D, F.G, (int)blockIdx.x); pg8::EpiResidual E{xs, cs, MODl, XR};
            pg8::gemm_phase<pg8::EpiResidual, pg8::DenseOrder, true>(F.lds + RING_OFF, D, S, E); SEAM(); }
        if (IN(13)) for (int rp_ = 0; rp_ < REPS(13); ++rp_) { PH(); F.curk = 13; if (PROBE_SEC >= 100) F.tph0 = clock64(); ph_route(F, XR, INP(I_NFFN) + l * D, MODl, RTW_T + (size_t)l * 2 * 64 * 1024, INP(I_RTB) + l * NE, XN, l, LIST, SLOTPOS, SLOTG, ntok); __syncthreads();
{ const int rr_ = RR(29);
#pragma nounroll
            for (int q_ = 0; q_ < rr_; ++q_) { ph_convert_experts(F, INP(I_EWG) + (size_t)l * NE * D * EFF, INP(I_EWU) + (size_t)l * NE * D * EFF, INP(I_EWD) + (size_t)l * NE * EFF * D,
                               INP(I_SWG) + (size_t)l * D * EFF, INP(I_SWU) + (size_t)l * D * EFF, INP(I_SWD) + (size_t)l * EFF * D, WGU_T, WD_T); __syncthreads(); } }
            SEAM(); }
        if (IN(14)) for (int rp_ = 0; rp_ < REPS(14); ++rp_) { PH(); F.curk = 14; if (PROBE_SEC >= 100) F.tph0 = clock64(); moe_build_tab(F, l, ntok); MoeTab T = moe_tab(F);
            pg8::MoeOrder1 S{XN, WGU_T, LIST, T, F.G, F.vcu  , T.ups[65] * 2}; pg8::EpiSwiglu E{HACT};
            pg8::gemm_phase<pg8::EpiSwiglu, pg8::MoeOrder1, true>(F.lds + RING_OFF, D, S, E); SEAM(); }
        if (IN(15)) for (int rp_ = 0; rp_ < REPS(15); ++rp_) { PH(); F.curk = 15; if (PROBE_SEC >= 100) F.tph0 = clock64(); moe_build_tab(F, l, ntok); MoeTab T = moe_tab(F);
            pg8::MoeOrder2 S{HACT, WD_T, T, F.G, F.vcu, T.ups[65] * 4}; pg8::EpiDown E{Y, XR, MODl};
            int k2 = EFF; asm volatile("" : "+s"(k2));
            pg8::gemm_phase<pg8::EpiDown, pg8::MoeOrder2, true>(F.lds + RING_OFF, k2, S, E); SEAM(); }
        if (IN(16)) for (int rp_ = 0; rp_ < REPS(16); ++rp_) { PH(); F.curk = 16; if (PROBE_SEC >= 100) F.tph0 = clock64(); moe_build_tab(F, l, ntok);
            if (l == 0) ph_combine_norm<false>(F, Y, SLOTPOS, SLOTG, MODl, XR, ntok, INP(I_NMIX) + D, MOD + (size_t)5 * 6144, XN, nullptr);
            else ph_combine_norm<true>(F, Y, SLOTPOS, SLOTG, MODl, XR, ntok, INP(I_NFIN), nullptr, nullptr, a.out);
            if (l == 0) SEAM(); }
    }

__global__ void __launch_bounds__(NTHR, 2) mega(MArgs a) {
    extern __shared__ __attribute__((aligned(16))) unsigned char lds_raw[];
    Frame F; F.lds = (LAS unsigned char*)lds_raw; F.MISC = (volatile LAS unsigned*)(F.lds + MISC_OFF);
    F.tid = threadIdx.x; F.lane = F.tid & 63; F.wave = __builtin_amdgcn_readfirstlane(F.tid >> 6); F.tacc = 0ull;
    F.G = gridDim.x; { const int bx = blockIdx.x; F.vcu = (F.G % 8 == 0) ? (bx % 8) * (F.G / 8) + bx / 8 : bx; }
    unsigned char* ws = a.ws; F.ctl = (gu32*)ws;
    for (int u = F.tid; u < (LDS_BYTES - LDSCTL_OFF) / 4; u += NTHR) ((LAS unsigned*)(F.lds + LDSCTL_OFF))[u] = 0u;
    __syncthreads();
    XcdBarrier bar = xcd_barrier_post((unsigned*)(F.ctl + CW_BAR) + a.bar_region * XCD_BAR_WORDS, F.MISC + 8);
    GAS unsigned char* wsb = (GAS unsigned char*)ws;
    int half = 0, c256 = 0; LAS float* shh = nullptr;

    if (IN(0)) for (int rp_ = 0; rp_ < REPS(0); ++rp_) { PH(); F.curk = 0; if (PROBE_SEC >= 100) F.tph0 = clock64(); ph_mod(F, INP(I_C), INP(I_CCTX), INP(I_ADAW), INP(I_ADAB), MOD); ph_convert_small(F, INP(I_WIN), INP(I_WVRES), INP(I_WOUT), WIN_T, WOUT_T); ph_convert_router(F, INP(I_RTW), RTW_T); ph_convert_rwkv(F, INP(I_RWW2), INP(I_RWA2), INP(I_RWV2), INP(I_RWG2), RWT); SEAM(); }
    layer_body<0>(F, a, bar, ws);
    layer_body<1>(F, a, bar, ws);
    if (PROBE_SEC >= 0) { const unsigned long long t0_ = clock64(); while (clock64() - t0_ < F.tacc) __builtin_amdgcn_s_sleep(4); }
#undef PH
#undef MOD
#undef XN
#undef XR
#undef P
#undef WIN_T
#undef WOUT_T
#undef VF
#undef BON
#undef GG
#undef YS
#undef SV
#undef SI
#undef WGU_T
#undef WD_T
#undef HACT
#undef Y
#undef DZ
#undef BSC
#undef YS2A
#undef YS2B
#undef LLA
#undef LBB
#undef LSUM
#undef LCIN
#undef LIST
#undef SLOTPOS
#undef SLOTG
#undef RTW_T
#undef RWT
#undef MIX
#undef IN
#undef SEAM
}

extern "C" void kernel_launch(void* const* d_in, const int* in_sizes, int n_in, void* d_out, int out_size, void* d_ws, size_t ws_size, hipStream_t stream) {
    static int grid = 0;
    if (grid == 0) {
        if (n_in != I_N || ws_size < WS_END) { fprintf(stderr, "kernel_launch: bad n_in %d or ws %zu\n", n_in, ws_size); grid = -1; return; }
        int dev = 0, cus = 0;
        if (hipGetDevice(&dev) != hipSuccess || hipDeviceGetAttribute(&cus, hipDeviceAttributeMultiprocessorCount, dev) != hipSuccess) { grid = -1; return; }
        if (hipFuncSetAttribute((const void*)mega, hipFuncAttributeMaxDynamicSharedMemorySize, LDS_BYTES) != hipSuccess) { grid = -1; return; }
        int per_cu = 0; (void)hipOccupancyMaxActiveBlocksPerMultiprocessor(&per_cu, (const void*)mega, NTHR, LDS_BYTES); (void)hipGetLastError();
        grid = cus;
    }
    if (grid < 0) return;
    unsigned char* ws = (unsigned char*)d_ws;
    (void)hipMemsetAsync(ws, 0, CTL_ZERO_BYTES, stream);
    MArgs ma{}; for (int i = 0; i < I_N; ++i) ma.in[i] = (const float*)d_in[i]; ma.out = (float*)d_out; ma.ws = ws;
    ma.ph_lo = 0; ma.ph_hi = 18; ma.l_lo = 0; ma.l_hi = 2; ma.bar_region = 0;
    hipLaunchKernelGGL(mega, dim3(grid), dim3(NTHR), LDS_BYTES, stream, ma);
}
```

```cpp
#include <hip/hip_runtime.h>
#include <cstdio>
#include <cstdint>

typedef unsigned short bf16;
#ifndef PROBE_SEC
#define PROBE_SEC -1
#endif
__device__ unsigned long long g_tsec_dummy;
#define TSEC_BEGIN(id) unsigned long long ts0_##id = 0; if ((id) == PROBE_SEC) { asm volatile("s_waitcnt vmcnt(0) lgkmcnt(0)" ::: "memory"); ts0_##id = clock64(); }
#define TSECN_BEGIN(id) unsigned long long tn0_##id = 0; if ((id) == PROBE_SEC) { tn0_##id = clock64(); }
#define TSECN_END(id) if ((id) == PROBE_SEC) { F.tacc += clock64() - tn0_##id; }
#define TSEC_END(id) if ((id) == PROBE_SEC) { asm volatile("s_waitcnt vmcnt(0) lgkmcnt(0)" ::: "memory"); F.tacc += clock64() - ts0_##id; }
#ifndef PROBE_MASK
#define PROBE_MASK 0
#endif
#define REPS(k) (((PROBE_MASK >> (k)) & 1) ? 2 : 1)
#define RR(k) ([]() { int r_ = REPS(k); asm volatile("" : "+s"(r_)); return r_; }())
__device__ __forceinline__ float bf2f(bf16 v) { return __uint_as_float(((unsigned)v) << 16); }
typedef float f32x2_ __attribute__((ext_vector_type(2)));
typedef __bf16 bf16x2_ __attribute__((ext_vector_type(2)));
__device__ __forceinline__ unsigned cvtpk_bf16(float lo, float hi) { f32x2_ v = {lo, hi}; bf16x2_ b = __builtin_convertvector(v, bf16x2_); return __builtin_bit_cast(unsigned, b); }
__device__ __forceinline__ bf16 f2bf(float f) { return (bf16)(cvtpk_bf16(f, f) & 0xffffu); }

constexpr int D = 1024, NB = 4, SEQ = 4096, CTXL = 256;
constexpr int NX = NB * SEQ;
constexpr int NC = NB * CTXL;
constexpr int MT = NX + NC;
constexpr int NIN = 3536, NINV = 3568, LDP = 3584;
constexpr int RW_OFF = 0, RET_OFF = 960, GDN_OFF = 1984, LRU_OFF = 3024, VRES_OFF = 3536;
constexpr int NE = 64, TOPK = 8, EFF = 256;
constexpr int NSTEP = CTXL + SEQ;

constexpr size_t MiB = 1u << 20;
constexpr size_t WS_MOD = 1 * MiB;
constexpr size_t WS_XN = 2 * MiB;
constexpr size_t WS_XR = 36 * MiB;
constexpr size_t WS_VF = 104 * MiB;
constexpr size_t WS_LIST = 121 * MiB;
constexpr size_t WS_SLOTG = 126 * MiB;
constexpr size_t WS_RTW = 127 * MiB;
constexpr size_t WS_RWT = 128 * MiB;
constexpr size_t WS_SLOT = 130 * MiB;
constexpr size_t WS_WIN = 131 * MiB;
constexpr size_t WS_WOUT = 145 * MiB;
constexpr size_t WS_SI = 149 * MiB;
constexpr size_t WS_LLA = 253 * MiB;
constexpr size_t WS_LB = 270 * MiB;
constexpr size_t WS_LSUM = 287 * MiB;
constexpr size_t WS_LCIN = 289 * MiB;
constexpr size_t WS_BSC = 290 * MiB;
constexpr size_t WS_YS2B = 291 * MiB;
constexpr size_t WS_P = 319 * MiB;
constexpr size_t WS_BON = 438 * MiB;
constexpr size_t WS_G = 455 * MiB;
constexpr size_t WS_YS = 472 * MiB;
constexpr size_t WS_SV = 506 * MiB;
constexpr size_t WS_DZ = 523 * MiB;
constexpr size_t WS_WD = 149 * MiB;
constexpr size_t WS_HACT = 182 * MiB;
constexpr size_t WS_Y = 267 * MiB;
constexpr size_t WS_WGU = 267 * MiB;
constexpr size_t WS_END = 540 * MiB;

struct Row { int b, t, L, isx; };
__device__ __forceinline__ Row row_of(int m) { Row r; if (m < NX) { r.b = m >> 12; r.t = m & 4095; r.L = SEQ; r.isx = 1; } else { int q = m - NX; r.b = q >> 8; r.t = q & 255; r.L = CTXL; r.isx = 0; } return r; }
__device__ __forceinline__ float frcp_(float x) { return __builtin_amdgcn_rcpf(x); }
__device__ __forceinline__ float sigmoidf_(float x) { return frcp_(1.f + __expf(-x)); }
__device__ __forceinline__ float softplusf_(float x) { return x > 20.f ? x : __logf(1.f + __expf(x)); }
__device__ __forceinline__ float siluf_(float x) { return x * frcp_(1.f + __expf(-x)); }
__device__ __forceinline__ float tanhf_(float x) { const float xc = fminf(fmaxf(x, -15.f), 15.f); return 1.f - 2.f * frcp_(1.f + __expf(2.f * xc)); }
#define DPPF(v, ctrl) __int_as_float(__builtin_amdgcn_update_dpp(0, __float_as_int(v), (ctrl), 0xf, 0xf, true))
__device__ __forceinline__ float wave_sum(float v) {
    v += DPPF(v, 0xB1); v += DPPF(v, 0x4E); v += DPPF(v, 0x141); v += DPPF(v, 0x140);
    return (__int_as_float(__builtin_amdgcn_readlane(__float_as_int(v), 0)) + __int_as_float(__builtin_amdgcn_readlane(__float_as_int(v), 16))) +
           (__int_as_float(__builtin_amdgcn_readlane(__float_as_int(v), 32)) + __int_as_float(__builtin_amdgcn_readlane(__float_as_int(v), 48)));
}


__device__ __forceinline__ float* si_ptr(float* SI, int d, int m, int h, int vec) { return SI + ((((size_t)d * MT + m) * 4 + h) * 5 + vec) * 64; }

struct RwP { const float *mu, *w0, *w2, *a0, *a2, *g2, *kk, *ka, *rk, *v0, *v2; };

__device__ __forceinline__ int step_row(int b, int d, int s) { if (s < CTXL) { const int tc = d ? CTXL - 1 - s : s; return NX + b * CTXL + tc; } const int tx = d ? SEQ - 1 - (s - CTXL) : (s - CTXL); return b * SEQ + tx; }
struct LruP { const float *cw, *cb, *wa, *ba, *wx, *bx, *lam; };


enum { I_X = 0, I_C, I_CTX, I_CCTX, I_ADAW, I_ADAB, I_NMIX, I_NFFN, I_NFIN, I_WIN, I_WVRES, I_WOUT, I_RWMU, I_RWW0, I_RWW2, I_RWA0, I_RWA2, I_RWG2, I_RWKK, I_RWKA, I_RWRK, I_RWLNW, I_RWLNB, I_RWV0, I_RWV2,
       I_RETL, I_GCW, I_GALOG, I_GDT, I_GNW, I_LCW, I_LCB, I_LWA, I_LBA, I_LWX, I_LBX, I_LLAM, I_RTW, I_RTB, I_EWG, I_EWU, I_EWD, I_SWG, I_SWU, I_SWD, I_N };
#define GAS __attribute__((address_space(1)))
#define LAS __attribute__((address_space(3)))
typedef unsigned v4u __attribute__((ext_vector_type(4)));
typedef float f32x4 __attribute__((ext_vector_type(4)));
typedef short bf16x8 __attribute__((ext_vector_type(8)));
typedef GAS unsigned gu32;
#define RLX_AGENT __ATOMIC_RELAXED, __HIP_MEMORY_SCOPE_AGENT
#define LDS_WAIT() asm volatile("s_waitcnt lgkmcnt(0)" ::: "memory")
#define VM_WAIT() asm volatile("s_waitcnt vmcnt(0)" ::: "memory")
#define LDS_BARRIER() do { asm volatile("s_waitcnt lgkmcnt(0)" ::: "memory"); __builtin_amdgcn_s_barrier(); asm volatile("" ::: "memory"); } while (0)
__device__ __forceinline__ unsigned pk2(float lo, float hi) { return cvtpk_bf16(lo, hi); }
__device__ __forceinline__ unsigned long long pack4(f32x4 v) { return (unsigned long long)pk2(v.x, v.y) | ((unsigned long long)pk2(v.z, v.w) << 32); }

namespace pg8 {
#define PG8_LAS __attribute__((address_space(3)))
typedef unsigned short bf16_t;
typedef unsigned u32x4 __attribute__((ext_vector_type(4)));
constexpr int BM = 256, BK = 64, HALF = 128, HTB = HALF * BK * 2, STAGE_BYTES = 8 * HTB, NXCD = 8, WGM = 8;
__host__ __device__ __forceinline__ int lds_byte(int r, int c) { const int st = (r >> 4) * 2 + (c >> 5), rr = r & 15, cc = c & 31, ob = rr * 64 + cc * 2; return st * 1024 + (ob ^ (((ob >> 9) & 1) << 5)); }
__host__ __device__ __forceinline__ void stage_rc(int b, int& R, int& C) { const int st = b / 1024, sb = b % 1024, swz = sb ^ (((sb >> 9) & 1) << 5); R = (st >> 1) * 16 + swz / 64; C = (st & 1) * 32 + (swz % 64) / 2; }
__host__ __device__ __forceinline__ int perm32(int rho) { const int n = rho >> 4, i = rho & 15; return 8 * (i >> 2) + 4 * n + (i & 3); }
__device__ __forceinline__ unsigned cvt_pk_bf16(float lo, float hi) { unsigned r; asm volatile("v_cvt_pk_bf16_f32 %0, %1, %2" : "=v"(r) : "v"(lo), "v"(hi)); return r; }

struct Unit { const char* A; const char* B; int pm, pn, e, nrows, rb; };

struct DenseOrder {
    static constexpr bool GATHER = false;
    const bf16_t* A; const bf16_t* Bt; int K, nM, nN, nwg, G, c;
    __device__ void init(const bf16_t* A_, const bf16_t* Bt_, int M, int N, int K_, int G_, int c_) { A = A_; Bt = Bt_; K = K_; nM = M / BM; nN = N / BM; nwg = nM * nN; G = G_; c = c_; }
    __device__ bool next(int i, Unit& u) const {
        const long L = (long)i * G + c; if (L >= nwg) return false;
        int wgid = (int)L; { const int q = nwg / NXCD, r = nwg % NXCD, xcd = wgid % NXCD, off = wgid / NXCD; wgid = (xcd < r ? xcd * (q + 1) : r * (q + 1) + (xcd - r) * q) + off; }
        const int nig = WGM * nN, gid = wgid / nig, fm = gid * WGM, gsz = (nM - fm) < WGM ? (nM - fm) : WGM;
        u.pm = fm + ((wgid % nig) % gsz); u.pn = (wgid % nig) / gsz; u.e = 0; u.nrows = BM; u.rb = 0;
        u.A = (const char*)A + (size_t)u.pm * BM * K * 2; u.B = (const char*)Bt + (size_t)u.pn * BM * K * 2; return true;
    }
    __device__ __forceinline__ unsigned a_off(const Unit&, int h, int R, int C) const { return (unsigned)((h * HALF + R) * K + C) * 2u; }
};

template <class Epi, class Sched, bool ALIGN_EPI = false>
__device__ __forceinline__ void gemm_phase(PG8_LAS unsigned char* lds, const int K, const Sched& S, const Epi& E) {
    int tid = threadIdx.x; asm volatile("" : "+v"(tid));
    const int wid = __builtin_amdgcn_readfirstlane(tid >> 6), lane = tid & 63, wr = wid >> 2, wc = wid & 3, fr = lane & 15, fq = lane >> 4;
    const int nt = K / BK;
    unsigned voffB[2];
#pragma unroll
    for (int i = 0; i < 2; ++i) { int R, C; stage_rc(tid * 16 + i * 8192, R, C); const int Rb = Epi::PERM ? ((R & ~31) + perm32(R & 31)) : R; voffB[i] = (unsigned)(Rb * K + C) * 2u; }
    const size_t kstep = (size_t)(BK * 2);
    const size_t hstep = (size_t)HALF * K * 2;
    const unsigned ldsw = (unsigned)wid * 1024u;
    const int aoff = lds_byte(wr * 64 + fr, fq * 8), boff = lds_byte(wc * 32 + fr, fq * 8);
#define PG8_SA(b, h) (((b) * 2 + (h)) * HTB)
#define PG8_SB(b, h) ((4 + (b) * 2 + (h)) * HTB)
#define PG8_STAGE(bufoff, gbase, voff) do { _Pragma("unroll") for (int _i = 0; _i < 2; ++_i) \
        __builtin_amdgcn_global_load_lds((const unsigned*)((const char*)(gbase) + (voff)[_i]), (PG8_LAS unsigned*)(lds + (bufoff) + ldsw + _i * 8192), 16, 0, 0); } while (0)
#define PG8_LDA(dst, b, h) do { _Pragma("unroll") for (int m = 0; m < 4; ++m) _Pragma("unroll") for (int k = 0; k < 2; ++k) dst[m][k] = *(const PG8_LAS bf16x8*)(lds + PG8_SA(b, h) + aoff + m * 2048 + k * 1024); } while (0)
#define PG8_LDB(dst, b, h) do { _Pragma("unroll") for (int n = 0; n < 2; ++n) _Pragma("unroll") for (int k = 0; k < 2; ++k) dst[n][k] = *(const PG8_LAS bf16x8*)(lds + PG8_SB(b, h) + boff + n * 2048 + k * 1024); } while (0)
#define PG8_MMA(ai, bj, At, Bt) do { __builtin_amdgcn_s_setprio(1); _Pragma("unroll") for (int m = 0; m < 4; ++m) _Pragma("unroll") for (int n = 0; n < 2; ++n) _Pragma("unroll") for (int k = 0; k < 2; ++k) \
        acc[ai][bj][m][n] = __builtin_amdgcn_mfma_f32_16x16x32_bf16(Bt[n][k], At[m][k], acc[ai][bj][m][n], 0, 0, 0); __builtin_amdgcn_s_setprio(0); } while (0)
#define PG8_WAIT_V(n) asm volatile("s_waitcnt vmcnt(" #n ")" ::: "memory")
#define PG8_WAIT_L(n) asm volatile("s_waitcnt lgkmcnt(" #n ")" ::: "memory")
#define PG8_BAR __builtin_amdgcn_s_barrier()
#define PG8_SCHED __builtin_amdgcn_sched_barrier(0)
    Unit cur, nxt; int ui = 0;
    if (!S.next(0, cur)) return;
    f32x4 acc[2][2][4][2];
#pragma unroll
    for (int a = 0; a < 2; ++a)
#pragma unroll
        for (int b = 0; b < 2; ++b)
#pragma unroll
            for (int m = 0; m < 4; ++m)
#pragma unroll
                for (int n = 0; n < 2; ++n) acc[a][b][m][n] = (f32x4){0.f, 0.f, 0.f, 0.f};
    bf16x8 At[4][2], B0[2][2], B1[2][2];
    unsigned cv0[2], cv1[2], nv0[2], nv1[2];
#pragma unroll
    for (int i = 0; i < 2; ++i) { int R, C; stage_rc(tid * 16 + i * 8192, R, C); cv0[i] = S.a_off(cur, 0, R, C); cv1[i] = S.a_off(cur, 1, R, C); nv0[i] = cv0[i]; nv1[i] = cv1[i]; }
    const char* cA = cur.A; const char* cB = cur.B;
    PG8_STAGE(PG8_SB(0, 0), cB, voffB); PG8_STAGE(PG8_SB(0, 1), cB + hstep, voffB); PG8_STAGE(PG8_SA(0, 0), cA, cv0); PG8_STAGE(PG8_SA(0, 1), cA, cv1);
    if (wr == 1) PG8_BAR;
    PG8_WAIT_V(2); PG8_BAR;
    PG8_STAGE(PG8_SB(1, 0), cB + kstep, voffB); PG8_STAGE(PG8_SA(1, 0), cA + kstep, cv0); PG8_STAGE(PG8_SB(1, 1), cB + hstep + kstep, voffB);
    PG8_WAIT_V(6); PG8_BAR;
    for (;;) {
        const bool has_next = S.next(ui + 1, nxt);
        const char* nA = has_next ? nxt.A : cA; const char* nB = has_next ? nxt.B : cB;
        if constexpr (Sched::GATHER) {
        if (has_next) {
#pragma unroll
            for (int i = 0; i < 2; ++i) { int tt = threadIdx.x; asm volatile("" : "+v"(tt)); int R, C; stage_rc(tt * 16 + i * 8192, R, C); nv0[i] = S.a_off(nxt, 0, R, C); nv1[i] = S.a_off(nxt, 1, R, C); } }
        else {
#pragma unroll
            for (int i = 0; i < 2; ++i) { nv0[i] = cv0[i]; nv1[i] = cv1[i]; } } }
        for (int t = 0; t < nt; t += 2) {
            const bool last = (t == nt - 2);
            const char* a1 = cA + (size_t)(t + 1) * kstep;
            const char* a2 = last ? nA : cA + (size_t)(t + 2) * kstep; const char* b2 = last ? nB : cB + (size_t)(t + 2) * kstep;
            const char* a3 = a2 + kstep; const char* b3 = b2 + kstep;
            unsigned x0[2], x1[2];
#pragma unroll
            for (int i = 0; i < 2; ++i) { if constexpr (Sched::GATHER) { x0[i] = last ? nv0[i] : cv0[i]; x1[i] = last ? nv1[i] : cv1[i]; } else { x0[i] = cv0[i]; x1[i] = cv1[i]; } }
            PG8_LDB(B0, 0, 0); PG8_LDB(B1, 0, 1); PG8_SCHED; PG8_LDA(At, 0, 0); PG8_STAGE(PG8_SA(1, 1), a1, cv1);
            PG8_WAIT_V(8); PG8_WAIT_L(0); PG8_BAR; PG8_MMA(0, 0, At, B0); PG8_MMA(0, 1, At, B1); PG8_BAR; PG8_SCHED;
            PG8_LDA(At, 0, 1); PG8_STAGE(PG8_SB(0, 0), b2, voffB); PG8_STAGE(PG8_SB(0, 1), b2 + hstep, voffB); PG8_STAGE(PG8_SA(0, 0), a2, x0);
            PG8_WAIT_V(8); PG8_WAIT_L(0); PG8_BAR; PG8_MMA(1, 0, At, B0); PG8_MMA(1, 1, At, B1); PG8_BAR; PG8_SCHED;
            PG8_LDB(B0, 1, 0); PG8_LDB(B1, 1, 1); PG8_SCHED; PG8_LDA(At, 1, 0); PG8_STAGE(PG8_SA(0, 1), a2, x1);
            PG8_WAIT_V(8); PG8_WAIT_L(0); PG8_BAR; PG8_MMA(0, 0, At, B0); PG8_MMA(0, 1, At, B1); PG8_BAR; PG8_SCHED;
            PG8_LDA(At, 1, 1); PG8_STAGE(PG8_SB(1, 0), b3, voffB); PG8_STAGE(PG8_SB(1, 1), b3 + hstep, voffB); PG8_STAGE(PG8_SA(1, 0), a3, x0);
            PG8_WAIT_V(8); PG8_WAIT_L(0); PG8_BAR; PG8_MMA(1, 0, At, B0); PG8_MMA(1, 1, At, B1); PG8_BAR; PG8_SCHED;
        }
        if constexpr (ALIGN_EPI) { if (wr == 0) PG8_BAR; }
        E(acc, cur, wr, wc, fr, fq);
        if (!has_next) break;
#pragma unroll
        for (int a = 0; a < 2; ++a)
#pragma unroll
            for (int b = 0; b < 2; ++b)
#pragma unroll
                for (int m = 0; m < 4; ++m)
#pragma unroll
                    for (int n = 0; n < 2; ++n) acc[a][b][m][n] = (f32x4){0.f, 0.f, 0.f, 0.f};
        cur = nxt; cA = nA; cB = nB; ++ui;
        if constexpr (Sched::GATHER) {
#pragma unroll
            for (int i = 0; i < 2; ++i) { cv0[i] = nv0[i]; cv1[i] = nv1[i]; } }
        if constexpr (ALIGN_EPI) { if (wr == 1) PG8_BAR; }
    }
    PG8_WAIT_V(0);
    if constexpr (!ALIGN_EPI) { if (wr == 0) PG8_BAR; }
    PG8_BAR;
#undef PG8_SA
#undef PG8_SB
#undef PG8_STAGE
#undef PG8_LDA
#undef PG8_LDB
#undef PG8_MMA
#undef PG8_WAIT_V
#undef PG8_WAIT_L
#undef PG8_BAR
#undef PG8_SCHED
}

struct EpiStoreBf16 {
    static constexpr bool PERM = true;
    bf16_t* O; int ldc;
    __device__ __forceinline__ void operator()(const f32x4 (&acc)[2][2][4][2], const Unit& u, int wr, int wc, int fr, int fq) const {
        asm volatile("" : "+v"(fr), "+v"(fq));
        const int row0 = u.pm * BM + wr * 64 + fr, col0 = u.pn * BM + wc * 32 + 8 * fq;
#pragma unroll
        for (int ai = 0; ai < 2; ++ai)
#pragma unroll
            for (int m = 0; m < 4; ++m) { bf16_t* rowp = O + (size_t)(row0 + ai * HALF + m * 16) * ldc + col0;
#pragma unroll
                for (int bj = 0; bj < 2; ++bj) { const f32x4 v0 = acc[ai][bj][m][0], v1 = acc[ai][bj][m][1];
                    u32x4 w; w.x = cvt_pk_bf16(v0[0], v0[1]); w.y = cvt_pk_bf16(v0[2], v0[3]); w.z = cvt_pk_bf16(v1[0], v1[1]); w.w = cvt_pk_bf16(v1[2], v1[3]);
                    *(u32x4*)(rowp + bj * HALF) = w; } }
    }
};
struct EpiResidual {
    static constexpr bool PERM = false;
    const float* xs; const float* cs; const float* MODl; float* XR;
    __device__ __forceinline__ void operator()(const f32x4 (&acc)[2][2][4][2], const Unit& u, int wr, int wc, int fr, int fq) const {
        asm volatile("" : "+v"(fr), "+v"(fq));
        const int row0 = u.pm * BM + wr * 64 + fr, col0 = u.pn * BM + wc * 32 + 4 * fq;
#pragma unroll
        for (int ai = 0; ai < 2; ++ai)
#pragma unroll
            for (int m = 0; m < 4; ++m) { const int row = row0 + ai * HALF + m * 16;
                const float* xin = row < NX ? xs + (size_t)row * D : cs + (size_t)(row - NX) * D; const int rb = row < NX ? (row >> 12) : 4;
                const float* md = MODl + (size_t)rb * 6144 + 2 * 1024; float* o = XR + (size_t)row * D;
#pragma unroll
                for (int bj = 0; bj < 2; ++bj)
#pragma unroll
                    for (int n = 0; n < 2; ++n) { const int c = col0 + bj * HALF + n * 16; const f32x4 xi = *(const f32x4*)(xin + c), mm = *(const f32x4*)(md + c); *(f32x4*)(o + c) = xi + mm * acc[ai][bj][m][n]; } }
    }
};
}

#define XB_TMO      128
#define XB_XCNT(j)  (256  + 64 * (j))
#define XB_XSUB(j)  (1280 + 64 * (j))
#define XB_XGEN(j)  (2304 + 64 * (j))
#define XB_TOP      3328
#define XB_TOPGEN   3392
#define XCD_BAR_WORDS 3456
#define XB_SPIN_CAP (1u << 22)
__device__ __forceinline__ unsigned xb_ld(unsigned* p)              { return __hip_atomic_load(p, __ATOMIC_RELAXED, __HIP_MEMORY_SCOPE_AGENT); }
__device__ __forceinline__ unsigned xb_add(unsigned* p, unsigned v) { return __hip_atomic_fetch_add(p, v, __ATOMIC_RELAXED, __HIP_MEMORY_SCOPE_AGENT); }
__device__ __forceinline__ unsigned xb_xcc_id() { return (unsigned)__builtin_amdgcn_s_getreg((3 << 11) | 20) & 0xFu; }
#define XB_SPIN(cond, bar) do { unsigned _sp = 0; while (cond) { __builtin_amdgcn_s_sleep(1); \
    if ((++_sp & 255u) == 0u) { if (xb_ld(&(bar)[XB_TMO])) break; if (_sp > XB_SPIN_CAP) { atomicAdd(&(bar)[XB_TMO], 1u); break; } } } } while (0)
struct XcdBarrier { unsigned* bar; unsigned x; volatile LAS unsigned* st; };
__device__ __forceinline__ XcdBarrier xcd_barrier_post(unsigned* bar, volatile LAS unsigned* st) {
    XcdBarrier b; b.bar = bar; b.x = (unsigned)__builtin_amdgcn_readfirstlane((int)xb_xcc_id()); b.st = st;
    if (threadIdx.x == 0) (void)xb_add(&bar[XB_XCNT(b.x)], 1u);
    return b;
}
__device__ __forceinline__ void xcd_barrier_complete(unsigned* bar, unsigned x, unsigned& nloc, unsigned& nx) {
    const unsigned G = gridDim.x * gridDim.y * gridDim.z;
    unsigned sum, cnt, mine, sp = 0u;
    for (;;) {
        sum = 0u; cnt = 0u; mine = 0u;
#pragma unroll
        for (unsigned j = 0; j < 16; ++j) { const unsigned c = xb_ld(&bar[XB_XCNT(j)]); sum += c; cnt += (c > 0u) ? 1u : 0u; mine = (j == x) ? c : mine; }
        if (sum == G) break;
        __builtin_amdgcn_s_sleep(1);
        if ((++sp & 255u) == 0u) { if (xb_ld(&bar[XB_TMO])) break; if (sp > XB_SPIN_CAP) { atomicAdd(&bar[XB_TMO], 1u); break; } }
    }
    nloc = mine > 0u ? mine : 1u; nx = cnt > 0u ? cnt : 1u;
}
__device__ __forceinline__ void xcd_barrier(const XcdBarrier& b) {
    asm volatile("s_waitcnt vmcnt(0)" ::: "memory");
    __syncthreads();
    if (threadIdx.x == 0) {
        unsigned* bar = b.bar; const unsigned bx = (unsigned)__builtin_amdgcn_readfirstlane((int)xb_xcc_id());
        __builtin_amdgcn_s_waitcnt(0);
        unsigned nloc = b.st[0], nx = b.st[1];
        if (nloc == 0u) { xcd_barrier_complete(bar, bx, nloc, nx); b.st[0] = nloc; b.st[1] = nx; }
        const unsigned old = xb_add(&bar[XB_XSUB(bx)], 1u);
        const unsigned gen = old / nloc;
        if (old + 1u == (gen + 1u) * nloc) {
            __builtin_amdgcn_fence(__ATOMIC_RELEASE, "agent");
            asm volatile("s_waitcnt vmcnt(0)" ::: "memory");
            const unsigned og = xb_add(&bar[XB_TOP], 1u);
            const unsigned tg = og / nx;
            if (og + 1u == (tg + 1u) * nx) xb_add(&bar[XB_TOPGEN], 1u);
            else XB_SPIN(xb_ld(&bar[XB_TOPGEN]) == tg, bar);
            __builtin_amdgcn_fence(__ATOMIC_ACQUIRE, "agent");
            xb_add(&bar[XB_XGEN(bx)], 1u);
            asm volatile("s_waitcnt vmcnt(0)" ::: "memory");
        } else {
            XB_SPIN(xb_ld(&bar[XB_XGEN(bx)]) == gen, bar);
            __builtin_amdgcn_fence(__ATOMIC_ACQUIRE, "agent");
            asm volatile("s_waitcnt vmcnt(0)" ::: "memory");
        }
    }
    __syncthreads();
}

constexpr int NWAVES = 8, NTHR = 512;
constexpr int RING_OFF = 0, RING_BYTES = 131072;
constexpr int LDSCTL_OFF = RING_BYTES, MISC_OFF = LDSCTL_OFF + 320;
constexpr int LDS_BYTES = 147456;
constexpr int CW_BAR = 4096;
constexpr size_t CTL_ZERO_BYTES = 1 * MiB;

struct MArgs {
    const float* in[45]; float* out; unsigned char* ws; int ph_lo, ph_hi, l_lo, l_hi, bar_region, pad;
};
struct Frame { LAS unsigned char* lds; volatile LAS unsigned* MISC; gu32* ctl; int tid, lane, wave, vcu, G; unsigned long long tacc, tph0; int curk; };

__device__ __forceinline__ void transpose_item(const float* W, int ldw, int N, int k0, int n0, bf16* WT, int ldt, int drow0, LAS float* scr, int lane) {
    const int nn = n0 + (lane & 31); const bool okn = nn < N;
#pragma unroll 8
    for (int i = 0; i < 32; ++i) { const int kk = 2 * i + (lane >> 5); scr[kk * 33 + (lane & 31)] = okn ? W[(size_t)(k0 + kk) * ldw + nn] : 0.f; }
    LDS_WAIT(); asm volatile("" ::: "memory");
    const int c = lane & 7;
#pragma unroll
    for (int j = 0; j < 4; ++j) { const int n = (lane >> 3) + 8 * j; const LAS float* s = scr + (8 * c) * 33 + n;
        v4u o; o.x = pk2(s[0 * 33], s[1 * 33]); o.y = pk2(s[2 * 33], s[3 * 33]); o.z = pk2(s[4 * 33], s[5 * 33]); o.w = pk2(s[6 * 33], s[7 * 33]);
        if (n0 + n < N) *(GAS v4u*)(WT + (size_t)(drow0 + n) * ldt + k0 + 8 * c) = o; }
    LDS_WAIT(); asm volatile("" ::: "memory");
}

__device__ __forceinline__ void ph_mod(Frame& F, const float* c, const float* cctx, const float* ada_w, const float* ada_b, float* MOD) {
    LAS float* s = (LAS float*)(F.lds + RING_OFF);
    LAS float* red = s + 5 * 1024;
    for (int i = F.tid; i < 5 * 1024; i += NTHR) { const int r = i >> 10, k = i & 1023; const float v = r < 4 ? c[r * 1024 + k] : cctx[k]; s[i] = siluf_(v); }
    __syncthreads();
    for (int u = F.vcu; u < 192; u += F.G) {
        const int l = u / 96, j0 = (u % 96) * 64, cl = F.tid & 63, kp = F.tid >> 6;
        const float* W = ada_w + (size_t)l * 1024 * 6144 + j0 + cl;
        float acc[5] = {0.f, 0.f, 0.f, 0.f, 0.f};
        for (int k = kp * 128; k < kp * 128 + 128; ++k) { const float w = W[(size_t)k * 6144];
#pragma unroll
            for (int r = 0; r < 5; ++r) acc[r] += s[r * 1024 + k] * w; }
#pragma unroll
        for (int r = 0; r < 5; ++r) red[(kp * 5 + r) * 64 + cl] = acc[r];
        __syncthreads();
        if (F.tid < 320) { const int r = F.tid >> 6; float a = ada_b[l * 6144 + j0 + cl];
#pragma unroll
            for (int q = 0; q < 8; ++q) a += red[(q * 5 + r) * 64 + cl];
            MOD[((size_t)l * 5 + r) * 6144 + j0 + cl] = a; }
        __syncthreads();
    }
}
__device__ __forceinline__ void ph_convert_small(Frame& F, const float* w_in, const float* w_vres, const float* w_out, bf16* WIN_T  , bf16* WOUT_T  , int l_lo, int l_hi) {
    LAS float* scr = (LAS float*)(F.lds + RING_OFF + 32768 + F.wave * 16384 / 2);
    scr = (LAS float*)(F.lds + RING_OFF + 32768 + F.wave * 9216);
    const int gw = F.vcu * NWAVES + F.wave, NGW = F.G * NWAVES;
    constexpr int NB_IN = (NIN + 31) / 32;
    constexpr int I_IN = 16 * NB_IN, I_VR = 16 * 1, I_OUT = 16 * 32;
    constexpr int PER_L = I_IN + I_VR + I_OUT;
    for (int it = gw + l_lo * PER_L; it < l_hi * PER_L; it += NGW) {
        const int l = it / PER_L; int r = it % PER_L;
        if (r < I_IN) { const int kb = r / NB_IN, nb = r % NB_IN; transpose_item(w_in + (size_t)l * D * NIN, NIN, NIN, kb * 64, nb * 32, WIN_T + (size_t)l * LDP * D, D, nb * 32, scr, F.lane); continue; } r -= I_IN;
        if (r < I_VR) { if (l == 1) transpose_item(w_vres, 32, 32, r * 64, 0, WIN_T + (size_t)LDP * D, D, NIN, scr, F.lane); continue; } r -= I_VR;
        { const int kb = r / 32, nb = r % 32; transpose_item(w_out + (size_t)l * D * D, D, D, kb * 64, nb * 32, WOUT_T + (size_t)l * D * D, D, nb * 32, scr, F.lane); }
    }
}
__device__ __forceinline__ void ph_norm_mod(Frame& F, const float* xs, const float* cs, const float* gain, const float* MODl, int si, bf16* XN, int nrows) {
    const int gw = F.vcu * NWAVES + F.wave, NGW = F.G * NWAVES, lane = F.lane;
    for (int m0 = gw; m0 < nrows; m0 += 2 * NGW) {
        const int m1 = m0 + NGW < nrows ? m0 + NGW : m0;
        const float* s0 = m0 < NX ? xs + (size_t)m0 * D : cs + (size_t)(m0 - NX) * D; const float* s1 = m1 < NX ? xs + (size_t)m1 * D : cs + (size_t)(m1 - NX) * D;
        f32x4 v0[4], v1[4]; float q0 = 0.f, q1 = 0.f;
#pragma unroll
        for (int j = 0; j < 4; ++j) { v0[j] = *(const f32x4*)(s0 + 4 * lane + 256 * j); v1[j] = *(const f32x4*)(s1 + 4 * lane + 256 * j); }
#pragma unroll
        for (int j = 0; j < 4; ++j) { q0 += (v0[j].x * v0[j].x + v0[j].y * v0[j].y) + (v0[j].z * v0[j].z + v0[j].w * v0[j].w); q1 += (v1[j].x * v1[j].x + v1[j].y * v1[j].y) + (v1[j].z * v1[j].z + v1[j].w * v1[j].w); }
        q0 = wave_sum(q0); q1 = wave_sum(q1); const float r0 = rsqrtf(q0 * (1.f / D) + 1e-6f), r1 = rsqrtf(q1 * (1.f / D) + 1e-6f);
        const float* md0 = MODl + (size_t)(m0 < NX ? (m0 >> 12) : 4) * 6144; const float* md1 = MODl + (size_t)(m1 < NX ? (m1 >> 12) : 4) * 6144;
#pragma unroll
        for (int j = 0; j < 4; ++j) { const int ci = 4 * lane + 256 * j; const f32x4 g = *(const f32x4*)(gain + ci);
            const f32x4 y0 = v0[j] * r0 * g * (*(const f32x4*)(md0 + (si + 1) * 1024 + ci) + 1.f) + *(const f32x4*)(md0 + si * 1024 + ci);
            const f32x4 y1 = v1[j] * r1 * g * (*(const f32x4*)(md1 + (si + 1) * 1024 + ci) + 1.f) + *(const f32x4*)(md1 + si * 1024 + ci);
            *(unsigned long long*)(XN + (size_t)m0 * D + ci) = pack4(y0); *(unsigned long long*)(XN + (size_t)m1 * D + ci) = pack4(y1); }
    }
}

typedef short bf16x4 __attribute__((ext_vector_type(4)));
constexpr int CW_CNT = 16384;
constexpr int TAB_OFF = LDSCTL_OFF + 1024;
struct MoeTab { LAS int* cnt; LAS int* ups; LAS int* ro; };
__device__ __forceinline__ MoeTab moe_tab(Frame& F) { MoeTab t; t.cnt = (LAS int*)(F.lds + TAB_OFF); t.ups = t.cnt + 80; t.ro = t.ups + 80; return t; }
__device__ __forceinline__ void moe_build_tab(Frame& F, int layer, int ntok) {
    MoeTab T = moe_tab(F);
    if (F.tid < 64) T.cnt[F.tid] = (int)__hip_atomic_load(F.ctl + CW_CNT + (layer * 64 + F.tid) * 64, RLX_AGENT);
    if (F.tid == 64) T.cnt[64] = ntok;
    __syncthreads();
    if (F.tid == 0) { int u = 0, r = 0; for (int e = 0; e < 65; ++e) { T.ups[e] = u; T.ro[e] = r; u += (T.cnt[e] + 255) >> 8; r += T.cnt[e]; } T.ups[65] = u; T.ro[65] = r; }
    __syncthreads();
}
__device__ __forceinline__ int uni(int v) { return __builtin_amdgcn_readfirstlane(v); }
__device__ __forceinline__ const char* uni_ptr(const char* p) { unsigned long long v = (unsigned long long)p; unsigned lo = __builtin_amdgcn_readfirstlane((unsigned)v), hi = __builtin_amdgcn_readfirstlane((unsigned)(v >> 32)); return (const char*)(((unsigned long long)hi << 32) | lo); }

__device__ __forceinline__ void ph_convert_router(Frame& F, const float* rtw, bf16* RT) {
    for (int i = F.vcu * NTHR + F.tid; i < 2 * 64 * 1024; i += F.G * NTHR) { const int l = i >> 16, e = (i >> 10) & 63, k = i & 1023;
        const float x = rtw[((size_t)l * 1024 + k) * 64 + e]; const bf16 hi = f2bf(x); const bf16 lo = f2bf(x - bf2f(hi));
        RT[(((size_t)l * 2 + 0) * 64 + e) * 1024 + k] = hi; RT[(((size_t)l * 2 + 1) * 64 + e) * 1024 + k] = lo; }
}
__device__ __forceinline__ void ph_route(Frame& F, const float* XR, const float* gain, const float* MODl, const bf16* RTl  , const float* rbias, bf16* XN, int layer,
                                         unsigned* LIST, int* SLOTPOS, float* SLOTG, int ntok) {
    constexpr int HSTR = 2064;
    LAS unsigned char* HH = F.lds + RING_OFF;
    LAS unsigned char* HL = F.lds + RING_OFF + 16 * HSTR;
    LAS float* part = (LAS float*)(F.lds + RING_OFF + 32 * HSTR);
    LAS float* sc = (LAS float*)(F.lds + RING_OFF + 32 * HSTR + 32768);
    LAS int* lcnt = (LAS int*)(F.lds + RING_OFF + 32 * HSTR + 32768 + 4096);
    LAS int* lbase = lcnt + 64;
    if (F.tid < 64) lcnt[F.tid] = 0;
    const int lane = F.lane, wv = F.wave, tid = F.tid, r = lane & 15, g = lane >> 4;
    const int ngrp = ntok / 16;
    bf16x4 BH[4][8], BL[4][8];
    { const GAS bf16* R = (const GAS bf16*)RTl;
#pragma unroll
      for (int nt = 0; nt < 4; ++nt)
#pragma unroll
          for (int ks = 0; ks < 8; ++ks) { const size_t o = (size_t)(16 * nt + r) * 1024 + 128 * wv + 16 * ks + 4 * g; BH[nt][ks] = *(const GAS bf16x4*)(R + o); BL[nt][ks] = *(const GAS bf16x4*)(R + 65536 + o); } }
    f32x4 vq[2][4];
    { const int m0 = (F.vcu < ngrp ? F.vcu : 0) * 16 + 2 * wv;
#pragma unroll
      for (int tt = 0; tt < 2; ++tt)
#pragma unroll
          for (int j = 0; j < 4; ++j) vq[tt][j] = *(const GAS f32x4*)((const GAS float*)XR + (size_t)(m0 + tt) * D + 4 * lane + 256 * j); }
    for (int gi = F.vcu; gi < ngrp; gi += F.G) {
        TSEC_BEGIN(20)
#pragma unroll
        for (int tt = 0; tt < 2; ++tt) {
            const int tl = 2 * wv + tt, m = gi * 16 + tl;
            const int rb = m < NX ? (m >> 12) : 4; const float* md = MODl + (size_t)rb * 6144;
            float ss = 0.f;
#pragma unroll
            for (int j = 0; j < 4; ++j) { const f32x4 x = vq[tt][j]; ss += (x.x * x.x + x.y * x.y) + (x.z * x.z + x.w * x.w); }
            ss = wave_sum(ss); const float rs = rsqrtf(ss * (1.f / D) + 1e-6f);
#pragma unroll
            for (int j = 0; j < 4; ++j) { const int ci = 4 * lane + 256 * j; const f32x4 gg = *(const f32x4*)(gain + ci), sh = *(const f32x4*)(md + 3 * 1024 + ci), scl = *(const f32x4*)(md + 4 * 1024 + ci);
                const f32x4 y = vq[tt][j] * rs * gg * (scl + 1.f) + sh;
                const unsigned h0 = pk2(y.x, y.y), h1 = pk2(y.z, y.w);
                const f32x4 yl = (f32x4){y.x - __uint_as_float(h0 << 16), y.y - __uint_as_float(h0 & 0xffff0000u), y.z - __uint_as_float(h1 << 16), y.w - __uint_as_float(h1 & 0xffff0000u)};
                const unsigned long long hw = (unsigned long long)h0 | ((unsigned long long)h1 << 32);
                *(LAS unsigned long long*)(HH + tl * HSTR + ci * 2) = hw; *(LAS unsigned long long*)(HL + tl * HSTR + ci * 2) = pack4(yl);
                *(unsigned long long*)(XN + (size_t)m * D + ci) = hw; }
        }
        { const int gn = gi + F.G < ngrp ? gi + F.G : gi; const int m0 = gn * 16 + 2 * wv;
#pragma unroll
          for (int tt = 0; tt < 2; ++tt)
#pragma unroll
              for (int j = 0; j < 4; ++j) vq[tt][j] = *(const GAS f32x4*)((const GAS float*)XR + (size_t)(m0 + tt) * D + 4 * lane + 256 * j); }
        LDS_BARRIER();
        TSEC_END(20)
        TSEC_BEGIN(21)
        { f32x4 acc[4];
#pragma unroll
          for (int nt = 0; nt < 4; ++nt) acc[nt] = (f32x4){0.f, 0.f, 0.f, 0.f};
#pragma unroll
          for (int ks = 0; ks < 8; ++ks) { const int ko = (128 * wv + 16 * ks + 4 * g) * 2; const bf16x4 ah = *(const LAS bf16x4*)(HH + r * HSTR + ko), al = *(const LAS bf16x4*)(HL + r * HSTR + ko);
#pragma unroll
              for (int nt = 0; nt < 4; ++nt) { acc[nt] = __builtin_amdgcn_mfma_f32_16x16x16bf16_1k(ah, BH[nt][ks], acc[nt], 0, 0, 0); acc[nt] = __builtin_amdgcn_mfma_f32_16x16x16bf16_1k(al, BH[nt][ks], acc[nt], 0, 0, 0);
                  acc[nt] = __builtin_amdgcn_mfma_f32_16x16x16bf16_1k(ah, BL[nt][ks], acc[nt], 0, 0, 0); } }
#pragma unroll
          for (int nt = 0; nt < 4; ++nt)
#pragma unroll
              for (int i = 0; i < 4; ++i) part[(wv * 16 + 4 * g + i) * 64 + 16 * nt + r] = acc[nt][i]; }
        LDS_BARRIER();
#pragma unroll
        for (int q = 0; q < 2; ++q) { const int t = (tid >> 6) + 8 * q, e = tid & 63; float a = 0.f;
#pragma unroll
            for (int kp = 0; kp < 8; ++kp) a += part[(kp * 16 + t) * 64 + e];
            sc[t * 64 + e] = sigmoidf_(a); }
        LDS_BARRIER();
        TSEC_END(21)
        TSEC_BEGIN(22)
#pragma unroll
        for (int tt = 0; tt < 2; ++tt) {
            const int tl = 2 * wv + tt, m = gi * 16 + tl;
            const float s = sc[tl * 64 + lane]; const float sel = s + rbias[lane]; int rank8 = 0;
#pragma unroll 16
            for (int j = 0; j < 64; ++j) { const float oj = __int_as_float(__builtin_amdgcn_readlane(__float_as_int(sel), j)); rank8 += (oj > sel || (oj == sel && j < lane)) ? 1 : 0; }
            const int myk = rank8 < 8 ? rank8 : -1;
            const float ssum = wave_sum(myk >= 0 ? s : 0.f);
            if (myk >= 0) { const int lr = __hip_atomic_fetch_add(lcnt + lane, 1, __ATOMIC_RELAXED, __HIP_MEMORY_SCOPE_WORKGROUP);
                SLOTPOS[(size_t)m * 8 + myk] = (lane << 16) | lr; SLOTG[(size_t)m * 8 + myk] = 2.5f * s * __builtin_amdgcn_rcpf(ssum); }
        }
        LDS_BARRIER();
        TSEC_END(22)
    }
    asm volatile("s_waitcnt vmcnt(0)" ::: "memory"); __syncthreads();
    if (F.tid < 64) { const int n = lcnt[F.tid]; lbase[F.tid] = n > 0 ? (int)__hip_atomic_fetch_add(F.ctl + CW_CNT + (layer * 64 + F.tid) * 64, (unsigned)n, RLX_AGENT) : 0; }
    __syncthreads();
    for (int gi = F.vcu; gi < ngrp; gi += F.G) {
        if (tid < 128) { const int m = gi * 16 + (tid >> 3), k = tid & 7; const int sp = (int)__hip_atomic_load((unsigned*)SLOTPOS + (size_t)m * 8 + k, RLX_AGENT); const int e = sp >> 16, rk = lbase[e] + (sp & 0xffff);
            SLOTPOS[(size_t)m * 8 + k] = (e << 16) | rk; LIST[(size_t)e * MT + rk] = (unsigned)m; } }
}
__device__ __forceinline__ void ph_convert_experts(Frame& F, const float* wg, const float* wu, const float* wd, const float* sg, const float* su, const float* sd, bf16* WGU_T, bf16* WD_T) {
    LAS float* scr = (LAS float*)(F.lds + RING_OFF + F.wave * 9216);
    const int gw = F.vcu * NWAVES + F.wave, NGW = F.G * NWAVES;
    for (int it = gw; it < 65 * 384; it += NGW) {
        const int e = it / 384; int r = it % 384;
        const float* Wg = e < 64 ? wg + (size_t)e * D * EFF : sg; const float* Wu = e < 64 ? wu + (size_t)e * D * EFF : su; const float* Wd = e < 64 ? wd + (size_t)e * EFF * D : sd;
        if (r < 256) { const float* W = r < 128 ? Wg : Wu; const int up = r >= 128; r &= 127; const int kb = r >> 3, nb = r & 7, n0 = nb * 32;
            transpose_item(W, EFF, EFF, kb * 64, n0, WGU_T + (size_t)e * 512 * D, D, (n0 >> 7) * 256 + (n0 & 127) + up * 128, scr, F.lane); }
        else { r -= 256; const int kb = r >> 5, nb = r & 31; transpose_item(Wd, D, D, kb * 64, nb * 32, WD_T + (size_t)e * D * EFF, EFF, nb * 32, scr, F.lane); }
    }
}
namespace pg8 {
struct MoeOrder1 {          static constexpr bool GATHER = true;
    const bf16_t* XN; const bf16_t* WGU; const unsigned* LIST; MoeTab T; int G, c, total;
    __device__ bool next(int i, Unit& u) const {
        const int L = i * G + c; if (L >= total) return false;
        const int pn = L & 1, ru = L >> 1; int lo = 0, hi = 64;
        while (lo < hi) { const int mid = (lo + hi + 1) >> 1; if (T.ups[mid] <= ru) lo = mid; else hi = mid - 1; }
        const int e = uni(lo), j = uni(ru - T.ups[lo]);
        u.e = e; u.pm = j; u.pn = pn; u.nrows = uni(min(256, T.cnt[e] - j * 256)); u.rb = uni(T.ro[e] + j * 256);
        u.A = (const char*)XN; u.B = uni_ptr((const char*)WGU + ((size_t)e * 512 + (size_t)pn * 256) * D * 2); return true;
    }
    __device__ __forceinline__ unsigned a_off(const Unit& u, int h, int R, int C) const {
        const int idx = h * HALF + R; int tok = 0;
        if (idx < u.nrows) tok = u.e < 64 ? (int)LIST[(size_t)u.e * MT + u.pm * 256 + idx] : u.pm * 256 + idx;
        return (unsigned)(tok * D + C) * 2u;
    }
};
struct MoeOrder2 {          static constexpr bool GATHER = false;
    const bf16_t* HACT; const bf16_t* WD; MoeTab T; int G, c, total;
    __device__ bool next(int i, Unit& u) const {
        const int L = i * G + c; if (L >= total) return false;
        const int pn = L & 3, ru = L >> 2; int lo = 0, hi = 64;
        while (lo < hi) { const int mid = (lo + hi + 1) >> 1; if (T.ups[mid] <= ru) lo = mid; else hi = mid - 1; }
        const int e = uni(lo), j = uni(ru - T.ups[lo]);
        u.e = e; u.pm = j; u.pn = pn; u.nrows = uni(min(256, T.cnt[e] - j * 256)); u.rb = uni(T.ro[e] + j * 256);
        u.A = uni_ptr((const char*)HACT + (size_t)u.rb * EFF * 2); u.B = uni_ptr((const char*)WD + ((size_t)e * D + (size_t)pn * 256) * EFF * 2); return true;
    }
    __device__ __forceinline__ unsigned a_off(const Unit&, int h, int R, int C) const { return (unsigned)((h * HALF + R) * EFF + C) * 2u; }
};
struct EpiSwiglu {
    static constexpr bool PERM = true;
    bf16_t* HACT;
    __device__ __forceinline__ void operator()(const f32x4 (&acc)[2][2][4][2], const Unit& u, int wr, int wc, int fr, int fq) const {
        asm volatile("" : "+v"(fr), "+v"(fq));
#pragma unroll
        for (int ai = 0; ai < 2; ++ai)
#pragma unroll
            for (int m = 0; m < 4; ++m) { const int r = ai * HALF + wr * 64 + m * 16 + fr;
                if (r < u.nrows) { const f32x4 g0 = acc[ai][0][m][0], g1 = acc[ai][0][m][1], u0 = acc[ai][1][m][0], u1 = acc[ai][1][m][1];
                    float o[8];
#pragma unroll
                    for (int q = 0; q < 4; ++q) { o[q] = g0[q] * __builtin_amdgcn_rcpf(1.f + __expf(-g0[q])) * u0[q]; o[4 + q] = g1[q] * __builtin_amdgcn_rcpf(1.f + __expf(-g1[q])) * u1[q]; }
                    u32x4 w; w.x = cvt_pk_bf16(o[0], o[1]); w.y = cvt_pk_bf16(o[2], o[3]); w.z = cvt_pk_bf16(o[4], o[5]); w.w = cvt_pk_bf16(o[6], o[7]);
                    *(u32x4*)(HACT + (size_t)(u.rb + r) * EFF + u.pn * 128 + wc * 32 + 8 * fq) = w; } }
    }
};
struct EpiDown {
    static constexpr bool PERM = true;
    bf16_t* Y; float* XR; const float* MODl;
    __device__ __forceinline__ void operator()(const f32x4 (&acc)[2][2][4][2], const Unit& u, int wr, int wc, int fr, int fq) const {
        asm volatile("" : "+v"(fr), "+v"(fq));
        const unsigned lcol = (unsigned)(wc * 32 + 8 * fq);
        if (u.e < 64) {
            GAS char* ybase = (GAS char*)uni_ptr((const char*)(Y + (size_t)u.rb * D + u.pn * BM));
#pragma unroll
            for (int ai = 0; ai < 2; ++ai)
#pragma unroll
                for (int m = 0; m < 4; ++m) { const int r = ai * HALF + wr * 64 + m * 16 + fr;
                    if (r < u.nrows) { const unsigned off = ((unsigned)r * D + lcol) * 2u;
#pragma unroll
                        for (int bj = 0; bj < 2; ++bj) { const f32x4 v0 = acc[ai][bj][m][0], v1 = acc[ai][bj][m][1];
                            u32x4 w; w.x = cvt_pk_bf16(v0[0], v0[1]); w.y = cvt_pk_bf16(v0[2], v0[3]); w.z = cvt_pk_bf16(v1[0], v1[1]); w.w = cvt_pk_bf16(v1[2], v1[3]);
                            *(GAS u32x4*)(ybase + off + bj * HALF * 2) = w; } } }
        } else {
            const int m0 = u.pm * 256; const int rb = m0 < NX ? (m0 >> 12) : 4;
            const GAS char* mdb = (const GAS char*)uni_ptr((const char*)(MODl + (size_t)rb * 6144 + 5 * 1024 + u.pn * BM)); GAS char* xb = (GAS char*)uni_ptr((const char*)(XR + (size_t)m0 * D + u.pn * BM));
#pragma unroll
            for (int ai = 0; ai < 2; ++ai)
#pragma unroll
                for (int m = 0; m < 4; ++m) { const int r = ai * HALF + wr * 64 + m * 16 + fr;
                    if (r < u.nrows) {
#pragma unroll
                        for (int bj = 0; bj < 2; ++bj)
#pragma unroll
                            for (int n = 0; n < 2; ++n) { const unsigned c = (unsigned)(bj * HALF) + lcol + 4u * n; const unsigned off = ((unsigned)r * D + c) * 4u;
                                const f32x4 xi = *(const GAS f32x4*)(xb + off), mm = *(const GAS f32x4*)(mdb + c * 4u); *(GAS f32x4*)(xb + off) = xi + mm * acc[ai][bj][m][n]; } }
                    asm volatile("" ::: "memory"); }
        }
    }
};
}
template <bool FINAL>
__device__ __forceinline__ void ph_combine_norm(Frame& F, const bf16* Y, const int* SLOTPOS, const float* SLOTG, const float* MODl, float* XR, int ntok, const float* gainN, const float* MODn, bf16* XN, float* out) {
    MoeTab T = moe_tab(F);
    const int gw = F.vcu * NWAVES + F.wave, NGW = F.G * NWAVES, lane = F.lane;
    for (int m = gw; m < ntok; m += NGW) {
        const int rb = m < NX ? (m >> 12) : 4; const float* md = MODl + (size_t)rb * 6144 + 5 * 1024;
        float acc[16];
#pragma unroll
        for (int q = 0; q < 16; ++q) acc[q] = 0.f;
#pragma unroll
        for (int s = 0; s < 8; ++s) { const int sp = SLOTPOS[(size_t)m * 8 + s]; const int row = T.ro[sp >> 16] + (sp & 0xffff); const float gs = SLOTG[(size_t)m * 8 + s];
            const bf16* yr = Y + (size_t)row * D;
#pragma unroll
            for (int j = 0; j < 4; ++j) { const unsigned long long w = *(const unsigned long long*)(yr + 4 * lane + 256 * j);
                acc[4 * j + 0] += gs * __uint_as_float((unsigned)(w & 0xffffull) << 16); acc[4 * j + 1] += gs * __uint_as_float((unsigned)((w >> 16) & 0xffffull) << 16);
                acc[4 * j + 2] += gs * __uint_as_float((unsigned)((w >> 32) & 0xffffull) << 16); acc[4 * j + 3] += gs * __uint_as_float((unsigned)((w >> 48) & 0xffffull) << 16); } }
        f32x4 x[4]; float ss = 0.f;
#pragma unroll
        for (int j = 0; j < 4; ++j) { const int ci = 4 * lane + 256 * j; float* o = XR + (size_t)m * D + ci; const f32x4 xi = *(const f32x4*)o, mm = *(const f32x4*)(md + ci);
            x[j] = xi + mm * (f32x4){acc[4 * j], acc[4 * j + 1], acc[4 * j + 2], acc[4 * j + 3]};
            if (!FINAL) *(f32x4*)o = x[j];
            ss += (x[j].x * x[j].x + x[j].y * x[j].y) + (x[j].z * x[j].z + x[j].w * x[j].w); }
        ss = wave_sum(ss); const float rs = rsqrtf(ss * (1.f / D) + 1e-6f);
        const float* mdn = FINAL ? nullptr : MODn + (size_t)rb * 6144;
#pragma unroll
        for (int j = 0; j < 4; ++j) { const int ci = 4 * lane + 256 * j; const f32x4 g = *(const f32x4*)(gainN + ci);
            if (FINAL) *(f32x4*)(out + (size_t)m * D + ci) = x[j] * rs * g;
            else { const f32x4 y = x[j] * rs * g * (*(const f32x4*)(mdn + 1024 + ci) + 1.f) + *(const f32x4*)(mdn + ci); *(unsigned long long*)(XN + (size_t)m * D + ci) = pack4(y); } }
    }
}


#define MFMA16(a, b, c) __builtin_amdgcn_mfma_f32_16x16x16bf16_1k((a), (b), (c), 0, 0, 0)
__device__ __forceinline__ bf16x8 cat8(bf16x4 lo, bf16x4 hi) { return __builtin_shufflevector(lo, hi, 0, 1, 2, 3, 4, 5, 6, 7); }
#define MFMA32P(a0, a1, b0, b1, c) __builtin_amdgcn_mfma_f32_16x16x32_bf16(cat8((a0), (a1)), cat8((b0), (b1)), (c), 0, 0, 0)
constexpr int LSTR = 144;
constexpr int IMG = 64 * LSTR;
constexpr int ROPE_OFF = 120 * 1024;
__device__ __forceinline__ bf16x4 ldsfrag(const LAS unsigned char* img, int row, int k0) { return *(const LAS bf16x4*)(img + row * LSTR + k0 * 2); }
__device__ __forceinline__ f32x4 zero4() { return (f32x4){0.f, 0.f, 0.f, 0.f}; }
__device__ __forceinline__ f32x4 nt_tile64(const LAS unsigned char* A, int m0, const LAS unsigned char* B, int n0, int lane, f32x4 acc) {
    const int r = lane & 15, g = lane >> 4;
#pragma unroll
    for (int s = 0; s < 4; s += 2) acc = MFMA32P(ldsfrag(A, m0 + r, 16 * s + 4 * g), ldsfrag(A, m0 + r, 16 * s + 16 + 4 * g), ldsfrag(B, n0 + r, 16 * s + 4 * g), ldsfrag(B, n0 + r, 16 * s + 16 + 4 * g), acc);
    return acc;
}
__device__ __forceinline__ void unpack8(v4u w, float (&o)[8]) {
    o[0] = __uint_as_float(w.x << 16); o[1] = __uint_as_float(w.x & 0xffff0000u); o[2] = __uint_as_float(w.y << 16); o[3] = __uint_as_float(w.y & 0xffff0000u);
    o[4] = __uint_as_float(w.z << 16); o[5] = __uint_as_float(w.z & 0xffff0000u); o[6] = __uint_as_float(w.w << 16); o[7] = __uint_as_float(w.w & 0xffff0000u); }
struct TB { int m0, b, j, isx, t0; };
__device__ __forceinline__ TB tb_of(int tb) { TB r; if (tb < 256) { r.b = tb >> 6; r.j = tb & 63; r.isx = 1; r.m0 = tb * 64; r.t0 = r.j * 64; } else { const int q = tb - 256; r.b = q >> 2; r.j = q & 3; r.isx = 0; r.m0 = NX + q * 64; r.t0 = r.j * 64; } return r; }
__device__ __forceinline__ int chunk_of(const TB& t, int d) { return t.isx ? 4 + (d ? 63 - t.j : t.j) : (d ? 3 - t.j : t.j); }
__device__ __forceinline__ void build_rope(Frame& F) {
    LAS float* tab = (LAS float*)(F.lds + ROPE_OFF);
    for (int i = F.tid; i < 1024; i += NTHR) { const int pos = i >> 4, jj = i & 15; const float inv = __powf(10000.f, -(float)jj * (1.f / 16.f)); float sn, cs; sincosf((float)pos * inv, &sn, &cs); tab[2 * i] = cs; tab[2 * i + 1] = sn; }
}
__device__ __forceinline__ void load16(const bf16* P, int m, int col0, int dq, float (&lo)[8], float (&hi)[8]) {
    const v4u a = *(const v4u*)(P + (size_t)m * LDP + col0 + 8 * dq), b = *(const v4u*)(P + (size_t)m * LDP + col0 + 32 + 8 * dq); unpack8(a, lo); unpack8(b, hi); }
__device__ __forceinline__ void rope16(Frame& F, int t, int dq, float (&lo)[8], float (&hi)[8]) {
    const LAS float* tab = (const LAS float*)(F.lds + ROPE_OFF); const int pos = dq < 2 ? (t >> 6) : (t & 63); const int j0 = (8 * dq) & 15;
#pragma unroll
    for (int e = 0; e < 8; ++e) { const float cs = tab[2 * (pos * 16 + j0 + e)], sn = tab[2 * (pos * 16 + j0 + e) + 1]; const float a = lo[e], b = hi[e]; lo[e] = a * cs - b * sn; hi[e] = a * sn + b * cs; }
}
__device__ __forceinline__ void st_tok16(LAS unsigned char* img, int s, int dq, const float (&lo)[8], const float (&hi)[8]) {
    v4u a, b; a.x = pk2(lo[0], lo[1]); a.y = pk2(lo[2], lo[3]); a.z = pk2(lo[4], lo[5]); a.w = pk2(lo[6], lo[7]); b.x = pk2(hi[0], hi[1]); b.y = pk2(hi[2], hi[3]); b.z = pk2(hi[4], hi[5]); b.w = pk2(hi[6], hi[7]);
    *(LAS v4u*)(img + s * LSTR + 16 * dq) = a; *(LAS v4u*)(img + s * LSTR + 64 + 16 * dq) = b; }
__device__ __forceinline__ void st_chn16(LAS unsigned char* img, int s, int dq, const float (&lo)[8], const float (&hi)[8], float scale) {
#pragma unroll
    for (int e = 0; e < 8; ++e) { *(LAS bf16*)(img + (8 * dq + e) * LSTR + 2 * s) = f2bf(lo[e] * scale); *(LAS bf16*)(img + (32 + 8 * dq + e) * LSTR + 2 * s) = f2bf(hi[e] * scale); } }

__device__ __forceinline__ bf16* dz_blob(bf16* DZ, int d, int b, int h, int n) { return DZ + ((size_t)(((d * 4 + b) * 4 + h) * 68 + n)) * 4096; }
__device__ __forceinline__ void ph_ret_pre(Frame& F, const bf16* P, const float* lam, bf16* DZ) {
    const int half = F.tid >> 8, ht = F.tid & 255, s = ht & 63, dq = ht >> 6, wq = F.wave & 3, lane = F.lane;
    LAS unsigned char* hb = F.lds + RING_OFF + half * (3 * IMG);
    LAS unsigned char* KFT = hb, * KBT = hb + IMG, * VT = hb + 2 * IMG;
    for (int it = F.vcu; it < 544; it += F.G) {
        const int item = it * 2 + half, tbi = item >> 2, h = item & 3; const TB tb = tb_of(tbi);
        const float lgf = -lam[h], lgb = -lam[4 + h];
        { float lo[8], hi[8]; const int m = tb.m0 + s;
          load16(P, m, RET_OFF + 256 + h * 64, dq, lo, hi); if (tb.isx) rope16(F, tb.t0 + s, dq, lo, hi);
          st_chn16(KFT, s, dq, lo, hi, 0.125f * __expf((float)(63 - s) * lgf)); st_chn16(KBT, s, dq, lo, hi, 0.125f * __expf((float)s * lgb));
          load16(P, m, RET_OFF + 512 + h * 64, dq, lo, hi); st_chn16(VT, s, dq, lo, hi, 1.f); }
        LDS_BARRIER();
#pragma unroll
        for (int d = 0; d < 2; ++d) { bf16* blob = dz_blob(DZ, d, tb.b, h, chunk_of(tb, d)); const LAS unsigned char* KT = d ? KBT : KFT;
#pragma unroll
            for (int vt = 0; vt < 4; ++vt) { const f32x4 acc = nt_tile64(KT, 16 * wq, VT, 16 * vt, lane, zero4());
                *(unsigned long long*)(blob + (16 * vt + (lane & 15)) * 64 + 16 * wq + 4 * (lane >> 4)) = pack4(acc); } }
        LDS_BARRIER();
    }
}
__device__ __forceinline__ void ph_ret_prefix(Frame& F, const float* lam, bf16* DZ) {
    const int e = F.vcu * NTHR + F.tid;
    if (e >= 32 * 4096) return;
    const int seq = e >> 12, el = e & 4095, d = seq >> 4, h = seq & 3;
    const float gC = __expf(-64.f * lam[d * 4 + h]);
    GAS bf16* base = (GAS bf16*)DZ + (size_t)seq * 68 * 4096 + el; float z = 0.f;
#pragma unroll 1
    for (int n = 0; n < 68; n += 17) { float tmp[17];
#pragma unroll
        for (int u = 0; u < 17; ++u) tmp[u] = bf2f(base[(size_t)(n + u) * 4096]);
#pragma unroll
        for (int u = 0; u < 17; ++u) { base[(size_t)(n + u) * 4096] = f2bf(z); z = gC * z + tmp[u]; } }
}
__device__ __forceinline__ void ph_ret_post(Frame& F, const bf16* P, const float* lam, const bf16* DZ, bf16* MIX) {
    const int half = F.tid >> 8, ht = F.tid & 255, s = ht & 63, dq = ht >> 6, wq = F.wave & 3, lane = F.lane, r = lane & 15, g = lane >> 4;
    LAS unsigned char* hb = F.lds + RING_OFF + half * (4 * IMG);
    LAS unsigned char* Qi = hb, * Ki = hb + IMG, * VT = hb + 2 * IMG, * Wi = hb + 3 * IMG;
    for (int it = F.vcu; it < 544; it += F.G) {
        const int item = it * 2 + half, tbi = item >> 2, h = item & 3; const TB tb = tb_of(tbi);
        const float lgf = -lam[h], lgb = -lam[4 + h];
        { float lo[8], hi[8]; const int m = tb.m0 + s;
          load16(P, m, RET_OFF + h * 64, dq, lo, hi); if (tb.isx) rope16(F, tb.t0 + s, dq, lo, hi); st_tok16(Qi, s, dq, lo, hi);
          load16(P, m, RET_OFF + 256 + h * 64, dq, lo, hi); if (tb.isx) rope16(F, tb.t0 + s, dq, lo, hi);
#pragma unroll
          for (int e = 0; e < 8; ++e) { lo[e] *= 0.125f; hi[e] *= 0.125f; }
          st_tok16(Ki, s, dq, lo, hi);
          load16(P, m, RET_OFF + 512 + h * 64, dq, lo, hi); st_chn16(VT, s, dq, lo, hi, 1.f); }
        LDS_BARRIER();
        const int s0 = 16 * wq, sl = s0 + r;
#pragma unroll
        for (int jt = 0; jt < 4; ++jt) { f32x4 acc = nt_tile64(Ki, 16 * jt, Qi, s0, lane, zero4());
#pragma unroll
            for (int i = 0; i < 4; ++i) { const int j = 16 * jt + 4 * g + i; const float wf = j <= sl ? __expf((float)(sl - j) * lgf) : 0.f, wb = j >= sl ? __expf((float)(j - sl) * lgb) : 0.f; acc[i] *= (wf + wb); }
            *(LAS unsigned long long*)(Wi + sl * LSTR + 2 * (16 * jt + 4 * g)) = pack4(acc); }
        LDS_WAIT();
        const bf16* Zf = dz_blob((bf16*)DZ, 0, tb.b, h, chunk_of(tb, 0)); const bf16* Zb = dz_blob((bf16*)DZ, 1, tb.b, h, chunk_of(tb, 1));
        const float ef = __expf((float)(sl + 1) * lgf), eb = __expf((float)(64 - sl) * lgb);
        f32x4 o[4]; float ssq = 0.f;
#pragma unroll
        for (int vt = 0; vt < 4; ++vt) { f32x4 aw = nt_tile64(VT, 16 * vt, Wi, s0, lane, zero4()), af = zero4(), ab = zero4();
#pragma unroll
            for (int ks = 0; ks < 4; ++ks) { const bf16x4 qf = ldsfrag(Qi, sl, 16 * ks + 4 * g);
                const bf16x4 zf = *(const bf16x4*)(Zf + (16 * vt + r) * 64 + 16 * ks + 4 * g), zb = *(const bf16x4*)(Zb + (16 * vt + r) * 64 + 16 * ks + 4 * g);
                af = MFMA16(zf, qf, af); ab = MFMA16(zb, qf, ab); }
            o[vt] = aw + af * ef + ab * eb; ssq += (o[vt].x * o[vt].x + o[vt].y * o[vt].y) + (o[vt].z * o[vt].z + o[vt].w * o[vt].w); }
        ssq += __shfl_xor(ssq, 16); ssq += __shfl_xor(ssq, 32);
        const float rs = rsqrtf(ssq * (1.f / 64.f) + 1e-6f); const int m = tb.m0 + sl;
#pragma unroll
        for (int vt = 0; vt < 4; ++vt) { const int vd = 16 * vt + 4 * g; const unsigned long long gw = *(const unsigned long long*)(P + (size_t)m * LDP + RET_OFF + 768 + h * 64 + vd);
            f32x4 y; y.x = o[vt].x * rs * siluf_(__uint_as_float((unsigned)(gw & 0xffffull) << 16)); y.y = o[vt].y * rs * siluf_(__uint_as_float((unsigned)((gw >> 16) & 0xffffull) << 16));
            y.z = o[vt].z * rs * siluf_(__uint_as_float((unsigned)((gw >> 32) & 0xffffull) << 16)); y.w = o[vt].w * rs * siluf_(__uint_as_float((unsigned)((gw >> 48) & 0xffffull) << 16));
            *(unsigned long long*)(MIX + (size_t)m * D + 256 + h * 64 + vd) = pack4(y); }
        LDS_BARRIER();
    }
}

constexpr int IT_KP = 0, IT_RP = 8192, IT_BH = 16384, IT_UT = 24576, IT_Y0 = 32768, IT_D0 = 40960, IT_GC = 49152, ITEM_BYTES = 49664;
__device__ __forceinline__ int swz(int r, int c) { return r * 128 + (((c >> 2) ^ (r & 15)) << 3) + (c & 3) * 2; }
__device__ __forceinline__ GAS unsigned char* item_ptr(unsigned char* BL, int seq, int n) { return (GAS unsigned char*)BL + ((size_t)seq * 68 + n) * ITEM_BYTES; }
__device__ __forceinline__ bf16x4 cvt4(f32x4 v) { unsigned long long p = pack4(v); return __builtin_bit_cast(bf16x4, p); }
__device__ __forceinline__ f32x4 up4(unsigned long long w) { f32x4 r; r.x = __uint_as_float((unsigned)(w & 0xffffull) << 16); r.y = __uint_as_float((unsigned)((w >> 16) & 0xffffull) << 16);
    r.z = __uint_as_float((unsigned)((w >> 32) & 0xffffull) << 16); r.w = __uint_as_float((unsigned)((w >> 48) & 0xffffull) << 16); return r; }
constexpr int PI_A0 = 0, PI_A1 = 1, PI_A2 = 2, PI_A3 = 3, PI_KAPT = 4, PI_RHOT = 5, PI_VT = 6, PI_KHT = 7, PI_M1 = 8, PI_M2 = 9, PI_M3 = 10, PI_M4 = 11;
constexpr int PRE_TINV = 12 * IMG;
constexpr int PRE_ARR = PRE_TINV + 4 * 16 * 40;
__device__ __forceinline__ LAS unsigned char* pimg(Frame& F, int i) { return F.lds + RING_OFF + i * IMG; }

template <bool SCALAR>
__device__ __forceinline__ void dplr_core(Frame& F, GAS unsigned char* item) {
    int lane = F.lane; asm volatile("" : "+v"(lane));
    int w = F.wave; asm volatile("" : "+s"(w)); const int r = lane & 15, g = lane >> 4;
    const LAS float* Gs = (const LAS float*)(F.lds + RING_OFF + PRE_ARR); const LAS float* GM1 = Gs + 64; const LAS float* BETA = Gs + 128;
    TSEC_BEGIN(4)
    if (SCALAR) {
#pragma unroll
        for (int q = 0; q < 4; ++q) { const int e = w * 4 + q, which = e >> 4, tj = (e >> 2) & 3, tt = e & 3;
            LAS unsigned char* Ma = pimg(F, which ? PI_M3 : PI_M1); LAS unsigned char* Mb = pimg(F, which ? PI_M4 : PI_M2);
            f32x4 va = zero4(), vb = zero4(); const int t = 16 * tt + r;
            if (tj <= tt) { const f32x4 acc = nt_tile64(pimg(F, PI_A0), 16 * tj, pimg(F, which ? PI_A1 : PI_A0), 16 * tt, lane, zero4());
                const float gt = which ? Gs[t] : GM1[t];
#pragma unroll
                for (int i = 0; i < 4; ++i) { const int j = 16 * tj + 4 * g + i; const bool ok = which ? (j <= t) : (j < t); const float bj = BETA[j];
                    va[i] = ok ? acc[i] * bj * __expf(gt - GM1[j]) : 0.f; vb[i] = ok ? acc[i] * bj * __expf(gt - Gs[j]) : 0.f; } }
            *(LAS unsigned long long*)(Ma + t * LSTR + 2 * (16 * tj + 4 * g)) = pack4(va); *(LAS unsigned long long*)(Mb + t * LSTR + 2 * (16 * tj + 4 * g)) = pack4(vb); }
    } else {
#pragma unroll
        for (int q = 0; q < 8; ++q) { const int e = w * 8 + q, mi = e >> 4, tj = (e >> 2) & 3, tt = e & 3;
            LAS unsigned char* M = pimg(F, PI_M1 + mi); f32x4 va = zero4(); const int t = 16 * tt + r;
            if (tj <= tt) { const f32x4 acc = nt_tile64(pimg(F, (mi & 1) ? PI_A2 : PI_A1), 16 * tj, pimg(F, (mi & 2) ? PI_A3 : PI_A0), 16 * tt, lane, zero4());
#pragma unroll
                for (int i = 0; i < 4; ++i) { const int j = 16 * tj + 4 * g + i; const bool ok = (mi & 2) ? (j <= t) : (j < t); va[i] = ok ? acc[i] : 0.f; } }
            *(LAS unsigned long long*)(M + t * LSTR + 2 * (16 * tj + 4 * g)) = pack4(va); }
    }
    LDS_BARRIER();
    TSEC_END(4)
    TSEC_BEGIN(5)
    if (w == 0) { const int blk = lane >> 4, c = lane & 15; const LAS unsigned char* M1 = pimg(F, PI_M1); float x[16];
#pragma unroll
        for (int rr = 0; rr < 16; ++rr) { float a[16]; const v4u lo = *(const LAS v4u*)(M1 + (16 * blk + rr) * LSTR + 32 * blk), hi = *(const LAS v4u*)(M1 + (16 * blk + rr) * LSTR + 32 * blk + 16);
            { float t8[8]; unpack8(lo, t8);
#pragma unroll
              for (int q = 0; q < 8; ++q) a[q] = t8[q]; unpack8(hi, t8);
#pragma unroll
              for (int q = 0; q < 8; ++q) a[8 + q] = t8[q]; }
            float s = (rr == c) ? 1.f : 0.f;
#pragma unroll
            for (int j = 0; j < rr; ++j) s -= a[j] * x[j];
            x[rr] = s; }
        LAS unsigned char* TI = F.lds + RING_OFF + PRE_TINV + blk * 16 * 40;
#pragma unroll
        for (int rr = 0; rr < 16; ++rr) *(LAS bf16*)(TI + rr * 40 + 2 * c) = f2bf(x[rr]); }
    LDS_BARRIER();
    TSEC_END(5)
    TSEC_BEGIN(6)
    const LAS unsigned char* M1 = pimg(F, PI_M1); const LAS unsigned char* M2 = pimg(F, PI_M2); const LAS unsigned char* M3 = pimg(F, PI_M3); const LAS unsigned char* M4 = pimg(F, PI_M4);
    const LAS unsigned char* VT = pimg(F, PI_VT);
    f32x4 x[4];
    if (w < 4) {
#pragma unroll
        for (int tb = 0; tb < 4; ++tb) { f32x4 acc = zero4();
#pragma unroll
            for (int jb = 0; jb <= tb; ++jb) acc = MFMA16(ldsfrag(M2, 16 * tb + r, 16 * jb + 4 * g), ldsfrag(VT, 16 * w + r, 16 * jb + 4 * g), acc);
            x[tb] = acc; }
    } else { const LAS unsigned char* KAPT = pimg(F, PI_KAPT);
#pragma unroll
        for (int tb = 0; tb < 4; ++tb) x[tb] = up4(*(const LAS unsigned long long*)(KAPT + (16 * (w - 4) + r) * LSTR + 2 * (16 * tb + 4 * g))); }
#pragma unroll
    for (int i = 0; i < 4; ++i) { f32x4 acc = zero4();
#pragma unroll
        for (int j = 0; j < i; ++j) acc = MFMA16(ldsfrag(M1, 16 * i + r, 16 * j + 4 * g), cvt4(x[j]), acc);
        const f32x4 rhs = x[i] - acc;
        const bf16x4 tf = *(const LAS bf16x4*)(F.lds + RING_OFF + PRE_TINV + (i * 16 + r) * 40 + 8 * g);
        x[i] = MFMA16(tf, cvt4(rhs), zero4()); }
    if (w < 4) {
        const int v = 16 * w + r; GAS bf16* UT = (GAS bf16*)(item + IT_UT) + v * 64; GAS bf16* Y0T = (GAS bf16*)(item + IT_Y0) + v * 64; GAS bf16* D0T = (GAS bf16*)(item + IT_D0) + v * 64;
        const LAS unsigned char* KHT = pimg(F, PI_KHT);
#pragma unroll
        for (int tb = 0; tb < 4; ++tb) { *(GAS unsigned long long*)(UT + 16 * tb + 4 * g) = pack4(x[tb]);
            f32x4 a4 = zero4(), a3 = zero4();
#pragma unroll
            for (int jb = 0; jb <= tb; ++jb) { a4 = MFMA16(ldsfrag(M4, 16 * tb + r, 16 * jb + 4 * g), ldsfrag(VT, v, 16 * jb + 4 * g), a4); a3 = MFMA16(ldsfrag(M3, 16 * tb + r, 16 * jb + 4 * g), cvt4(x[jb]), a3); }
            *(GAS unsigned long long*)(Y0T + 16 * tb + 4 * g) = pack4(a4 - a3);
            f32x4 d0 = zero4();
#pragma unroll
            for (int sb = 0; sb < 4; ++sb) d0 = MFMA16(ldsfrag(KHT, 16 * tb + r, 16 * sb + 4 * g), ldsfrag(VT, v, 16 * sb + 4 * g), d0);
            *(GAS unsigned long long*)(D0T + 16 * tb + 4 * g) = pack4(d0); }
    } else {
        const int k = 16 * (w - 4) + r; const LAS unsigned char* RHOT = pimg(F, PI_RHOT); LAS unsigned char* KPi = pimg(F, PI_A2); LAS unsigned char* RPi = pimg(F, PI_A3);
#pragma unroll
        for (int tb = 0; tb < 4; ++tb) { f32x4 a3 = zero4();
#pragma unroll
            for (int jb = 0; jb <= tb; ++jb) a3 = MFMA16(ldsfrag(M3, 16 * tb + r, 16 * jb + 4 * g), cvt4(x[jb]), a3);
            const f32x4 rp = up4(*(const LAS unsigned long long*)(RHOT + k * LSTR + 2 * (16 * tb + 4 * g))) - a3;
#pragma unroll
            for (int i = 0; i < 4; ++i) { const int t = 16 * tb + 4 * g + i; *(LAS bf16*)(KPi + swz(t, k)) = f2bf(x[tb][i]); *(LAS bf16*)(RPi + swz(t, k)) = f2bf(rp[i]); } }
    }
    LDS_BARRIER();
    TSEC_END(6)
    TSEC_BEGIN(7)
    { const v4u a = *(const LAS v4u*)(pimg(F, PI_A2) + F.tid * 16), b = *(const LAS v4u*)(pimg(F, PI_A3) + F.tid * 16);
      *(GAS v4u*)(item + IT_KP + F.tid * 16) = a; *(GAS v4u*)(item + IT_RP + F.tid * 16) = b; }
    LDS_BARRIER();
    TSEC_END(7)
}

__device__ __forceinline__ void gdn_pre_item(Frame& F, const bf16* P, const float* cw, const float* alog, const float* dtb, unsigned char* BL, int tbi, int h, int d) {
    int w = F.wave; asm volatile("" : "+s"(w));
    const TB tb = tb_of(tbi); const int lane = F.lane, L = tb.isx ? SEQ : CTXL;
    LAS float* Gs = (LAS float*)(F.lds + RING_OFF + PRE_ARR); LAS float* GM1 = Gs + 64; LAS float* BETA = Gs + 128; LAS float* LAa = Gs + 192;
    const int seq = (d * 4 + tb.b) * 4 + h; GAS unsigned char* item = item_ptr(BL, seq, chunk_of(tb, d));
    TSEC_BEGIN(1)
    constexpr int GSTR = 400;
    LAS unsigned char* STG = pimg(F, PI_M1);
    { const GAS bf16* Pg = (const GAS bf16*)P;
#pragma unroll
      for (int q = 0; q < 4; ++q) { const int e0 = F.tid + q * NTHR, e = e0 < 68 * 24 ? e0 : 68 * 24 - 1; const int row = e / 24, ch = e % 24, sg = ch >> 3, part = ch & 7; const int t = tb.t0 - 2 + row;
              const bool ok = t >= 0 && t < L; const int rowc = ok ? row : 2;
              v4u val = *(const GAS v4u*)(Pg + (size_t)(tb.m0 - 2 + rowc) * LDP + GDN_OFF + sg * 256 + h * 64 + part * 8);
              if (!ok) val = (v4u){0u, 0u, 0u, 0u};
              *(LAS v4u*)(STG + row * GSTR + ch * 16) = val; } }
    float qv[8], kv[8], vv[8];
    const float Aexp = __expf(alog[d * 4 + h]), dt = dtb[d * 4 + h];
    float Gall, GM1all, BEall;
    { const GAS bf16* Pg = (const GAS bf16*)P; const int tau = d ? 63 - lane : lane; const size_t mo = (size_t)(tb.m0 + tau) * LDP + GDN_OFF;
      const float ar = bf2f(Pg[mo + 768 + d * 4 + h]), br = bf2f(Pg[mo + 776 + d * 4 + h]);
      const float la = -Aexp * softplusf_(ar + dt); BEall = sigmoidf_(br); float gsum = la;
#pragma unroll
      for (int o = 1; o < 64; o <<= 1) { const float t = __shfl_up(gsum, o); if (lane >= o) gsum += t; }
      Gall = gsum; GM1all = gsum - la;
      if (w == 0) { Gs[lane] = Gall; GM1[lane] = GM1all; BETA[lane] = BEall; } }
    LDS_BARRIER();
    { float cwv[3][4];
#pragma unroll
      for (int c3 = 0; c3 < 3; ++c3)
#pragma unroll
          for (int j = 0; j < 4; ++j) cwv[c3][j] = cw[j * 768 + c3 * 256 + h * 64 + lane];
#pragma unroll
      for (int u = 0; u < 8; ++u) { const int s = 8 * w + u, tau = d ? 63 - s : s;
          float acc3[3] = {0.f, 0.f, 0.f};
#pragma unroll
          for (int j = 0; j < 4; ++j)
#pragma unroll
              for (int c3 = 0; c3 < 3; ++c3) acc3[c3] += bf2f(*(const LAS bf16*)(STG + (tau + j) * GSTR + (c3 * 64 + lane) * 2)) * cwv[c3][j];
          const float o0 = siluf_(acc3[0]), o1 = siluf_(acc3[1]), o2 = siluf_(acc3[2]);
          const float qs = wave_sum(o0 * o0), ks = wave_sum(o1 * o1);
          qv[u] = o0 * rsqrtf(qs + 1e-6f) * 0.125f; kv[u] = o1 * rsqrtf(ks + 1e-6f); vv[u] = o2;
          } }
    TSEC_END(1)
    TSEC_BEGIN(3)
    const float gc = __int_as_float(__builtin_amdgcn_readlane(__float_as_int(Gall), 63));
#pragma unroll
    for (int u = 0; u < 8; ++u) { const int s = 8 * w + u; const float gg = __int_as_float(__builtin_amdgcn_readlane(__float_as_int(Gall), s)), gm = __int_as_float(__builtin_amdgcn_readlane(__float_as_int(GM1all), s)), be = __int_as_float(__builtin_amdgcn_readlane(__float_as_int(BEall), s));
        *(LAS bf16*)(pimg(F, PI_A0) + s * LSTR + 2 * lane) = f2bf(kv[u]); *(LAS bf16*)(pimg(F, PI_A1) + s * LSTR + 2 * lane) = f2bf(qv[u]);
        *(LAS bf16*)(pimg(F, PI_KAPT) + lane * LSTR + 2 * s) = f2bf(kv[u] * __expf(gm)); *(LAS bf16*)(pimg(F, PI_RHOT) + lane * LSTR + 2 * s) = f2bf(qv[u] * __expf(gg));
        *(LAS bf16*)(pimg(F, PI_VT) + lane * LSTR + 2 * s) = f2bf(vv[u]); *(LAS bf16*)(pimg(F, PI_KHT) + lane * LSTR + 2 * s) = f2bf(be * kv[u] * __expf(gc - gg));
        *(GAS bf16*)(item + IT_BH + swz(lane, s)) = f2bf(be * kv[u] * __expf(gc - gm)); }
    if (w == 0) ((GAS float*)(item + IT_GC))[lane] = __expf(gc);
    LDS_BARRIER();
    TSEC_END(3)
    dplr_core<true>(F, item);
}
__device__ __forceinline__ void ph_gdn_pre(Frame& F, const bf16* P, const float* cw, const float* alog, const float* dtb, unsigned char* BL) {
    for (int it = F.vcu; it < 272 * 8; it += F.G) { const int tbi = it >> 3, h = (it >> 1) & 3, d = it & 1; gdn_pre_item(F, P, cw, alog, dtb, BL, tbi, h, d); }
}

constexpr int SLOT_BYTES = 24576;
__device__ __forceinline__ void dplr_scan_seq(Frame& F, const unsigned char* BLgen, int seq, float* YSgen0, float* YSgen1) {
    const GAS unsigned char* BL = (const GAS unsigned char*)BLgen; GAS float* YS = (GAS float*)((seq >> 4) ? YSgen1 : YSgen0);
    const int w = F.wave, lane = F.lane, r = lane & 15, g = lane >> 4;
    const int d = seq >> 4, b = (seq >> 2) & 3, h = seq & 3;
    LAS unsigned char* ring = F.lds + RING_OFF;
    if (w >= 4) {
        const int lw = w - 4;
#define SCAN_ISSUE(n) do { const GAS unsigned char* src = BL + ((size_t)seq * 68 + (n)) * ITEM_BYTES + lw * 6144 + lane * 16; LAS unsigned char* dst = ring + ((n) % 5) * SLOT_BYTES + lw * 6144; \
        _Pragma("unroll") for (int q = 0; q < 6; ++q) __builtin_amdgcn_global_load_lds((const GAS unsigned*)(src + q * 1024), (LAS unsigned*)(dst + q * 1024), 16, 0, 0); } while (0)
        SCAN_ISSUE(0); SCAN_ISSUE(1); SCAN_ISSUE(2); SCAN_ISSUE(3);
        asm volatile("s_waitcnt vmcnt(18)" ::: "memory");
        __builtin_amdgcn_s_barrier(); asm volatile("" ::: "memory");
        for (int n = 0; n < 68; ++n) {
            if (n + 4 < 68) { SCAN_ISSUE(n + 4); asm volatile("s_waitcnt vmcnt(18)" ::: "memory"); }
            else asm volatile("s_waitcnt vmcnt(0)" ::: "memory");
            __builtin_amdgcn_s_barrier(); asm volatile("" ::: "memory");
        }
#undef SCAN_ISSUE
    } else {
        const int v = 16 * w + r;
        f32x4 z[4];
#pragma unroll
        for (int kb = 0; kb < 4; ++kb) z[kb] = zero4();
        struct Strip { unsigned long long ut[4], y0[4], d0[4]; f32x4 gc[4]; };
#define STRIP_LOAD(S, n) do { const GAS unsigned char* it_ = BL + ((size_t)seq * 68 + (n)) * ITEM_BYTES; const GAS bf16* UT_ = (const GAS bf16*)(it_ + IT_UT) + v * 64; const GAS bf16* Y0_ = (const GAS bf16*)(it_ + IT_Y0) + v * 64; \
        const GAS bf16* D0_ = (const GAS bf16*)(it_ + IT_D0) + v * 64; const GAS float* GC_ = (const GAS float*)(it_ + IT_GC); \
        _Pragma("unroll") for (int q = 0; q < 4; ++q) { S.ut[q] = *(const GAS unsigned long long*)(UT_ + 16 * q + 4 * g); S.y0[q] = *(const GAS unsigned long long*)(Y0_ + 16 * q + 4 * g); \
            S.d0[q] = *(const GAS unsigned long long*)(D0_ + 16 * q + 4 * g); S.gc[q] = *(const GAS f32x4*)(GC_ + 16 * q + 4 * g); } } while (0)
#define SCAN_BODY(S, n, SL) do { TSECN_BEGIN(8) const LAS unsigned char* slot = ring + (SL) * SLOT_BYTES; const LAS unsigned char* sx0 = slot + xo[0]; const LAS unsigned char* sx1 = slot + xo[1]; const LAS unsigned char* sx2 = slot + xo[2]; const LAS unsigned char* sx3 = slot + xo[3]; \
        bf16x4 zb[4]; _Pragma("unroll") for (int kb = 0; kb < 4; ++kb) zb[kb] = cvt4(z[kb]); \
        f32x4 sa[4], y[4]; \
        _Pragma("unroll") for (int tt = 0; tt < 4; ++tt) { sa[tt] = up4(S.ut[tt]); y[tt] = up4(S.y0[tt]); } \
        _Pragma("unroll") for (int kp = 0; kp < 2; ++kp) { const LAS unsigned char* sxa = kp == 0 ? sx0 : sx2; const LAS unsigned char* sxb = kp == 0 ? sx1 : sx3;     \
            _Pragma("unroll") for (int tt = 0; tt < 4; ++tt) { sa[tt] = MFMA32P(*(const LAS bf16x4*)(sxa + IT_KP + tt * 2048), *(const LAS bf16x4*)(sxb + IT_KP + tt * 2048), zb[2 * kp], zb[2 * kp + 1], sa[tt]); \
                y[tt] = MFMA32P(*(const LAS bf16x4*)(sxa + IT_RP + tt * 2048), *(const LAS bf16x4*)(sxb + IT_RP + tt * 2048), zb[2 * kp], zb[2 * kp + 1], y[tt]); } } \
        bf16x4 sb[4]; _Pragma("unroll") for (int tt = 0; tt < 4; ++tt) sb[tt] = cvt4(sa[tt]); \
        f32x4 zu[4]; _Pragma("unroll") for (int kb = 0; kb < 4; ++kb) zu[kb] = zero4(); \
        _Pragma("unroll") for (int tp = 0; tp < 2; ++tp) { const LAS unsigned char* sxa = tp == 0 ? sx0 : sx2; const LAS unsigned char* sxb = tp == 0 ? sx1 : sx3; \
            _Pragma("unroll") for (int kb = 0; kb < 4; ++kb) zu[kb] = MFMA32P(*(const LAS bf16x4*)(sxa + IT_BH + kb * 2048), *(const LAS bf16x4*)(sxb + IT_BH + kb * 2048), sb[2 * tp], sb[2 * tp + 1], zu[kb]); } \
        _Pragma("unroll") for (int kb = 0; kb < 4; ++kb) z[kb] = S.gc[kb] * z[kb] + up4(S.d0[kb]) - zu[kb]; \
        { int m0; if ((n) < 4) { const int j = d ? 3 - (n) : (n); m0 = NX + (b * 4 + j) * 64; } else { const int j = d ? 63 - ((n) - 4) : ((n) - 4); m0 = (b * 64 + j) * 64; } \
          GAS float* yb = YS + (size_t)m0 * 256 + h * 64 + v; \
          _Pragma("unroll") for (int tt = 0; tt < 4; ++tt) _Pragma("unroll") for (int i = 0; i < 4; ++i) { const int t = 16 * tt + 4 * g + i, tau = d ? 63 - t : t; yb[(size_t)tau * 256] = y[tt][i]; } } \
        if ((n) + 2 < 68) STRIP_LOAD(S, (n) + 2); \
        TSECN_END(8) TSECN_BEGIN(9) \
        asm volatile("" ::: "memory"); __builtin_amdgcn_s_barrier(); asm volatile("" ::: "memory"); TSECN_END(9) } while (0)
        int xo[4];
#pragma unroll
        for (int q = 0; q < 4; ++q) xo[q] = r * 128 + (((4 * q + g) ^ r) << 3);
        Strip S0, S1; STRIP_LOAD(S0, 0); STRIP_LOAD(S1, 1);
        __builtin_amdgcn_s_barrier(); asm volatile("" ::: "memory");
        for (int n = 0; n < 68; n += 2) { SCAN_BODY(S0, n, (n % 5)); SCAN_BODY(S1, n + 1, ((n + 1) % 5)); }
#undef STRIP_LOAD
#undef SCAN_BODY
    }
}
constexpr int RWT_A2 = 2 * 2 * 256 * 32, RWT_V2 = 2 * RWT_A2, RWT_G2 = RWT_V2 + 256 * 32, RWT_TOTAL = RWT_G2 + 2 * 256 * 64;
__device__ __forceinline__ void ph_convert_rwkv(Frame& F, const float* w2, const float* a2, const float* v2, const float* g2, bf16* RWTp) {
    for (int i = F.vcu * NTHR + F.tid; i < RWT_TOTAL; i += F.G * NTHR) {
        float x;
        if (i < RWT_V2) { const int which = i >= RWT_A2, r = i - which * RWT_A2, ld = r >> 13, c = (r >> 5) & 255, j = r & 31; x = (which ? a2 : w2)[((size_t)ld * 32 + j) * 256 + c]; }
        else if (i < RWT_G2) { const int r = i - RWT_V2, c = r >> 5, j = r & 31; x = v2[j * 256 + c]; }
        else { const int r = i - RWT_G2, l = r >> 14, c = (r >> 6) & 255, j = r & 63; x = g2[((size_t)l * 64 + j) * 256 + c]; }
        RWTp[i] = f2bf(x); }
}
constexpr int RW_RSTR = 720;
constexpr int RW_RAW = 0, RW_TW = 55296, RW_AD = RW_TW + 64 * 80, RW_VD = RW_AD + 64 * 80, RW_GD = RW_VD + 64 * 80, RW_ZZ = RW_GD + 64 * 144, RW_ZA = RW_ZZ + 16384, RW_ZV = RW_ZA + 16384, RW_ZG = RW_ZV + IMG;
static_assert(RW_ZG + IMG <= RING_BYTES && 66 * RW_RSTR <= RW_TW, "RWKV prep LDS map");
constexpr int RW_WT = LDSCTL_OFF + 4096;
__device__ __forceinline__ void rwkv_pre_item(Frame& F, const bf16* Pgen, const RwP& wp, const bf16* RWTg, int layer, float* VF, float* SV, float* GB, float* BSC, unsigned char* BL, int tbi, int h, int d) {
    int w = F.wave; asm volatile("" : "+s"(w));
    const GAS bf16* P = (const GAS bf16*)Pgen; const GAS bf16* RWTp = (const GAS bf16*)RWTg;
    const TB tb = tb_of(tbi); const int lane = F.lane, tid = F.tid, L = tb.isx ? SEQ : CTXL, c = h * 64 + lane, r = lane & 15, g = lane >> 4;
    LAS unsigned char* lds = F.lds + RING_OFF; LAS float* WT = (LAS float*)(F.lds + RW_WT);
    const int seq = (d * 4 + tb.b) * 4 + h; GAS unsigned char* item = item_ptr(BL, seq, chunk_of(tb, d));
#pragma unroll
    for (int q = 0; q < 6; ++q) { const int e0 = tid + q * NTHR, e = e0 < 66 * 44 ? e0 : 66 * 44 - 1; const int row = e / 44, ch = e % 44; const int t = tb.t0 - 1 + row; const bool ok = t >= 0 && t < L; const int rowc = ok ? row : 1;
        const int pcol = ch < 24 ? (ch >> 3) * 256 + h * 64 + (ch & 7) * 8 : ch < 28 ? 768 + d * 32 + (ch - 24) * 8 : ch < 32 ? 832 + d * 32 + (ch - 28) * 8 : ch < 40 ? 896 + (ch - 32) * 8 : VRES_OFF + (ch - 40) * 8;
        v4u val = *(const GAS v4u*)(P + (size_t)(tb.m0 - 1 + rowc) * LDP + pcol); if (!ok) val = (v4u){0u, 0u, 0u, 0u};
        *(LAS v4u*)(lds + RW_RAW + row * RW_RSTR + ch * 16) = val; }
    float svf[8];
#pragma unroll
    for (int u = 0; u < 8; ++u) { const int s = 8 * w + u, tau = d ? 63 - s : s; svf[u] = layer ? VF[(size_t)(tb.m0 + tau) * 256 + c] : 0.f; }
    LDS_BARRIER();
#define RAWV(row, col) bf2f(*(const LAS bf16*)(lds + RW_RAW + (row) * RW_RSTR + (col) * 2))
#define RSHF(tau_, col, mu_) ([&]() { const float p_ = RAWV((tau_) + 1, col); return p_ + (0.5f * (RAWV((tau_), col) + RAWV((tau_) + 2, col)) - p_) * (mu_); }())
    { const int tau = tid & 63, cg = tid >> 6;
#pragma unroll 4
      for (int q = 0; q < 20; ++q) { const int j = cg * 20 + q;
          if (j < 32) { const float x = RSHF(tau, 192 + j, wp.mu[768 + d * 32 + j]); *(LAS bf16*)(lds + RW_TW + tau * 80 + 2 * j) = f2bf(tanhf_(x)); }
          else if (j < 64) { const float x = RSHF(tau, 224 + (j - 32), wp.mu[832 + d * 32 + (j - 32)]); *(LAS bf16*)(lds + RW_AD + tau * 80 + 2 * (j - 32)) = f2bf(x); }
          else if (j < 128) { const float x = RSHF(tau, 256 + (j - 64), wp.mu[896 + (j - 64)]); *(LAS bf16*)(lds + RW_GD + tau * 144 + 2 * (j - 64)) = f2bf(sigmoidf_(x)); }
          else { *(LAS bf16*)(lds + RW_VD + tau * 80 + 2 * (j - 128)) = *(const LAS bf16*)(lds + RW_RAW + (tau + 1) * RW_RSTR + (320 + (j - 128)) * 2); } } }
    LDS_BARRIER();
    { const int p = w >> 1; const bool live = p < 2 || (p == 2 && layer) || (p == 3 && d == 0);
      if (live) { const int ksteps = p == 3 ? 4 : 2, astr = p == 3 ? 144 : 80; const LAS unsigned char* A = lds + (p == 0 ? RW_TW : p == 1 ? RW_AD : p == 2 ? RW_VD : RW_GD);
          const GAS bf16* Bw = p == 0 ? RWTp + ((size_t)(layer * 2 + d) * 256 + h * 64) * 32 : p == 1 ? RWTp + RWT_A2 + ((size_t)(layer * 2 + d) * 256 + h * 64) * 32 : p == 2 ? RWTp + RWT_V2 + (size_t)(h * 64) * 32 : RWTp + RWT_G2 + ((size_t)layer * 256 + h * 64) * 64;
          const int bstr = p == 3 ? 64 : 32;
#pragma unroll
          for (int sq = 0; sq < 2; ++sq) { const int st = 2 * (w & 1) + sq;
#pragma unroll
              for (int ct = 0; ct < 4; ++ct) { f32x4 acc = zero4();
                  for (int ks = 0; ks < ksteps; ++ks) { const bf16x4 af = *(const LAS bf16x4*)(A + (16 * st + r) * astr + (16 * ks + 4 * g) * 2); const bf16x4 bfr = *(const GAS bf16x4*)(Bw + (size_t)(16 * ct + r) * bstr + 16 * ks + 4 * g); acc = MFMA16(af, bfr, acc); }
#pragma unroll
                  for (int i = 0; i < 4; ++i) { const int tau = 16 * st + 4 * g + i, cc = 16 * ct + r;
                      if (p == 0) *(LAS float*)(lds + RW_ZZ + (tau * 64 + cc) * 4) = acc[i]; else if (p == 1) *(LAS float*)(lds + RW_ZA + (tau * 64 + cc) * 4) = acc[i];
                      else if (p == 2) *(LAS bf16*)(lds + RW_ZV + tau * LSTR + 2 * cc) = f2bf(acc[i]); else *(LAS bf16*)(lds + RW_ZG + tau * LSTR + 2 * cc) = f2bf(acc[i]); } } } } }
    LDS_BARRIER();
    float rv[8], kn[8], kd[8], bv[8], sv[8], lwv[8], gl[8]; float run = 0.f;
    { const float w0c = wp.w0[d * 256 + c], a0c = wp.a0[d * 256 + c], kkc = wp.kk[c], kac = wp.ka[c], rkc = wp.rk[c], v0c = layer ? wp.v0[c] : 0.f;
      const float mur = wp.mu[c], muk = wp.mu[256 + c], muv = wp.mu[512 + c];
#pragma unroll
      for (int u = 0; u < 8; ++u) { const int s = 8 * w + u, tau = d ? 63 - s : s, m = tb.m0 + tau;
          const float rr = RSHF(tau, lane, mur), kraw = RSHF(tau, 64 + lane, muk); float v = RSHF(tau, 128 + lane, muv);
          const float z = w0c + *(const LAS float*)(lds + RW_ZZ + (tau * 64 + lane) * 4), za = a0c + *(const LAS float*)(lds + RW_ZA + (tau * 64 + lane) * 4);
          const float lw = -0.6065306597f * sigmoidf_(z), a = sigmoidf_(za);
          const float kkr = kraw * kkc; const float kkn = kkr * rsqrtf(wave_sum(kkr * kkr) + 1e-6f);
          const float kdv = kraw * (1.f + (a - 1.f) * kac);
          const float bs = wave_sum(rr * kdv * rkc);
          if (lane == 0) BSC[((size_t)d * MT + m) * 4 + h] = bs;
          if (layer) { const float zv = v0c + bf2f(*(const LAS bf16*)(lds + RW_ZV + tau * LSTR + 2 * lane)); v = v + (svf[u] - v) * sigmoidf_(zv); }
          if (d == 0) { if (!layer) VF[(size_t)m * 256 + c] = v; SV[(size_t)m * 256 + c] = v; GB[(size_t)m * 256 + c] = bf2f(*(const LAS bf16*)(lds + RW_ZG + tau * LSTR + 2 * lane)); }
          run += lw; rv[u] = rr; kn[u] = kkn; kd[u] = kdv; bv[u] = kkn * a; sv[u] = v; lwv[u] = lw; gl[u] = run; } }
#undef RSHF
#undef RAWV
    WT[w * 64 + lane] = run;
    LDS_BARRIER();
    float off = 0.f, gc = 0.f;
#pragma unroll
    for (int q = 0; q < 8; ++q) { const float t = WT[q * 64 + lane]; gc += t; if (q < w) off += t; }
#pragma unroll
    for (int u = 0; u < 8; ++u) { const int s = 8 * w + u; const float G = off + gl[u]; const float eg = __expf(G), eng = __expf(-G), egc = __expf(gc - G); const bf16 kap = f2bf(kn[u] * __expf(G - lwv[u])), rho = f2bf(rv[u] * eg);
        *(LAS bf16*)(pimg(F, PI_A0) + s * LSTR + 2 * lane) = kap; *(LAS bf16*)(pimg(F, PI_KAPT) + lane * LSTR + 2 * s) = kap;
        *(LAS bf16*)(pimg(F, PI_A1) + s * LSTR + 2 * lane) = f2bf(bv[u] * eng); *(LAS bf16*)(pimg(F, PI_A2) + s * LSTR + 2 * lane) = f2bf(kd[u] * eng);
        *(LAS bf16*)(pimg(F, PI_A3) + s * LSTR + 2 * lane) = rho; *(LAS bf16*)(pimg(F, PI_RHOT) + lane * LSTR + 2 * s) = rho;
        *(LAS bf16*)(pimg(F, PI_VT) + lane * LSTR + 2 * s) = f2bf(sv[u]); *(LAS bf16*)(pimg(F, PI_KHT) + lane * LSTR + 2 * s) = f2bf(kd[u] * egc);
        *(GAS bf16*)(item + IT_BH + swz(lane, s)) = f2bf(bv[u] * egc); }
    if (w == 0) ((GAS float*)(item + IT_GC))[lane] = __expf(gc);
    LDS_BARRIER();
    dplr_core<false>(F, item);
}
__device__ __forceinline__ void ph_rwkv_pre(Frame& F, const bf16* P, const RwP& wp, const bf16* RWTg, int layer, float* VF, float* SV, float* GB, float* BSC, unsigned char* BL) {
    for (int it = F.vcu; it < 272 * 8; it += F.G) { const int tbi = it >> 3, h = (it >> 1) & 3, d = it & 1; rwkv_pre_item(F, P, wp, RWTg, layer, VF, SV, GB, BSC, BL, tbi, h, d); }
}

__device__ __forceinline__ void ph_rwkv_post(Frame& F, const float* YSg, const float* BSCg, const float* SVg, const float* Gg, const float* lnw, const float* lnb, bf16* MIXg) {
    const GAS float* YS = (const GAS float*)YSg; const GAS float* BSC = (const GAS float*)BSCg; const GAS float* SV = (const GAS float*)SVg; const GAS float* G = (const GAS float*)Gg; GAS bf16* MIX = (GAS bf16*)MIXg;
    const int gw = F.vcu * NWAVES + F.wave, NGW = F.G * NWAVES, lane = F.lane;
    for (int i0 = gw; i0 < MT * 4; i0 += 4 * NGW) {
        float y[4], bon[4], gg[4]; int mm[4], cc[4]; bool ok[4];
#pragma unroll
        for (int q = 0; q < 4; ++q) { const int it = i0 + q * NGW; ok[q] = it < MT * 4; const int itc = ok[q] ? it : i0; const int m = itc >> 2, h = itc & 3, c = h * 64 + lane; mm[q] = m; cc[q] = c;
            y[q] = YS[(size_t)m * 256 + c] + YS[((size_t)MT + m) * 256 + c]; bon[q] = (BSC[(size_t)m * 4 + h] + BSC[((size_t)MT + m) * 4 + h]) * SV[(size_t)m * 256 + c]; gg[q] = G[(size_t)m * 256 + c]; }
#pragma unroll
        for (int q = 0; q < 4; ++q) { const float mu = wave_sum(y[q]) * (1.f / 64.f); const float dlt = y[q] - mu; const float var = wave_sum(dlt * dlt) * (1.f / 64.f);
            const float yn = dlt * rsqrtf(var + 64e-5f); const float o = (yn * lnw[cc[q]] + lnb[cc[q]] + bon[q]) * gg[q];
            if (ok[q]) MIX[(size_t)mm[q] * D + cc[q]] = f2bf(o); }
    }
}
__device__ __forceinline__ void ph_hnorm_post(Frame& F, const float* YSag, const float* YSbg, const bf16* Pg, int gate_off, const float* nw, bf16* MIXg, int mix_off) {
    const GAS float* YSa = (const GAS float*)YSag; const GAS float* YSb = (const GAS float*)YSbg; const GAS bf16* P = (const GAS bf16*)Pg; GAS bf16* MIX = (GAS bf16*)MIXg;
    const int gw = F.vcu * NWAVES + F.wave, NGW = F.G * NWAVES, lane = F.lane; const float nwv = nw[lane];
    for (int i0 = gw; i0 < MT * 4; i0 += 4 * NGW) {
        float o[4], g[4]; int mm[4], cc[4]; bool ok[4];
#pragma unroll
        for (int q = 0; q < 4; ++q) { const int it = i0 + q * NGW; ok[q] = it < MT * 4; const int itc = ok[q] ? it : i0; const int m = itc >> 2, c = (itc & 3) * 64 + lane; mm[q] = m; cc[q] = c;
            o[q] = YSa[(size_t)m * 256 + c] + YSb[(size_t)m * 256 + c]; g[q] = bf2f(P[(size_t)m * LDP + gate_off + c]); }
#pragma unroll
        for (int q = 0; q < 4; ++q) { const float ms = wave_sum(o[q] * o[q]) * (1.f / 64.f); const float y = o[q] * rsqrtf(ms + 1e-6f) * siluf_(g[q]) * nwv;
            if (ok[q]) MIX[(size_t)mm[q] * D + mix_off + cc[q]] = f2bf(y); }
    }
}
__device__ __forceinline__ void ph_lru_pre(Frame& F, const bf16* Pgen, const LruP& wp, bf16* LLAg, bf16* LBg, float* LSUMg) {
    const GAS bf16* P = (const GAS bf16*)Pgen; GAS bf16* LLA = (GAS bf16*)LLAg; GAS bf16* LB = (GAS bf16*)LBg; GAS float* LSUM = (GAS float*)LSUMg;
    const int w = F.wave, lane = F.lane, r = lane & 15, g = lane >> 4, tid = F.tid;
    LAS unsigned char* XM = F.lds + RING_OFF;
    LAS unsigned char* WA = F.lds + RING_OFF + 1 * IMG;
    LAS unsigned char* WX = F.lds + RING_OFF + 2 * IMG;
    LAS float* LAs = (LAS float*)(F.lds + RING_OFF + 3 * IMG);
    LAS float* BBs = LAs + 4096;
    const int dh = F.vcu & 7, d = dh >> 2, h = dh & 3;
    { const float* wa = wp.wa + (size_t)dh * 4096; const float* wx = wp.wx + (size_t)dh * 4096;
#pragma unroll
      for (int q = 0; q < 8; ++q) { const int e = tid + q * NTHR, i = e >> 6, j = e & 63; *(LAS bf16*)(WA + j * LSTR + 2 * i) = f2bf(wa[e]); *(LAS bf16*)(WX + j * LSTR + 2 * i) = f2bf(wx[e]); } }
    const int cc = tid & 63, sg = tid >> 6, c = h * 64 + cc;
    const float cb = wp.cb[c]; float cwv[4];
#pragma unroll
    for (int j = 0; j < 4; ++j) cwv[j] = wp.cw[j * 256 + c];
    for (int it = F.vcu; it < 272 * 8; it += F.G) {
        const int tbi = it >> 3; const TB tb = tb_of(tbi); const int L = tb.isx ? SEQ : CTXL;
        { const GAS bf16* pc = P + (size_t)tb.m0 * LDP + LRU_OFF + c; float rowv[11];
#pragma unroll
          for (int q = 0; q < 11; ++q) { const int s = 8 * sg - 2 + q, t = tb.t0 + s; const bool ok = t >= 0 && t < L; const int sc = ok ? s : 8 * sg; const float v = bf2f(pc[(ptrdiff_t)sc * LDP]); rowv[q] = ok ? v : 0.f; }
#pragma unroll
          for (int u = 0; u < 8; ++u) { const float xm = cb + rowv[u] * cwv[0] + rowv[u + 1] * cwv[1] + rowv[u + 2] * cwv[2] + rowv[u + 3] * cwv[3];
              *(LAS bf16*)(XM + (8 * sg + u) * LSTR + 2 * cc) = f2bf(xm); } }
        LDS_BARRIER();
        { const int tt = w & 3, jh = w >> 2;
#pragma unroll
          for (int jq = 0; jq < 2; ++jq) { const int jt = 2 * jh + jq;
              const f32x4 ra = nt_tile64(XM, 16 * tt, WA, 16 * jt, lane, zero4()), rx = nt_tile64(XM, 16 * tt, WX, 16 * jt, lane, zero4());
              const int j = 16 * jt + r, cj = h * 64 + j; const float ba = wp.ba[d * 256 + cj], bx = wp.bx[d * 256 + cj], lam8 = -8.f * softplusf_(-wp.lam[d * 256 + cj]);
#pragma unroll
              for (int i = 0; i < 4; ++i) { const int s = 16 * tt + 4 * g + i; const float xm = bf2f(*(const LAS bf16*)(XM + s * LSTR + 2 * j));
                  const float la = lam8 * sigmoidf_(ra[i] + ba); const float bb = __builtin_amdgcn_sqrtf(fmaxf(1.f - __expf(2.f * la), 0.f)) * sigmoidf_(rx[i] + bx) * xm;
                  LAs[s * 64 + j] = la; BBs[s * 64 + j] = bb;
                  const size_t o = ((size_t)d * MT + tb.m0 + s) * 256 + cj; LLA[o] = f2bf(la); LB[o] = f2bf(bb); } } }
        LDS_BARRIER();
        if (w == 0) { float sl = 0.f, hh = 0.f;
#pragma unroll 8
            for (int s = 0; s < 64; ++s) { const int tau = d ? 63 - s : s; const float la = LAs[tau * 64 + lane], bb = BBs[tau * 64 + lane]; sl += la; hh = __expf(la) * hh + bb; }
            LSUM[(((size_t)d * 272 + tbi) * 2 + 0) * 256 + h * 64 + lane] = sl; LSUM[(((size_t)d * 272 + tbi) * 2 + 1) * 256 + h * 64 + lane] = hh; }
        LDS_BARRIER();
    }
}
__device__ __forceinline__ void ph_lru_carry(Frame& F, const float* LSUMg, float* LCINg) {
    if (blockIdx.x >= 4) return;
    const GAS float* LSUM = (const GAS float*)LSUMg; GAS float* LCIN = (GAS float*)LCINg;
    const int e = blockIdx.x * NTHR + F.tid, c = e & 255, bd = e >> 8, d = bd & 1, b = bd >> 1;
    float hh = 0.f;
#pragma unroll 1
    for (int n0 = 0; n0 < 68; n0 += 17) { float sl[17], he[17]; int tb_[17];
#pragma unroll
        for (int u = 0; u < 17; ++u) { const int n = n0 + u; tb_[u] = n < 4 ? 256 + b * 4 + (d ? 3 - n : n) : b * 64 + (d ? 63 - (n - 4) : (n - 4));
            sl[u] = LSUM[(((size_t)d * 272 + tb_[u]) * 2 + 0) * 256 + c]; he[u] = LSUM[(((size_t)d * 272 + tb_[u]) * 2 + 1) * 256 + c]; }
#pragma unroll
        for (int u = 0; u < 17; ++u) { LCIN[((size_t)d * 272 + tb_[u]) * 256 + c] = hh; hh = __expf(sl[u]) * hh + he[u]; } }
}
__device__ __forceinline__ void ph_lru_post(Frame& F, const bf16* P, const bf16* LLA, const bf16* LB, const float* LCIN, bf16* MIX) {
    const int half = F.tid >> 8, c = F.tid & 255;
    for (int it = F.vcu; it < 136; it += F.G) { const int tbi = it * 2 + half; const TB tb = tb_of(tbi);
        float hf[64]; float hh = LCIN[((size_t)0 * 272 + tbi) * 256 + c];
        const GAS bf16* pa = (const GAS bf16*)(LLA + (size_t)tb.m0 * 256 + c); const GAS bf16* pb = (const GAS bf16*)(LB + (size_t)tb.m0 * 256 + c);
#pragma unroll
        for (int s0 = 0; s0 < 64; s0 += 8) { float la[8], bb[8];
            asm volatile("" : "+v"(pa), "+v"(pb));
#pragma unroll
            for (int u = 0; u < 8; ++u) { la[u] = bf2f(pa[u * 256]); bb[u] = bf2f(pb[u * 256]); }
#pragma unroll
            for (int u = 0; u < 8; ++u) { hh = __expf(la[u]) * hh + bb[u]; hf[s0 + u] = hh; }
            pa += 8 * 256; pb += 8 * 256; }
        hh = LCIN[((size_t)1 * 272 + tbi) * 256 + c];
        pa = (const GAS bf16*)(LLA + ((size_t)MT + tb.m0 + 56) * 256 + c); pb = (const GAS bf16*)(LB + ((size_t)MT + tb.m0 + 56) * 256 + c);
        const GAS bf16* pg = (const GAS bf16*)(P + (size_t)(tb.m0 + 56) * LDP + LRU_OFF + 256 + c); GAS bf16* pm = (GAS bf16*)(MIX + (size_t)(tb.m0 + 56) * D + 768 + c);
#pragma unroll
        for (int s0 = 56; s0 >= 0; s0 -= 8) { float la[8], bb[8], gt[8];
            asm volatile("" : "+v"(pa), "+v"(pb), "+v"(pg), "+v"(pm));
#pragma unroll
            for (int u = 0; u < 8; ++u) { la[u] = bf2f(pa[(7 - u) * 256]); bb[u] = bf2f(pb[(7 - u) * 256]); gt[u] = bf2f(pg[(7 - u) * LDP]); }
#pragma unroll
            for (int u = 0; u < 8; ++u) { const int s = s0 + 7 - u; hh = __expf(la[u]) * hh + bb[u];
                const float ge = 0.5f * gt[u] * (1.f + tanhf_(0.7978845608f * (gt[u] + 0.044715f * gt[u] * gt[u] * gt[u])));
                pm[(7 - u) * D] = f2bf((hf[s] + hh) * ge); }
            pa -= 8 * 256; pb -= 8 * 256; pg -= 8 * LDP; pm -= 8 * D; }
    }
}

__device__ __forceinline__ void ph_final_norm(Frame& F, const float* XR, const float* gain, float* out) {
    const int gw = F.vcu * NWAVES + F.wave, NGW = F.G * NWAVES, lane = F.lane;
    for (int m = gw; m < NX; m += NGW) {
        const float* src = XR + (size_t)m * D; f32x4 v[4]; float ss = 0.f;
#pragma unroll
        for (int j = 0; j < 4; ++j) { v[j] = *(const f32x4*)(src + 4 * lane + 256 * j); ss += (v[j].x * v[j].x + v[j].y * v[j].y) + (v[j].z * v[j].z + v[j].w * v[j].w); }
        ss = wave_sum(ss); const float rs = rsqrtf(ss * (1.f / D) + 1e-6f);
#pragma unroll
        for (int j = 0; j < 4; ++j) { const int ci = 4 * lane + 256 * j; *(f32x4*)(out + (size_t)m * D + ci) = v[j] * rs * *(const f32x4*)(gain + ci); }
    }
}

#define INP(i) ([&]() { int ii_ = (i); asm volatile("" : "+s"(ii_)); return (const float*)(const GAS float*)a.in[ii_]; }())
#ifndef PH_MASK
#define PH_MASK 0xfffff
#endif
#define IN(k) ((PH_MASK >> (k)) & 1)
#define SEAM() do { xcd_barrier(bar); if (PROBE_SEC == 100 + F.curk) F.tacc += clock64() - F.tph0; } while (0)
#define MOD ((float*)(GAS float*)(wsb + WS_MOD))
#define XN ((bf16*)(GAS bf16*)(wsb + WS_XN))
#define XR ((float*)(GAS float*)(wsb + WS_XR))
#define P ((bf16*)(GAS bf16*)(wsb + WS_P))
#define WIN_T ((bf16*)(GAS bf16*)(wsb + WS_WIN))
#define WOUT_T ((bf16*)(GAS bf16*)(wsb + WS_WOUT))
#define VF ((float*)(GAS float*)(wsb + WS_VF))
#define BON ((float*)(GAS float*)(wsb + WS_BON))
#define GG ((float*)(GAS float*)(wsb + WS_G))
#define YS ((float*)(GAS float*)(wsb + WS_YS))
#define SV ((float*)(GAS float*)(wsb + WS_SV))
#define SI ((float*)(GAS float*)(wsb + WS_SI))
#define WGU_T ((bf16*)(GAS bf16*)(wsb + WS_WGU))
#define WD_T ((bf16*)(GAS bf16*)(wsb + WS_WD))
#define HACT ((bf16*)(GAS bf16*)(wsb + WS_HACT))
#define Y ((bf16*)(GAS bf16*)(wsb + WS_Y))
#define DZ ((bf16*)(GAS bf16*)(wsb + WS_DZ))
#define BSC ((float*)(GAS float*)(wsb + WS_BSC))
#define YS2A ((float*)(GAS float*)(wsb + WS_BON))
#define YS2B ((float*)(GAS float*)(wsb + WS_YS2B))
#define LLA ((bf16*)(GAS bf16*)(wsb + WS_LLA))
#define LBB ((bf16*)(GAS bf16*)(wsb + WS_LB))
#define LSUM ((float*)(GAS float*)(wsb + WS_LSUM))
#define LCIN ((float*)(GAS float*)(wsb + WS_LCIN))
#define LIST ((unsigned*)(GAS unsigned*)(wsb + WS_LIST))
#define SLOTPOS ((int*)(GAS int*)(wsb + WS_SLOT))
#define SLOTG ((float*)(GAS float*)(wsb + WS_SLOTG))
#define RTW_T ((bf16*)(GAS bf16*)(wsb + WS_RTW))
#define RWT ((bf16*)(GAS bf16*)(wsb + WS_RWT))
#define MIX XN
#define PH() do { wsb = (GAS unsigned char*)ws; asm volatile("" : "+s"(wsb)); int t_ = threadIdx.x; asm volatile("" : "+v"(t_)); F.tid = t_; F.lane = t_ & 63; F.wave = __builtin_amdgcn_readfirstlane(t_ >> 6); half = t_ >> 8; c256 = t_ & 255; \
        shh = (LAS float*)(F.lds + RING_OFF + half * 8192); } while (0)

template <int l>
__device__ __forceinline__ void layer_body(Frame& F, const MArgs& a, const XcdBarrier& bar, unsigned char* ws) {
    GAS unsigned char* wsb = (GAS unsigned char*)ws; int half = 0, c256 = 0; LAS float* shh = nullptr;
        const float* MODl = MOD + (size_t)l * 5 * 6144;
        const float* xs = l == 0 ? INP(I_X) : XR; const float* cs = l == 0 ? INP(I_CTX) : XR + (size_t)NX * D;
        const int ntok = l == 0 ? MT : NX;
        if (IN(1) && l == 0) for (int rp_ = 0; rp_ < REPS(1); ++rp_) { PH(); F.curk = 1; if (PROBE_SEC >= 100) F.tph0 = clock64(); ph_norm_mod(F, xs, cs, INP(I_NMIX) + l * D, MODl, 0, XN, MT); __syncthreads();
            ph_convert_small(F, INP(I_WIN), INP(I_WVRES), INP(I_WOUT), WIN_T, WOUT_T, 1, 2); ph_convert_router(F, INP(I_RTW), RTW_T); ph_convert_rwkv(F, INP(I_RWW2), INP(I_RWA2), INP(I_RWV2), INP(I_RWG2), RWT); SEAM(); }
        if (IN(2)) for (int rp_ = 0; rp_ < REPS(2); ++rp_) { PH(); F.curk = 2; if (PROBE_SEC >= 100) F.tph0 = clock64(); pg8::DenseOrder S; S.init(XN, WIN_T + (size_t)l * LDP * D, MT, LDP, D, F.G, (int)blockIdx.x); pg8::EpiStoreBf16 E{P, LDP};
            pg8::gemm_phase<pg8::EpiStoreBf16, pg8::DenseOrder, true>(F.lds + RING_OFF, D, S, E); SEAM(); }
        float* LA = SI; float* LB = SI + (size_t)2 * MT * 256;
        if (IN(3)) for (int rp_ = 0; rp_ < REPS(3); ++rp_) { PH(); F.curk = 3; if (PROBE_SEC >= 100) F.tph0 = clock64(); const RwP rwp{INP(I_RWMU) + l * 960, INP(I_RWW0) + l * 512, INP(I_RWW2) + l * 2 * 32 * 256, INP(I_RWA0) + l * 512, INP(I_RWA2) + l * 2 * 32 * 256, INP(I_RWG2) + l * 64 * 256, INP(I_RWKK) + l * 256, INP(I_RWKA) + l * 256,
                      INP(I_RWRK) + l * 256, INP(I_RWV0), INP(I_RWV2)};
            ph_rwkv_pre(F, P, rwp, RWT, l, VF, SV, GG, BSC, (unsigned char*)SI); SEAM(); }
        if (IN(4)) for (int rp_ = 0; rp_ < REPS(4); ++rp_) { PH(); F.curk = 4; if (PROBE_SEC >= 100) F.tph0 = clock64();
            if (blockIdx.x < 32) { TSECN_BEGIN(30) dplr_scan_seq(F, (const unsigned char*)SI, (int)blockIdx.x, YS, YS + (size_t)MT * 256); TSECN_END(30) }
            else { TSECN_BEGIN(31) const int vcu0 = F.vcu, G0 = F.G; F.vcu = (int)blockIdx.x - 32; F.G = G0 - 32;
                { const LruP lrp{INP(I_LCW) + l * 4 * 256, INP(I_LCB) + l * 256, INP(I_LWA) + (size_t)l * 2 * 4 * 64 * 64, INP(I_LBA) + l * 512, INP(I_LWX) + (size_t)l * 2 * 4 * 64 * 64, INP(I_LBX) + l * 512, INP(I_LLAM) + l * 512};
                  ph_lru_pre(F, P, lrp, LLA, LBB, LSUM); }
                __syncthreads(); build_rope(F); __syncthreads(); ph_ret_pre(F, P, INP(I_RETL) + l * 8, DZ);
                F.vcu = vcu0; F.G = G0; TSECN_END(31) }
            SEAM(); }
        if (IN(5)) for (int rp_ = 0; rp_ < REPS(5); ++rp_) { PH(); F.curk = 5; if (PROBE_SEC >= 100) F.tph0 = clock64();
            ph_gdn_pre(F, P, INP(I_GCW) + l * 4 * 768, INP(I_GALOG) + l * 8, INP(I_GDT) + l * 8, (unsigned char*)SI);
            ph_ret_prefix(F, INP(I_RETL) + l * 8, DZ); ph_lru_carry(F, LSUM, LCIN); SEAM(); }
        if (IN(8)) for (int rp_ = 0; rp_ < REPS(8); ++rp_) { PH(); F.curk = 8; if (PROBE_SEC >= 100) F.tph0 = clock64();
            if (blockIdx.x < 32) { TSECN_BEGIN(30) dplr_scan_seq(F, (const unsigned char*)SI, (int)blockIdx.x, YS2A, YS2B); TSECN_END(30) }
            else { TSECN_BEGIN(32) const int vcu0 = F.vcu, G0 = F.G; F.vcu = (int)blockIdx.x - 32; F.G = G0 - 32;
                ph_rwkv_post(F, YS, BSC, SV, GG, INP(I_RWLNW) + l * 256, INP(I_RWLNB) + l * 256, MIX);
                build_rope(F); __syncthreads(); ph_ret_post(F, P, INP(I_RETL) + l * 8, DZ, MIX); __syncthreads(); ph_lru_post(F, P, LLA, LBB, LCIN, MIX);
                F.vcu = vcu0; F.G = G0; TSECN_END(32) }
            SEAM(); }
        if (IN(9)) for (int rp_ = 0; rp_ < REPS(9); ++rp_) { PH(); F.curk = 9; if (PROBE_SEC >= 100) F.tph0 = clock64(); ph_hnorm_post(F, YS2A, YS2B, P, GDN_OFF + 784, INP(I_GNW) + l * 64, MIX, 512); SEAM(); }
        if (IN(12)) for (int rp_ = 0; rp_ < REPS(12); ++rp_) { PH(); F.curk = 12; if (PROBE_SEC >= 100) F.tph0 = clock64(); pg8::DenseOrder S; S.init(MIX, WOUT_T + (size_t)l * D * D, l == 0 ? MT : NX  , D, D, F.G, (int)blockIdx.x); pg8::EpiResidual E{xs, cs, MODl, XR};
            pg8::gemm_phase<pg8::EpiResidual, pg8::DenseOrder, true>(F.lds + RING_OFF, D, S, E); SEAM(); }
        if (IN(13)) for (int rp_ = 0; rp_ < REPS(13); ++rp_) { PH(); F.curk = 13; if (PROBE_SEC >= 100) F.tph0 = clock64(); ph_route(F, XR, INP(I_NFFN) + l * D, MODl, RTW_T + (size_t)l * 2 * 64 * 1024, INP(I_RTB) + l * NE, XN, l, LIST, SLOTPOS, SLOTG, ntok); __syncthreads();
            { ph_convert_experts(F, INP(I_EWG) + (size_t)l * NE * D * EFF, INP(I_EWU) + (size_t)l * NE * D * EFF, INP(I_EWD) + (size_t)l * NE * EFF * D,
                               INP(I_SWG) + (size_t)l * D * EFF, INP(I_SWU) + (size_t)l * D * EFF, INP(I_SWD) + (size_t)l * EFF * D, WGU_T, WD_T); }
            SEAM(); }
        if (IN(14)) for (int rp_ = 0; rp_ < REPS(14); ++rp_) { PH(); F.curk = 14; if (PROBE_SEC >= 100) F.tph0 = clock64(); moe_build_tab(F, l, ntok); MoeTab T = moe_tab(F);
            pg8::MoeOrder1 S{XN, WGU_T, LIST, T, F.G, F.vcu  , T.ups[65] * 2}; pg8::EpiSwiglu E{HACT};
            pg8::gemm_phase<pg8::EpiSwiglu, pg8::MoeOrder1, true>(F.lds + RING_OFF, D, S, E); SEAM(); }
        if (IN(15)) for (int rp_ = 0; rp_ < REPS(15); ++rp_) { PH(); F.curk = 15; if (PROBE_SEC >= 100) F.tph0 = clock64(); moe_build_tab(F, l, ntok); MoeTab T = moe_tab(F);
            pg8::MoeOrder2 S{HACT, WD_T, T, F.G, F.vcu, T.ups[65] * 4}; pg8::EpiDown E{Y, XR, MODl};
            int k2 = EFF; asm volatile("" : "+s"(k2));
            pg8::gemm_phase<pg8::EpiDown, pg8::MoeOrder2, true>(F.lds + RING_OFF, k2, S, E); SEAM(); }
        if (IN(16)) for (int rp_ = 0; rp_ < REPS(16); ++rp_) { PH(); F.curk = 16; if (PROBE_SEC >= 100) F.tph0 = clock64(); moe_build_tab(F, l, ntok);
            if (l == 0) ph_combine_norm<false>(F, Y, SLOTPOS, SLOTG, MODl, XR, ntok, INP(I_NMIX) + D, MOD + (size_t)5 * 6144, XN, nullptr);
            else ph_combine_norm<true>(F, Y, SLOTPOS, SLOTG, MODl, XR, ntok, INP(I_NFIN), nullptr, nullptr, a.out);
            if (l == 0) SEAM(); }
    }

__global__ void __launch_bounds__(NTHR, 2) mega(MArgs a) {
    extern __shared__ __attribute__((aligned(16))) unsigned char lds_raw[];
    Frame F; F.lds = (LAS unsigned char*)lds_raw; F.MISC = (volatile LAS unsigned*)(F.lds + MISC_OFF);
    F.tid = threadIdx.x; F.lane = F.tid & 63; F.wave = __builtin_amdgcn_readfirstlane(F.tid >> 6); F.tacc = 0ull;
    F.G = gridDim.x; { const int bx = blockIdx.x; F.vcu = (F.G % 8 == 0) ? (bx % 8) * (F.G / 8) + bx / 8 : bx; }
    unsigned char* ws = a.ws; F.ctl = (gu32*)ws;
    for (int u = F.tid; u < (LDS_BYTES - LDSCTL_OFF) / 4; u += NTHR) ((LAS unsigned*)(F.lds + LDSCTL_OFF))[u] = 0u;
    __syncthreads();
    XcdBarrier bar = xcd_barrier_post((unsigned*)(F.ctl + CW_BAR) + a.bar_region * XCD_BAR_WORDS, F.MISC + 8);
    GAS unsigned char* wsb = (GAS unsigned char*)ws;
    int half = 0, c256 = 0; LAS float* shh = nullptr;

    if (IN(0)) for (int rp_ = 0; rp_ < REPS(0); ++rp_) { PH(); F.curk = 0; if (PROBE_SEC >= 100) F.tph0 = clock64(); ph_mod(F, INP(I_C), INP(I_CCTX), INP(I_ADAW), INP(I_ADAB), MOD); ph_convert_small(F, INP(I_WIN), INP(I_WVRES), INP(I_WOUT), WIN_T, WOUT_T, 0, 1);     SEAM(); }
    layer_body<0>(F, a, bar, ws);
    layer_body<1>(F, a, bar, ws);
    if (PROBE_SEC >= 0) { const unsigned long long t0_ = clock64(); while (clock64() - t0_ < F.tacc) __builtin_amdgcn_s_sleep(4); }
#undef PH
#undef MOD
#undef XN
#undef XR
#undef P
#undef WIN_T
#undef WOUT_T
#undef VF
#undef BON
#undef GG
#undef YS
#undef SV
#undef SI
#undef WGU_T
#undef WD_T
#undef HACT
#undef Y
#undef DZ
#undef BSC
#undef YS2A
#undef YS2B
#undef LLA
#undef LBB
#undef LSUM
#undef LCIN
#undef LIST
#undef SLOTPOS
#undef SLOTG
#undef RTW_T
#undef RWT
#undef MIX
#undef IN
#undef SEAM
}

extern "C" void kernel_launch(void* const* d_in, const int* in_sizes, int n_in, void* d_out, int out_size, void* d_ws, size_t ws_size, hipStream_t stream) {
    static int grid = 0;
    if (grid == 0) {
        if (n_in != I_N || ws_size < WS_END) { fprintf(stderr, "kernel_launch: bad n_in %d or ws %zu\n", n_in, ws_size); grid = -1; return; }
        int dev = 0, cus = 0;
        if (hipGetDevice(&dev) != hipSuccess || hipDeviceGetAttribute(&cus, hipDeviceAttributeMultiprocessorCount, dev) != hipSuccess) { grid = -1; return; }
        if (hipFuncSetAttribute((const void*)mega, hipFuncAttributeMaxDynamicSharedMemorySize, LDS_BYTES) != hipSuccess) { grid = -1; return; }
        int per_cu = 0; (void)hipOccupancyMaxActiveBlocksPerMultiprocessor(&per_cu, (const void*)mega, NTHR, LDS_BYTES); (void)hipGetLastError();
        grid = cus;
    }
    if (grid < 0) return;
    unsigned char* ws = (unsigned char*)d_ws;
    (void)hipMemsetAsync(ws, 0, CTL_ZERO_BYTES, stream);
    MArgs ma{}; for (int i = 0; i < I_N; ++i) ma.in[i] = (const float*)d_in[i]; ma.out = (float*)d_out; ma.ws = ws;
    ma.ph_lo = 0; ma.ph_hi = 18; ma.l_lo = 0; ma.l_hi = 2; ma.bar_region = 0;
    hipLaunchKernelGGL(mega, dim3(grid), dim3(NTHR), LDS_BYTES, stream, ma);
}
```

```cpp
#include <hip/hip_runtime.h>
#include <cstdio>
#include <cstdint>

typedef unsigned short bf16;
#ifndef PROBE_SEC
#define PROBE_SEC -1
#endif
__device__ unsigned long long g_tsec_dummy;
#define TSEC_BEGIN(id) unsigned long long ts0_##id = 0; if ((id) == PROBE_SEC) { asm volatile("s_waitcnt vmcnt(0) lgkmcnt(0)" ::: "memory"); ts0_##id = clock64(); }
#define TSECN_BEGIN(id) unsigned long long tn0_##id = 0; if ((id) == PROBE_SEC) { tn0_##id = clock64(); }
#define TSECN_END(id) if ((id) == PROBE_SEC) { F.tacc += clock64() - tn0_##id; }
#define TSEC_END(id) if ((id) == PROBE_SEC) { asm volatile("s_waitcnt vmcnt(0) lgkmcnt(0)" ::: "memory"); F.tacc += clock64() - ts0_##id; }
#ifndef PROBE_MASK
#define PROBE_MASK 0
#endif
#define REPS(k) (((PROBE_MASK >> (k)) & 1) ? 2 : 1)
#define RR(k) ([]() { int r_ = REPS(k); asm volatile("" : "+s"(r_)); return r_; }())
__device__ __forceinline__ float bf2f(bf16 v) { return __uint_as_float(((unsigned)v) << 16); }
typedef float f32x2_ __attribute__((ext_vector_type(2)));
typedef __bf16 bf16x2_ __attribute__((ext_vector_type(2)));
__device__ __forceinline__ unsigned cvtpk_bf16(float lo, float hi) { f32x2_ v = {lo, hi}; bf16x2_ b = __builtin_convertvector(v, bf16x2_); return __builtin_bit_cast(unsigned, b); }
__device__ __forceinline__ bf16 f2bf(float f) { return (bf16)(cvtpk_bf16(f, f) & 0xffffu); }

constexpr int D = 1024, NB = 4, SEQ = 4096, CTXL = 256;
constexpr int NX = NB * SEQ;
constexpr int NC = NB * CTXL;
constexpr int MT = NX + NC;
constexpr int NIN = 3536, NINV = 3568, LDP = 3584;
constexpr int RW_OFF = 0, RET_OFF = 960, GDN_OFF = 1984, LRU_OFF = 3024, VRES_OFF = 3536;
constexpr int NE = 64, TOPK = 8, EFF = 256;
constexpr int NSTEP = CTXL + SEQ;

constexpr size_t MiB = 1u << 20;
constexpr size_t WS_MOD = 1 * MiB;
constexpr size_t WS_XN = 2 * MiB;
constexpr size_t WS_XR = 36 * MiB;
constexpr size_t WS_VF = 104 * MiB;
constexpr size_t WS_LIST = 121 * MiB;
constexpr size_t WS_SLOTG = 126 * MiB;
constexpr size_t WS_RTW = 127 * MiB;
constexpr size_t WS_RWT = 128 * MiB;
constexpr size_t WS_SLOT = 130 * MiB;
constexpr size_t WS_WIN = 131 * MiB;
constexpr size_t WS_WOUT = 145 * MiB;
constexpr size_t WS_SI = 149 * MiB;
constexpr size_t WS_LLA = 253 * MiB;
constexpr size_t WS_LB = 270 * MiB;
constexpr size_t WS_LSUM = 287 * MiB;
constexpr size_t WS_LCIN = 289 * MiB;
constexpr size_t WS_BSC = 290 * MiB;
constexpr size_t WS_YS2B = 291 * MiB;
constexpr size_t WS_P = 319 * MiB;
constexpr size_t WS_BON = 438 * MiB;
constexpr size_t WS_G = 455 * MiB;
constexpr size_t WS_YS = 472 * MiB;
constexpr size_t WS_SV = 506 * MiB;
constexpr size_t WS_DZ = 523 * MiB;
constexpr size_t WS_WD = 149 * MiB;
constexpr size_t WS_HACT = 182 * MiB;
constexpr size_t WS_Y = 267 * MiB;
constexpr size_t WS_WGU = 267 * MiB;
constexpr size_t WS_END = 540 * MiB;

struct Row { int b, t, L, isx; };
__device__ __forceinline__ Row row_of(int m) { Row r; if (m < NX) { r.b = m >> 12; r.t = m & 4095; r.L = SEQ; r.isx = 1; } else { int q = m - NX; r.b = q >> 8; r.t = q & 255; r.L = CTXL; r.isx = 0; } return r; }
__device__ __forceinline__ float frcp_(float x) { return __builtin_amdgcn_rcpf(x); }
__device__ __forceinline__ float sigmoidf_(float x) { return frcp_(1.f + __expf(-x)); }
__device__ __forceinline__ float softplusf_(float x) { return x > 20.f ? x : __logf(1.f + __expf(x)); }
__device__ __forceinline__ float siluf_(float x) { return x * frcp_(1.f + __expf(-x)); }
__device__ __forceinline__ float tanhf_(float x) { const float xc = fminf(fmaxf(x, -15.f), 15.f); return 1.f - 2.f * frcp_(1.f + __expf(2.f * xc)); }
#define DPPF(v, ctrl) __int_as_float(__builtin_amdgcn_update_dpp(0, __float_as_int(v), (ctrl), 0xf, 0xf, true))
__device__ __forceinline__ float wave_sum(float v) {
    v += DPPF(v, 0xB1); v += DPPF(v, 0x4E); v += DPPF(v, 0x141); v += DPPF(v, 0x140);
    return (__int_as_float(__builtin_amdgcn_readlane(__float_as_int(v), 0)) + __int_as_float(__builtin_amdgcn_readlane(__float_as_int(v), 16))) +
           (__int_as_float(__builtin_amdgcn_readlane(__float_as_int(v), 32)) + __int_as_float(__builtin_amdgcn_readlane(__float_as_int(v), 48)));
}


__device__ __forceinline__ float* si_ptr(float* SI, int d, int m, int h, int vec) { return SI + ((((size_t)d * MT + m) * 4 + h) * 5 + vec) * 64; }

struct RwP { const float *mu, *w0, *w2, *a0, *a2, *g2, *kk, *ka, *rk, *v0, *v2; };

__device__ __forceinline__ int step_row(int b, int d, int s) { if (s < CTXL) { const int tc = d ? CTXL - 1 - s : s; return NX + b * CTXL + tc; } const int tx = d ? SEQ - 1 - (s - CTXL) : (s - CTXL); return b * SEQ + tx; }
struct LruP { const float *cw, *cb, *wa, *ba, *wx, *bx, *lam; };


enum { I_X = 0, I_C, I_CTX, I_CCTX, I_ADAW, I_ADAB, I_NMIX, I_NFFN, I_NFIN, I_WIN, I_WVRES, I_WOUT, I_RWMU, I_RWW0, I_RWW2, I_RWA0, I_RWA2, I_RWG2, I_RWKK, I_RWKA, I_RWRK, I_RWLNW, I_RWLNB, I_RWV0, I_RWV2,
       I_RETL, I_GCW, I_GALOG, I_GDT, I_GNW, I_LCW, I_LCB, I_LWA, I_LBA, I_LWX, I_LBX, I_LLAM, I_RTW, I_RTB, I_EWG, I_EWU, I_EWD, I_SWG, I_SWU, I_SWD, I_N };
#define GAS __attribute__((address_space(1)))
#define LAS __attribute__((address_space(3)))
typedef unsigned v4u __attribute__((ext_vector_type(4)));
typedef float f32x4 __attribute__((ext_vector_type(4)));
typedef short bf16x8 __attribute__((ext_vector_type(8)));
typedef GAS unsigned gu32;
#define RLX_AGENT __ATOMIC_RELAXED, __HIP_MEMORY_SCOPE_AGENT
#define LDS_WAIT() asm volatile("s_waitcnt lgkmcnt(0)" ::: "memory")
#define VM_WAIT() asm volatile("s_waitcnt vmcnt(0)" ::: "memory")
#define LDS_BARRIER() do { asm volatile("s_waitcnt lgkmcnt(0)" ::: "memory"); __builtin_amdgcn_s_barrier(); asm volatile("" ::: "memory"); } while (0)
__device__ __forceinline__ unsigned pk2(float lo, float hi) { return cvtpk_bf16(lo, hi); }
__device__ __forceinline__ unsigned long long pack4(f32x4 v) { return (unsigned long long)pk2(v.x, v.y) | ((unsigned long long)pk2(v.z, v.w) << 32); }

namespace pg8 {
#define PG8_LAS __attribute__((address_space(3)))
typedef unsigned short bf16_t;
typedef unsigned u32x4 __attribute__((ext_vector_type(4)));
constexpr int BM = 256, BK = 64, HALF = 128, HTB = HALF * BK * 2, STAGE_BYTES = 8 * HTB, NXCD = 8, WGM = 8;
__host__ __device__ __forceinline__ int lds_byte(int r, int c) { const int st = (r >> 4) * 2 + (c >> 5), rr = r & 15, cc = c & 31, ob = rr * 64 + cc * 2; return st * 1024 + (ob ^ (((ob >> 9) & 1) << 5)); }
__host__ __device__ __forceinline__ void stage_rc(int b, int& R, int& C) { const int st = b / 1024, sb = b % 1024, swz = sb ^ (((sb >> 9) & 1) << 5); R = (st >> 1) * 16 + swz / 64; C = (st & 1) * 32 + (swz % 64) / 2; }
__host__ __device__ __forceinline__ int perm32(int rho) { const int n = rho >> 4, i = rho & 15; return 8 * (i >> 2) + 4 * n + (i & 3); }
__device__ __forceinline__ unsigned cvt_pk_bf16(float lo, float hi) { unsigned r; asm volatile("v_cvt_pk_bf16_f32 %0, %1, %2" : "=v"(r) : "v"(lo), "v"(hi)); return r; }

struct Unit { const char* A; const char* B; int pm, pn, e, nrows, rb; };

struct DenseOrder {
    static constexpr bool GATHER = false;
    const bf16_t* A; const bf16_t* Bt; int K, nM, nN, nwg, G, c;
    __device__ void init(const bf16_t* A_, const bf16_t* Bt_, int M, int N, int K_, int G_, int c_) { A = A_; Bt = Bt_; K = K_; nM = M / BM; nN = N / BM; nwg = nM * nN; G = G_; c = c_; }
    __device__ bool next(int i, Unit& u) const {
        const long L = (long)i * G + c; if (L >= nwg) return false;
        int wgid = (int)L; { const int q = nwg / NXCD, r = nwg % NXCD, xcd = wgid % NXCD, off = wgid / NXCD; wgid = (xcd < r ? xcd * (q + 1) : r * (q + 1) + (xcd - r) * q) + off; }
        const int nig = WGM * nN, gid = wgid / nig, fm = gid * WGM, gsz = (nM - fm) < WGM ? (nM - fm) : WGM;
        u.pm = fm + ((wgid % nig) % gsz); u.pn = (wgid % nig) / gsz; u.e = 0; u.nrows = BM; u.rb = 0;
        u.A = (const char*)A + (size_t)u.pm * BM * K * 2; u.B = (const char*)Bt + (size_t)u.pn * BM * K * 2; return true;
    }
    __device__ __forceinline__ unsigned a_off(const Unit&, int h, int R, int C) const { return (unsigned)((h * HALF + R) * K + C) * 2u; }
};

template <class Epi, class Sched, bool ALIGN_EPI = false>
__device__ __forceinline__ void gemm_phase(PG8_LAS unsigned char* lds, const int K, const Sched& S, const Epi& E) {
    int tid = threadIdx.x; asm volatile("" : "+v"(tid));
    const int wid = __builtin_amdgcn_readfirstlane(tid >> 6), lane = tid & 63, wr = wid >> 2, wc = wid & 3, fr = lane & 15, fq = lane >> 4;
    const int nt = K / BK;
    unsigned voffB[2];
#pragma unroll
    for (int i = 0; i < 2; ++i) { int R, C; stage_rc(tid * 16 + i * 8192, R, C); const int Rb = Epi::PERM ? ((R & ~31) + perm32(R & 31)) : R; voffB[i] = (unsigned)(Rb * K + C) * 2u; }
    const size_t kstep = (size_t)(BK * 2);
    const size_t hstep = (size_t)HALF * K * 2;
    const unsigned ldsw = (unsigned)wid * 1024u;
    const int aoff = lds_byte(wr * 64 + fr, fq * 8), boff = lds_byte(wc * 32 + fr, fq * 8);
#define PG8_SA(b, h) (((b) * 2 + (h)) * HTB)
#define PG8_SB(b, h) ((4 + (b) * 2 + (h)) * HTB)
#define PG8_STAGE(bufoff, gbase, voff) do { _Pragma("unroll") for (int _i = 0; _i < 2; ++_i) \
        __builtin_amdgcn_global_load_lds((const unsigned*)((const char*)(gbase) + (voff)[_i]), (PG8_LAS unsigned*)(lds + (bufoff) + ldsw + _i * 8192), 16, 0, 0); } while (0)
#define PG8_LDA(dst, b, h) do { _Pragma("unroll") for (int m = 0; m < 4; ++m) _Pragma("unroll") for (int k = 0; k < 2; ++k) dst[m][k] = *(const PG8_LAS bf16x8*)(lds + PG8_SA(b, h) + aoff + m * 2048 + k * 1024); } while (0)
#define PG8_LDB(dst, b, h) do { _Pragma("unroll") for (int n = 0; n < 2; ++n) _Pragma("unroll") for (int k = 0; k < 2; ++k) dst[n][k] = *(const PG8_LAS bf16x8*)(lds + PG8_SB(b, h) + boff + n * 2048 + k * 1024); } while (0)
#define PG8_MMA(ai, bj, At, Bt) do { __builtin_amdgcn_s_setprio(1); _Pragma("unroll") for (int m = 0; m < 4; ++m) _Pragma("unroll") for (int n = 0; n < 2; ++n) _Pragma("unroll") for (int k = 0; k < 2; ++k) \
        acc[ai][bj][m][n] = __builtin_amdgcn_mfma_f32_16x16x32_bf16(Bt[n][k], At[m][k], acc[ai][bj][m][n], 0, 0, 0); __builtin_amdgcn_s_setprio(0); } while (0)
#define PG8_WAIT_V(n) asm volatile("s_waitcnt vmcnt(" #n ")" ::: "memory")
#define PG8_WAIT_L(n) asm volatile("s_waitcnt lgkmcnt(" #n ")" ::: "memory")
#define PG8_BAR __builtin_amdgcn_s_barrier()
#define PG8_SCHED __builtin_amdgcn_sched_barrier(0)
    Unit cur, nxt; int ui = 0;
    if (!S.next(0, cur)) return;
    f32x4 acc[2][2][4][2];
#pragma unroll
    for (int a = 0; a < 2; ++a)
#pragma unroll
        for (int b = 0; b < 2; ++b)
#pragma unroll
            for (int m = 0; m < 4; ++m)
#pragma unroll
                for (int n = 0; n < 2; ++n) acc[a][b][m][n] = (f32x4){0.f, 0.f, 0.f, 0.f};
    bf16x8 At[4][2], B0[2][2], B1[2][2];
    unsigned cv0[2], cv1[2], nv0[2], nv1[2];
#pragma unroll
    for (int i = 0; i < 2; ++i) { int R, C; stage_rc(tid * 16 + i * 8192, R, C); cv0[i] = S.a_off(cur, 0, R, C); cv1[i] = S.a_off(cur, 1, R, C); nv0[i] = cv0[i]; nv1[i] = cv1[i]; }
    const char* cA = cur.A; const char* cB = cur.B;
    PG8_STAGE(PG8_SB(0, 0), cB, voffB); PG8_STAGE(PG8_SB(0, 1), cB + hstep, voffB); PG8_STAGE(PG8_SA(0, 0), cA, cv0); PG8_STAGE(PG8_SA(0, 1), cA, cv1);
    if (wr == 1) PG8_BAR;
    PG8_WAIT_V(2); PG8_BAR;
    PG8_STAGE(PG8_SB(1, 0), cB + kstep, voffB); PG8_STAGE(PG8_SA(1, 0), cA + kstep, cv0); PG8_STAGE(PG8_SB(1, 1), cB + hstep + kstep, voffB);
    PG8_WAIT_V(6); PG8_BAR;
    for (;;) {
        const bool has_next = S.next(ui + 1, nxt);
        const char* nA = has_next ? nxt.A : cA; const char* nB = has_next ? nxt.B : cB;
        if constexpr (Sched::GATHER) {
        if (has_next) {
#pragma unroll
            for (int i = 0; i < 2; ++i) { int tt = threadIdx.x; asm volatile("" : "+v"(tt)); int R, C; stage_rc(tt * 16 + i * 8192, R, C); nv0[i] = S.a_off(nxt, 0, R, C); nv1[i] = S.a_off(nxt, 1, R, C); } }
        else {
#pragma unroll
            for (int i = 0; i < 2; ++i) { nv0[i] = cv0[i]; nv1[i] = cv1[i]; } } }
        for (int t = 0; t < nt; t += 2) {
            const bool last = (t == nt - 2);
            const char* a1 = cA + (size_t)(t + 1) * kstep;
            const char* a2 = last ? nA : cA + (size_t)(t + 2) * kstep; const char* b2 = last ? nB : cB + (size_t)(t + 2) * kstep;
            const char* a3 = a2 + kstep; const char* b3 = b2 + kstep;
            unsigned x0[2], x1[2];
#pragma unroll
            for (int i = 0; i < 2; ++i) { if constexpr (Sched::GATHER) { x0[i] = last ? nv0[i] : cv0[i]; x1[i] = last ? nv1[i] : cv1[i]; } else { x0[i] = cv0[i]; x1[i] = cv1[i]; } }
            PG8_LDB(B0, 0, 0); PG8_LDB(B1, 0, 1); PG8_SCHED; PG8_LDA(At, 0, 0); PG8_STAGE(PG8_SA(1, 1), a1, cv1);
            PG8_WAIT_V(8); PG8_WAIT_L(0); PG8_BAR; PG8_MMA(0, 0, At, B0); PG8_MMA(0, 1, At, B1); PG8_BAR; PG8_SCHED;
            PG8_LDA(At, 0, 1); PG8_STAGE(PG8_SB(0, 0), b2, voffB); PG8_STAGE(PG8_SB(0, 1), b2 + hstep, voffB); PG8_STAGE(PG8_SA(0, 0), a2, x0);
            PG8_WAIT_V(8); PG8_WAIT_L(0); PG8_BAR; PG8_MMA(1, 0, At, B0); PG8_MMA(1, 1, At, B1); PG8_BAR; PG8_SCHED;
            PG8_LDB(B0, 1, 0); PG8_LDB(B1, 1, 1); PG8_SCHED; PG8_LDA(At, 1, 0); PG8_STAGE(PG8_SA(0, 1), a2, x1);
            PG8_WAIT_V(8); PG8_WAIT_L(0); PG8_BAR; PG8_MMA(0, 0, At, B0); PG8_MMA(0, 1, At, B1); PG8_BAR; PG8_SCHED;
            PG8_LDA(At, 1, 1); PG8_STAGE(PG8_SB(1, 0), b3, voffB); PG8_STAGE(PG8_SB(1, 1), b3 + hstep, voffB); PG8_STAGE(PG8_SA(1, 0), a3, x0);
            PG8_WAIT_V(8); PG8_WAIT_L(0); PG8_BAR; PG8_MMA(1, 0, At, B0); PG8_MMA(1, 1, At, B1); PG8_BAR; PG8_SCHED;
        }
        if constexpr (ALIGN_EPI) { if (wr == 0) PG8_BAR; }
        E(acc, cur, wr, wc, fr, fq);
        if (!has_next) break;
#pragma unroll
        for (int a = 0; a < 2; ++a)
#pragma unroll
            for (int b = 0; b < 2; ++b)
#pragma unroll
                for (int m = 0; m < 4; ++m)
#pragma unroll
                    for (int n = 0; n < 2; ++n) acc[a][b][m][n] = (f32x4){0.f, 0.f, 0.f, 0.f};
        cur = nxt; cA = nA; cB = nB; ++ui;
        if constexpr (Sched::GATHER) {
#pragma unroll
            for (int i = 0; i < 2; ++i) { cv0[i] = nv0[i]; cv1[i] = nv1[i]; } }
        if constexpr (ALIGN_EPI) { if (wr == 1) PG8_BAR; }
    }
    PG8_WAIT_V(0);
    if constexpr (!ALIGN_EPI) { if (wr == 0) PG8_BAR; }
    PG8_BAR;
#undef PG8_SA
#undef PG8_SB
#undef PG8_STAGE
#undef PG8_LDA
#undef PG8_LDB
#undef PG8_MMA
#undef PG8_WAIT_V
#undef PG8_WAIT_L
#undef PG8_BAR
#undef PG8_SCHED
}

struct EpiStoreBf16 {
    static constexpr bool PERM = true;
    bf16_t* O; int ldc;
    __device__ __forceinline__ void operator()(const f32x4 (&acc)[2][2][4][2], const Unit& u, int wr, int wc, int fr, int fq) const {
        asm volatile("" : "+v"(fr), "+v"(fq));
        const int row0 = u.pm * BM + wr * 64 + fr, col0 = u.pn * BM + wc * 32 + 8 * fq;
#pragma unroll
        for (int ai = 0; ai < 2; ++ai)
#pragma unroll
            for (int m = 0; m < 4; ++m) { bf16_t* rowp = O + (size_t)(row0 + ai * HALF + m * 16) * ldc + col0;
#pragma unroll
                for (int bj = 0; bj < 2; ++bj) { const f32x4 v0 = acc[ai][bj][m][0], v1 = acc[ai][bj][m][1];
                    u32x4 w; w.x = cvt_pk_bf16(v0[0], v0[1]); w.y = cvt_pk_bf16(v0[2], v0[3]); w.z = cvt_pk_bf16(v1[0], v1[1]); w.w = cvt_pk_bf16(v1[2], v1[3]);
                    *(u32x4*)(rowp + bj * HALF) = w; } }
    }
};
struct EpiResidual {
    static constexpr bool PERM = false;
    const float* xs; const float* cs; const float* MODl; float* XR;
    __device__ __forceinline__ void operator()(const f32x4 (&acc)[2][2][4][2], const Unit& u, int wr, int wc, int fr, int fq) const {
        asm volatile("" : "+v"(fr), "+v"(fq));
        const int row0 = u.pm * BM + wr * 64 + fr, col0 = u.pn * BM + wc * 32 + 4 * fq;
#pragma unroll
        for (int ai = 0; ai < 2; ++ai)
#pragma unroll
            for (int m = 0; m < 4; ++m) { const int row = row0 + ai * HALF + m * 16;
                const float* xin = row < NX ? xs + (size_t)row * D : cs + (size_t)(row - NX) * D; const int rb = row < NX ? (row >> 12) : 4;
                const float* md = MODl + (size_t)rb * 6144 + 2 * 1024; float* o = XR + (size_t)row * D;
#pragma unroll
                for (int bj = 0; bj < 2; ++bj)
#pragma unroll
                    for (int n = 0; n < 2; ++n) { const int c = col0 + bj * HALF + n * 16; const f32x4 xi = *(const f32x4*)(xin + c), mm = *(const f32x4*)(md + c); *(f32x4*)(o + c) = xi + mm * acc[ai][bj][m][n]; } }
    }
};
}

#define XB_TMO      128
#define XB_XCNT(j)  (256  + 64 * (j))
#define XB_XSUB(j)  (1280 + 64 * (j))
#define XB_XGEN(j)  (2304 + 64 * (j))
#define XB_TOP      3328
#define XB_TOPGEN   3392
#define XCD_BAR_WORDS 3456
#define XB_SPIN_CAP (1u << 22)
__device__ __forceinline__ unsigned xb_ld(unsigned* p)              { return __hip_atomic_load(p, __ATOMIC_RELAXED, __HIP_MEMORY_SCOPE_AGENT); }
__device__ __forceinline__ unsigned xb_add(unsigned* p, unsigned v) { return __hip_atomic_fetch_add(p, v, __ATOMIC_RELAXED, __HIP_MEMORY_SCOPE_AGENT); }
__device__ __forceinline__ unsigned xb_xcc_id() { return (unsigned)__builtin_amdgcn_s_getreg((3 << 11) | 20) & 0xFu; }
#define XB_SPIN(cond, bar) do { unsigned _sp = 0; while (cond) { __builtin_amdgcn_s_sleep(1); \
    if ((++_sp & 255u) == 0u) { if (xb_ld(&(bar)[XB_TMO])) break; if (_sp > XB_SPIN_CAP) { atomicAdd(&(bar)[XB_TMO], 1u); break; } } } } while (0)
struct XcdBarrier { unsigned* bar; unsigned x; volatile LAS unsigned* st; };
__device__ __forceinline__ XcdBarrier xcd_barrier_post(unsigned* bar, volatile LAS unsigned* st) {
    XcdBarrier b; b.bar = bar; b.x = (unsigned)__builtin_amdgcn_readfirstlane((int)xb_xcc_id()); b.st = st;
    if (threadIdx.x == 0) (void)xb_add(&bar[XB_XCNT(b.x)], 1u);
    return b;
}
__device__ __forceinline__ void xcd_barrier_complete(unsigned* bar, unsigned x, unsigned& nloc, unsigned& nx) {
    const unsigned G = gridDim.x * gridDim.y * gridDim.z;
    unsigned sum, cnt, mine, sp = 0u;
    for (;;) {
        sum = 0u; cnt = 0u; mine = 0u;
#pragma unroll
        for (unsigned j = 0; j < 16; ++j) { const unsigned c = xb_ld(&bar[XB_XCNT(j)]); sum += c; cnt += (c > 0u) ? 1u : 0u; mine = (j == x) ? c : mine; }
        if (sum == G) break;
        __builtin_amdgcn_s_sleep(1);
        if ((++sp & 255u) == 0u) { if (xb_ld(&bar[XB_TMO])) break; if (sp > XB_SPIN_CAP) { atomicAdd(&bar[XB_TMO], 1u); break; } }
    }
    nloc = mine > 0u ? mine : 1u; nx = cnt > 0u ? cnt : 1u;
}
__device__ __forceinline__ void xcd_barrier(const XcdBarrier& b) {
    asm volatile("s_waitcnt vmcnt(0)" ::: "memory");
    __syncthreads();
    if (threadIdx.x == 0) {
        unsigned* bar = b.bar; const unsigned bx = (unsigned)__builtin_amdgcn_readfirstlane((int)xb_xcc_id());
        __builtin_amdgcn_s_waitcnt(0);
        unsigned nloc = b.st[0], nx = b.st[1];
        if (nloc == 0u) { xcd_barrier_complete(bar, bx, nloc, nx); b.st[0] = nloc; b.st[1] = nx; }
        const unsigned old = xb_add(&bar[XB_XSUB(bx)], 1u);
        const unsigned gen = old / nloc;
        if (old + 1u == (gen + 1u) * nloc) {
            __builtin_amdgcn_fence(__ATOMIC_RELEASE, "agent");
            asm volatile("s_waitcnt vmcnt(0)" ::: "memory");
            const unsigned og = xb_add(&bar[XB_TOP], 1u);
            const unsigned tg = og / nx;
            if (og + 1u == (tg + 1u) * nx) xb_add(&bar[XB_TOPGEN], 1u);
            else XB_SPIN(xb_ld(&bar[XB_TOPGEN]) == tg, bar);
            __builtin_amdgcn_fence(__ATOMIC_ACQUIRE, "agent");
            xb_add(&bar[XB_XGEN(bx)], 1u);
            asm volatile("s_waitcnt vmcnt(0)" ::: "memory");
        } else {
            XB_SPIN(xb_ld(&bar[XB_XGEN(bx)]) == gen, bar);
            __builtin_amdgcn_fence(__ATOMIC_ACQUIRE, "agent");
            asm volatile("s_waitcnt vmcnt(0)" ::: "memory");
        }
    }
    __syncthreads();
}

constexpr int NWAVES = 8, NTHR = 512;
constexpr int RING_OFF = 0, RING_BYTES = 131072;
constexpr int LDSCTL_OFF = RING_BYTES, MISC_OFF = LDSCTL_OFF + 320;
constexpr int LDS_BYTES = 147456;
constexpr int CW_BAR = 4096;
constexpr size_t CTL_ZERO_BYTES = 1 * MiB;

struct MArgs {
    const float* in[45]; float* out; unsigned char* ws; int ph_lo, ph_hi, l_lo, l_hi, bar_region, pad;
};
struct Frame { LAS unsigned char* lds; volatile LAS unsigned* MISC; gu32* ctl; int tid, lane, wave, vcu, G; unsigned long long tacc, tph0; int curk; };

__device__ __forceinline__ void transpose_item(const float* W, int ldw, int N, int k0, int n0, bf16* WT, int ldt, int drow0, LAS float* scr, int lane) {
    const int nn = n0 + (lane & 31); const bool okn = nn < N;
#pragma unroll 8
    for (int i = 0; i < 32; ++i) { const int kk = 2 * i + (lane >> 5); scr[kk * 33 + (lane & 31)] = okn ? W[(size_t)(k0 + kk) * ldw + nn] : 0.f; }
    LDS_WAIT(); asm volatile("" ::: "memory");
    const int c = lane & 7;
#pragma unroll
    for (int j = 0; j < 4; ++j) { const int n = (lane >> 3) + 8 * j; const LAS float* s = scr + (8 * c) * 33 + n;
        v4u o; o.x = pk2(s[0 * 33], s[1 * 33]); o.y = pk2(s[2 * 33], s[3 * 33]); o.z = pk2(s[4 * 33], s[5 * 33]); o.w = pk2(s[6 * 33], s[7 * 33]);
        if (n0 + n < N) *(GAS v4u*)(WT + (size_t)(drow0 + n) * ldt + k0 + 8 * c) = o; }
    LDS_WAIT(); asm volatile("" ::: "memory");
}

__device__ __forceinline__ void ph_mod(Frame& F, const float* c, const float* cctx, const float* ada_w, const float* ada_b, float* MOD) {
    LAS float* s = (LAS float*)(F.lds + RING_OFF);
    LAS float* red = s + 5 * 1024;
    for (int i = F.tid; i < 5 * 1024; i += NTHR) { const int r = i >> 10, k = i & 1023; const float v = r < 4 ? c[r * 1024 + k] : cctx[k]; s[i] = siluf_(v); }
    __syncthreads();
    for (int u = F.vcu; u < 192; u += F.G) {
        const int l = u / 96, j0 = (u % 96) * 64, cl = F.tid & 63, kp = F.tid >> 6;
        const float* W = ada_w + (size_t)l * 1024 * 6144 + j0 + cl;
        float acc[5] = {0.f, 0.f, 0.f, 0.f, 0.f};
        for (int k = kp * 128; k < kp * 128 + 128; ++k) { const float w = W[(size_t)k * 6144];
#pragma unroll
            for (int r = 0; r < 5; ++r) acc[r] += s[r * 1024 + k] * w; }
#pragma unroll
        for (int r = 0; r < 5; ++r) red[(kp * 5 + r) * 64 + cl] = acc[r];
        __syncthreads();
        if (F.tid < 320) { const int r = F.tid >> 6; float a = ada_b[l * 6144 + j0 + cl];
#pragma unroll
            for (int q = 0; q < 8; ++q) a += red[(q * 5 + r) * 64 + cl];
            MOD[((size_t)l * 5 + r) * 6144 + j0 + cl] = a; }
        __syncthreads();
    }
}
__device__ __forceinline__ void ph_convert_small(Frame& F, const float* w_in, const float* w_vres, const float* w_out, bf16* WIN_T  , bf16* WOUT_T  , int l_lo, int l_hi) {
    LAS float* scr = (LAS float*)(F.lds + RING_OFF + 32768 + F.wave * 16384 / 2);
    scr = (LAS float*)(F.lds + RING_OFF + 32768 + F.wave * 9216);
    const int gw = F.vcu * NWAVES + F.wave, NGW = F.G * NWAVES;
    constexpr int NB_IN = (NIN + 31) / 32;
    constexpr int I_IN = 16 * NB_IN, I_VR = 16 * 1, I_OUT = 16 * 32;
    constexpr int PER_L = I_IN + I_VR + I_OUT;
    for (int it = gw + l_lo * PER_L; it < l_hi * PER_L; it += NGW) {
        const int l = it / PER_L; int r = it % PER_L;
        if (r < I_IN) { const int kb = r / NB_IN, nb = r % NB_IN; transpose_item(w_in + (size_t)l * D * NIN, NIN, NIN, kb * 64, nb * 32, WIN_T + (size_t)l * LDP * D, D, nb * 32, scr, F.lane); continue; } r -= I_IN;
        if (r < I_VR) { if (l == 1) transpose_item(w_vres, 32, 32, r * 64, 0, WIN_T + (size_t)LDP * D, D, NIN, scr, F.lane); continue; } r -= I_VR;
        { const int kb = r / 32, nb = r % 32; transpose_item(w_out + (size_t)l * D * D, D, D, kb * 64, nb * 32, WOUT_T + (size_t)l * D * D, D, nb * 32, scr, F.lane); }
    }
}
__device__ __forceinline__ void ph_norm_mod(Frame& F, const float* xs, const float* cs, const float* gain, const float* MODl, int si, bf16* XN, int nrows) {
    const int gw = F.vcu * NWAVES + F.wave, NGW = F.G * NWAVES, lane = F.lane;
    for (int m0 = gw; m0 < nrows; m0 += 2 * NGW) {
        const int m1 = m0 + NGW < nrows ? m0 + NGW : m0;
        const float* s0 = m0 < NX ? xs + (size_t)m0 * D : cs + (size_t)(m0 - NX) * D; const float* s1 = m1 < NX ? xs + (size_t)m1 * D : cs + (size_t)(m1 - NX) * D;
        f32x4 v0[4], v1[4]; float q0 = 0.f, q1 = 0.f;
#pragma unroll
        for (int j = 0; j < 4; ++j) { v0[j] = *(const f32x4*)(s0 + 4 * lane + 256 * j); v1[j] = *(const f32x4*)(s1 + 4 * lane + 256 * j); }
#pragma unroll
        for (int j = 0; j < 4; ++j) { q0 += (v0[j].x * v0[j].x + v0[j].y * v0[j].y) + (v0[j].z * v0[j].z + v0[j].w * v0[j].w); q1 += (v1[j].x * v1[j].x + v1[j].y * v1[j].y) + (v1[j].z * v1[j].z + v1[j].w * v1[j].w); }
        q0 = wave_sum(q0); q1 = wave_sum(q1); const float r0 = rsqrtf(q0 * (1.f / D) + 1e-6f), r1 = rsqrtf(q1 * (1.f / D) + 1e-6f);
        const float* md0 = MODl + (size_t)(m0 < NX ? (m0 >> 12) : 4) * 6144; const float* md1 = MODl + (size_t)(m1 < NX ? (m1 >> 12) : 4) * 6144;
#pragma unroll
        for (int j = 0; j < 4; ++j) { const int ci = 4 * lane + 256 * j; const f32x4 g = *(const f32x4*)(gain + ci);
            const f32x4 y0 = v0[j] * r0 * g * (*(const f32x4*)(md0 + (si + 1) * 1024 + ci) + 1.f) + *(const f32x4*)(md0 + si * 1024 + ci);
            const f32x4 y1 = v1[j] * r1 * g * (*(const f32x4*)(md1 + (si + 1) * 1024 + ci) + 1.f) + *(const f32x4*)(md1 + si * 1024 + ci);
            *(unsigned long long*)(XN + (size_t)m0 * D + ci) = pack4(y0); *(unsigned long long*)(XN + (size_t)m1 * D + ci) = pack4(y1); }
    }
}

typedef short bf16x4 __attribute__((ext_vector_type(4)));
constexpr int CW_CNT = 16384;
constexpr int TAB_OFF = LDSCTL_OFF + 1024;
struct MoeTab { LAS int* cnt; LAS int* ups; LAS int* ro; };
__device__ __forceinline__ MoeTab moe_tab(Frame& F) { MoeTab t; t.cnt = (LAS int*)(F.lds + TAB_OFF); t.ups = t.cnt + 80; t.ro = t.ups + 80; return t; }
__device__ __forceinline__ void moe_build_tab(Frame& F, int layer, int ntok) {
    MoeTab T = moe_tab(F);
    if (F.tid < 64) T.cnt[F.tid] = (int)__hip_atomic_load(F.ctl + CW_CNT + (layer * 64 + F.tid) * 64, RLX_AGENT);
    if (F.tid == 64) T.cnt[64] = ntok;
    __syncthreads();
    if (F.tid == 0) { int u = 0, r = 0; for (int e = 0; e < 65; ++e) { T.ups[e] = u; T.ro[e] = r; u += (T.cnt[e] + 255) >> 8; r += T.cnt[e]; } T.ups[65] = u; T.ro[65] = r; }
    __syncthreads();
}
__device__ __forceinline__ int uni(int v) { return __builtin_amdgcn_readfirstlane(v); }
__device__ __forceinline__ const char* uni_ptr(const char* p) { unsigned long long v = (unsigned long long)p; unsigned lo = __builtin_amdgcn_readfirstlane((unsigned)v), hi = __builtin_amdgcn_readfirstlane((unsigned)(v >> 32)); return (const char*)(((unsigned long long)hi << 32) | lo); }

__device__ __forceinline__ void ph_convert_router(Frame& F, const float* rtw, bf16* RT) {
    for (int i = F.vcu * NTHR + F.tid; i < 2 * 64 * 1024; i += F.G * NTHR) { const int l = i >> 16, e = (i >> 10) & 63, k = i & 1023;
        const float x = rtw[((size_t)l * 1024 + k) * 64 + e]; const bf16 hi = f2bf(x); const bf16 lo = f2bf(x - bf2f(hi));
        RT[(((size_t)l * 2 + 0) * 64 + e) * 1024 + k] = hi; RT[(((size_t)l * 2 + 1) * 64 + e) * 1024 + k] = lo; }
}
__device__ __forceinline__ void ph_route(Frame& F, const float* XR, const float* gain, const float* MODl, const bf16* RTl  , const float* rbias, bf16* XN, int layer,
                                         unsigned* LIST, int* SLOTPOS, float* SLOTG, int ntok) {
    constexpr int HSTR = 2064;
    LAS unsigned char* HH = F.lds + RING_OFF;
    LAS unsigned char* HL = F.lds + RING_OFF + 16 * HSTR;
    LAS float* part = (LAS float*)(F.lds + RING_OFF + 32 * HSTR);
    LAS float* sc = (LAS float*)(F.lds + RING_OFF + 32 * HSTR + 32768);
    LAS int* lcnt = (LAS int*)(F.lds + RING_OFF + 32 * HSTR + 32768 + 4096);
    LAS int* lbase = lcnt + 64;
    if (F.tid < 64) lcnt[F.tid] = 0;
    const int lane = F.lane, wv = F.wave, tid = F.tid, r = lane & 15, g = lane >> 4;
    const int ngrp = ntok / 16;
    bf16x4 BH[4][8], BL[4][8];
    { const GAS bf16* R = (const GAS bf16*)RTl;
#pragma unroll
      for (int nt = 0; nt < 4; ++nt)
#pragma unroll
          for (int ks = 0; ks < 8; ++ks) { const size_t o = (size_t)(16 * nt + r) * 1024 + 128 * wv + 16 * ks + 4 * g; BH[nt][ks] = *(const GAS bf16x4*)(R + o); BL[nt][ks] = *(const GAS bf16x4*)(R + 65536 + o); } }
    f32x4 vq[2][4];
    { const int m0 = (F.vcu < ngrp ? F.vcu : 0) * 16 + 2 * wv;
#pragma unroll
      for (int tt = 0; tt < 2; ++tt)
#pragma unroll
          for (int j = 0; j < 4; ++j) vq[tt][j] = *(const GAS f32x4*)((const GAS float*)XR + (size_t)(m0 + tt) * D + 4 * lane + 256 * j); }
    for (int gi = F.vcu; gi < ngrp; gi += F.G) {
        TSEC_BEGIN(20)
#pragma unroll
        for (int tt = 0; tt < 2; ++tt) {
            const int tl = 2 * wv + tt, m = gi * 16 + tl;
            const int rb = m < NX ? (m >> 12) : 4; const float* md = MODl + (size_t)rb * 6144;
            float ss = 0.f;
#pragma unroll
            for (int j = 0; j < 4; ++j) { const f32x4 x = vq[tt][j]; ss += (x.x * x.x + x.y * x.y) + (x.z * x.z + x.w * x.w); }
            ss = wave_sum(ss); const float rs = rsqrtf(ss * (1.f / D) + 1e-6f);
#pragma unroll
            for (int j = 0; j < 4; ++j) { const int ci = 4 * lane + 256 * j; const f32x4 gg = *(const f32x4*)(gain + ci), sh = *(const f32x4*)(md + 3 * 1024 + ci), scl = *(const f32x4*)(md + 4 * 1024 + ci);
                const f32x4 y = vq[tt][j] * rs * gg * (scl + 1.f) + sh;
                const unsigned h0 = pk2(y.x, y.y), h1 = pk2(y.z, y.w);
                const f32x4 yl = (f32x4){y.x - __uint_as_float(h0 << 16), y.y - __uint_as_float(h0 & 0xffff0000u), y.z - __uint_as_float(h1 << 16), y.w - __uint_as_float(h1 & 0xffff0000u)};
                const unsigned long long hw = (unsigned long long)h0 | ((unsigned long long)h1 << 32);
                *(LAS unsigned long long*)(HH + tl * HSTR + ci * 2) = hw; *(LAS unsigned long long*)(HL + tl * HSTR + ci * 2) = pack4(yl);
                *(unsigned long long*)(XN + (size_t)m * D + ci) = hw; }
        }
        { const int gn = gi + F.G < ngrp ? gi + F.G : gi; const int m0 = gn * 16 + 2 * wv;
#pragma unroll
          for (int tt = 0; tt < 2; ++tt)
#pragma unroll
              for (int j = 0; j < 4; ++j) vq[tt][j] = *(const GAS f32x4*)((const GAS float*)XR + (size_t)(m0 + tt) * D + 4 * lane + 256 * j); }
        LDS_BARRIER();
        TSEC_END(20)
        TSEC_BEGIN(21)
        { f32x4 acc[4];
#pragma unroll
          for (int nt = 0; nt < 4; ++nt) acc[nt] = (f32x4){0.f, 0.f, 0.f, 0.f};
#pragma unroll
          for (int ks = 0; ks < 8; ++ks) { const int ko = (128 * wv + 16 * ks + 4 * g) * 2; const bf16x4 ah = *(const LAS bf16x4*)(HH + r * HSTR + ko), al = *(const LAS bf16x4*)(HL + r * HSTR + ko);
#pragma unroll
              for (int nt = 0; nt < 4; ++nt) { acc[nt] = __builtin_amdgcn_mfma_f32_16x16x16bf16_1k(ah, BH[nt][ks], acc[nt], 0, 0, 0); acc[nt] = __builtin_amdgcn_mfma_f32_16x16x16bf16_1k(al, BH[nt][ks], acc[nt], 0, 0, 0);
                  acc[nt] = __builtin_amdgcn_mfma_f32_16x16x16bf16_1k(ah, BL[nt][ks], acc[nt], 0, 0, 0); } }
#pragma unroll
          for (int nt = 0; nt < 4; ++nt)
#pragma unroll
              for (int i = 0; i < 4; ++i) part[(wv * 16 + 4 * g + i) * 64 + 16 * nt + r] = acc[nt][i]; }
        LDS_BARRIER();
#pragma unroll
        for (int q = 0; q < 2; ++q) { const int t = (tid >> 6) + 8 * q, e = tid & 63; float a = 0.f;
#pragma unroll
            for (int kp = 0; kp < 8; ++kp) a += part[(kp * 16 + t) * 64 + e];
            sc[t * 64 + e] = sigmoidf_(a); }
        LDS_BARRIER();
        TSEC_END(21)
        TSEC_BEGIN(22)
#pragma unroll
        for (int tt = 0; tt < 2; ++tt) {
            const int tl = 2 * wv + tt, m = gi * 16 + tl;
            const float s = sc[tl * 64 + lane]; const float sel = s + rbias[lane]; int rank8 = 0;
#pragma unroll 16
            for (int j = 0; j < 64; ++j) { const float oj = __int_as_float(__builtin_amdgcn_readlane(__float_as_int(sel), j)); rank8 += (oj > sel || (oj == sel && j < lane)) ? 1 : 0; }
            const int myk = rank8 < 8 ? rank8 : -1;
            const float ssum = wave_sum(myk >= 0 ? s : 0.f);
            if (myk >= 0) { const int lr = __hip_atomic_fetch_add(lcnt + lane, 1, __ATOMIC_RELAXED, __HIP_MEMORY_SCOPE_WORKGROUP);
                SLOTPOS[(size_t)m * 8 + myk] = (lane << 16) | lr; SLOTG[(size_t)m * 8 + myk] = 2.5f * s * __builtin_amdgcn_rcpf(ssum); }
        }
        LDS_BARRIER();
        TSEC_END(22)
    }
    asm volatile("s_waitcnt vmcnt(0)" ::: "memory"); __syncthreads();
    if (F.tid < 64) { const int n = lcnt[F.tid]; lbase[F.tid] = n > 0 ? (int)__hip_atomic_fetch_add(F.ctl + CW_CNT + (layer * 64 + F.tid) * 64, (unsigned)n, RLX_AGENT) : 0; }
    __syncthreads();
    for (int gi = F.vcu; gi < ngrp; gi += F.G) {
        if (tid < 128) { const int m = gi * 16 + (tid >> 3), k = tid & 7; const int sp = (int)__hip_atomic_load((unsigned*)SLOTPOS + (size_t)m * 8 + k, RLX_AGENT); const int e = sp >> 16, rk = lbase[e] + (sp & 0xffff);
            SLOTPOS[(size_t)m * 8 + k] = (e << 16) | rk; LIST[(size_t)e * MT + rk] = (unsigned)m; } }
}
__device__ __forceinline__ void ph_convert_experts(Frame& F, const float* wg, const float* wu, const float* wd, const float* sg, const float* su, const float* sd, bf16* WGU_T, bf16* WD_T) {
    LAS float* scr = (LAS float*)(F.lds + RING_OFF + F.wave * 9216);
    const int gw = F.vcu * NWAVES + F.wave, NGW = F.G * NWAVES;
    for (int it = gw; it < 65 * 384; it += NGW) {
        const int e = it / 384; int r = it % 384;
        const float* Wg = e < 64 ? wg + (size_t)e * D * EFF : sg; const float* Wu = e < 64 ? wu + (size_t)e * D * EFF : su; const float* Wd = e < 64 ? wd + (size_t)e * EFF * D : sd;
        if (r < 256) { const float* W = r < 128 ? Wg : Wu; const int up = r >= 128; r &= 127; const int kb = r >> 3, nb = r & 7, n0 = nb * 32;
            transpose_item(W, EFF, EFF, kb * 64, n0, WGU_T + (size_t)e * 512 * D, D, (n0 >> 7) * 256 + (n0 & 127) + up * 128, scr, F.lane); }
        else { r -= 256; const int kb = r >> 5, nb = r & 31; transpose_item(Wd, D, D, kb * 64, nb * 32, WD_T + (size_t)e * D * EFF, EFF, nb * 32, scr, F.lane); }
    }
}
namespace pg8 {
struct MoeOrder1 {          static constexpr bool GATHER = true;
    const bf16_t* XN; const bf16_t* WGU; const unsigned* LIST; MoeTab T; int G, c, total;
    __device__ bool next(int i, Unit& u) const {
        const int L = i * G + c; if (L >= total) return false;
        const int pn = L & 1, ru = L >> 1; int lo = 0, hi = 64;
        while (lo < hi) { const int mid = (lo + hi + 1) >> 1; if (T.ups[mid] <= ru) lo = mid; else hi = mid - 1; }
        const int e = uni(lo), j = uni(ru - T.ups[lo]);
        u.e = e; u.pm = j; u.pn = pn; u.nrows = uni(min(256, T.cnt[e] - j * 256)); u.rb = uni(T.ro[e] + j * 256);
        u.A = (const char*)XN; u.B = uni_ptr((const char*)WGU + ((size_t)e * 512 + (size_t)pn * 256) * D * 2); return true;
    }
    __device__ __forceinline__ unsigned a_off(const Unit& u, int h, int R, int C) const {
        const int idx = h * HALF + R; int tok = 0;
        if (idx < u.nrows) tok = u.e < 64 ? (int)LIST[(size_t)u.e * MT + u.pm * 256 + idx] : u.pm * 256 + idx;
        return (unsigned)(tok * D + C) * 2u;
    }
};
struct MoeOrder2 {          static constexpr bool GATHER = false;
    const bf16_t* HACT; const bf16_t* WD; MoeTab T; int G, c, total;
    __device__ bool next(int i, Unit& u) const {
        const int L = i * G + c; if (L >= total) return false;
        const int pn = L & 3, ru = L >> 2; int lo = 0, hi = 64;
        while (lo < hi) { const int mid = (lo + hi + 1) >> 1; if (T.ups[mid] <= ru) lo = mid; else hi = mid - 1; }
        const int e = uni(lo), j = uni(ru - T.ups[lo]);
        u.e = e; u.pm = j; u.pn = pn; u.nrows = uni(min(256, T.cnt[e] - j * 256)); u.rb = uni(T.ro[e] + j * 256);
        u.A = uni_ptr((const char*)HACT + (size_t)u.rb * EFF * 2); u.B = uni_ptr((const char*)WD + ((size_t)e * D + (size_t)pn * 256) * EFF * 2); return true;
    }
    __device__ __forceinline__ unsigned a_off(const Unit&, int h, int R, int C) const { return (unsigned)((h * HALF + R) * EFF + C) * 2u; }
};
struct EpiSwiglu {
    static constexpr bool PERM = true;
    bf16_t* HACT;
    __device__ __forceinline__ void operator()(const f32x4 (&acc)[2][2][4][2], const Unit& u, int wr, int wc, int fr, int fq) const {
        asm volatile("" : "+v"(fr), "+v"(fq));
#pragma unroll
        for (int ai = 0; ai < 2; ++ai)
#pragma unroll
            for (int m = 0; m < 4; ++m) { const int r = ai * HALF + wr * 64 + m * 16 + fr;
                if (r < u.nrows) { const f32x4 g0 = acc[ai][0][m][0], g1 = acc[ai][0][m][1], u0 = acc[ai][1][m][0], u1 = acc[ai][1][m][1];
                    float o[8];
#pragma unroll
                    for (int q = 0; q < 4; ++q) { o[q] = g0[q] * __builtin_amdgcn_rcpf(1.f + __expf(-g0[q])) * u0[q]; o[4 + q] = g1[q] * __builtin_amdgcn_rcpf(1.f + __expf(-g1[q])) * u1[q]; }
                    u32x4 w; w.x = cvt_pk_bf16(o[0], o[1]); w.y = cvt_pk_bf16(o[2], o[3]); w.z = cvt_pk_bf16(o[4], o[5]); w.w = cvt_pk_bf16(o[6], o[7]);
                    *(u32x4*)(HACT + (size_t)(u.rb + r) * EFF + u.pn * 128 + wc * 32 + 8 * fq) = w; } }
    }
};
struct EpiDown {
    static constexpr bool PERM = true;
    bf16_t* Y; float* XR; const float* MODl;
    __device__ __forceinline__ void operator()(const f32x4 (&acc)[2][2][4][2], const Unit& u, int wr, int wc, int fr, int fq) const {
        asm volatile("" : "+v"(fr), "+v"(fq));
        const unsigned lcol = (unsigned)(wc * 32 + 8 * fq);
        if (u.e < 64) {
            GAS char* ybase = (GAS char*)uni_ptr((const char*)(Y + (size_t)u.rb * D + u.pn * BM));
#pragma unroll
            for (int ai = 0; ai < 2; ++ai)
#pragma unroll
                for (int m = 0; m < 4; ++m) { const int r = ai * HALF + wr * 64 + m * 16 + fr;
                    if (r < u.nrows) { const unsigned off = ((unsigned)r * D + lcol) * 2u;
#pragma unroll
                        for (int bj = 0; bj < 2; ++bj) { const f32x4 v0 = acc[ai][bj][m][0], v1 = acc[ai][bj][m][1];
                            u32x4 w; w.x = cvt_pk_bf16(v0[0], v0[1]); w.y = cvt_pk_bf16(v0[2], v0[3]); w.z = cvt_pk_bf16(v1[0], v1[1]); w.w = cvt_pk_bf16(v1[2], v1[3]);
                            *(GAS u32x4*)(ybase + off + bj * HALF * 2) = w; } } }
        } else {
            const int m0 = u.pm * 256; const int rb = m0 < NX ? (m0 >> 12) : 4;
            const GAS char* mdb = (const GAS char*)uni_ptr((const char*)(MODl + (size_t)rb * 6144 + 5 * 1024 + u.pn * BM)); GAS char* xb = (GAS char*)uni_ptr((const char*)(XR + (size_t)m0 * D + u.pn * BM));
#pragma unroll
            for (int ai = 0; ai < 2; ++ai)
#pragma unroll
                for (int m = 0; m < 4; ++m) { const int r = ai * HALF + wr * 64 + m * 16 + fr;
                    if (r < u.nrows) {
#pragma unroll
                        for (int bj = 0; bj < 2; ++bj)
#pragma unroll
                            for (int n = 0; n < 2; ++n) { const unsigned c = (unsigned)(bj * HALF) + lcol + 4u * n; const unsigned off = ((unsigned)r * D + c) * 4u;
                                const f32x4 xi = *(const GAS f32x4*)(xb + off), mm = *(const GAS f32x4*)(mdb + c * 4u); *(GAS f32x4*)(xb + off) = xi + mm * acc[ai][bj][m][n]; } }
                    asm volatile("" ::: "memory"); }
        }
    }
};
}
template <bool FINAL>
__device__ __forceinline__ void ph_combine_norm(Frame& F, const bf16* Y, const int* SLOTPOS, const float* SLOTG, const float* MODl, float* XR, int ntok, const float* gainN, const float* MODn, bf16* XN, float* out) {
    MoeTab T = moe_tab(F);
    const int gw = F.vcu * NWAVES + F.wave, NGW = F.G * NWAVES, lane = F.lane;
    for (int m = gw; m < ntok; m += NGW) {
        const int rb = m < NX ? (m >> 12) : 4; const float* md = MODl + (size_t)rb * 6144 + 5 * 1024;
        float acc[16];
#pragma unroll
        for (int q = 0; q < 16; ++q) acc[q] = 0.f;
#pragma unroll
        for (int s = 0; s < 8; ++s) { const int sp = SLOTPOS[(size_t)m * 8 + s]; const int row = T.ro[sp >> 16] + (sp & 0xffff); const float gs = SLOTG[(size_t)m * 8 + s];
            const bf16* yr = Y + (size_t)row * D;
#pragma unroll
            for (int j = 0; j < 4; ++j) { const unsigned long long w = *(const unsigned long long*)(yr + 4 * lane + 256 * j);
                acc[4 * j + 0] += gs * __uint_as_float((unsigned)(w & 0xffffull) << 16); acc[4 * j + 1] += gs * __uint_as_float((unsigned)((w >> 16) & 0xffffull) << 16);
                acc[4 * j + 2] += gs * __uint_as_float((unsigned)((w >> 32) & 0xffffull) << 16); acc[4 * j + 3] += gs * __uint_as_float((unsigned)((w >> 48) & 0xffffull) << 16); } }
        f32x4 x[4]; float ss = 0.f;
#pragma unroll
        for (int j = 0; j < 4; ++j) { const int ci = 4 * lane + 256 * j; float* o = XR + (size_t)m * D + ci; const f32x4 xi = *(const f32x4*)o, mm = *(const f32x4*)(md + ci);
            x[j] = xi + mm * (f32x4){acc[4 * j], acc[4 * j + 1], acc[4 * j + 2], acc[4 * j + 3]};
            if (!FINAL) *(f32x4*)o = x[j];
            ss += (x[j].x * x[j].x + x[j].y * x[j].y) + (x[j].z * x[j].z + x[j].w * x[j].w); }
        ss = wave_sum(ss); const float rs = rsqrtf(ss * (1.f / D) + 1e-6f);
        const float* mdn = FINAL ? nullptr : MODn + (size_t)rb * 6144;
#pragma unroll
        for (int j = 0; j < 4; ++j) { const int ci = 4 * lane + 256 * j; const f32x4 g = *(const f32x4*)(gainN + ci);
            if (FINAL) *(f32x4*)(out + (size_t)m * D + ci) = x[j] * rs * g;
            else { const f32x4 y = x[j] * rs * g * (*(const f32x4*)(mdn + 1024 + ci) + 1.f) + *(const f32x4*)(mdn + ci); *(unsigned long long*)(XN + (size_t)m * D + ci) = pack4(y); } }
    }
}


#define MFMA16(a, b, c) __builtin_amdgcn_mfma_f32_16x16x16bf16_1k((a), (b), (c), 0, 0, 0)
__device__ __forceinline__ bf16x8 cat8(bf16x4 lo, bf16x4 hi) { return __builtin_shufflevector(lo, hi, 0, 1, 2, 3, 4, 5, 6, 7); }
#define MFMA32P(a0, a1, b0, b1, c) __builtin_amdgcn_mfma_f32_16x16x32_bf16(cat8((a0), (a1)), cat8((b0), (b1)), (c), 0, 0, 0)
constexpr int LSTR = 144;
constexpr int IMG = 64 * LSTR;
constexpr int ROPE_OFF = 120 * 1024;
__device__ __forceinline__ bf16x4 ldsfrag(const LAS unsigned char* img, int row, int k0) { return *(const LAS bf16x4*)(img + row * LSTR + k0 * 2); }
__device__ __forceinline__ f32x4 zero4() { return (f32x4){0.f, 0.f, 0.f, 0.f}; }
__device__ __forceinline__ f32x4 nt_tile64(const LAS unsigned char* A, int m0, const LAS unsigned char* B, int n0, int lane, f32x4 acc) {
    const int r = lane & 15, g = lane >> 4;
#pragma unroll
    for (int s = 0; s < 4; s += 2) acc = MFMA32P(ldsfrag(A, m0 + r, 16 * s + 4 * g), ldsfrag(A, m0 + r, 16 * s + 16 + 4 * g), ldsfrag(B, n0 + r, 16 * s + 4 * g), ldsfrag(B, n0 + r, 16 * s + 16 + 4 * g), acc);
    return acc;
}
__device__ __forceinline__ void unpack8(v4u w, float (&o)[8]) {
    o[0] = __uint_as_float(w.x << 16); o[1] = __uint_as_float(w.x & 0xffff0000u); o[2] = __uint_as_float(w.y << 16); o[3] = __uint_as_float(w.y & 0xffff0000u);
    o[4] = __uint_as_float(w.z << 16); o[5] = __uint_as_float(w.z & 0xffff0000u); o[6] = __uint_as_float(w.w << 16); o[7] = __uint_as_float(w.w & 0xffff0000u); }
struct TB { int m0, b, j, isx, t0; };
__device__ __forceinline__ TB tb_of(int tb) { TB r; if (tb < 256) { r.b = tb >> 6; r.j = tb & 63; r.isx = 1; r.m0 = tb * 64; r.t0 = r.j * 64; } else { const int q = tb - 256; r.b = q >> 2; r.j = q & 3; r.isx = 0; r.m0 = NX + q * 64; r.t0 = r.j * 64; } return r; }
__device__ __forceinline__ int chunk_of(const TB& t, int d) { return t.isx ? 4 + (d ? 63 - t.j : t.j) : (d ? 3 - t.j : t.j); }
__device__ __forceinline__ void build_rope(Frame& F) {
    LAS float* tab = (LAS float*)(F.lds + ROPE_OFF);
    for (int i = F.tid; i < 1024; i += NTHR) { const int pos = i >> 4, jj = i & 15; const float inv = __powf(10000.f, -(float)jj * (1.f / 16.f)); float sn, cs; sincosf((float)pos * inv, &sn, &cs); tab[2 * i] = cs; tab[2 * i + 1] = sn; }
}
__device__ __forceinline__ void load16(const bf16* P, int m, int col0, int dq, float (&lo)[8], float (&hi)[8]) {
    const v4u a = *(const v4u*)(P + (size_t)m * LDP + col0 + 8 * dq), b = *(const v4u*)(P + (size_t)m * LDP + col0 + 32 + 8 * dq); unpack8(a, lo); unpack8(b, hi); }
__device__ __forceinline__ void rope16(Frame& F, int t, int dq, float (&lo)[8], float (&hi)[8]) {
    const LAS float* tab = (const LAS float*)(F.lds + ROPE_OFF); const int pos = dq < 2 ? (t >> 6) : (t & 63); const int j0 = (8 * dq) & 15;
#pragma unroll
    for (int e = 0; e < 8; ++e) { const float cs = tab[2 * (pos * 16 + j0 + e)], sn = tab[2 * (pos * 16 + j0 + e) + 1]; const float a = lo[e], b = hi[e]; lo[e] = a * cs - b * sn; hi[e] = a * sn + b * cs; }
}
__device__ __forceinline__ void st_tok16(LAS unsigned char* img, int s, int dq, const float (&lo)[8], const float (&hi)[8]) {
    v4u a, b; a.x = pk2(lo[0], lo[1]); a.y = pk2(lo[2], lo[3]); a.z = pk2(lo[4], lo[5]); a.w = pk2(lo[6], lo[7]); b.x = pk2(hi[0], hi[1]); b.y = pk2(hi[2], hi[3]); b.z = pk2(hi[4], hi[5]); b.w = pk2(hi[6], hi[7]);
    *(LAS v4u*)(img + s * LSTR + 16 * dq) = a; *(LAS v4u*)(img + s * LSTR + 64 + 16 * dq) = b; }
__device__ __forceinline__ void st_chn16(LAS unsigned char* img, int s, int dq, const float (&lo)[8], const float (&hi)[8], float scale) {
#pragma unroll
    for (int e = 0; e < 8; ++e) { *(LAS bf16*)(img + (8 * dq + e) * LSTR + 2 * s) = f2bf(lo[e] * scale); *(LAS bf16*)(img + (32 + 8 * dq + e) * LSTR + 2 * s) = f2bf(hi[e] * scale); } }

__device__ __forceinline__ bf16* dz_blob(bf16* DZ, int d, int b, int h, int n) { return DZ + ((size_t)(((d * 4 + b) * 4 + h) * 68 + n)) * 4096; }
__device__ __forceinline__ void ph_ret_pre(Frame& F, const bf16* P, const float* lam, bf16* DZ) {
    const int half = F.tid >> 8, ht = F.tid & 255, s = ht & 63, dq = ht >> 6, wq = F.wave & 3, lane = F.lane;
    LAS unsigned char* hb = F.lds + RING_OFF + half * (3 * IMG);
    LAS unsigned char* KFT = hb, * KBT = hb + IMG, * VT = hb + 2 * IMG;
    for (int it = F.vcu; it < 544; it += F.G) {
        const int item = it * 2 + half, tbi = item >> 2, h = item & 3; const TB tb = tb_of(tbi);
        const float lgf = -lam[h], lgb = -lam[4 + h];
        { float lo[8], hi[8]; const int m = tb.m0 + s;
          load16(P, m, RET_OFF + 256 + h * 64, dq, lo, hi); if (tb.isx) rope16(F, tb.t0 + s, dq, lo, hi);
          st_chn16(KFT, s, dq, lo, hi, 0.125f * __expf((float)(63 - s) * lgf)); st_chn16(KBT, s, dq, lo, hi, 0.125f * __expf((float)s * lgb));
          load16(P, m, RET_OFF + 512 + h * 64, dq, lo, hi); st_chn16(VT, s, dq, lo, hi, 1.f); }
        LDS_BARRIER();
#pragma unroll
        for (int d = 0; d < 2; ++d) { bf16* blob = dz_blob(DZ, d, tb.b, h, chunk_of(tb, d)); const LAS unsigned char* KT = d ? KBT : KFT;
#pragma unroll
            for (int vt = 0; vt < 4; ++vt) { const f32x4 acc = nt_tile64(KT, 16 * wq, VT, 16 * vt, lane, zero4());
                *(unsigned long long*)(blob + (16 * vt + (lane & 15)) * 64 + 16 * wq + 4 * (lane >> 4)) = pack4(acc); } }
        LDS_BARRIER();
    }
}
__device__ __forceinline__ void ph_ret_prefix(Frame& F, const float* lam, bf16* DZ) {
    for (int e = F.vcu * NTHR + F.tid; e < 32 * 4096; e += F.G * NTHR) {
        const int seq = e >> 12, el = e & 4095, d = seq >> 4, h = seq & 3;
        const float gC = __expf(-64.f * lam[d * 4 + h]);
        GAS bf16* base = (GAS bf16*)DZ + (size_t)seq * 68 * 4096 + el; float z = 0.f;
#pragma unroll 1
        for (int n = 0; n < 68; n += 17) { float tmp[17];
#pragma unroll
            for (int u = 0; u < 17; ++u) tmp[u] = bf2f(base[(size_t)(n + u) * 4096]);
#pragma unroll
            for (int u = 0; u < 17; ++u) { base[(size_t)(n + u) * 4096] = f2bf(z); z = gC * z + tmp[u]; } } }
}
__device__ __forceinline__ void ph_ret_post(Frame& F, const bf16* P, const float* lam, const bf16* DZ, bf16* MIX) {
    const int half = F.tid >> 8, ht = F.tid & 255, s = ht & 63, dq = ht >> 6, wq = F.wave & 3, lane = F.lane, r = lane & 15, g = lane >> 4;
    LAS unsigned char* hb = F.lds + RING_OFF + half * (4 * IMG);
    LAS unsigned char* Qi = hb, * Ki = hb + IMG, * VT = hb + 2 * IMG, * Wi = hb + 3 * IMG;
    for (int it = F.vcu; it < 544; it += F.G) {
        const int item = it * 2 + half, tbi = item >> 2, h = item & 3; const TB tb = tb_of(tbi);
        const float lgf = -lam[h], lgb = -lam[4 + h];
        { float lo[8], hi[8]; const int m = tb.m0 + s;
          load16(P, m, RET_OFF + h * 64, dq, lo, hi); if (tb.isx) rope16(F, tb.t0 + s, dq, lo, hi); st_tok16(Qi, s, dq, lo, hi);
          load16(P, m, RET_OFF + 256 + h * 64, dq, lo, hi); if (tb.isx) rope16(F, tb.t0 + s, dq, lo, hi);
#pragma unroll
          for (int e = 0; e < 8; ++e) { lo[e] *= 0.125f; hi[e] *= 0.125f; }
          st_tok16(Ki, s, dq, lo, hi);
          load16(P, m, RET_OFF + 512 + h * 64, dq, lo, hi); st_chn16(VT, s, dq, lo, hi, 1.f); }
        LDS_BARRIER();
        const int s0 = 16 * wq, sl = s0 + r;
#pragma unroll
        for (int jt = 0; jt < 4; ++jt) { f32x4 acc = nt_tile64(Ki, 16 * jt, Qi, s0, lane, zero4());
#pragma unroll
            for (int i = 0; i < 4; ++i) { const int j = 16 * jt + 4 * g + i; const float wf = j <= sl ? __expf((float)(sl - j) * lgf) : 0.f, wb = j >= sl ? __expf((float)(j - sl) * lgb) : 0.f; acc[i] *= (wf + wb); }
            *(LAS unsigned long long*)(Wi + sl * LSTR + 2 * (16 * jt + 4 * g)) = pack4(acc); }
        LDS_WAIT();
        const bf16* Zf = dz_blob((bf16*)DZ, 0, tb.b, h, chunk_of(tb, 0)); const bf16* Zb = dz_blob((bf16*)DZ, 1, tb.b, h, chunk_of(tb, 1));
        const float ef = __expf((float)(sl + 1) * lgf), eb = __expf((float)(64 - sl) * lgb);
        f32x4 o[4]; float ssq = 0.f;
#pragma unroll
        for (int vt = 0; vt < 4; ++vt) { f32x4 aw = nt_tile64(VT, 16 * vt, Wi, s0, lane, zero4()), af = zero4(), ab = zero4();
#pragma unroll
            for (int ks = 0; ks < 4; ++ks) { const bf16x4 qf = ldsfrag(Qi, sl, 16 * ks + 4 * g);
                const bf16x4 zf = *(const bf16x4*)(Zf + (16 * vt + r) * 64 + 16 * ks + 4 * g), zb = *(const bf16x4*)(Zb + (16 * vt + r) * 64 + 16 * ks + 4 * g);
                af = MFMA16(zf, qf, af); ab = MFMA16(zb, qf, ab); }
            o[vt] = aw + af * ef + ab * eb; ssq += (o[vt].x * o[vt].x + o[vt].y * o[vt].y) + (o[vt].z * o[vt].z + o[vt].w * o[vt].w); }
        ssq += __shfl_xor(ssq, 16); ssq += __shfl_xor(ssq, 32);
        const float rs = rsqrtf(ssq * (1.f / 64.f) + 1e-6f); const int m = tb.m0 + sl;
#pragma unroll
        for (int vt = 0; vt < 4; ++vt) { const int vd = 16 * vt + 4 * g; const unsigned long long gw = *(const unsigned long long*)(P + (size_t)m * LDP + RET_OFF + 768 + h * 64 + vd);
            f32x4 y; y.x = o[vt].x * rs * siluf_(__uint_as_float((unsigned)(gw & 0xffffull) << 16)); y.y = o[vt].y * rs * siluf_(__uint_as_float((unsigned)((gw >> 16) & 0xffffull) << 16));
            y.z = o[vt].z * rs * siluf_(__uint_as_float((unsigned)((gw >> 32) & 0xffffull) << 16)); y.w = o[vt].w * rs * siluf_(__uint_as_float((unsigned)((gw >> 48) & 0xffffull) << 16));
            *(unsigned long long*)(MIX + (size_t)m * D + 256 + h * 64 + vd) = pack4(y); }
        LDS_BARRIER();
    }
}

constexpr int IT_KP = 0, IT_RP = 8192, IT_BH = 16384, IT_UT = 24576, IT_Y0 = 32768, IT_D0 = 40960, IT_GC = 49152, ITEM_BYTES = 49664;
__device__ __forceinline__ int swz(int r, int c) { return r * 128 + (((c >> 2) ^ (r & 15)) << 3) + (c & 3) * 2; }
__device__ __forceinline__ GAS unsigned char* item_ptr(unsigned char* BL, int seq, int n) { return (GAS unsigned char*)BL + ((size_t)seq * 68 + n) * ITEM_BYTES; }
__device__ __forceinline__ bf16x4 cvt4(f32x4 v) { unsigned long long p = pack4(v); return __builtin_bit_cast(bf16x4, p); }
__device__ __forceinline__ f32x4 up4(unsigned long long w) { f32x4 r; r.x = __uint_as_float((unsigned)(w & 0xffffull) << 16); r.y = __uint_as_float((unsigned)((w >> 16) & 0xffffull) << 16);
    r.z = __uint_as_float((unsigned)((w >> 32) & 0xffffull) << 16); r.w = __uint_as_float((unsigned)((w >> 48) & 0xffffull) << 16); return r; }
constexpr int PI_A0 = 0, PI_A1 = 1, PI_A2 = 2, PI_A3 = 3, PI_KAPT = 4, PI_RHOT = 5, PI_VT = 6, PI_KHT = 7, PI_M1 = 8, PI_M2 = 9, PI_M3 = 10, PI_M4 = 11;
constexpr int PRE_TINV = 12 * IMG;
constexpr int PRE_ARR = PRE_TINV + 4 * 16 * 40;
__device__ __forceinline__ LAS unsigned char* pimg(Frame& F, int i) { return F.lds + RING_OFF + i * IMG; }

template <bool SCALAR>
__device__ __forceinline__ void dplr_core(Frame& F, GAS unsigned char* item) {
    int lane = F.lane; asm volatile("" : "+v"(lane));
    int w = F.wave; asm volatile("" : "+s"(w)); const int r = lane & 15, g = lane >> 4;
    const LAS float* Gs = (const LAS float*)(F.lds + RING_OFF + PRE_ARR); const LAS float* GM1 = Gs + 64; const LAS float* BETA = Gs + 128;
    TSEC_BEGIN(4)
    if (SCALAR) {
#pragma unroll
        for (int q = 0; q < 4; ++q) { const int e = w * 4 + q, which = e >> 4, tj = (e >> 2) & 3, tt = e & 3;
            LAS unsigned char* Ma = pimg(F, which ? PI_M3 : PI_M1); LAS unsigned char* Mb = pimg(F, which ? PI_M4 : PI_M2);
            f32x4 va = zero4(), vb = zero4(); const int t = 16 * tt + r;
            if (tj <= tt) { const f32x4 acc = nt_tile64(pimg(F, PI_A0), 16 * tj, pimg(F, which ? PI_A1 : PI_A0), 16 * tt, lane, zero4());
                const float gt = which ? Gs[t] : GM1[t];
#pragma unroll
                for (int i = 0; i < 4; ++i) { const int j = 16 * tj + 4 * g + i; const bool ok = which ? (j <= t) : (j < t); const float bj = BETA[j];
                    va[i] = ok ? acc[i] * bj * __expf(gt - GM1[j]) : 0.f; vb[i] = ok ? acc[i] * bj * __expf(gt - Gs[j]) : 0.f; } }
            *(LAS unsigned long long*)(Ma + t * LSTR + 2 * (16 * tj + 4 * g)) = pack4(va); *(LAS unsigned long long*)(Mb + t * LSTR + 2 * (16 * tj + 4 * g)) = pack4(vb); }
    } else {
#pragma unroll
        for (int q = 0; q < 8; ++q) { const int e = w * 8 + q, mi = e >> 4, tj = (e >> 2) & 3, tt = e & 3;
            LAS unsigned char* M = pimg(F, PI_M1 + mi); f32x4 va = zero4(); const int t = 16 * tt + r;
            if (tj <= tt) { const f32x4 acc = nt_tile64(pimg(F, (mi & 1) ? PI_A2 : PI_A1), 16 * tj, pimg(F, (mi & 2) ? PI_A3 : PI_A0), 16 * tt, lane, zero4());
#pragma unroll
                for (int i = 0; i < 4; ++i) { const int j = 16 * tj + 4 * g + i; const bool ok = (mi & 2) ? (j <= t) : (j < t); va[i] = ok ? acc[i] : 0.f; } }
            *(LAS unsigned long long*)(M + t * LSTR + 2 * (16 * tj + 4 * g)) = pack4(va); }
    }
    LDS_BARRIER();
    TSEC_END(4)
    TSEC_BEGIN(5)
    if (w == 0) { const int blk = lane >> 4, c = lane & 15; const LAS unsigned char* M1 = pimg(F, PI_M1); float x[16];
#pragma unroll
        for (int rr = 0; rr < 16; ++rr) { float a[16]; const v4u lo = *(const LAS v4u*)(M1 + (16 * blk + rr) * LSTR + 32 * blk), hi = *(const LAS v4u*)(M1 + (16 * blk + rr) * LSTR + 32 * blk + 16);
            { float t8[8]; unpack8(lo, t8);
#pragma unroll
              for (int q = 0; q < 8; ++q) a[q] = t8[q]; unpack8(hi, t8);
#pragma unroll
              for (int q = 0; q < 8; ++q) a[8 + q] = t8[q]; }
            float s = (rr == c) ? 1.f : 0.f;
#pragma unroll
            for (int j = 0; j < rr; ++j) s -= a[j] * x[j];
            x[rr] = s; }
        LAS unsigned char* TI = F.lds + RING_OFF + PRE_TINV + blk * 16 * 40;
#pragma unroll
        for (int rr = 0; rr < 16; ++rr) *(LAS bf16*)(TI + rr * 40 + 2 * c) = f2bf(x[rr]); }
    LDS_BARRIER();
    TSEC_END(5)
    TSEC_BEGIN(6)
    const LAS unsigned char* M1 = pimg(F, PI_M1); const LAS unsigned char* M2 = pimg(F, PI_M2); const LAS unsigned char* M3 = pimg(F, PI_M3); const LAS unsigned char* M4 = pimg(F, PI_M4);
    const LAS unsigned char* VT = pimg(F, PI_VT);
    f32x4 x[4];
    if (w < 4) {
#pragma unroll
        for (int tb = 0; tb < 4; ++tb) { f32x4 acc = zero4();
#pragma unroll
            for (int jb = 0; jb <= tb; ++jb) acc = MFMA16(ldsfrag(M2, 16 * tb + r, 16 * jb + 4 * g), ldsfrag(VT, 16 * w + r, 16 * jb + 4 * g), acc);
            x[tb] = acc; }
    } else { const LAS unsigned char* KAPT = pimg(F, PI_KAPT);
#pragma unroll
        for (int tb = 0; tb < 4; ++tb) x[tb] = up4(*(const LAS unsigned long long*)(KAPT + (16 * (w - 4) + r) * LSTR + 2 * (16 * tb + 4 * g))); }
#pragma unroll
    for (int i = 0; i < 4; ++i) { f32x4 acc = zero4();
#pragma unroll
        for (int j = 0; j < i; ++j) acc = MFMA16(ldsfrag(M1, 16 * i + r, 16 * j + 4 * g), cvt4(x[j]), acc);
        const f32x4 rhs = x[i] - acc;
        const bf16x4 tf = *(const LAS bf16x4*)(F.lds + RING_OFF + PRE_TINV + (i * 16 + r) * 40 + 8 * g);
        x[i] = MFMA16(tf, cvt4(rhs), zero4()); }
    if (w < 4) {
        const int v = 16 * w + r; GAS bf16* UT = (GAS bf16*)(item + IT_UT) + v * 64; GAS bf16* Y0T = (GAS bf16*)(item + IT_Y0) + v * 64; GAS bf16* D0T = (GAS bf16*)(item + IT_D0) + v * 64;
        const LAS unsigned char* KHT = pimg(F, PI_KHT);
#pragma unroll
        for (int tb = 0; tb < 4; ++tb) { *(GAS unsigned long long*)(UT + 16 * tb + 4 * g) = pack4(x[tb]);
            f32x4 a4 = zero4(), a3 = zero4();
#pragma unroll
            for (int jb = 0; jb <= tb; ++jb) { a4 = MFMA16(ldsfrag(M4, 16 * tb + r, 16 * jb + 4 * g), ldsfrag(VT, v, 16 * jb + 4 * g), a4); a3 = MFMA16(ldsfrag(M3, 16 * tb + r, 16 * jb + 4 * g), cvt4(x[jb]), a3); }
            *(GAS unsigned long long*)(Y0T + 16 * tb + 4 * g) = pack4(a4 - a3);
            f32x4 d0 = zero4();
#pragma unroll
            for (int sb = 0; sb < 4; ++sb) d0 = MFMA16(ldsfrag(KHT, 16 * tb + r, 16 * sb + 4 * g), ldsfrag(VT, v, 16 * sb + 4 * g), d0);
            *(GAS unsigned long long*)(D0T + 16 * tb + 4 * g) = pack4(d0); }
    } else {
        const int k = 16 * (w - 4) + r; const LAS unsigned char* RHOT = pimg(F, PI_RHOT); LAS unsigned char* KPi = pimg(F, PI_A2); LAS unsigned char* RPi = pimg(F, PI_A3);
#pragma unroll
        for (int tb = 0; tb < 4; ++tb) { f32x4 a3 = zero4();
#pragma unroll
            for (int jb = 0; jb <= tb; ++jb) a3 = MFMA16(ldsfrag(M3, 16 * tb + r, 16 * jb + 4 * g), cvt4(x[jb]), a3);
            const f32x4 rp = up4(*(const LAS unsigned long long*)(RHOT + k * LSTR + 2 * (16 * tb + 4 * g))) - a3;
#pragma unroll
            for (int i = 0; i < 4; ++i) { const int t = 16 * tb + 4 * g + i; *(LAS bf16*)(KPi + swz(t, k)) = f2bf(x[tb][i]); *(LAS bf16*)(RPi + swz(t, k)) = f2bf(rp[i]); } }
    }
    LDS_BARRIER();
    TSEC_END(6)
    TSEC_BEGIN(7)
    { const v4u a = *(const LAS v4u*)(pimg(F, PI_A2) + F.tid * 16), b = *(const LAS v4u*)(pimg(F, PI_A3) + F.tid * 16);
      *(GAS v4u*)(item + IT_KP + F.tid * 16) = a; *(GAS v4u*)(item + IT_RP + F.tid * 16) = b; }
    LDS_BARRIER();
    TSEC_END(7)
}

__device__ __forceinline__ void gdn_pre_item(Frame& F, const bf16* P, const float* cw, const float* alog, const float* dtb, unsigned char* BL, int tbi, int h, int d) {
    int w = F.wave; asm volatile("" : "+s"(w));
    const TB tb = tb_of(tbi); const int lane = F.lane, L = tb.isx ? SEQ : CTXL;
    LAS float* Gs = (LAS float*)(F.lds + RING_OFF + PRE_ARR); LAS float* GM1 = Gs + 64; LAS float* BETA = Gs + 128; LAS float* LAa = Gs + 192;
    const int seq = (d * 4 + tb.b) * 4 + h; GAS unsigned char* item = item_ptr(BL, seq, chunk_of(tb, d));
    TSEC_BEGIN(1)
    constexpr int GSTR = 400;
    LAS unsigned char* STG = pimg(F, PI_M1);
    { const GAS bf16* Pg = (const GAS bf16*)P;
#pragma unroll
      for (int q = 0; q < 4; ++q) { const int e0 = F.tid + q * NTHR, e = e0 < 68 * 24 ? e0 : 68 * 24 - 1; const int row = e / 24, ch = e % 24, sg = ch >> 3, part = ch & 7; const int t = tb.t0 - 2 + row;
              const bool ok = t >= 0 && t < L; const int rowc = ok ? row : 2;
              v4u val = *(const GAS v4u*)(Pg + (size_t)(tb.m0 - 2 + rowc) * LDP + GDN_OFF + sg * 256 + h * 64 + part * 8);
              if (!ok) val = (v4u){0u, 0u, 0u, 0u};
              *(LAS v4u*)(STG + row * GSTR + ch * 16) = val; } }
    float qv[8], kv[8], vv[8];
    const float Aexp = __expf(alog[d * 4 + h]), dt = dtb[d * 4 + h];
    float Gall, GM1all, BEall;
    { const GAS bf16* Pg = (const GAS bf16*)P; const int tau = d ? 63 - lane : lane; const size_t mo = (size_t)(tb.m0 + tau) * LDP + GDN_OFF;
      const float ar = bf2f(Pg[mo + 768 + d * 4 + h]), br = bf2f(Pg[mo + 776 + d * 4 + h]);
      const float la = -Aexp * softplusf_(ar + dt); BEall = sigmoidf_(br); float gsum = la;
#pragma unroll
      for (int o = 1; o < 64; o <<= 1) { const float t = __shfl_up(gsum, o); if (lane >= o) gsum += t; }
      Gall = gsum; GM1all = gsum - la;
      if (w == 0) { Gs[lane] = Gall; GM1[lane] = GM1all; BETA[lane] = BEall; } }
    LDS_BARRIER();
    { float cwv[3][4];
#pragma unroll
      for (int c3 = 0; c3 < 3; ++c3)
#pragma unroll
          for (int j = 0; j < 4; ++j) cwv[c3][j] = cw[j * 768 + c3 * 256 + h * 64 + lane];
#pragma unroll
      for (int u = 0; u < 8; ++u) { const int s = 8 * w + u, tau = d ? 63 - s : s;
          float acc3[3] = {0.f, 0.f, 0.f};
#pragma unroll
          for (int j = 0; j < 4; ++j)
#pragma unroll
              for (int c3 = 0; c3 < 3; ++c3) acc3[c3] += bf2f(*(const LAS bf16*)(STG + (tau + j) * GSTR + (c3 * 64 + lane) * 2)) * cwv[c3][j];
          const float o0 = siluf_(acc3[0]), o1 = siluf_(acc3[1]), o2 = siluf_(acc3[2]);
          const float qs = wave_sum(o0 * o0), ks = wave_sum(o1 * o1);
          qv[u] = o0 * rsqrtf(qs + 1e-6f) * 0.125f; kv[u] = o1 * rsqrtf(ks + 1e-6f); vv[u] = o2;
          } }
    TSEC_END(1)
    TSEC_BEGIN(3)
    const float gc = __int_as_float(__builtin_amdgcn_readlane(__float_as_int(Gall), 63));
#pragma unroll
    for (int u = 0; u < 8; ++u) { const int s = 8 * w + u; const float gg = __int_as_float(__builtin_amdgcn_readlane(__float_as_int(Gall), s)), gm = __int_as_float(__builtin_amdgcn_readlane(__float_as_int(GM1all), s)), be = __int_as_float(__builtin_amdgcn_readlane(__float_as_int(BEall), s));
        *(LAS bf16*)(pimg(F, PI_A0) + s * LSTR + 2 * lane) = f2bf(kv[u]); *(LAS bf16*)(pimg(F, PI_A1) + s * LSTR + 2 * lane) = f2bf(qv[u]);
        *(LAS bf16*)(pimg(F, PI_KAPT) + lane * LSTR + 2 * s) = f2bf(kv[u] * __expf(gm)); *(LAS bf16*)(pimg(F, PI_RHOT) + lane * LSTR + 2 * s) = f2bf(qv[u] * __expf(gg));
        *(LAS bf16*)(pimg(F, PI_VT) + lane * LSTR + 2 * s) = f2bf(vv[u]); *(LAS bf16*)(pimg(F, PI_KHT) + lane * LSTR + 2 * s) = f2bf(be * kv[u] * __expf(gc - gg));
        *(GAS bf16*)(item + IT_BH + swz(lane, s)) = f2bf(be * kv[u] * __expf(gc - gm)); }
    if (w == 0) ((GAS float*)(item + IT_GC))[lane] = __expf(gc);
    LDS_BARRIER();
    TSEC_END(3)
    dplr_core<true>(F, item);
}
__device__ __forceinline__ void ph_gdn_pre(Frame& F, const bf16* P, const float* cw, const float* alog, const float* dtb, unsigned char* BL) {
    for (int it = F.vcu; it < 272 * 8; it += F.G) { const int tbi = it >> 3, h = (it >> 1) & 3, d = it & 1; gdn_pre_item(F, P, cw, alog, dtb, BL, tbi, h, d); }
}

constexpr int SLOT_BYTES = 24576;
__device__ __forceinline__ void dplr_scan_seq(Frame& F, const unsigned char* BLgen, int seq, float* YSgen0, float* YSgen1) {
    const GAS unsigned char* BL = (const GAS unsigned char*)BLgen; GAS float* YS = (GAS float*)((seq >> 4) ? YSgen1 : YSgen0);
    const int w = F.wave, lane = F.lane, r = lane & 15, g = lane >> 4;
    const int d = seq >> 4, b = (seq >> 2) & 3, h = seq & 3;
    LAS unsigned char* ring = F.lds + RING_OFF;
    if (w >= 4) {
        const int lw = w - 4;
#define SCAN_ISSUE(n) do { const GAS unsigned char* src = BL + ((size_t)seq * 68 + (n)) * ITEM_BYTES + lw * 6144 + lane * 16; LAS unsigned char* dst = ring + ((n) % 5) * SLOT_BYTES + lw * 6144; \
        _Pragma("unroll") for (int q = 0; q < 6; ++q) __builtin_amdgcn_global_load_lds((const GAS unsigned*)(src + q * 1024), (LAS unsigned*)(dst + q * 1024), 16, 0, 0); } while (0)
        SCAN_ISSUE(0); SCAN_ISSUE(1); SCAN_ISSUE(2); SCAN_ISSUE(3);
        asm volatile("s_waitcnt vmcnt(18)" ::: "memory");
        __builtin_amdgcn_s_barrier(); asm volatile("" ::: "memory");
        for (int n = 0; n < 68; ++n) {
            if (n + 4 < 68) { SCAN_ISSUE(n + 4); asm volatile("s_waitcnt vmcnt(18)" ::: "memory"); }
            else asm volatile("s_waitcnt vmcnt(0)" ::: "memory");
            __builtin_amdgcn_s_barrier(); asm volatile("" ::: "memory");
        }
#undef SCAN_ISSUE
    } else {
        const int v = 16 * w + r;
        f32x4 z[4];
#pragma unroll
        for (int kb = 0; kb < 4; ++kb) z[kb] = zero4();
        struct Strip { unsigned long long ut[4], y0[4], d0[4]; f32x4 gc[4]; };
#define STRIP_LOAD(S, n) do { const GAS unsigned char* it_ = BL + ((size_t)seq * 68 + (n)) * ITEM_BYTES; const GAS bf16* UT_ = (const GAS bf16*)(it_ + IT_UT) + v * 64; const GAS bf16* Y0_ = (const GAS bf16*)(it_ + IT_Y0) + v * 64; \
        const GAS bf16* D0_ = (const GAS bf16*)(it_ + IT_D0) + v * 64; const GAS float* GC_ = (const GAS float*)(it_ + IT_GC); \
        _Pragma("unroll") for (int q = 0; q < 4; ++q) { S.ut[q] = *(const GAS unsigned long long*)(UT_ + 16 * q + 4 * g); S.y0[q] = *(const GAS unsigned long long*)(Y0_ + 16 * q + 4 * g); \
            S.d0[q] = *(const GAS unsigned long long*)(D0_ + 16 * q + 4 * g); S.gc[q] = *(const GAS f32x4*)(GC_ + 16 * q + 4 * g); } } while (0)
#define SCAN_BODY(S, n, SL) do { TSECN_BEGIN(8) const LAS unsigned char* slot = ring + (SL) * SLOT_BYTES; const LAS unsigned char* sx0 = slot + xo[0]; const LAS unsigned char* sx1 = slot + xo[1]; const LAS unsigned char* sx2 = slot + xo[2]; const LAS unsigned char* sx3 = slot + xo[3]; \
        bf16x4 zb[4]; _Pragma("unroll") for (int kb = 0; kb < 4; ++kb) zb[kb] = cvt4(z[kb]); \
        f32x4 sa[4], y[4]; \
        _Pragma("unroll") for (int tt = 0; tt < 4; ++tt) { sa[tt] = up4(S.ut[tt]); y[tt] = up4(S.y0[tt]); } \
        _Pragma("unroll") for (int kp = 0; kp < 2; ++kp) { const LAS unsigned char* sxa = kp == 0 ? sx0 : sx2; const LAS unsigned char* sxb = kp == 0 ? sx1 : sx3;     \
            _Pragma("unroll") for (int tt = 0; tt < 4; ++tt) { sa[tt] = MFMA32P(*(const LAS bf16x4*)(sxa + IT_KP + tt * 2048), *(const LAS bf16x4*)(sxb + IT_KP + tt * 2048), zb[2 * kp], zb[2 * kp + 1], sa[tt]); \
                y[tt] = MFMA32P(*(const LAS bf16x4*)(sxa + IT_RP + tt * 2048), *(const LAS bf16x4*)(sxb + IT_RP + tt * 2048), zb[2 * kp], zb[2 * kp + 1], y[tt]); } } \
        bf16x4 sb[4]; _Pragma("unroll") for (int tt = 0; tt < 4; ++tt) sb[tt] = cvt4(sa[tt]); \
        f32x4 zu[4]; _Pragma("unroll") for (int kb = 0; kb < 4; ++kb) zu[kb] = zero4(); \
        _Pragma("unroll") for (int tp = 0; tp < 2; ++tp) { const LAS unsigned char* sxa = tp == 0 ? sx0 : sx2; const LAS unsigned char* sxb = tp == 0 ? sx1 : sx3; \
            _Pragma("unroll") for (int kb = 0; kb < 4; ++kb) zu[kb] = MFMA32P(*(const LAS bf16x4*)(sxa + IT_BH + kb * 2048), *(const LAS bf16x4*)(sxb + IT_BH + kb * 2048), sb[2 * tp], sb[2 * tp + 1], zu[kb]); } \
        _Pragma("unroll") for (int kb = 0; kb < 4; ++kb) z[kb] = S.gc[kb] * z[kb] + up4(S.d0[kb]) - zu[kb]; \
        { int m0; if ((n) < 4) { const int j = d ? 3 - (n) : (n); m0 = NX + (b * 4 + j) * 64; } else { const int j = d ? 63 - ((n) - 4) : ((n) - 4); m0 = (b * 64 + j) * 64; } \
          GAS float* yb = YS + (size_t)m0 * 256 + h * 64 + v; \
          _Pragma("unroll") for (int tt = 0; tt < 4; ++tt) _Pragma("unroll") for (int i = 0; i < 4; ++i) { const int t = 16 * tt + 4 * g + i, tau = d ? 63 - t : t; yb[(size_t)tau * 256] = y[tt][i]; } } \
        if ((n) + 2 < 68) STRIP_LOAD(S, (n) + 2); \
        TSECN_END(8) TSECN_BEGIN(9) \
        asm volatile("" ::: "memory"); __builtin_amdgcn_s_barrier(); asm volatile("" ::: "memory"); TSECN_END(9) } while (0)
        int xo[4];
#pragma unroll
        for (int q = 0; q < 4; ++q) xo[q] = r * 128 + (((4 * q + g) ^ r) << 3);
        Strip S0, S1; STRIP_LOAD(S0, 0); STRIP_LOAD(S1, 1);
        __builtin_amdgcn_s_barrier(); asm volatile("" ::: "memory");
        for (int n = 0; n < 68; n += 2) { SCAN_BODY(S0, n, (n % 5)); SCAN_BODY(S1, n + 1, ((n + 1) % 5)); }
#undef STRIP_LOAD
#undef SCAN_BODY
    }
}
constexpr int RWT_A2 = 2 * 2 * 256 * 32, RWT_V2 = 2 * RWT_A2, RWT_G2 = RWT_V2 + 256 * 32, RWT_TOTAL = RWT_G2 + 2 * 256 * 64;
__device__ __forceinline__ void ph_convert_rwkv(Frame& F, const float* w2, const float* a2, const float* v2, const float* g2, bf16* RWTp) {
    for (int i = F.vcu * NTHR + F.tid; i < RWT_TOTAL; i += F.G * NTHR) {
        float x;
        if (i < RWT_V2) { const int which = i >= RWT_A2, r = i - which * RWT_A2, ld = r >> 13, c = (r >> 5) & 255, j = r & 31; x = (which ? a2 : w2)[((size_t)ld * 32 + j) * 256 + c]; }
        else if (i < RWT_G2) { const int r = i - RWT_V2, c = r >> 5, j = r & 31; x = v2[j * 256 + c]; }
        else { const int r = i - RWT_G2, l = r >> 14, c = (r >> 6) & 255, j = r & 63; x = g2[((size_t)l * 64 + j) * 256 + c]; }
        RWTp[i] = f2bf(x); }
}
constexpr int RW_RSTR = 720;
constexpr int RW_RAW = 0, RW_TW = 55296, RW_AD = RW_TW + 64 * 80, RW_VD = RW_AD + 64 * 80, RW_GD = RW_VD + 64 * 80, RW_ZZ = RW_GD + 64 * 144, RW_ZA = RW_ZZ + 16384, RW_ZV = RW_ZA + 16384, RW_ZG = RW_ZV + IMG;
static_assert(RW_ZG + IMG <= RING_BYTES && 66 * RW_RSTR <= RW_TW, "RWKV prep LDS map");
constexpr int RW_WT = LDSCTL_OFF + 4096;
__device__ __forceinline__ void rwkv_pre_item(Frame& F, const bf16* Pgen, const RwP& wp, const bf16* RWTg, int layer, float* VF, float* SV, float* GB, float* BSC, unsigned char* BL, int tbi, int h, int d) {
    int w = F.wave; asm volatile("" : "+s"(w));
    const GAS bf16* P = (const GAS bf16*)Pgen; const GAS bf16* RWTp = (const GAS bf16*)RWTg;
    const TB tb = tb_of(tbi); const int lane = F.lane, tid = F.tid, L = tb.isx ? SEQ : CTXL, c = h * 64 + lane, r = lane & 15, g = lane >> 4;
    LAS unsigned char* lds = F.lds + RING_OFF; LAS float* WT = (LAS float*)(F.lds + RW_WT);
    const int seq = (d * 4 + tb.b) * 4 + h; GAS unsigned char* item = item_ptr(BL, seq, chunk_of(tb, d));
#pragma unroll
    for (int q = 0; q < 6; ++q) { const int e0 = tid + q * NTHR, e = e0 < 66 * 44 ? e0 : 66 * 44 - 1; const int row = e / 44, ch = e % 44; const int t = tb.t0 - 1 + row; const bool ok = t >= 0 && t < L; const int rowc = ok ? row : 1;
        const int pcol = ch < 24 ? (ch >> 3) * 256 + h * 64 + (ch & 7) * 8 : ch < 28 ? 768 + d * 32 + (ch - 24) * 8 : ch < 32 ? 832 + d * 32 + (ch - 28) * 8 : ch < 40 ? 896 + (ch - 32) * 8 : VRES_OFF + (ch - 40) * 8;
        v4u val = *(const GAS v4u*)(P + (size_t)(tb.m0 - 1 + rowc) * LDP + pcol); if (!ok) val = (v4u){0u, 0u, 0u, 0u};
        *(LAS v4u*)(lds + RW_RAW + row * RW_RSTR + ch * 16) = val; }
    float svf[8];
#pragma unroll
    for (int u = 0; u < 8; ++u) { const int s = 8 * w + u, tau = d ? 63 - s : s; svf[u] = layer ? VF[(size_t)(tb.m0 + tau) * 256 + c] : 0.f; }
    LDS_BARRIER();
#define RAWV(row, col) bf2f(*(const LAS bf16*)(lds + RW_RAW + (row) * RW_RSTR + (col) * 2))
#define RSHF(tau_, col, mu_) ([&]() { const float p_ = RAWV((tau_) + 1, col); return p_ + (0.5f * (RAWV((tau_), col) + RAWV((tau_) + 2, col)) - p_) * (mu_); }())
    { const int tau = tid & 63, cg = tid >> 6;
#pragma unroll 4
      for (int q = 0; q < 20; ++q) { const int j = cg * 20 + q;
          if (j < 32) { const float x = RSHF(tau, 192 + j, wp.mu[768 + d * 32 + j]); *(LAS bf16*)(lds + RW_TW + tau * 80 + 2 * j) = f2bf(tanhf_(x)); }
          else if (j < 64) { const float x = RSHF(tau, 224 + (j - 32), wp.mu[832 + d * 32 + (j - 32)]); *(LAS bf16*)(lds + RW_AD + tau * 80 + 2 * (j - 32)) = f2bf(x); }
          else if (j < 128) { const float x = RSHF(tau, 256 + (j - 64), wp.mu[896 + (j - 64)]); *(LAS bf16*)(lds + RW_GD + tau * 144 + 2 * (j - 64)) = f2bf(sigmoidf_(x)); }
          else { *(LAS bf16*)(lds + RW_VD + tau * 80 + 2 * (j - 128)) = *(const LAS bf16*)(lds + RW_RAW + (tau + 1) * RW_RSTR + (320 + (j - 128)) * 2); } } }
    LDS_BARRIER();
    { const int p = w >> 1; const bool live = p < 2 || (p == 2 && layer) || (p == 3 && d == 0);
      if (live) { const int ksteps = p == 3 ? 4 : 2, astr = p == 3 ? 144 : 80; const LAS unsigned char* A = lds + (p == 0 ? RW_TW : p == 1 ? RW_AD : p == 2 ? RW_VD : RW_GD);
          const GAS bf16* Bw = p == 0 ? RWTp + ((size_t)(layer * 2 + d) * 256 + h * 64) * 32 : p == 1 ? RWTp + RWT_A2 + ((size_t)(layer * 2 + d) * 256 + h * 64) * 32 : p == 2 ? RWTp + RWT_V2 + (size_t)(h * 64) * 32 : RWTp + RWT_G2 + ((size_t)layer * 256 + h * 64) * 64;
          const int bstr = p == 3 ? 64 : 32;
#pragma unroll
          for (int sq = 0; sq < 2; ++sq) { const int st = 2 * (w & 1) + sq;
#pragma unroll
              for (int ct = 0; ct < 4; ++ct) { f32x4 acc = zero4();
                  for (int ks = 0; ks < ksteps; ++ks) { const bf16x4 af = *(const LAS bf16x4*)(A + (16 * st + r) * astr + (16 * ks + 4 * g) * 2); const bf16x4 bfr = *(const GAS bf16x4*)(Bw + (size_t)(16 * ct + r) * bstr + 16 * ks + 4 * g); acc = MFMA16(af, bfr, acc); }
#pragma unroll
                  for (int i = 0; i < 4; ++i) { const int tau = 16 * st + 4 * g + i, cc = 16 * ct + r;
                      if (p == 0) *(LAS float*)(lds + RW_ZZ + (tau * 64 + cc) * 4) = acc[i]; else if (p == 1) *(LAS float*)(lds + RW_ZA + (tau * 64 + cc) * 4) = acc[i];
                      else if (p == 2) *(LAS bf16*)(lds + RW_ZV + tau * LSTR + 2 * cc) = f2bf(acc[i]); else *(LAS bf16*)(lds + RW_ZG + tau * LSTR + 2 * cc) = f2bf(acc[i]); } } } } }
    LDS_BARRIER();
    float rv[8], kn[8], kd[8], bv[8], sv[8], lwv[8], gl[8]; float run = 0.f;
    { const float w0c = wp.w0[d * 256 + c], a0c = wp.a0[d * 256 + c], kkc = wp.kk[c], kac = wp.ka[c], rkc = wp.rk[c], v0c = layer ? wp.v0[c] : 0.f;
      const float mur = wp.mu[c], muk = wp.mu[256 + c], muv = wp.mu[512 + c];
#pragma unroll
      for (int u = 0; u < 8; ++u) { const int s = 8 * w + u, tau = d ? 63 - s : s, m = tb.m0 + tau;
          const float rr = RSHF(tau, lane, mur), kraw = RSHF(tau, 64 + lane, muk); float v = RSHF(tau, 128 + lane, muv);
          const float z = w0c + *(const LAS float*)(lds + RW_ZZ + (tau * 64 + lane) * 4), za = a0c + *(const LAS float*)(lds + RW_ZA + (tau * 64 + lane) * 4);
          const float lw = -0.6065306597f * sigmoidf_(z), a = sigmoidf_(za);
          const float kkr = kraw * kkc; const float kkn = kkr * rsqrtf(wave_sum(kkr * kkr) + 1e-6f);
          const float kdv = kraw * (1.f + (a - 1.f) * kac);
          const float bs = wave_sum(rr * kdv * rkc);
          if (lane == 0) BSC[((size_t)d * MT + m) * 4 + h] = bs;
          if (layer) { const float zv = v0c + bf2f(*(const LAS bf16*)(lds + RW_ZV + tau * LSTR + 2 * lane)); v = v + (svf[u] - v) * sigmoidf_(zv); }
          if (d == 0) { if (!layer) VF[(size_t)m * 256 + c] = v; SV[(size_t)m * 256 + c] = v; GB[(size_t)m * 256 + c] = bf2f(*(const LAS bf16*)(lds + RW_ZG + tau * LSTR + 2 * lane)); }
          run += lw; rv[u] = rr; kn[u] = kkn; kd[u] = kdv; bv[u] = kkn * a; sv[u] = v; lwv[u] = lw; gl[u] = run; } }
#undef RSHF
#undef RAWV
    WT[w * 64 + lane] = run;
    LDS_BARRIER();
    float off = 0.f, gc = 0.f;
#pragma unroll
    for (int q = 0; q < 8; ++q) { const float t = WT[q * 64 + lane]; gc += t; if (q < w) off += t; }
#pragma unroll
    for (int u = 0; u < 8; ++u) { const int s = 8 * w + u; const float G = off + gl[u]; const float eg = __expf(G), eng = __expf(-G), egc = __expf(gc - G); const bf16 kap = f2bf(kn[u] * __expf(G - lwv[u])), rho = f2bf(rv[u] * eg);
        *(LAS bf16*)(pimg(F, PI_A0) + s * LSTR + 2 * lane) = kap; *(LAS bf16*)(pimg(F, PI_KAPT) + lane * LSTR + 2 * s) = kap;
        *(LAS bf16*)(pimg(F, PI_A1) + s * LSTR + 2 * lane) = f2bf(bv[u] * eng); *(LAS bf16*)(pimg(F, PI_A2) + s * LSTR + 2 * lane) = f2bf(kd[u] * eng);
        *(LAS bf16*)(pimg(F, PI_A3) + s * LSTR + 2 * lane) = rho; *(LAS bf16*)(pimg(F, PI_RHOT) + lane * LSTR + 2 * s) = rho;
        *(LAS bf16*)(pimg(F, PI_VT) + lane * LSTR + 2 * s) = f2bf(sv[u]); *(LAS bf16*)(pimg(F, PI_KHT) + lane * LSTR + 2 * s) = f2bf(kd[u] * egc);
        *(GAS bf16*)(item + IT_BH + swz(lane, s)) = f2bf(bv[u] * egc); }
    if (w == 0) ((GAS float*)(item + IT_GC))[lane] = __expf(gc);
    LDS_BARRIER();
    dplr_core<false>(F, item);
}
__device__ __forceinline__ void ph_rwkv_pre(Frame& F, const bf16* P, const RwP& wp, const bf16* RWTg, int layer, float* VF, float* SV, float* GB, float* BSC, unsigned char* BL) {
    for (int it = F.vcu; it < 272 * 8; it += F.G) { const int tbi = it >> 3, h = (it >> 1) & 3, d = it & 1; rwkv_pre_item(F, P, wp, RWTg, layer, VF, SV, GB, BSC, BL, tbi, h, d); }
}

__device__ __forceinline__ void ph_rwkv_post(Frame& F, const float* YSg, const float* BSCg, const float* SVg, const float* Gg, const float* lnw, const float* lnb, bf16* MIXg) {
    const GAS float* YS = (const GAS float*)YSg; const GAS float* BSC = (const GAS float*)BSCg; const GAS float* SV = (const GAS float*)SVg; const GAS float* G = (const GAS float*)Gg; GAS bf16* MIX = (GAS bf16*)MIXg;
    const int gw = F.vcu * NWAVES + F.wave, NGW = F.G * NWAVES, lane = F.lane;
    for (int i0 = gw; i0 < MT * 4; i0 += 4 * NGW) {
        float y[4], bon[4], gg[4]; int mm[4], cc[4]; bool ok[4];
#pragma unroll
        for (int q = 0; q < 4; ++q) { const int it = i0 + q * NGW; ok[q] = it < MT * 4; const int itc = ok[q] ? it : i0; const int m = itc >> 2, h = itc & 3, c = h * 64 + lane; mm[q] = m; cc[q] = c;
            y[q] = YS[(size_t)m * 256 + c] + YS[((size_t)MT + m) * 256 + c]; bon[q] = (BSC[(size_t)m * 4 + h] + BSC[((size_t)MT + m) * 4 + h]) * SV[(size_t)m * 256 + c]; gg[q] = G[(size_t)m * 256 + c]; }
#pragma unroll
        for (int q = 0; q < 4; ++q) { const float mu = wave_sum(y[q]) * (1.f / 64.f); const float dlt = y[q] - mu; const float var = wave_sum(dlt * dlt) * (1.f / 64.f);
            const float yn = dlt * rsqrtf(var + 64e-5f); const float o = (yn * lnw[cc[q]] + lnb[cc[q]] + bon[q]) * gg[q];
            if (ok[q]) MIX[(size_t)mm[q] * D + cc[q]] = f2bf(o); }
    }
}
__device__ __forceinline__ void ph_hnorm_post(Frame& F, const float* YSag, const float* YSbg, const bf16* Pg, int gate_off, const float* nw, bf16* MIXg, int mix_off) {
    const GAS float* YSa = (const GAS float*)YSag; const GAS float* YSb = (const GAS float*)YSbg; const GAS bf16* P = (const GAS bf16*)Pg; GAS bf16* MIX = (GAS bf16*)MIXg;
    const int gw = F.vcu * NWAVES + F.wave, NGW = F.G * NWAVES, lane = F.lane; const float nwv = nw[lane];
    for (int i0 = gw; i0 < MT * 4; i0 += 4 * NGW) {
        float o[4], g[4]; int mm[4], cc[4]; bool ok[4];
#pragma unroll
        for (int q = 0; q < 4; ++q) { const int it = i0 + q * NGW; ok[q] = it < MT * 4; const int itc = ok[q] ? it : i0; const int m = itc >> 2, c = (itc & 3) * 64 + lane; mm[q] = m; cc[q] = c;
            o[q] = YSa[(size_t)m * 256 + c] + YSb[(size_t)m * 256 + c]; g[q] = bf2f(P[(size_t)m * LDP + gate_off + c]); }
#pragma unroll
        for (int q = 0; q < 4; ++q) { const float ms = wave_sum(o[q] * o[q]) * (1.f / 64.f); const float y = o[q] * rsqrtf(ms + 1e-6f) * siluf_(g[q]) * nwv;
            if (ok[q]) MIX[(size_t)mm[q] * D + mix_off + cc[q]] = f2bf(y); }
    }
}
__device__ __forceinline__ void ph_lru_pre(Frame& F, const bf16* Pgen, const LruP& wp, bf16* LLAg, bf16* LBg, float* LSUMg) {
    const GAS bf16* P = (const GAS bf16*)Pgen; GAS bf16* LLA = (GAS bf16*)LLAg; GAS bf16* LB = (GAS bf16*)LBg; GAS float* LSUM = (GAS float*)LSUMg;
    const int w = F.wave, lane = F.lane, r = lane & 15, g = lane >> 4, tid = F.tid;
    LAS unsigned char* XM = F.lds + RING_OFF;
    LAS unsigned char* WA = F.lds + RING_OFF + 1 * IMG;
    LAS unsigned char* WX = F.lds + RING_OFF + 2 * IMG;
    LAS float* LAs = (LAS float*)(F.lds + RING_OFF + 3 * IMG);
    LAS float* BBs = LAs + 4096;
    const int dh = F.vcu & 7, d = dh >> 2, h = dh & 3;
    { const float* wa = wp.wa + (size_t)dh * 4096; const float* wx = wp.wx + (size_t)dh * 4096;
#pragma unroll
      for (int q = 0; q < 8; ++q) { const int e = tid + q * NTHR, i = e >> 6, j = e & 63; *(LAS bf16*)(WA + j * LSTR + 2 * i) = f2bf(wa[e]); *(LAS bf16*)(WX + j * LSTR + 2 * i) = f2bf(wx[e]); } }
    const int cc = tid & 63, sg = tid >> 6, c = h * 64 + cc;
    const float cb = wp.cb[c]; float cwv[4];
#pragma unroll
    for (int j = 0; j < 4; ++j) cwv[j] = wp.cw[j * 256 + c];
    for (int it = F.vcu; it < 272 * 8; it += F.G) {
        const int tbi = it >> 3; const TB tb = tb_of(tbi); const int L = tb.isx ? SEQ : CTXL;
        { const GAS bf16* pc = P + (size_t)tb.m0 * LDP + LRU_OFF + c; float rowv[11];
#pragma unroll
          for (int q = 0; q < 11; ++q) { const int s = 8 * sg - 2 + q, t = tb.t0 + s; const bool ok = t >= 0 && t < L; const int sc = ok ? s : 8 * sg; const float v = bf2f(pc[(ptrdiff_t)sc * LDP]); rowv[q] = ok ? v : 0.f; }
#pragma unroll
          for (int u = 0; u < 8; ++u) { const float xm = cb + rowv[u] * cwv[0] + rowv[u + 1] * cwv[1] + rowv[u + 2] * cwv[2] + rowv[u + 3] * cwv[3];
              *(LAS bf16*)(XM + (8 * sg + u) * LSTR + 2 * cc) = f2bf(xm); } }
        LDS_BARRIER();
        { const int tt = w & 3, jh = w >> 2;
#pragma unroll
          for (int jq = 0; jq < 2; ++jq) { const int jt = 2 * jh + jq;
              const f32x4 ra = nt_tile64(XM, 16 * tt, WA, 16 * jt, lane, zero4()), rx = nt_tile64(XM, 16 * tt, WX, 16 * jt, lane, zero4());
              const int j = 16 * jt + r, cj = h * 64 + j; const float ba = wp.ba[d * 256 + cj], bx = wp.bx[d * 256 + cj], lam8 = -8.f * softplusf_(-wp.lam[d * 256 + cj]);
#pragma unroll
              for (int i = 0; i < 4; ++i) { const int s = 16 * tt + 4 * g + i; const float xm = bf2f(*(const LAS bf16*)(XM + s * LSTR + 2 * j));
                  const float la = lam8 * sigmoidf_(ra[i] + ba); const float bb = __builtin_amdgcn_sqrtf(fmaxf(1.f - __expf(2.f * la), 0.f)) * sigmoidf_(rx[i] + bx) * xm;
                  LAs[s * 64 + j] = la; BBs[s * 64 + j] = bb;
                  const size_t o = ((size_t)d * MT + tb.m0 + s) * 256 + cj; LLA[o] = f2bf(la); LB[o] = f2bf(bb); } } }
        LDS_BARRIER();
        if (w == 0) { float sl = 0.f, hh = 0.f;
#pragma unroll 8
            for (int s = 0; s < 64; ++s) { const int tau = d ? 63 - s : s; const float la = LAs[tau * 64 + lane], bb = BBs[tau * 64 + lane]; sl += la; hh = __expf(la) * hh + bb; }
            LSUM[(((size_t)d * 272 + tbi) * 2 + 0) * 256 + h * 64 + lane] = sl; LSUM[(((size_t)d * 272 + tbi) * 2 + 1) * 256 + h * 64 + lane] = hh; }
        LDS_BARRIER();
    }
}
__device__ __forceinline__ void ph_lru_carry(Frame& F, const float* LSUMg, float* LCINg) {
    if (blockIdx.x >= 4) return;
    const GAS float* LSUM = (const GAS float*)LSUMg; GAS float* LCIN = (GAS float*)LCINg;
    const int e = blockIdx.x * NTHR + F.tid, c = e & 255, bd = e >> 8, d = bd & 1, b = bd >> 1;
    float hh = 0.f;
#pragma unroll 1
    for (int n0 = 0; n0 < 68; n0 += 17) { float sl[17], he[17]; int tb_[17];
#pragma unroll
        for (int u = 0; u < 17; ++u) { const int n = n0 + u; tb_[u] = n < 4 ? 256 + b * 4 + (d ? 3 - n : n) : b * 64 + (d ? 63 - (n - 4) : (n - 4));
            sl[u] = LSUM[(((size_t)d * 272 + tb_[u]) * 2 + 0) * 256 + c]; he[u] = LSUM[(((size_t)d * 272 + tb_[u]) * 2 + 1) * 256 + c]; }
#pragma unroll
        for (int u = 0; u < 17; ++u) { LCIN[((size_t)d * 272 + tb_[u]) * 256 + c] = hh; hh = __expf(sl[u]) * hh + he[u]; } }
}
__device__ __forceinline__ void ph_lru_post(Frame& F, const bf16* P, const bf16* LLA, const bf16* LB, const float* LCIN, bf16* MIX) {
    const int half = F.tid >> 8, c = F.tid & 255;
    for (int it = F.vcu; it < 136; it += F.G) { const int tbi = it * 2 + half; const TB tb = tb_of(tbi);
        float hf[64]; float hh = LCIN[((size_t)0 * 272 + tbi) * 256 + c];
        const GAS bf16* pa = (const GAS bf16*)(LLA + (size_t)tb.m0 * 256 + c); const GAS bf16* pb = (const GAS bf16*)(LB + (size_t)tb.m0 * 256 + c);
#pragma unroll
        for (int s0 = 0; s0 < 64; s0 += 8) { float la[8], bb[8];
            asm volatile("" : "+v"(pa), "+v"(pb));
#pragma unroll
            for (int u = 0; u < 8; ++u) { la[u] = bf2f(pa[u * 256]); bb[u] = bf2f(pb[u * 256]); }
#pragma unroll
            for (int u = 0; u < 8; ++u) { hh = __expf(la[u]) * hh + bb[u]; hf[s0 + u] = hh; }
            pa += 8 * 256; pb += 8 * 256; }
        hh = LCIN[((size_t)1 * 272 + tbi) * 256 + c];
        pa = (const GAS bf16*)(LLA + ((size_t)MT + tb.m0 + 56) * 256 + c); pb = (const GAS bf16*)(LB + ((size_t)MT + tb.m0 + 56) * 256 + c);
        const GAS bf16* pg = (const GAS bf16*)(P + (size_t)(tb.m0 + 56) * LDP + LRU_OFF + 256 + c); GAS bf16* pm = (GAS bf16*)(MIX + (size_t)(tb.m0 + 56) * D + 768 + c);
#pragma unroll
        for (int s0 = 56; s0 >= 0; s0 -= 8) { float la[8], bb[8], gt[8];
            asm volatile("" : "+v"(pa), "+v"(pb), "+v"(pg), "+v"(pm));
#pragma unroll
            for (int u = 0; u < 8; ++u) { la[u] = bf2f(pa[(7 - u) * 256]); bb[u] = bf2f(pb[(7 - u) * 256]); gt[u] = bf2f(pg[(7 - u) * LDP]); }
#pragma unroll
            for (int u = 0; u < 8; ++u) { const int s = s0 + 7 - u; hh = __expf(la[u]) * hh + bb[u];
                const float ge = 0.5f * gt[u] * (1.f + tanhf_(0.7978845608f * (gt[u] + 0.044715f * gt[u] * gt[u] * gt[u])));
                pm[(7 - u) * D] = f2bf((hf[s] + hh) * ge); }
            pa -= 8 * 256; pb -= 8 * 256; pg -= 8 * LDP; pm -= 8 * D; }
    }
}

__device__ __forceinline__ void ph_final_norm(Frame& F, const float* XR, const float* gain, float* out) {
    const int gw = F.vcu * NWAVES + F.wave, NGW = F.G * NWAVES, lane = F.lane;
    for (int m = gw; m < NX; m += NGW) {
        const float* src = XR + (size_t)m * D; f32x4 v[4]; float ss = 0.f;
#pragma unroll
        for (int j = 0; j < 4; ++j) { v[j] = *(const f32x4*)(src + 4 * lane + 256 * j); ss += (v[j].x * v[j].x + v[j].y * v[j].y) + (v[j].z * v[j].z + v[j].w * v[j].w); }
        ss = wave_sum(ss); const float rs = rsqrtf(ss * (1.f / D) + 1e-6f);
#pragma unroll
        for (int j = 0; j < 4; ++j) { const int ci = 4 * lane + 256 * j; *(f32x4*)(out + (size_t)m * D + ci) = v[j] * rs * *(const f32x4*)(gain + ci); }
    }
}

#define INP(i) ([&]() { int ii_ = (i); asm volatile("" : "+s"(ii_)); return (const float*)(const GAS float*)a.in[ii_]; }())
#ifndef PH_MASK
#define PH_MASK 0xfffff
#endif
#define IN(k) ((PH_MASK >> (k)) & 1)
#define SEAM() do { xcd_barrier(bar); if (PROBE_SEC == 100 + F.curk) F.tacc += clock64() - F.tph0; } while (0)
#define MOD ((float*)(GAS float*)(wsb + WS_MOD))
#define XN ((bf16*)(GAS bf16*)(wsb + WS_XN))
#define XR ((float*)(GAS float*)(wsb + WS_XR))
#define P ((bf16*)(GAS bf16*)(wsb + WS_P))
#define WIN_T ((bf16*)(GAS bf16*)(wsb + WS_WIN))
#define WOUT_T ((bf16*)(GAS bf16*)(wsb + WS_WOUT))
#define VF ((float*)(GAS float*)(wsb + WS_VF))
#define BON ((float*)(GAS float*)(wsb + WS_BON))
#define GG ((float*)(GAS float*)(wsb + WS_G))
#define YS ((float*)(GAS float*)(wsb + WS_YS))
#define SV ((float*)(GAS float*)(wsb + WS_SV))
#define SI ((float*)(GAS float*)(wsb + WS_SI))
#define WGU_T ((bf16*)(GAS bf16*)(wsb + WS_WGU))
#define WD_T ((bf16*)(GAS bf16*)(wsb + WS_WD))
#define HACT ((bf16*)(GAS bf16*)(wsb + WS_HACT))
#define Y ((bf16*)(GAS bf16*)(wsb + WS_Y))
#define DZ ((bf16*)(GAS bf16*)(wsb + WS_DZ))
#define BSC ((float*)(GAS float*)(wsb + WS_BSC))
#define YS2A ((float*)(GAS float*)(wsb + WS_BON))
#define YS2B ((float*)(GAS float*)(wsb + WS_YS2B))
#define LLA ((bf16*)(GAS bf16*)(wsb + WS_LLA))
#define LBB ((bf16*)(GAS bf16*)(wsb + WS_LB))
#define LSUM ((float*)(GAS float*)(wsb + WS_LSUM))
#define LCIN ((float*)(GAS float*)(wsb + WS_LCIN))
#define LIST ((unsigned*)(GAS unsigned*)(wsb + WS_LIST))
#define SLOTPOS ((int*)(GAS int*)(wsb + WS_SLOT))
#define SLOTG ((float*)(GAS float*)(wsb + WS_SLOTG))
#define RTW_T ((bf16*)(GAS bf16*)(wsb + WS_RTW))
#define RWT ((bf16*)(GAS bf16*)(wsb + WS_RWT))
#define MIX XN
#define PH() do { wsb = (GAS unsigned char*)ws; asm volatile("" : "+s"(wsb)); int t_ = threadIdx.x; asm volatile("" : "+v"(t_)); F.tid = t_; F.lane = t_ & 63; F.wave = __builtin_amdgcn_readfirstlane(t_ >> 6); half = t_ >> 8; c256 = t_ & 255; \
        shh = (LAS float*)(F.lds + RING_OFF + half * 8192); } while (0)

template <int l>
__device__ __forceinline__ void layer_body(Frame& F, const MArgs& a, const XcdBarrier& bar, unsigned char* ws) {
    GAS unsigned char* wsb = (GAS unsigned char*)ws; int half = 0, c256 = 0; LAS float* shh = nullptr;
        const float* MODl = MOD + (size_t)l * 5 * 6144;
        const float* xs = l == 0 ? INP(I_X) : XR; const float* cs = l == 0 ? INP(I_CTX) : XR + (size_t)NX * D;
        const int ntok = l == 0 ? MT : NX;
        if (IN(1) && l == 0) for (int rp_ = 0; rp_ < REPS(1); ++rp_) { PH(); F.curk = 1; if (PROBE_SEC >= 100) F.tph0 = clock64(); ph_norm_mod(F, xs, cs, INP(I_NMIX) + l * D, MODl, 0, XN, MT); __syncthreads();
            ph_convert_small(F, INP(I_WIN), INP(I_WVRES), INP(I_WOUT), WIN_T, WOUT_T, 1, 2); ph_convert_router(F, INP(I_RTW), RTW_T); ph_convert_rwkv(F, INP(I_RWW2), INP(I_RWA2), INP(I_RWV2), INP(I_RWG2), RWT); SEAM(); }
        if (IN(2)) for (int rp_ = 0; rp_ < REPS(2); ++rp_) { PH(); F.curk = 2; if (PROBE_SEC >= 100) F.tph0 = clock64(); pg8::DenseOrder S; S.init(XN, WIN_T + (size_t)l * LDP * D, MT, LDP, D, F.G, (int)blockIdx.x); pg8::EpiStoreBf16 E{P, LDP};
            pg8::gemm_phase<pg8::EpiStoreBf16, pg8::DenseOrder, true>(F.lds + RING_OFF, D, S, E); SEAM(); }
        float* LA = SI; float* LB = SI + (size_t)2 * MT * 256;
        if (IN(3)) for (int rp_ = 0; rp_ < REPS(3); ++rp_) { PH(); F.curk = 3; if (PROBE_SEC >= 100) F.tph0 = clock64(); const RwP rwp{INP(I_RWMU) + l * 960, INP(I_RWW0) + l * 512, INP(I_RWW2) + l * 2 * 32 * 256, INP(I_RWA0) + l * 512, INP(I_RWA2) + l * 2 * 32 * 256, INP(I_RWG2) + l * 64 * 256, INP(I_RWKK) + l * 256, INP(I_RWKA) + l * 256,
                      INP(I_RWRK) + l * 256, INP(I_RWV0), INP(I_RWV2)};
            ph_rwkv_pre(F, P, rwp, RWT, l, VF, SV, GG, BSC, (unsigned char*)SI); SEAM(); }
        if (IN(4)) for (int rp_ = 0; rp_ < REPS(4); ++rp_) { PH(); F.curk = 4; if (PROBE_SEC >= 100) F.tph0 = clock64();
            if (blockIdx.x < 32) { TSECN_BEGIN(30) dplr_scan_seq(F, (const unsigned char*)SI, (int)blockIdx.x, YS, YS + (size_t)MT * 256); TSECN_END(30) }
            else { TSECN_BEGIN(31) const int vcu0 = F.vcu, G0 = F.G; F.vcu = (int)blockIdx.x - 32; F.G = G0 - 32;
                { const LruP lrp{INP(I_LCW) + l * 4 * 256, INP(I_LCB) + l * 256, INP(I_LWA) + (size_t)l * 2 * 4 * 64 * 64, INP(I_LBA) + l * 512, INP(I_LWX) + (size_t)l * 2 * 4 * 64 * 64, INP(I_LBX) + l * 512, INP(I_LLAM) + l * 512};
                  ph_lru_pre(F, P, lrp, LLA, LBB, LSUM); }
                __syncthreads(); build_rope(F); __syncthreads(); ph_ret_pre(F, P, INP(I_RETL) + l * 8, DZ);
                F.vcu = vcu0; F.G = G0; TSECN_END(31) }
            SEAM(); }
        if (IN(5)) for (int rp_ = 0; rp_ < REPS(5); ++rp_) { PH(); F.curk = 5; if (PROBE_SEC >= 100) F.tph0 = clock64();
            ph_gdn_pre(F, P, INP(I_GCW) + l * 4 * 768, INP(I_GALOG) + l * 8, INP(I_GDT) + l * 8, (unsigned char*)SI);
            ph_ret_prefix(F, INP(I_RETL) + l * 8, DZ); ph_lru_carry(F, LSUM, LCIN); SEAM(); }
        if (IN(8)) for (int rp_ = 0; rp_ < REPS(8); ++rp_) { PH(); F.curk = 8; if (PROBE_SEC >= 100) F.tph0 = clock64();
            if (blockIdx.x < 32) { TSECN_BEGIN(30) dplr_scan_seq(F, (const unsigned char*)SI, (int)blockIdx.x, YS2A, YS2B); TSECN_END(30) }
            else { TSECN_BEGIN(32) const int vcu0 = F.vcu, G0 = F.G; F.vcu = (int)blockIdx.x - 32; F.G = G0 - 32;
                ph_rwkv_post(F, YS, BSC, SV, GG, INP(I_RWLNW) + l * 256, INP(I_RWLNB) + l * 256, MIX);
                build_rope(F); __syncthreads(); ph_ret_post(F, P, INP(I_RETL) + l * 8, DZ, MIX); __syncthreads(); ph_lru_post(F, P, LLA, LBB, LCIN, MIX);
                F.vcu = vcu0; F.G = G0; TSECN_END(32) }
            SEAM(); }
        if (IN(9)) for (int rp_ = 0; rp_ < REPS(9); ++rp_) { PH(); F.curk = 9; if (PROBE_SEC >= 100) F.tph0 = clock64(); ph_hnorm_post(F, YS2A, YS2B, P, GDN_OFF + 784, INP(I_GNW) + l * 64, MIX, 512); SEAM(); }
        if (IN(12)) for (int rp_ = 0; rp_ < REPS(12); ++rp_) { PH(); F.curk = 12; if (PROBE_SEC >= 100) F.tph0 = clock64(); pg8::DenseOrder S; S.init(MIX, WOUT_T + (size_t)l * D * D, l == 0 ? MT : NX  , D, D, F.G, (int)blockIdx.x); pg8::EpiResidual E{xs, cs, MODl, XR};
            pg8::gemm_phase<pg8::EpiResidual, pg8::DenseOrder, true>(F.lds + RING_OFF, D, S, E); SEAM(); }
        if (IN(13)) for (int rp_ = 0; rp_ < REPS(13); ++rp_) { PH(); F.curk = 13; if (PROBE_SEC >= 100) F.tph0 = clock64(); ph_route(F, XR, INP(I_NFFN) + l * D, MODl, RTW_T + (size_t)l * 2 * 64 * 1024, INP(I_RTB) + l * NE, XN, l, LIST, SLOTPOS, SLOTG, ntok); __syncthreads();
            { ph_convert_experts(F, INP(I_EWG) + (size_t)l * NE * D * EFF, INP(I_EWU) + (size_t)l * NE * D * EFF, INP(I_EWD) + (size_t)l * NE * EFF * D,
                               INP(I_SWG) + (size_t)l * D * EFF, INP(I_SWU) + (size_t)l * D * EFF, INP(I_SWD) + (size_t)l * EFF * D, WGU_T, WD_T); }
            SEAM(); }
        if (IN(14)) for (int rp_ = 0; rp_ < REPS(14); ++rp_) { PH(); F.curk = 14; if (PROBE_SEC >= 100) F.tph0 = clock64(); moe_build_tab(F, l, ntok); MoeTab T = moe_tab(F);
            pg8::MoeOrder1 S{XN, WGU_T, LIST, T, F.G, F.vcu  , T.ups[65] * 2}; pg8::EpiSwiglu E{HACT};
            pg8::gemm_phase<pg8::EpiSwiglu, pg8::MoeOrder1, true>(F.lds + RING_OFF, D, S, E); SEAM(); }
        if (IN(15)) for (int rp_ = 0; rp_ < REPS(15); ++rp_) { PH(); F.curk = 15; if (PROBE_SEC >= 100) F.tph0 = clock64(); moe_build_tab(F, l, ntok); MoeTab T = moe_tab(F);
            pg8::MoeOrder2 S{HACT, WD_T, T, F.G, F.vcu, T.ups[65] * 4}; pg8::EpiDown E{Y, XR, MODl};
            int k2 = EFF; asm volatile("" : "+s"(k2));
            pg8::gemm_phase<pg8::EpiDown, pg8::MoeOrder2, true>(F.lds + RING_OFF, k2, S, E); SEAM(); }
        if (IN(16)) for (int rp_ = 0; rp_ < REPS(16); ++rp_) { PH(); F.curk = 16; if (PROBE_SEC >= 100) F.tph0 = clock64(); moe_build_tab(F, l, ntok);
            if (l == 0) ph_combine_norm<false>(F, Y, SLOTPOS, SLOTG, MODl, XR, ntok, INP(I_NMIX) + D, MOD + (size_t)5 * 6144, XN, nullptr);
            else ph_combine_norm<true>(F, Y, SLOTPOS, SLOTG, MODl, XR, ntok, INP(I_NFIN), nullptr, nullptr, a.out);
            if (l == 0) SEAM(); }
    }

__global__ void __launch_bounds__(NTHR, 2) mega(MArgs a) {
    extern __shared__ __attribute__((aligned(16))) unsigned char lds_raw[];
    Frame F; F.lds = (LAS unsigned char*)lds_raw; F.MISC = (volatile LAS unsigned*)(F.lds + MISC_OFF);
    F.tid = threadIdx.x; F.lane = F.tid & 63; F.wave = __builtin_amdgcn_readfirstlane(F.tid >> 6); F.tacc = 0ull;
    F.G = gridDim.x; { const int bx = blockIdx.x; F.vcu = (F.G % 8 == 0) ? (bx % 8) * (F.G / 8) + bx / 8 : bx; }
    unsigned char* ws = a.ws; F.ctl = (gu32*)ws;
    for (int u = F.tid; u < (LDS_BYTES - LDSCTL_OFF) / 4; u += NTHR) ((LAS unsigned*)(F.lds + LDSCTL_OFF))[u] = 0u;
    __syncthreads();
    XcdBarrier bar = xcd_barrier_post((unsigned*)(F.ctl + CW_BAR) + a.bar_region * XCD_BAR_WORDS, F.MISC + 8);
    GAS unsigned char* wsb = (GAS unsigned char*)ws;
    int half = 0, c256 = 0; LAS float* shh = nullptr;

    if (IN(0)) for (int rp_ = 0; rp_ < REPS(0); ++rp_) { PH(); F.curk = 0; if (PROBE_SEC >= 100) F.tph0 = clock64(); ph_mod(F, INP(I_C), INP(I_CCTX), INP(I_ADAW), INP(I_ADAB), MOD); ph_convert_small(F, INP(I_WIN), INP(I_WVRES), INP(I_WOUT), WIN_T, WOUT_T, 0, 1);     SEAM(); }
    layer_body<0>(F, a, bar, ws);
    layer_body<1>(F, a, bar, ws);
    if (PROBE_SEC >= 0) { const unsigned long long t0_ = clock64(); while (clock64() - t0_ < F.tacc) __builtin_amdgcn_s_sleep(4); }
#undef PH
#undef MOD
#undef XN
#undef XR
#undef P
#undef WIN_T
#undef WOUT_T
#undef VF
#undef BON
#undef GG
#undef YS
#undef SV
#undef SI
#undef WGU_T
#undef WD_T
#undef HACT
#undef Y
#undef DZ
#undef BSC
#undef YS2A
#undef YS2B
#undef LLA
#undef LBB
#undef LSUM
#undef LCIN
#undef LIST
#undef SLOTPOS
#undef SLOTG
#undef RTW_T
#undef RWT
#undef MIX
#undef IN
#undef SEAM
}

extern "C" void kernel_launch(void* const* d_in, const int* in_sizes, int n_in, void* d_out, int out_size, void* d_ws, size_t ws_size, hipStream_t stream) {
    static int grid = 0;
    if (grid == 0) {
        if (n_in != I_N || ws_size < WS_END) { fprintf(stderr, "kernel_launch: bad n_in %d or ws %zu\n", n_in, ws_size); grid = -1; return; }
        int dev = 0, cus = 0;
        if (hipGetDevice(&dev) != hipSuccess || hipDeviceGetAttribute(&cus, hipDeviceAttributeMultiprocessorCount, dev) != hipSuccess) { grid = -1; return; }
        if (hipFuncSetAttribute((const void*)mega, hipFuncAttributeMaxDynamicSharedMemorySize, LDS_BYTES) != hipSuccess) { grid = -1; return; }
        int per_cu = 0; (void)hipOccupancyMaxActiveBlocksPerMultiprocessor(&per_cu, (const void*)mega, NTHR, LDS_BYTES); (void)hipGetLastError();
        grid = cus;
    }
    if (grid < 0) return;
    unsigned char* ws = (unsigned char*)d_ws;
    (void)hipMemsetAsync(ws, 0, CTL_ZERO_BYTES, stream);
    MArgs ma{}; for (int i = 0; i < I_N; ++i) ma.in[i] = (const float*)d_in[i]; ma.out = (float*)d_out; ma.ws = ws;
    ma.ph_lo = 0; ma.ph_hi = 18; ma.l_lo = 0; ma.l_hi = 2; ma.bar_region = 0;
    hipLaunchKernelGGL(mega, dim3(grid), dim3(NTHR), LDS_BYTES, stream, ma);
}
```

```cpp
#include <hip/hip_runtime.h>
#include <cstdio>
#include <cstdint>

typedef unsigned short bf16;
#ifndef PROBE_SEC
#define PROBE_SEC -1
#endif
__device__ unsigned long long g_tsec_dummy;
#define TSEC_BEGIN(id) unsigned long long ts0_##id = 0; if ((id) == PROBE_SEC) { asm volatile("s_waitcnt vmcnt(0) lgkmcnt(0)" ::: "memory"); ts0_##id = clock64(); }
#define TSECN_BEGIN(id) unsigned long long tn0_##id = 0; if ((id) == PROBE_SEC) { tn0_##id = clock64(); }
#define TSECN_END(id) if ((id) == PROBE_SEC) { F.tacc += clock64() - tn0_##id; }
#define TSEC_END(id) if ((id) == PROBE_SEC) { asm volatile("s_waitcnt vmcnt(0) lgkmcnt(0)" ::: "memory"); F.tacc += clock64() - ts0_##id; }
#ifndef PROBE_MASK
#define PROBE_MASK 0
#endif
#define REPS(k) (((PROBE_MASK >> (k)) & 1) ? 2 : 1)
#define RR(k) ([]() { int r_ = REPS(k); asm volatile("" : "+s"(r_)); return r_; }())
__device__ __forceinline__ float bf2f(bf16 v) { return __uint_as_float(((unsigned)v) << 16); }
typedef float f32x2_ __attribute__((ext_vector_type(2)));
typedef __bf16 bf16x2_ __attribute__((ext_vector_type(2)));
__device__ __forceinline__ unsigned cvtpk_bf16(float lo, float hi) { f32x2_ v = {lo, hi}; bf16x2_ b = __builtin_convertvector(v, bf16x2_); return __builtin_bit_cast(unsigned, b); }
__device__ __forceinline__ bf16 f2bf(float f) { return (bf16)(cvtpk_bf16(f, f) & 0xffffu); }

constexpr int D = 1024, NB = 4, SEQ = 4096, CTXL = 256;
constexpr int NX = NB * SEQ;
constexpr int NC = NB * CTXL;
constexpr int MT = NX + NC;
constexpr int NIN = 3536, NINV = 3568, LDP = 3584;
constexpr int RW_OFF = 0, RET_OFF = 960, GDN_OFF = 1984, LRU_OFF = 3024, VRES_OFF = 3536;
constexpr int NE = 64, TOPK = 8, EFF = 256;
constexpr int NSTEP = CTXL + SEQ;

constexpr size_t MiB = 1u << 20;
constexpr size_t WS_MOD = 1 * MiB;
constexpr size_t WS_XN = 2 * MiB;
constexpr size_t WS_XR = 36 * MiB;
constexpr size_t WS_VF = 104 * MiB;
constexpr size_t WS_LIST = 121 * MiB;
constexpr size_t WS_SLOTG = 126 * MiB;
constexpr size_t WS_RTW = 127 * MiB;
constexpr size_t WS_RWT = 128 * MiB;
constexpr size_t WS_SLOT = 130 * MiB;
constexpr size_t WS_WIN = 131 * MiB;
constexpr size_t WS_WOUT = 145 * MiB;
constexpr size_t WS_SI = 149 * MiB;
constexpr size_t WS_LLA = 253 * MiB;
constexpr size_t WS_LB = 270 * MiB;
constexpr size_t WS_LSUM = 287 * MiB;
constexpr size_t WS_LCIN = 289 * MiB;
constexpr size_t WS_BSC = 290 * MiB;
constexpr size_t WS_YS2B = 291 * MiB;
constexpr size_t WS_P = 319 * MiB;
constexpr size_t WS_BON = 438 * MiB;
constexpr size_t WS_G = 455 * MiB;
constexpr size_t WS_YS = 472 * MiB;
constexpr size_t WS_SV = 506 * MiB;
constexpr size_t WS_DZ = 523 * MiB;
constexpr size_t WS_WD = 149 * MiB;
constexpr size_t WS_HACT = 182 * MiB;
constexpr size_t WS_Y = 267 * MiB;
constexpr size_t WS_WGU = 267 * MiB;
constexpr size_t WS_END = 540 * MiB;

struct Row { int b, t, L, isx; };
__device__ __forceinline__ Row row_of(int m) { Row r; if (m < NX) { r.b = m >> 12; r.t = m & 4095; r.L = SEQ; r.isx = 1; } else { int q = m - NX; r.b = q >> 8; r.t = q & 255; r.L = CTXL; r.isx = 0; } return r; }
__device__ __forceinline__ float frcp_(float x) { return __builtin_amdgcn_rcpf(x); }
__device__ __forceinline__ float sigmoidf_(float x) { return frcp_(1.f + __expf(-x)); }
__device__ __forceinline__ float softplusf_(float x) { return x > 20.f ? x : __logf(1.f + __expf(x)); }
__device__ __forceinline__ float siluf_(float x) { return x * frcp_(1.f + __expf(-x)); }
__device__ __forceinline__ float tanhf_(float x) { const float xc = fminf(fmaxf(x, -15.f), 15.f); return 1.f - 2.f * frcp_(1.f + __expf(2.f * xc)); }
#define DPPF(v, ctrl) __int_as_float(__builtin_amdgcn_update_dpp(0, __float_as_int(v), (ctrl), 0xf, 0xf, true))
__device__ __forceinline__ float wave_sum(float v) {
    v += DPPF(v, 0xB1); v += DPPF(v, 0x4E); v += DPPF(v, 0x141); v += DPPF(v, 0x140);
    return (__int_as_float(__builtin_amdgcn_readlane(__float_as_int(v), 0)) + __int_as_float(__builtin_amdgcn_readlane(__float_as_int(v), 16))) +
           (__int_as_float(__builtin_amdgcn_readlane(__float_as_int(v), 32)) + __int_as_float(__builtin_amdgcn_readlane(__float_as_int(v), 48)));
}


__device__ __forceinline__ float* si_ptr(float* SI, int d, int m, int h, int vec) { return SI + ((((size_t)d * MT + m) * 4 + h) * 5 + vec) * 64; }

struct RwP { const float *mu, *w0, *w2, *a0, *a2, *g2, *kk, *ka, *rk, *v0, *v2; };

__device__ __forceinline__ int step_row(int b, int d, int s) { if (s < CTXL) { const int tc = d ? CTXL - 1 - s : s; return NX + b * CTXL + tc; } const int tx = d ? SEQ - 1 - (s - CTXL) : (s - CTXL); return b * SEQ + tx; }
struct LruP { const float *cw, *cb, *wa, *ba, *wx, *bx, *lam; };


enum { I_X = 0, I_C, I_CTX, I_CCTX, I_ADAW, I_ADAB, I_NMIX, I_NFFN, I_NFIN, I_WIN, I_WVRES, I_WOUT, I_RWMU, I_RWW0, I_RWW2, I_RWA0, I_RWA2, I_RWG2, I_RWKK, I_RWKA, I_RWRK, I_RWLNW, I_RWLNB, I_RWV0, I_RWV2,
       I_RETL, I_GCW, I_GALOG, I_GDT, I_GNW, I_LCW, I_LCB, I_LWA, I_LBA, I_LWX, I_LBX, I_LLAM, I_RTW, I_RTB, I_EWG, I_EWU, I_EWD, I_SWG, I_SWU, I_SWD, I_N };
#define GAS __attribute__((address_space(1)))
#define LAS __attribute__((address_space(3)))
typedef unsigned v4u __attribute__((ext_vector_type(4)));
typedef float f32x4 __attribute__((ext_vector_type(4)));
typedef short bf16x8 __attribute__((ext_vector_type(8)));
typedef GAS unsigned gu32;
#define RLX_AGENT __ATOMIC_RELAXED, __HIP_MEMORY_SCOPE_AGENT
#define LDS_WAIT() asm volatile("s_waitcnt lgkmcnt(0)" ::: "memory")
#define VM_WAIT() asm volatile("s_waitcnt vmcnt(0)" ::: "memory")
#define LDS_BARRIER() do { asm volatile("s_waitcnt lgkmcnt(0)" ::: "memory"); __builtin_amdgcn_s_barrier(); asm volatile("" ::: "memory"); } while (0)
__device__ __forceinline__ unsigned pk2(float lo, float hi) { return cvtpk_bf16(lo, hi); }
__device__ __forceinline__ unsigned long long pack4(f32x4 v) { return (unsigned long long)pk2(v.x, v.y) | ((unsigned long long)pk2(v.z, v.w) << 32); }

namespace pg8 {
#define PG8_LAS __attribute__((address_space(3)))
typedef unsigned short bf16_t;
typedef unsigned u32x4 __attribute__((ext_vector_type(4)));
constexpr int BM = 256, BK = 64, HALF = 128, HTB = HALF * BK * 2, STAGE_BYTES = 8 * HTB, NXCD = 8, WGM = 8;
__host__ __device__ __forceinline__ int lds_byte(int r, int c) { const int st = (r >> 4) * 2 + (c >> 5), rr = r & 15, cc = c & 31, ob = rr * 64 + cc * 2; return st * 1024 + (ob ^ (((ob >> 9) & 1) << 5)); }
__host__ __device__ __forceinline__ void stage_rc(int b, int& R, int& C) { const int st = b / 1024, sb = b % 1024, swz = sb ^ (((sb >> 9) & 1) << 5); R = (st >> 1) * 16 + swz / 64; C = (st & 1) * 32 + (swz % 64) / 2; }
__host__ __device__ __forceinline__ int perm32(int rho) { const int n = rho >> 4, i = rho & 15; return 8 * (i >> 2) + 4 * n + (i & 3); }
__device__ __forceinline__ unsigned cvt_pk_bf16(float lo, float hi) { unsigned r; asm volatile("v_cvt_pk_bf16_f32 %0, %1, %2" : "=v"(r) : "v"(lo), "v"(hi)); return r; }

struct Unit { const char* A; const char* B; int pm, pn, e, nrows, rb; };

struct DenseOrder {
    static constexpr bool GATHER = false;
    const bf16_t* A; const bf16_t* Bt; int K, nM, nN, nwg, G, c;
    __device__ void init(const bf16_t* A_, const bf16_t* Bt_, int M, int N, int K_, int G_, int c_) { A = A_; Bt = Bt_; K = K_; nM = M / BM; nN = N / BM; nwg = nM * nN; G = G_; c = c_; }
    __device__ bool next(int i, Unit& u) const {
        const long L = (long)i * G + c; if (L >= nwg) return false;
        int wgid = (int)L; { const int q = nwg / NXCD, r = nwg % NXCD, xcd = wgid % NXCD, off = wgid / NXCD; wgid = (xcd < r ? xcd * (q + 1) : r * (q + 1) + (xcd - r) * q) + off; }
        const int nig = WGM * nN, gid = wgid / nig, fm = gid * WGM, gsz = (nM - fm) < WGM ? (nM - fm) : WGM;
        u.pm = fm + ((wgid % nig) % gsz); u.pn = (wgid % nig) / gsz; u.e = 0; u.nrows = BM; u.rb = 0;
        u.A = (const char*)A + (size_t)u.pm * BM * K * 2; u.B = (const char*)Bt + (size_t)u.pn * BM * K * 2; return true;
    }
    __device__ __forceinline__ unsigned a_off(const Unit&, int h, int R, int C) const { return (unsigned)((h * HALF + R) * K + C) * 2u; }
};

template <class Epi, class Sched, bool ALIGN_EPI = false>
__device__ __forceinline__ void gemm_phase(PG8_LAS unsigned char* lds, const int K, const Sched& S, const Epi& E) {
    int tid = threadIdx.x; asm volatile("" : "+v"(tid));
    const int wid = __builtin_amdgcn_readfirstlane(tid >> 6), lane = tid & 63, wr = wid >> 2, wc = wid & 3, fr = lane & 15, fq = lane >> 4;
    const int nt = K / BK;
    unsigned voffB[2];
#pragma unroll
    for (int i = 0; i < 2; ++i) { int R, C; stage_rc(tid * 16 + i * 8192, R, C); const int Rb = Epi::PERM ? ((R & ~31) + perm32(R & 31)) : R; voffB[i] = (unsigned)(Rb * K + C) * 2u; }
    const size_t kstep = (size_t)(BK * 2);
    const size_t hstep = (size_t)HALF * K * 2;
    const unsigned ldsw = (unsigned)wid * 1024u;
    const int aoff = lds_byte(wr * 64 + fr, fq * 8), boff = lds_byte(wc * 32 + fr, fq * 8);
#define PG8_SA(b, h) (((b) * 2 + (h)) * HTB)
#define PG8_SB(b, h) ((4 + (b) * 2 + (h)) * HTB)
#define PG8_STAGE(bufoff, gbase, voff) do { _Pragma("unroll") for (int _i = 0; _i < 2; ++_i) \
        __builtin_amdgcn_global_load_lds((const unsigned*)((const char*)(gbase) + (voff)[_i]), (PG8_LAS unsigned*)(lds + (bufoff) + ldsw + _i * 8192), 16, 0, 0); } while (0)
#define PG8_LDA(dst, b, h) do { _Pragma("unroll") for (int m = 0; m < 4; ++m) _Pragma("unroll") for (int k = 0; k < 2; ++k) dst[m][k] = *(const PG8_LAS bf16x8*)(lds + PG8_SA(b, h) + aoff + m * 2048 + k * 1024); } while (0)
#define PG8_LDB(dst, b, h) do { _Pragma("unroll") for (int n = 0; n < 2; ++n) _Pragma("unroll") for (int k = 0; k < 2; ++k) dst[n][k] = *(const PG8_LAS bf16x8*)(lds + PG8_SB(b, h) + boff + n * 2048 + k * 1024); } while (0)
#define PG8_MMA(ai, bj, At, Bt) do { __builtin_amdgcn_s_setprio(1); _Pragma("unroll") for (int m = 0; m < 4; ++m) _Pragma("unroll") for (int n = 0; n < 2; ++n) _Pragma("unroll") for (int k = 0; k < 2; ++k) \
        acc[ai][bj][m][n] = __builtin_amdgcn_mfma_f32_16x16x32_bf16(Bt[n][k], At[m][k], acc[ai][bj][m][n], 0, 0, 0); __builtin_amdgcn_s_setprio(0); } while (0)
#define PG8_WAIT_V(n) asm volatile("s_waitcnt vmcnt(" #n ")" ::: "memory")
#define PG8_WAIT_L(n) asm volatile("s_waitcnt lgkmcnt(" #n ")" ::: "memory")
#define PG8_BAR __builtin_amdgcn_s_barrier()
#define PG8_SCHED __builtin_amdgcn_sched_barrier(0)
    Unit cur, nxt; int ui = 0;
    if (!S.next(0, cur)) return;
    f32x4 acc[2][2][4][2];
#pragma unroll
    for (int a = 0; a < 2; ++a)
#pragma unroll
        for (int b = 0; b < 2; ++b)
#pragma unroll
            for (int m = 0; m < 4; ++m)
#pragma unroll
                for (int n = 0; n < 2; ++n) acc[a][b][m][n] = (f32x4){0.f, 0.f, 0.f, 0.f};
    bf16x8 At[4][2], B0[2][2], B1[2][2];
    unsigned cv0[2], cv1[2], nv0[2], nv1[2];
#pragma unroll
    for (int i = 0; i < 2; ++i) { int R, C; stage_rc(tid * 16 + i * 8192, R, C); cv0[i] = S.a_off(cur, 0, R, C); cv1[i] = S.a_off(cur, 1, R, C); nv0[i] = cv0[i]; nv1[i] = cv1[i]; }
    const char* cA = cur.A; const char* cB = cur.B;
    PG8_STAGE(PG8_SB(0, 0), cB, voffB); PG8_STAGE(PG8_SB(0, 1), cB + hstep, voffB); PG8_STAGE(PG8_SA(0, 0), cA, cv0); PG8_STAGE(PG8_SA(0, 1), cA, cv1);
    if (wr == 1) PG8_BAR;
    PG8_WAIT_V(2); PG8_BAR;
    PG8_STAGE(PG8_SB(1, 0), cB + kstep, voffB); PG8_STAGE(PG8_SA(1, 0), cA + kstep, cv0); PG8_STAGE(PG8_SB(1, 1), cB + hstep + kstep, voffB);
    PG8_WAIT_V(6); PG8_BAR;
    for (;;) {
        const bool has_next = S.next(ui + 1, nxt);
        const char* nA = has_next ? nxt.A : cA; const char* nB = has_next ? nxt.B : cB;
        if constexpr (Sched::GATHER) {
        if (has_next) {
#pragma unroll
            for (int i = 0; i < 2; ++i) { int tt = threadIdx.x; asm volatile("" : "+v"(tt)); int R, C; stage_rc(tt * 16 + i * 8192, R, C); nv0[i] = S.a_off(nxt, 0, R, C); nv1[i] = S.a_off(nxt, 1, R, C); } }
        else {
#pragma unroll
            for (int i = 0; i < 2; ++i) { nv0[i] = cv0[i]; nv1[i] = cv1[i]; } } }
        for (int t = 0; t < nt; t += 2) {
            const bool last = (t == nt - 2);
            const char* a1 = cA + (size_t)(t + 1) * kstep;
            const char* a2 = last ? nA : cA + (size_t)(t + 2) * kstep; const char* b2 = last ? nB : cB + (size_t)(t + 2) * kstep;
            const char* a3 = a2 + kstep; const char* b3 = b2 + kstep;
            unsigned x0[2], x1[2];
#pragma unroll
            for (int i = 0; i < 2; ++i) { if constexpr (Sched::GATHER) { x0[i] = last ? nv0[i] : cv0[i]; x1[i] = last ? nv1[i] : cv1[i]; } else { x0[i] = cv0[i]; x1[i] = cv1[i]; } }
            PG8_LDB(B0, 0, 0); PG8_LDB(B1, 0, 1); PG8_SCHED; PG8_LDA(At, 0, 0); PG8_STAGE(PG8_SA(1, 1), a1, cv1);
            PG8_WAIT_V(8); PG8_WAIT_L(0); PG8_BAR; PG8_MMA(0, 0, At, B0); PG8_MMA(0, 1, At, B1); PG8_BAR; PG8_SCHED;
            PG8_LDA(At, 0, 1); PG8_STAGE(PG8_SB(0, 0), b2, voffB); PG8_STAGE(PG8_SB(0, 1), b2 + hstep, voffB); PG8_STAGE(PG8_SA(0, 0), a2, x0);
            PG8_WAIT_V(8); PG8_WAIT_L(0); PG8_BAR; PG8_MMA(1, 0, At, B0); PG8_MMA(1, 1, At, B1); PG8_BAR; PG8_SCHED;
            PG8_LDB(B0, 1, 0); PG8_LDB(B1, 1, 1); PG8_SCHED; PG8_LDA(At, 1, 0); PG8_STAGE(PG8_SA(0, 1), a2, x1);
            PG8_WAIT_V(8); PG8_WAIT_L(0); PG8_BAR; PG8_MMA(0, 0, At, B0); PG8_MMA(0, 1, At, B1); PG8_BAR; PG8_SCHED;
            PG8_LDA(At, 1, 1); PG8_STAGE(PG8_SB(1, 0), b3, voffB); PG8_STAGE(PG8_SB(1, 1), b3 + hstep, voffB); PG8_STAGE(PG8_SA(1, 0), a3, x0);
            PG8_WAIT_V(8); PG8_WAIT_L(0); PG8_BAR; PG8_MMA(1, 0, At, B0); PG8_MMA(1, 1, At, B1); PG8_BAR; PG8_SCHED;
        }
        if constexpr (ALIGN_EPI) { if (wr == 0) PG8_BAR; }
        E(acc, cur, wr, wc, fr, fq);
        if (!has_next) break;
#pragma unroll
        for (int a = 0; a < 2; ++a)
#pragma unroll
            for (int b = 0; b < 2; ++b)
#pragma unroll
                for (int m = 0; m < 4; ++m)
#pragma unroll
                    for (int n = 0; n < 2; ++n) acc[a][b][m][n] = (f32x4){0.f, 0.f, 0.f, 0.f};
        cur = nxt; cA = nA; cB = nB; ++ui;
        if constexpr (Sched::GATHER) {
#pragma unroll
            for (int i = 0; i < 2; ++i) { cv0[i] = nv0[i]; cv1[i] = nv1[i]; } }
        if constexpr (ALIGN_EPI) { if (wr == 1) PG8_BAR; }
    }
    PG8_WAIT_V(0);
    if constexpr (!ALIGN_EPI) { if (wr == 0) PG8_BAR; }
    PG8_BAR;
#undef PG8_SA
#undef PG8_SB
#undef PG8_STAGE
#undef PG8_LDA
#undef PG8_LDB
#undef PG8_MMA
#undef PG8_WAIT_V
#undef PG8_WAIT_L
#undef PG8_BAR
#undef PG8_SCHED
}

struct EpiStoreBf16 {
    static constexpr bool PERM = true;
    bf16_t* O; int ldc;
    __device__ __forceinline__ void operator()(const f32x4 (&acc)[2][2][4][2], const Unit& u, int wr, int wc, int fr, int fq) const {
        asm volatile("" : "+v"(fr), "+v"(fq));
        const int row0 = u.pm * BM + wr * 64 + fr, col0 = u.pn * BM + wc * 32 + 8 * fq;
#pragma unroll
        for (int ai = 0; ai < 2; ++ai)
#pragma unroll
            for (int m = 0; m < 4; ++m) { bf16_t* rowp = O + (size_t)(row0 + ai * HALF + m * 16) * ldc + col0;
#pragma unroll
                for (int bj = 0; bj < 2; ++bj) { const f32x4 v0 = acc[ai][bj][m][0], v1 = acc[ai][bj][m][1];
                    u32x4 w; w.x = cvt_pk_bf16(v0[0], v0[1]); w.y = cvt_pk_bf16(v0[2], v0[3]); w.z = cvt_pk_bf16(v1[0], v1[1]); w.w = cvt_pk_bf16(v1[2], v1[3]);
                    *(u32x4*)(rowp + bj * HALF) = w; } }
    }
};
struct EpiResidual {
    static constexpr bool PERM = false;
    const float* xs; const float* cs; const float* MODl; float* XR;
    __device__ __forceinline__ void operator()(const f32x4 (&acc)[2][2][4][2], const Unit& u, int wr, int wc, int fr, int fq) const {
        asm volatile("" : "+v"(fr), "+v"(fq));
        const int row0 = u.pm * BM + wr * 64 + fr, col0 = u.pn * BM + wc * 32 + 4 * fq;
#pragma unroll
        for (int ai = 0; ai < 2; ++ai)
#pragma unroll
            for (int m = 0; m < 4; ++m) { const int row = row0 + ai * HALF + m * 16;
                const float* xin = row < NX ? xs + (size_t)row * D : cs + (size_t)(row - NX) * D; const int rb = row < NX ? (row >> 12) : 4;
                const float* md = MODl + (size_t)rb * 6144 + 2 * 1024; float* o = XR + (size_t)row * D;
#pragma unroll
                for (int bj = 0; bj < 2; ++bj)
#pragma unroll
                    for (int n = 0; n < 2; ++n) { const int c = col0 + bj * HALF + n * 16; const f32x4 xi = *(const f32x4*)(xin + c), mm = *(const f32x4*)(md + c); *(f32x4*)(o + c) = xi + mm * acc[ai][bj][m][n]; } }
    }
};
}

#define XB_TMO      128
#define XB_XCNT(j)  (256  + 64 * (j))
#define XB_XSUB(j)  (1280 + 64 * (j))
#define XB_XGEN(j)  (2304 + 64 * (j))
#define XB_TOP      3328
#define XB_TOPGEN   3392
#define XCD_BAR_WORDS 3456
#define XB_SPIN_CAP (1u << 22)
__device__ __forceinline__ unsigned xb_ld(unsigned* p)              { return __hip_atomic_load(p, __ATOMIC_RELAXED, __HIP_MEMORY_SCOPE_AGENT); }
__device__ __forceinline__ unsigned xb_add(unsigned* p, unsigned v) { return __hip_atomic_fetch_add(p, v, __ATOMIC_RELAXED, __HIP_MEMORY_SCOPE_AGENT); }
__device__ __forceinline__ unsigned xb_xcc_id() { return (unsigned)__builtin_amdgcn_s_getreg((3 << 11) | 20) & 0xFu; }
#define XB_SPIN(cond, bar) do { unsigned _sp = 0; while (cond) { __builtin_amdgcn_s_sleep(1); \
    if ((++_sp & 255u) == 0u) { if (xb_ld(&(bar)[XB_TMO])) break; if (_sp > XB_SPIN_CAP) { atomicAdd(&(bar)[XB_TMO], 1u); break; } } } } while (0)
struct XcdBarrier { unsigned* bar; unsigned x; volatile LAS unsigned* st; };
__device__ __forceinline__ XcdBarrier xcd_barrier_post(unsigned* bar, volatile LAS unsigned* st) {
    XcdBarrier b; b.bar = bar; b.x = (unsigned)__builtin_amdgcn_readfirstlane((int)xb_xcc_id()); b.st = st;
    if (threadIdx.x == 0) (void)xb_add(&bar[XB_XCNT(b.x)], 1u);
    return b;
}
__device__ __forceinline__ void xcd_barrier_complete(unsigned* bar, unsigned x, unsigned& nloc, unsigned& nx) {
    const unsigned G = gridDim.x * gridDim.y * gridDim.z;
    unsigned sum, cnt, mine, sp = 0u;
    for (;;) {
        sum = 0u; cnt = 0u; mine = 0u;
#pragma unroll
        for (unsigned j = 0; j < 16; ++j) { const unsigned c = xb_ld(&bar[XB_XCNT(j)]); sum += c; cnt += (c > 0u) ? 1u : 0u; mine = (j == x) ? c : mine; }
        if (sum == G) break;
        __builtin_amdgcn_s_sleep(1);
        if ((++sp & 255u) == 0u) { if (xb_ld(&bar[XB_TMO])) break; if (sp > XB_SPIN_CAP) { atomicAdd(&bar[XB_TMO], 1u); break; } }
    }
    nloc = mine > 0u ? mine : 1u; nx = cnt > 0u ? cnt : 1u;
}
__device__ __forceinline__ void xcd_barrier(const XcdBarrier& b) {
    asm volatile("s_waitcnt vmcnt(0)" ::: "memory");
    __syncthreads();
    if (threadIdx.x == 0) {
        unsigned* bar = b.bar; const unsigned bx = (unsigned)__builtin_amdgcn_readfirstlane((int)xb_xcc_id());
        __builtin_amdgcn_s_waitcnt(0);
        unsigned nloc = b.st[0], nx = b.st[1];
        if (nloc == 0u) { xcd_barrier_complete(bar, bx, nloc, nx); b.st[0] = nloc; b.st[1] = nx; }
        const unsigned old = xb_add(&bar[XB_XSUB(bx)], 1u);
        const unsigned gen = old / nloc;
        if (old + 1u == (gen + 1u) * nloc) {
            __builtin_amdgcn_fence(__ATOMIC_RELEASE, "agent");
            asm volatile("s_waitcnt vmcnt(0)" ::: "memory");
            const unsigned og = xb_add(&bar[XB_TOP], 1u);
            const unsigned tg = og / nx;
            if (og + 1u == (tg + 1u) * nx) xb_add(&bar[XB_TOPGEN], 1u);
            else XB_SPIN(xb_ld(&bar[XB_TOPGEN]) == tg, bar);
            __builtin_amdgcn_fence(__ATOMIC_ACQUIRE, "agent");
            xb_add(&bar[XB_XGEN(bx)], 1u);
            asm volatile("s_waitcnt vmcnt(0)" ::: "memory");
        } else {
            XB_SPIN(xb_ld(&bar[XB_XGEN(bx)]) == gen, bar);
            __builtin_amdgcn_fence(__ATOMIC_ACQUIRE, "agent");
            asm volatile("s_waitcnt vmcnt(0)" ::: "memory");
        }
    }
    __syncthreads();
}

constexpr int NWAVES = 8, NTHR = 512;
constexpr int RING_OFF = 0, RING_BYTES = 131072;
constexpr int LDSCTL_OFF = RING_BYTES, MISC_OFF = LDSCTL_OFF + 320;
constexpr int LDS_BYTES = 147456;
constexpr int CW_BAR = 4096;
constexpr size_t CTL_ZERO_BYTES = 1 * MiB;

struct MArgs {
    const float* in[45]; float* out; unsigned char* ws; int ph_lo, ph_hi, l_lo, l_hi, bar_region, pad;
};
struct Frame { LAS unsigned char* lds; volatile LAS unsigned* MISC; gu32* ctl; int tid, lane, wave, vcu, G; unsigned long long tacc, tph0; int curk; };

__device__ __forceinline__ void transpose_item(const float* W, int ldw, int N, int k0, int n0, bf16* WT, int ldt, int drow0, LAS float* scr, int lane) {
    const int nn = n0 + (lane & 31); const bool okn = nn < N;
#pragma unroll 8
    for (int i = 0; i < 32; ++i) { const int kk = 2 * i + (lane >> 5); scr[kk * 33 + (lane & 31)] = okn ? W[(size_t)(k0 + kk) * ldw + nn] : 0.f; }
    LDS_WAIT(); asm volatile("" ::: "memory");
    const int c = lane & 7;
#pragma unroll
    for (int j = 0; j < 4; ++j) { const int n = (lane >> 3) + 8 * j; const LAS float* s = scr + (8 * c) * 33 + n;
        v4u o; o.x = pk2(s[0 * 33], s[1 * 33]); o.y = pk2(s[2 * 33], s[3 * 33]); o.z = pk2(s[4 * 33], s[5 * 33]); o.w = pk2(s[6 * 33], s[7 * 33]);
        if (n0 + n < N) *(GAS v4u*)(WT + (size_t)(drow0 + n) * ldt + k0 + 8 * c) = o; }
    LDS_WAIT(); asm volatile("" ::: "memory");
}

__device__ __forceinline__ void ph_mod(Frame& F, const float* c, const float* cctx, const float* ada_w, const float* ada_b, float* MOD) {
    LAS float* s = (LAS float*)(F.lds + RING_OFF);
    LAS float* red = s + 5 * 1024;
    for (int i = F.tid; i < 5 * 1024; i += NTHR) { const int r = i >> 10, k = i & 1023; const float v = r < 4 ? c[r * 1024 + k] : cctx[k]; s[i] = siluf_(v); }
    __syncthreads();
    for (int u = F.vcu; u < 192; u += F.G) {
        const int l = u / 96, j0 = (u % 96) * 64, cl = F.tid & 63, kp = F.tid >> 6;
        const float* W = ada_w + (size_t)l * 1024 * 6144 + j0 + cl;
        float acc[5] = {0.f, 0.f, 0.f, 0.f, 0.f};
        for (int k = kp * 128; k < kp * 128 + 128; ++k) { const float w = W[(size_t)k * 6144];
#pragma unroll
            for (int r = 0; r < 5; ++r) acc[r] += s[r * 1024 + k] * w; }
#pragma unroll
        for (int r = 0; r < 5; ++r) red[(kp * 5 + r) * 64 + cl] = acc[r];
        __syncthreads();
        if (F.tid < 320) { const int r = F.tid >> 6; float a = ada_b[l * 6144 + j0 + cl];
#pragma unroll
            for (int q = 0; q < 8; ++q) a += red[(q * 5 + r) * 64 + cl];
            MOD[((size_t)l * 5 + r) * 6144 + j0 + cl] = a; }
        __syncthreads();
    }
}
__device__ __forceinline__ void ph_convert_small(Frame& F, const float* w_in, const float* w_vres, const float* w_out, bf16* WIN_T  , bf16* WOUT_T  , int l_lo, int l_hi) {
    LAS float* scr = (LAS float*)(F.lds + RING_OFF + 32768 + F.wave * 16384 / 2);
    scr = (LAS float*)(F.lds + RING_OFF + 32768 + F.wave * 9216);
    const int gw = F.vcu * NWAVES + F.wave, NGW = F.G * NWAVES;
    constexpr int NB_IN = (NIN + 31) / 32;
    constexpr int I_IN = 16 * NB_IN, I_VR = 16 * 1, I_OUT = 16 * 32;
    constexpr int PER_L = I_IN + I_VR + I_OUT;
    for (int it = gw + l_lo * PER_L; it < l_hi * PER_L; it += NGW) {
        const int l = it / PER_L; int r = it % PER_L;
        if (r < I_IN) { const int kb = r / NB_IN, nb = r % NB_IN; transpose_item(w_in + (size_t)l * D * NIN, NIN, NIN, kb * 64, nb * 32, WIN_T + (size_t)l * LDP * D, D, nb * 32, scr, F.lane); continue; } r -= I_IN;
        if (r < I_VR) { if (l == 1) transpose_item(w_vres, 32, 32, r * 64, 0, WIN_T + (size_t)LDP * D, D, NIN, scr, F.lane); continue; } r -= I_VR;
        { const int kb = r / 32, nb = r % 32; transpose_item(w_out + (size_t)l * D * D, D, D, kb * 64, nb * 32, WOUT_T + (size_t)l * D * D, D, nb * 32, scr, F.lane); }
    }
}
__device__ __forceinline__ void ph_norm_mod(Frame& F, const float* xs, const float* cs, const float* gain, const float* MODl, int si, bf16* XN, int nrows) {
    const int gw = F.vcu * NWAVES + F.wave, NGW = F.G * NWAVES, lane = F.lane;
    for (int m0 = gw; m0 < nrows; m0 += 2 * NGW) {
        const int m1 = m0 + NGW < nrows ? m0 + NGW : m0;
        const float* s0 = m0 < NX ? xs + (size_t)m0 * D : cs + (size_t)(m0 - NX) * D; const float* s1 = m1 < NX ? xs + (size_t)m1 * D : cs + (size_t)(m1 - NX) * D;
        f32x4 v0[4], v1[4]; float q0 = 0.f, q1 = 0.f;
#pragma unroll
        for (int j = 0; j < 4; ++j) { v0[j] = *(const f32x4*)(s0 + 4 * lane + 256 * j); v1[j] = *(const f32x4*)(s1 + 4 * lane + 256 * j); }
#pragma unroll
        for (int j = 0; j < 4; ++j) { q0 += (v0[j].x * v0[j].x + v0[j].y * v0[j].y) + (v0[j].z * v0[j].z + v0[j].w * v0[j].w); q1 += (v1[j].x * v1[j].x + v1[j].y * v1[j].y) + (v1[j].z * v1[j].z + v1[j].w * v1[j].w); }
        q0 = wave_sum(q0); q1 = wave_sum(q1); const float r0 = rsqrtf(q0 * (1.f / D) + 1e-6f), r1 = rsqrtf(q1 * (1.f / D) + 1e-6f);
        const float* md0 = MODl + (size_t)(m0 < NX ? (m0 >> 12) : 4) * 6144; const float* md1 = MODl + (size_t)(m1 < NX ? (m1 >> 12) : 4) * 6144;
#pragma unroll
        for (int j = 0; j < 4; ++j) { const int ci = 4 * lane + 256 * j; const f32x4 g = *(const f32x4*)(gain + ci);
            const f32x4 y0 = v0[j] * r0 * g * (*(const f32x4*)(md0 + (si + 1) * 1024 + ci) + 1.f) + *(const f32x4*)(md0 + si * 1024 + ci);
            const f32x4 y1 = v1[j] * r1 * g * (*(const f32x4*)(md1 + (si + 1) * 1024 + ci) + 1.f) + *(const f32x4*)(md1 + si * 1024 + ci);
            *(unsigned long long*)(XN + (size_t)m0 * D + ci) = pack4(y0); *(unsigned long long*)(XN + (size_t)m1 * D + ci) = pack4(y1); }
    }
}

typedef short bf16x4 __attribute__((ext_vector_type(4)));
constexpr int CW_CNT = 16384;
constexpr int TAB_OFF = LDSCTL_OFF + 1024;
struct MoeTab { LAS int* cnt; LAS int* ups; LAS int* ro; };
__device__ __forceinline__ MoeTab moe_tab(Frame& F) { MoeTab t; t.cnt = (LAS int*)(F.lds + TAB_OFF); t.ups = t.cnt + 80; t.ro = t.ups + 80; return t; }
__device__ __forceinline__ void moe_build_tab(Frame& F, int layer, int ntok) {
    MoeTab T = moe_tab(F);
    if (F.tid < 64) T.cnt[F.tid] = (int)__hip_atomic_load(F.ctl + CW_CNT + (layer * 64 + F.tid) * 64, RLX_AGENT);
    if (F.tid == 64) T.cnt[64] = ntok;
    __syncthreads();
    if (F.tid == 0) { int u = 0, r = 0; for (int e = 0; e < 65; ++e) { T.ups[e] = u; T.ro[e] = r; u += (T.cnt[e] + 255) >> 8; r += T.cnt[e]; } T.ups[65] = u; T.ro[65] = r; }
    __syncthreads();
}
__device__ __forceinline__ int uni(int v) { return __builtin_amdgcn_readfirstlane(v); }
__device__ __forceinline__ const char* uni_ptr(const char* p) { unsigned long long v = (unsigned long long)p; unsigned lo = __builtin_amdgcn_readfirstlane((unsigned)v), hi = __builtin_amdgcn_readfirstlane((unsigned)(v >> 32)); return (const char*)(((unsigned long long)hi << 32) | lo); }

__device__ __forceinline__ void ph_convert_router(Frame& F, const float* rtw, bf16* RT) {
    for (int i = F.vcu * NTHR + F.tid; i < 2 * 64 * 1024; i += F.G * NTHR) { const int l = i >> 16, e = (i >> 10) & 63, k = i & 1023;
        const float x = rtw[((size_t)l * 1024 + k) * 64 + e]; const bf16 hi = f2bf(x); const bf16 lo = f2bf(x - bf2f(hi));
        RT[(((size_t)l * 2 + 0) * 64 + e) * 1024 + k] = hi; RT[(((size_t)l * 2 + 1) * 64 + e) * 1024 + k] = lo; }
}
__device__ __forceinline__ void ph_route(Frame& F, const float* XR, const float* gain, const float* MODl, const bf16* RTl  , const float* rbias, bf16* XN, int layer,
                                         unsigned* LIST, int* SLOTPOS, float* SLOTG, int ntok) {
    constexpr int HSTR = 2064;
    LAS unsigned char* HH = F.lds + RING_OFF;
    LAS unsigned char* HL = F.lds + RING_OFF + 16 * HSTR;
    LAS float* part = (LAS float*)(F.lds + RING_OFF + 32 * HSTR);
    LAS float* sc = (LAS float*)(F.lds + RING_OFF + 32 * HSTR + 32768);
    LAS int* lcnt = (LAS int*)(F.lds + RING_OFF + 32 * HSTR + 32768 + 4096);
    LAS int* lbase = lcnt + 64;
    if (F.tid < 64) lcnt[F.tid] = 0;
    const int lane = F.lane, wv = F.wave, tid = F.tid, r = lane & 15, g = lane >> 4;
    const int ngrp = ntok / 16;
    bf16x4 BH[4][8], BL[4][8];
    { const GAS bf16* R = (const GAS bf16*)RTl;
#pragma unroll
      for (int nt = 0; nt < 4; ++nt)
#pragma unroll
          for (int ks = 0; ks < 8; ++ks) { const size_t o = (size_t)(16 * nt + r) * 1024 + 128 * wv + 16 * ks + 4 * g; BH[nt][ks] = *(const GAS bf16x4*)(R + o); BL[nt][ks] = *(const GAS bf16x4*)(R + 65536 + o); } }
    f32x4 vq[2][4];
    { const int m0 = (F.vcu < ngrp ? F.vcu : 0) * 16 + 2 * wv;
#pragma unroll
      for (int tt = 0; tt < 2; ++tt)
#pragma unroll
          for (int j = 0; j < 4; ++j) vq[tt][j] = *(const GAS f32x4*)((const GAS float*)XR + (size_t)(m0 + tt) * D + 4 * lane + 256 * j); }
    for (int gi = F.vcu; gi < ngrp; gi += F.G) {
        TSEC_BEGIN(20)
#pragma unroll
        for (int tt = 0; tt < 2; ++tt) {
            const int tl = 2 * wv + tt, m = gi * 16 + tl;
            const int rb = m < NX ? (m >> 12) : 4; const float* md = MODl + (size_t)rb * 6144;
            float ss = 0.f;
#pragma unroll
            for (int j = 0; j < 4; ++j) { const f32x4 x = vq[tt][j]; ss += (x.x * x.x + x.y * x.y) + (x.z * x.z + x.w * x.w); }
            ss = wave_sum(ss); const float rs = rsqrtf(ss * (1.f / D) + 1e-6f);
#pragma unroll
            for (int j = 0; j < 4; ++j) { const int ci = 4 * lane + 256 * j; const f32x4 gg = *(const f32x4*)(gain + ci), sh = *(const f32x4*)(md + 3 * 1024 + ci), scl = *(const f32x4*)(md + 4 * 1024 + ci);
                const f32x4 y = vq[tt][j] * rs * gg * (scl + 1.f) + sh;
                const unsigned h0 = pk2(y.x, y.y), h1 = pk2(y.z, y.w);
                const f32x4 yl = (f32x4){y.x - __uint_as_float(h0 << 16), y.y - __uint_as_float(h0 & 0xffff0000u), y.z - __uint_as_float(h1 << 16), y.w - __uint_as_float(h1 & 0xffff0000u)};
                const unsigned long long hw = (unsigned long long)h0 | ((unsigned long long)h1 << 32);
                *(LAS unsigned long long*)(HH + tl * HSTR + ci * 2) = hw; *(LAS unsigned long long*)(HL + tl * HSTR + ci * 2) = pack4(yl);
                *(unsigned long long*)(XN + (size_t)m * D + ci) = hw; }
        }
        { const int gn = gi + F.G < ngrp ? gi + F.G : gi; const int m0 = gn * 16 + 2 * wv;
#pragma unroll
          for (int tt = 0; tt < 2; ++tt)
#pragma unroll
              for (int j = 0; j < 4; ++j) vq[tt][j] = *(const GAS f32x4*)((const GAS float*)XR + (size_t)(m0 + tt) * D + 4 * lane + 256 * j); }
        LDS_BARRIER();
        TSEC_END(20)
        TSEC_BEGIN(21)
        { f32x4 acc[4];
#pragma unroll
          for (int nt = 0; nt < 4; ++nt) acc[nt] = (f32x4){0.f, 0.f, 0.f, 0.f};
#pragma unroll
          for (int ks = 0; ks < 8; ++ks) { const int ko = (128 * wv + 16 * ks + 4 * g) * 2; const bf16x4 ah = *(const LAS bf16x4*)(HH + r * HSTR + ko), al = *(const LAS bf16x4*)(HL + r * HSTR + ko);
#pragma unroll
              for (int nt = 0; nt < 4; ++nt) { acc[nt] = __builtin_amdgcn_mfma_f32_16x16x16bf16_1k(ah, BH[nt][ks], acc[nt], 0, 0, 0); acc[nt] = __builtin_amdgcn_mfma_f32_16x16x16bf16_1k(al, BH[nt][ks], acc[nt], 0, 0, 0);
                  acc[nt] = __builtin_amdgcn_mfma_f32_16x16x16bf16_1k(ah, BL[nt][ks], acc[nt], 0, 0, 0); } }
#pragma unroll
          for (int nt = 0; nt < 4; ++nt)
#pragma unroll
              for (int i = 0; i < 4; ++i) part[(wv * 16 + 4 * g + i) * 64 + 16 * nt + r] = acc[nt][i]; }
        LDS_BARRIER();
#pragma unroll
        for (int q = 0; q < 2; ++q) { const int t = (tid >> 6) + 8 * q, e = tid & 63; float a = 0.f;
#pragma unroll
            for (int kp = 0; kp < 8; ++kp) a += part[(kp * 16 + t) * 64 + e];
            sc[t * 64 + e] = sigmoidf_(a); }
        LDS_BARRIER();
        TSEC_END(21)
        TSEC_BEGIN(22)
#pragma unroll
        for (int tt = 0; tt < 2; ++tt) {
            const int tl = 2 * wv + tt, m = gi * 16 + tl;
            const float s = sc[tl * 64 + lane]; const float sel = s + rbias[lane]; int rank8 = 0;
#pragma unroll 16
            for (int j = 0; j < 64; ++j) { const float oj = __int_as_float(__builtin_amdgcn_readlane(__float_as_int(sel), j)); rank8 += (oj > sel || (oj == sel && j < lane)) ? 1 : 0; }
            const int myk = rank8 < 8 ? rank8 : -1;
            const float ssum = wave_sum(myk >= 0 ? s : 0.f);
            if (myk >= 0) { const int lr = __hip_atomic_fetch_add(lcnt + lane, 1, __ATOMIC_RELAXED, __HIP_MEMORY_SCOPE_WORKGROUP);
                SLOTPOS[(size_t)m * 8 + myk] = (lane << 16) | lr; SLOTG[(size_t)m * 8 + myk] = 2.5f * s * __builtin_amdgcn_rcpf(ssum); }
        }
        LDS_BARRIER();
        TSEC_END(22)
    }
    asm volatile("s_waitcnt vmcnt(0)" ::: "memory"); __syncthreads();
    if (F.tid < 64) { const int n = lcnt[F.tid]; lbase[F.tid] = n > 0 ? (int)__hip_atomic_fetch_add(F.ctl + CW_CNT + (layer * 64 + F.tid) * 64, (unsigned)n, RLX_AGENT) : 0; }
    __syncthreads();
    for (int gi = F.vcu; gi < ngrp; gi += F.G) {
        if (tid < 128) { const int m = gi * 16 + (tid >> 3), k = tid & 7; const int sp = (int)__hip_atomic_load((unsigned*)SLOTPOS + (size_t)m * 8 + k, RLX_AGENT); const int e = sp >> 16, rk = lbase[e] + (sp & 0xffff);
            SLOTPOS[(size_t)m * 8 + k] = (e << 16) | rk; LIST[(size_t)e * MT + rk] = (unsigned)m; } }
}
__device__ __forceinline__ void ph_convert_experts(Frame& F, const float* wg, const float* wu, const float* wd, const float* sg, const float* su, const float* sd, bf16* WGU_T, bf16* WD_T) {
    LAS float* scr = (LAS float*)(F.lds + RING_OFF + F.wave * 9216);
    const int gw = F.vcu * NWAVES + F.wave, NGW = F.G * NWAVES;
    for (int it = gw; it < 65 * 384; it += NGW) {
        const int e = it / 384; int r = it % 384;
        const float* Wg = e < 64 ? wg + (size_t)e * D * EFF : sg; const float* Wu = e < 64 ? wu + (size_t)e * D * EFF : su; const float* Wd = e < 64 ? wd + (size_t)e * EFF * D : sd;
        if (r < 256) { const float* W = r < 128 ? Wg : Wu; const int up = r >= 128; r &= 127; const int kb = r >> 3, nb = r & 7, n0 = nb * 32;
            transpose_item(W, EFF, EFF, kb * 64, n0, WGU_T + (size_t)e * 512 * D, D, (n0 >> 7) * 256 + (n0 & 127) + up * 128, scr, F.lane); }
        else { r -= 256; const int kb = r >> 5, nb = r & 31; transpose_item(Wd, D, D, kb * 64, nb * 32, WD_T + (size_t)e * D * EFF, EFF, nb * 32, scr, F.lane); }
    }
}
namespace pg8 {
struct MoeOrder1 {          static constexpr bool GATHER = true;
    const bf16_t* XN; const bf16_t* WGU; const unsigned* LIST; MoeTab T; int G, c, total;
    __device__ bool next(int i, Unit& u) const {
        const int L = i * G + c; if (L >= total) return false;
        const int pn = L & 1, ru = L >> 1; int lo = 0, hi = 64;
        while (lo < hi) { const int mid = (lo + hi + 1) >> 1; if (T.ups[mid] <= ru) lo = mid; else hi = mid - 1; }
        const int e = uni(lo), j = uni(ru - T.ups[lo]);
        u.e = e; u.pm = j; u.pn = pn; u.nrows = uni(min(256, T.cnt[e] - j * 256)); u.rb = uni(T.ro[e] + j * 256);
        u.A = (const char*)XN; u.B = uni_ptr((const char*)WGU + ((size_t)e * 512 + (size_t)pn * 256) * D * 2); return true;
    }
    __device__ __forceinline__ unsigned a_off(const Unit& u, int h, int R, int C) const {
        const int idx = h * HALF + R; int tok = 0;
        if (idx < u.nrows) tok = u.e < 64 ? (int)LIST[(size_t)u.e * MT + u.pm * 256 + idx] : u.pm * 256 + idx;
        return (unsigned)(tok * D + C) * 2u;
    }
};
struct MoeOrder2 {          static constexpr bool GATHER = false;
    const bf16_t* HACT; const bf16_t* WD; MoeTab T; int G, c, total;
    __device__ bool next(int i, Unit& u) const {
        const int L = i * G + c; if (L >= total) return false;
        const int pn = L & 3, ru = L >> 2; int lo = 0, hi = 64;
        while (lo < hi) { const int mid = (lo + hi + 1) >> 1; if (T.ups[mid] <= ru) lo = mid; else hi = mid - 1; }
        const int e = uni(lo), j = uni(ru - T.ups[lo]);
        u.e = e; u.pm = j; u.pn = pn; u.nrows = uni(min(256, T.cnt[e] - j * 256)); u.rb = uni(T.ro[e] + j * 256);
        u.A = uni_ptr((const char*)HACT + (size_t)u.rb * EFF * 2); u.B = uni_ptr((const char*)WD + ((size_t)e * D + (size_t)pn * 256) * EFF * 2); return true;
    }
    __device__ __forceinline__ unsigned a_off(const Unit&, int h, int R, int C) const { return (unsigned)((h * HALF + R) * EFF + C) * 2u; }
};
struct EpiSwiglu {
    static constexpr bool PERM = true;
    bf16_t* HACT;
    __device__ __forceinline__ void operator()(const f32x4 (&acc)[2][2][4][2], const Unit& u, int wr, int wc, int fr, int fq) const {
        asm volatile("" : "+v"(fr), "+v"(fq));
#pragma unroll
        for (int ai = 0; ai < 2; ++ai)
#pragma unroll
            for (int m = 0; m < 4; ++m) { const int r = ai * HALF + wr * 64 + m * 16 + fr;
                if (r < u.nrows) { const f32x4 g0 = acc[ai][0][m][0], g1 = acc[ai][0][m][1], u0 = acc[ai][1][m][0], u1 = acc[ai][1][m][1];
                    float o[8];
#pragma unroll
                    for (int q = 0; q < 4; ++q) { o[q] = g0[q] * __builtin_amdgcn_rcpf(1.f + __expf(-g0[q])) * u0[q]; o[4 + q] = g1[q] * __builtin_amdgcn_rcpf(1.f + __expf(-g1[q])) * u1[q]; }
                    u32x4 w; w.x = cvt_pk_bf16(o[0], o[1]); w.y = cvt_pk_bf16(o[2], o[3]); w.z = cvt_pk_bf16(o[4], o[5]); w.w = cvt_pk_bf16(o[6], o[7]);
                    *(u32x4*)(HACT + (size_t)(u.rb + r) * EFF + u.pn * 128 + wc * 32 + 8 * fq) = w; } }
    }
};
struct EpiDown {
    static constexpr bool PERM = true;
    bf16_t* Y; float* XR; const float* MODl;
    __device__ __forceinline__ void operator()(const f32x4 (&acc)[2][2][4][2], const Unit& u, int wr, int wc, int fr, int fq) const {
        asm volatile("" : "+v"(fr), "+v"(fq));
        const unsigned lcol = (unsigned)(wc * 32 + 8 * fq);
        if (u.e < 64) {
            GAS char* ybase = (GAS char*)uni_ptr((const char*)(Y + (size_t)u.rb * D + u.pn * BM));
#pragma unroll
            for (int ai = 0; ai < 2; ++ai)
#pragma unroll
                for (int m = 0; m < 4; ++m) { const int r = ai * HALF + wr * 64 + m * 16 + fr;
                    if (r < u.nrows) { const unsigned off = ((unsigned)r * D + lcol) * 2u;
#pragma unroll
                        for (int bj = 0; bj < 2; ++bj) { const f32x4 v0 = acc[ai][bj][m][0], v1 = acc[ai][bj][m][1];
                            u32x4 w; w.x = cvt_pk_bf16(v0[0], v0[1]); w.y = cvt_pk_bf16(v0[2], v0[3]); w.z = cvt_pk_bf16(v1[0], v1[1]); w.w = cvt_pk_bf16(v1[2], v1[3]);
                            *(GAS u32x4*)(ybase + off + bj * HALF * 2) = w; } } }
        } else {
            const int m0 = u.pm * 256; const int rb = m0 < NX ? (m0 >> 12) : 4;
            const GAS char* mdb = (const GAS char*)uni_ptr((const char*)(MODl + (size_t)rb * 6144 + 5 * 1024 + u.pn * BM)); GAS char* xb = (GAS char*)uni_ptr((const char*)(XR + (size_t)m0 * D + u.pn * BM));
#pragma unroll
            for (int ai = 0; ai < 2; ++ai)
#pragma unroll
                for (int m = 0; m < 4; ++m) { const int r = ai * HALF + wr * 64 + m * 16 + fr;
                    if (r < u.nrows) {
#pragma unroll
                        for (int bj = 0; bj < 2; ++bj)
#pragma unroll
                            for (int n = 0; n < 2; ++n) { const unsigned c = (unsigned)(bj * HALF) + lcol + 4u * n; const unsigned off = ((unsigned)r * D + c) * 4u;
                                const f32x4 xi = *(const GAS f32x4*)(xb + off), mm = *(const GAS f32x4*)(mdb + c * 4u); *(GAS f32x4*)(xb + off) = xi + mm * acc[ai][bj][m][n]; } }
                    asm volatile("" ::: "memory"); }
        }
    }
};
}
template <bool FINAL>
__device__ __forceinline__ void ph_combine_norm(Frame& F, const bf16* Y, const int* SLOTPOS, const float* SLOTG, const float* MODl, float* XR, int ntok, const float* gainN, const float* MODn, bf16* XN, float* out) {
    MoeTab T = moe_tab(F);
    const int gw = F.vcu * NWAVES + F.wave, NGW = F.G * NWAVES, lane = F.lane;
    for (int m = gw; m < ntok; m += NGW) {
        const int rb = m < NX ? (m >> 12) : 4; const float* md = MODl + (size_t)rb * 6144 + 5 * 1024;
        float acc[16];
#pragma unroll
        for (int q = 0; q < 16; ++q) acc[q] = 0.f;
#pragma unroll
        for (int s = 0; s < 8; ++s) { const int sp = SLOTPOS[(size_t)m * 8 + s]; const int row = T.ro[sp >> 16] + (sp & 0xffff); const float gs = SLOTG[(size_t)m * 8 + s];
            const bf16* yr = Y + (size_t)row * D;
#pragma unroll
            for (int j = 0; j < 4; ++j) { const unsigned long long w = *(const unsigned long long*)(yr + 4 * lane + 256 * j);
                acc[4 * j + 0] += gs * __uint_as_float((unsigned)(w & 0xffffull) << 16); acc[4 * j + 1] += gs * __uint_as_float((unsigned)((w >> 16) & 0xffffull) << 16);
                acc[4 * j + 2] += gs * __uint_as_float((unsigned)((w >> 32) & 0xffffull) << 16); acc[4 * j + 3] += gs * __uint_as_float((unsigned)((w >> 48) & 0xffffull) << 16); } }
        f32x4 x[4]; float ss = 0.f;
#pragma unroll
        for (int j = 0; j < 4; ++j) { const int ci = 4 * lane + 256 * j; float* o = XR + (size_t)m * D + ci; const f32x4 xi = *(const f32x4*)o, mm = *(const f32x4*)(md + ci);
            x[j] = xi + mm * (f32x4){acc[4 * j], acc[4 * j + 1], acc[4 * j + 2], acc[4 * j + 3]};
            if (!FINAL) *(f32x4*)o = x[j];
            ss += (x[j].x * x[j].x + x[j].y * x[j].y) + (x[j].z * x[j].z + x[j].w * x[j].w); }
        ss = wave_sum(ss); const float rs = rsqrtf(ss * (1.f / D) + 1e-6f);
        const float* mdn = FINAL ? nullptr : MODn + (size_t)rb * 6144;
#pragma unroll
        for (int j = 0; j < 4; ++j) { const int ci = 4 * lane + 256 * j; const f32x4 g = *(const f32x4*)(gainN + ci);
            if (FINAL) *(f32x4*)(out + (size_t)m * D + ci) = x[j] * rs * g;
            else { const f32x4 y = x[j] * rs * g * (*(const f32x4*)(mdn + 1024 + ci) + 1.f) + *(const f32x4*)(mdn + ci); *(unsigned long long*)(XN + (size_t)m * D + ci) = pack4(y); } }
    }
}


#define MFMA16(a, b, c) __builtin_amdgcn_mfma_f32_16x16x16bf16_1k((a), (b), (c), 0, 0, 0)
__device__ __forceinline__ bf16x8 cat8(bf16x4 lo, bf16x4 hi) { return __builtin_shufflevector(lo, hi, 0, 1, 2, 3, 4, 5, 6, 7); }
#define MFMA32P(a0, a1, b0, b1, c) __builtin_amdgcn_mfma_f32_16x16x32_bf16(cat8((a0), (a1)), cat8((b0), (b1)), (c), 0, 0, 0)
constexpr int LSTR = 144;
constexpr int IMG = 64 * LSTR;
constexpr int ROPE_OFF = 120 * 1024;
__device__ __forceinline__ bf16x4 ldsfrag(const LAS unsigned char* img, int row, int k0) { return *(const LAS bf16x4*)(img + row * LSTR + k0 * 2); }
__device__ __forceinline__ f32x4 zero4() { return (f32x4){0.f, 0.f, 0.f, 0.f}; }
__device__ __forceinline__ f32x4 nt_tile64(const LAS unsigned char* A, int m0, const LAS unsigned char* B, int n0, int lane, f32x4 acc) {
    const int r = lane & 15, g = lane >> 4;
#pragma unroll
    for (int s = 0; s < 4; s += 2) acc = MFMA32P(ldsfrag(A, m0 + r, 16 * s + 4 * g), ldsfrag(A, m0 + r, 16 * s + 16 + 4 * g), ldsfrag(B, n0 + r, 16 * s + 4 * g), ldsfrag(B, n0 + r, 16 * s + 16 + 4 * g), acc);
    return acc;
}
__device__ __forceinline__ void unpack8(v4u w, float (&o)[8]) {
    o[0] = __uint_as_float(w.x << 16); o[1] = __uint_as_float(w.x & 0xffff0000u); o[2] = __uint_as_float(w.y << 16); o[3] = __uint_as_float(w.y & 0xffff0000u);
    o[4] = __uint_as_float(w.z << 16); o[5] = __uint_as_float(w.z & 0xffff0000u); o[6] = __uint_as_float(w.w << 16); o[7] = __uint_as_float(w.w & 0xffff0000u); }
struct TB { int m0, b, j, isx, t0; };
__device__ __forceinline__ TB tb_of(int tb) { TB r; if (tb < 256) { r.b = tb >> 6; r.j = tb & 63; r.isx = 1; r.m0 = tb * 64; r.t0 = r.j * 64; } else { const int q = tb - 256; r.b = q >> 2; r.j = q & 3; r.isx = 0; r.m0 = NX + q * 64; r.t0 = r.j * 64; } return r; }
__device__ __forceinline__ int chunk_of(const TB& t, int d) { return t.isx ? 4 + (d ? 63 - t.j : t.j) : (d ? 3 - t.j : t.j); }
__device__ __forceinline__ void build_rope(Frame& F) {
    LAS float* tab = (LAS float*)(F.lds + ROPE_OFF);
    for (int i = F.tid; i < 1024; i += NTHR) { const int pos = i >> 4, jj = i & 15; const float inv = __powf(10000.f, -(float)jj * (1.f / 16.f)); float sn, cs; sincosf((float)pos * inv, &sn, &cs); tab[2 * i] = cs; tab[2 * i + 1] = sn; }
}
__device__ __forceinline__ void load16(const bf16* P, int m, int col0, int dq, float (&lo)[8], float (&hi)[8]) {
    const v4u a = *(const v4u*)(P + (size_t)m * LDP + col0 + 8 * dq), b = *(const v4u*)(P + (size_t)m * LDP + col0 + 32 + 8 * dq); unpack8(a, lo); unpack8(b, hi); }
__device__ __forceinline__ void rope16(Frame& F, int t, int dq, float (&lo)[8], float (&hi)[8]) {
    const LAS float* tab = (const LAS float*)(F.lds + ROPE_OFF); const int pos = dq < 2 ? (t >> 6) : (t & 63); const int j0 = (8 * dq) & 15;
#pragma unroll
    for (int e = 0; e < 8; ++e) { const float cs = tab[2 * (pos * 16 + j0 + e)], sn = tab[2 * (pos * 16 + j0 + e) + 1]; const float a = lo[e], b = hi[e]; lo[e] = a * cs - b * sn; hi[e] = a * sn + b * cs; }
}
__device__ __forceinline__ void st_tok16(LAS unsigned char* img, int s, int dq, const float (&lo)[8], const float (&hi)[8]) {
    v4u a, b; a.x = pk2(lo[0], lo[1]); a.y = pk2(lo[2], lo[3]); a.z = pk2(lo[4], lo[5]); a.w = pk2(lo[6], lo[7]); b.x = pk2(hi[0], hi[1]); b.y = pk2(hi[2], hi[3]); b.z = pk2(hi[4], hi[5]); b.w = pk2(hi[6], hi[7]);
    *(LAS v4u*)(img + s * LSTR + 16 * dq) = a; *(LAS v4u*)(img + s * LSTR + 64 + 16 * dq) = b; }
__device__ __forceinline__ void st_chn16(LAS unsigned char* img, int s, int dq, const float (&lo)[8], const float (&hi)[8], float scale) {
#pragma unroll
    for (int e = 0; e < 8; ++e) { *(LAS bf16*)(img + (8 * dq + e) * LSTR + 2 * s) = f2bf(lo[e] * scale); *(LAS bf16*)(img + (32 + 8 * dq + e) * LSTR + 2 * s) = f2bf(hi[e] * scale); } }

__device__ __forceinline__ bf16* dz_blob(bf16* DZ, int d, int b, int h, int n) { return DZ + ((size_t)(((d * 4 + b) * 4 + h) * 68 + n)) * 4096; }
__device__ __forceinline__ void ph_ret_pre(Frame& F, const bf16* P, const float* lam, bf16* DZ) {
    const int half = F.tid >> 8, ht = F.tid & 255, s = ht & 63, dq = ht >> 6, wq = F.wave & 3, lane = F.lane;
    LAS unsigned char* hb = F.lds + RING_OFF + half * (3 * IMG);
    LAS unsigned char* KFT = hb, * KBT = hb + IMG, * VT = hb + 2 * IMG;
    for (int it = F.vcu; it < 544; it += F.G) {
        const int item = it * 2 + half, tbi = item >> 2, h = item & 3; const TB tb = tb_of(tbi);
        const float lgf = -lam[h], lgb = -lam[4 + h];
        { float lo[8], hi[8]; const int m = tb.m0 + s;
          load16(P, m, RET_OFF + 256 + h * 64, dq, lo, hi); if (tb.isx) rope16(F, tb.t0 + s, dq, lo, hi);
          st_chn16(KFT, s, dq, lo, hi, 0.125f * __expf((float)(63 - s) * lgf)); st_chn16(KBT, s, dq, lo, hi, 0.125f * __expf((float)s * lgb));
          load16(P, m, RET_OFF + 512 + h * 64, dq, lo, hi); st_chn16(VT, s, dq, lo, hi, 1.f); }
        LDS_BARRIER();
#pragma unroll
        for (int d = 0; d < 2; ++d) { bf16* blob = dz_blob(DZ, d, tb.b, h, chunk_of(tb, d)); const LAS unsigned char* KT = d ? KBT : KFT;
#pragma unroll
            for (int vt = 0; vt < 4; ++vt) { const f32x4 acc = nt_tile64(KT, 16 * wq, VT, 16 * vt, lane, zero4());
                *(unsigned long long*)(blob + (16 * vt + (lane & 15)) * 64 + 16 * wq + 4 * (lane >> 4)) = pack4(acc); } }
        LDS_BARRIER();
    }
}
__device__ __forceinline__ void ph_ret_prefix(Frame& F, const float* lam, bf16* DZ) {
    for (int e = F.vcu * NTHR + F.tid; e < 32 * 4096; e += F.G * NTHR) {
        const int seq = e >> 12, el = e & 4095, d = seq >> 4, h = seq & 3;
        const float gC = __expf(-64.f * lam[d * 4 + h]);
        GAS bf16* base = (GAS bf16*)DZ + (size_t)seq * 68 * 4096 + el; float z = 0.f;
#pragma unroll 1
        for (int n = 0; n < 68; n += 17) { float tmp[17];
#pragma unroll
            for (int u = 0; u < 17; ++u) tmp[u] = bf2f(base[(size_t)(n + u) * 4096]);
#pragma unroll
            for (int u = 0; u < 17; ++u) { base[(size_t)(n + u) * 4096] = f2bf(z); z = gC * z + tmp[u]; } } }
}
__device__ __forceinline__ void ph_ret_post(Frame& F, const bf16* P, const float* lam, const bf16* DZ, bf16* MIX) {
    const int half = F.tid >> 8, ht = F.tid & 255, s = ht & 63, dq = ht >> 6, wq = F.wave & 3, lane = F.lane, r = lane & 15, g = lane >> 4;
    LAS unsigned char* hb = F.lds + RING_OFF + half * (4 * IMG);
    LAS unsigned char* Qi = hb, * Ki = hb + IMG, * VT = hb + 2 * IMG, * Wi = hb + 3 * IMG;
    for (int it = F.vcu; it < 544; it += F.G) {
        const int item = it * 2 + half, tbi = item >> 2, h = item & 3; const TB tb = tb_of(tbi);
        const float lgf = -lam[h], lgb = -lam[4 + h];
        { float lo[8], hi[8]; const int m = tb.m0 + s;
          load16(P, m, RET_OFF + h * 64, dq, lo, hi); if (tb.isx) rope16(F, tb.t0 + s, dq, lo, hi); st_tok16(Qi, s, dq, lo, hi);
          load16(P, m, RET_OFF + 256 + h * 64, dq, lo, hi); if (tb.isx) rope16(F, tb.t0 + s, dq, lo, hi);
#pragma unroll
          for (int e = 0; e < 8; ++e) { lo[e] *= 0.125f; hi[e] *= 0.125f; }
          st_tok16(Ki, s, dq, lo, hi);
          load16(P, m, RET_OFF + 512 + h * 64, dq, lo, hi); st_chn16(VT, s, dq, lo, hi, 1.f); }
        LDS_BARRIER();
        const int s0 = 16 * wq, sl = s0 + r;
#pragma unroll
        for (int jt = 0; jt < 4; ++jt) { f32x4 acc = nt_tile64(Ki, 16 * jt, Qi, s0, lane, zero4());
#pragma unroll
            for (int i = 0; i < 4; ++i) { const int j = 16 * jt + 4 * g + i; const float wf = j <= sl ? __expf((float)(sl - j) * lgf) : 0.f, wb = j >= sl ? __expf((float)(j - sl) * lgb) : 0.f; acc[i] *= (wf + wb); }
            *(LAS unsigned long long*)(Wi + sl * LSTR + 2 * (16 * jt + 4 * g)) = pack4(acc); }
        LDS_WAIT();
        const bf16* Zf = dz_blob((bf16*)DZ, 0, tb.b, h, chunk_of(tb, 0)); const bf16* Zb = dz_blob((bf16*)DZ, 1, tb.b, h, chunk_of(tb, 1));
        const float ef = __expf((float)(sl + 1) * lgf), eb = __expf((float)(64 - sl) * lgb);
        f32x4 o[4]; float ssq = 0.f;
#pragma unroll
        for (int vt = 0; vt < 4; ++vt) { f32x4 aw = nt_tile64(VT, 16 * vt, Wi, s0, lane, zero4()), af = zero4(), ab = zero4();
#pragma unroll
            for (int ks = 0; ks < 4; ++ks) { const bf16x4 qf = ldsfrag(Qi, sl, 16 * ks + 4 * g);
                const bf16x4 zf = *(const bf16x4*)(Zf + (16 * vt + r) * 64 + 16 * ks + 4 * g), zb = *(const bf16x4*)(Zb + (16 * vt + r) * 64 + 16 * ks + 4 * g);
                af = MFMA16(zf, qf, af); ab = MFMA16(zb, qf, ab); }
            o[vt] = aw + af * ef + ab * eb; ssq += (o[vt].x * o[vt].x + o[vt].y * o[vt].y) + (o[vt].z * o[vt].z + o[vt].w * o[vt].w); }
        ssq += __shfl_xor(ssq, 16); ssq += __shfl_xor(ssq, 32);
        const float rs = rsqrtf(ssq * (1.f / 64.f) + 1e-6f); const int m = tb.m0 + sl;
#pragma unroll
        for (int vt = 0; vt < 4; ++vt) { const int vd = 16 * vt + 4 * g; const unsigned long long gw = *(const unsigned long long*)(P + (size_t)m * LDP + RET_OFF + 768 + h * 64 + vd);
            f32x4 y; y.x = o[vt].x * rs * siluf_(__uint_as_float((unsigned)(gw & 0xffffull) << 16)); y.y = o[vt].y * rs * siluf_(__uint_as_float((unsigned)((gw >> 16) & 0xffffull) << 16));
            y.z = o[vt].z * rs * siluf_(__uint_as_float((unsigned)((gw >> 32) & 0xffffull) << 16)); y.w = o[vt].w * rs * siluf_(__uint_as_float((unsigned)((gw >> 48) & 0xffffull) << 16));
            *(unsigned long long*)(MIX + (size_t)m * D + 256 + h * 64 + vd) = pack4(y); }
        LDS_BARRIER();
    }
}

constexpr int IT_KP = 0, IT_RP = 8192, IT_BH = 16384, IT_UT = 24576, IT_Y0 = 32768, IT_D0 = 40960, IT_GC = 49152, ITEM_BYTES = 49664;
__device__ __forceinline__ int swz(int r, int c) { return r * 128 + (((c >> 2) ^ (r & 15)) << 3) + (c & 3) * 2; }
__device__ __forceinline__ GAS unsigned char* item_ptr(unsigned char* BL, int seq, int n) { return (GAS unsigned char*)BL + ((size_t)seq * 68 + n) * ITEM_BYTES; }
__device__ __forceinline__ bf16x4 cvt4(f32x4 v) { unsigned long long p = pack4(v); return __builtin_bit_cast(bf16x4, p); }
__device__ __forceinline__ f32x4 up4(unsigned long long w) { f32x4 r; r.x = __uint_as_float((unsigned)(w & 0xffffull) << 16); r.y = __uint_as_float((unsigned)((w >> 16) & 0xffffull) << 16);
    r.z = __uint_as_float((unsigned)((w >> 32) & 0xffffull) << 16); r.w = __uint_as_float((unsigned)((w >> 48) & 0xffffull) << 16); return r; }
constexpr int PI_A0 = 0, PI_A1 = 1, PI_A2 = 2, PI_A3 = 3, PI_KAPT = 4, PI_RHOT = 5, PI_VT = 6, PI_KHT = 7, PI_M1 = 8, PI_M2 = 9, PI_M3 = 10, PI_M4 = 11;
constexpr int PRE_TINV = 12 * IMG;
constexpr int PRE_ARR = PRE_TINV + 4 * 16 * 40;
__device__ __forceinline__ LAS unsigned char* pimg(Frame& F, int i) { return F.lds + RING_OFF + i * IMG; }

template <bool SCALAR>
__device__ __forceinline__ void dplr_core(Frame& F, GAS unsigned char* item) {
    int lane = F.lane; asm volatile("" : "+v"(lane));
    int w = F.wave; asm volatile("" : "+s"(w)); const int r = lane & 15, g = lane >> 4;
    const LAS float* Gs = (const LAS float*)(F.lds + RING_OFF + PRE_ARR); const LAS float* GM1 = Gs + 64; const LAS float* BETA = Gs + 128;
    TSEC_BEGIN(4)
    if (SCALAR) {
#pragma unroll
        for (int q = 0; q < 4; ++q) { const int e = w * 4 + q, which = e >> 4, tj = (e >> 2) & 3, tt = e & 3;
            LAS unsigned char* Ma = pimg(F, which ? PI_M3 : PI_M1); LAS unsigned char* Mb = pimg(F, which ? PI_M4 : PI_M2);
            f32x4 va = zero4(), vb = zero4(); const int t = 16 * tt + r;
            if (tj <= tt) { const f32x4 acc = nt_tile64(pimg(F, PI_A0), 16 * tj, pimg(F, which ? PI_A1 : PI_A0), 16 * tt, lane, zero4());
                const float gt = which ? Gs[t] : GM1[t];
#pragma unroll
                for (int i = 0; i < 4; ++i) { const int j = 16 * tj + 4 * g + i; const bool ok = which ? (j <= t) : (j < t); const float bj = BETA[j];
                    va[i] = ok ? acc[i] * bj * __expf(gt - GM1[j]) : 0.f; vb[i] = ok ? acc[i] * bj * __expf(gt - Gs[j]) : 0.f; } }
            *(LAS unsigned long long*)(Ma + t * LSTR + 2 * (16 * tj + 4 * g)) = pack4(va); *(LAS unsigned long long*)(Mb + t * LSTR + 2 * (16 * tj + 4 * g)) = pack4(vb); }
    } else {
#pragma unroll
        for (int q = 0; q < 8; ++q) { const int e = w * 8 + q, mi = e >> 4, tj = (e >> 2) & 3, tt = e & 3;
            LAS unsigned char* M = pimg(F, PI_M1 + mi); f32x4 va = zero4(); const int t = 16 * tt + r;
            if (tj <= tt) { const f32x4 acc = nt_tile64(pimg(F, (mi & 1) ? PI_A2 : PI_A1), 16 * tj, pimg(F, (mi & 2) ? PI_A3 : PI_A0), 16 * tt, lane, zero4());
#pragma unroll
                for (int i = 0; i < 4; ++i) { const int j = 16 * tj + 4 * g + i; const bool ok = (mi & 2) ? (j <= t) : (j < t); va[i] = ok ? acc[i] : 0.f; } }
            *(LAS unsigned long long*)(M + t * LSTR + 2 * (16 * tj + 4 * g)) = pack4(va); }
    }
    LDS_BARRIER();
    TSEC_END(4)
    TSEC_BEGIN(5)
    if (w == 0) { const int blk = lane >> 4, c = lane & 15; const LAS unsigned char* M1 = pimg(F, PI_M1); float x[16];
#pragma unroll
        for (int rr = 0; rr < 16; ++rr) { float a[16]; const v4u lo = *(const LAS v4u*)(M1 + (16 * blk + rr) * LSTR + 32 * blk), hi = *(const LAS v4u*)(M1 + (16 * blk + rr) * LSTR + 32 * blk + 16);
            { float t8[8]; unpack8(lo, t8);
#pragma unroll
              for (int q = 0; q < 8; ++q) a[q] = t8[q]; unpack8(hi, t8);
#pragma unroll
              for (int q = 0; q < 8; ++q) a[8 + q] = t8[q]; }
            float s = (rr == c) ? 1.f : 0.f;
#pragma unroll
            for (int j = 0; j < rr; ++j) s -= a[j] * x[j];
            x[rr] = s; }
        LAS unsigned char* TI = F.lds + RING_OFF + PRE_TINV + blk * 16 * 40;
#pragma unroll
        for (int rr = 0; rr < 16; ++rr) *(LAS bf16*)(TI + rr * 40 + 2 * c) = f2bf(x[rr]); }
    LDS_BARRIER();
    TSEC_END(5)
    TSEC_BEGIN(6)
    const LAS unsigned char* M1 = pimg(F, PI_M1); const LAS unsigned char* M2 = pimg(F, PI_M2); const LAS unsigned char* M3 = pimg(F, PI_M3); const LAS unsigned char* M4 = pimg(F, PI_M4);
    const LAS unsigned char* VT = pimg(F, PI_VT);
    f32x4 x[4];
    if (w < 4) {
#pragma unroll
        for (int tb = 0; tb < 4; ++tb) { f32x4 acc = zero4();
#pragma unroll
            for (int jb = 0; jb <= tb; ++jb) acc = MFMA16(ldsfrag(M2, 16 * tb + r, 16 * jb + 4 * g), ldsfrag(VT, 16 * w + r, 16 * jb + 4 * g), acc);
            x[tb] = acc; }
    } else { const LAS unsigned char* KAPT = pimg(F, PI_KAPT);
#pragma unroll
        for (int tb = 0; tb < 4; ++tb) x[tb] = up4(*(const LAS unsigned long long*)(KAPT + (16 * (w - 4) + r) * LSTR + 2 * (16 * tb + 4 * g))); }
#pragma unroll
    for (int i = 0; i < 4; ++i) { f32x4 acc = zero4();
#pragma unroll
        for (int j = 0; j < i; ++j) acc = MFMA16(ldsfrag(M1, 16 * i + r, 16 * j + 4 * g), cvt4(x[j]), acc);
        const f32x4 rhs = x[i] - acc;
        const bf16x4 tf = *(const LAS bf16x4*)(F.lds + RING_OFF + PRE_TINV + (i * 16 + r) * 40 + 8 * g);
        x[i] = MFMA16(tf, cvt4(rhs), zero4()); }
    if (w < 4) {
        const int v = 16 * w + r; GAS bf16* UT = (GAS bf16*)(item + IT_UT) + v * 64; GAS bf16* Y0T = (GAS bf16*)(item + IT_Y0) + v * 64; GAS bf16* D0T = (GAS bf16*)(item + IT_D0) + v * 64;
        const LAS unsigned char* KHT = pimg(F, PI_KHT);
#pragma unroll
        for (int tb = 0; tb < 4; ++tb) { *(GAS unsigned long long*)(UT + 16 * tb + 4 * g) = pack4(x[tb]);
            f32x4 a4 = zero4(), a3 = zero4();
#pragma unroll
            for (int jb = 0; jb <= tb; ++jb) { a4 = MFMA16(ldsfrag(M4, 16 * tb + r, 16 * jb + 4 * g), ldsfrag(VT, v, 16 * jb + 4 * g), a4); a3 = MFMA16(ldsfrag(M3, 16 * tb + r, 16 * jb + 4 * g), cvt4(x[jb]), a3); }
            *(GAS unsigned long long*)(Y0T + 16 * tb + 4 * g) = pack4(a4 - a3);
            f32x4 d0 = zero4();
#pragma unroll
            for (int sb = 0; sb < 4; ++sb) d0 = MFMA16(ldsfrag(KHT, 16 * tb + r, 16 * sb + 4 * g), ldsfrag(VT, v, 16 * sb + 4 * g), d0);
            *(GAS unsigned long long*)(D0T + 16 * tb + 4 * g) = pack4(d0); }
    } else {
        const int k = 16 * (w - 4) + r; const LAS unsigned char* RHOT = pimg(F, PI_RHOT); LAS unsigned char* KPi = pimg(F, PI_A2); LAS unsigned char* RPi = pimg(F, PI_A3);
#pragma unroll
        for (int tb = 0; tb < 4; ++tb) { f32x4 a3 = zero4();
#pragma unroll
            for (int jb = 0; jb <= tb; ++jb) a3 = MFMA16(ldsfrag(M3, 16 * tb + r, 16 * jb + 4 * g), cvt4(x[jb]), a3);
            const f32x4 rp = up4(*(const LAS unsigned long long*)(RHOT + k * LSTR + 2 * (16 * tb + 4 * g))) - a3;
#pragma unroll
            for (int i = 0; i < 4; ++i) { const int t = 16 * tb + 4 * g + i; *(LAS bf16*)(KPi + swz(t, k)) = f2bf(x[tb][i]); *(LAS bf16*)(RPi + swz(t, k)) = f2bf(rp[i]); } }
    }
    LDS_BARRIER();
    TSEC_END(6)
    TSEC_BEGIN(7)
    { const v4u a = *(const LAS v4u*)(pimg(F, PI_A2) + F.tid * 16), b = *(const LAS v4u*)(pimg(F, PI_A3) + F.tid * 16);
      *(GAS v4u*)(item + IT_KP + F.tid * 16) = a; *(GAS v4u*)(item + IT_RP + F.tid * 16) = b; }
    LDS_BARRIER();
    TSEC_END(7)
}

__device__ __forceinline__ void st_chn8(LAS unsigned char* img, int lane, int w, const float (&v)[8]) { v4u o; o.x = pk2(v[0], v[1]); o.y = pk2(v[2], v[3]); o.z = pk2(v[4], v[5]); o.w = pk2(v[6], v[7]); *(LAS v4u*)(img + lane * LSTR + 16 * w) = o; }
__device__ __forceinline__ void st_bh8(GAS unsigned char* bh, int lane, int w, const float (&v)[8]) {
    *(GAS unsigned long long*)(bh + lane * 128 + (((2 * w) ^ (lane & 15)) << 3)) = (unsigned long long)pk2(v[0], v[1]) | ((unsigned long long)pk2(v[2], v[3]) << 32);
    *(GAS unsigned long long*)(bh + lane * 128 + (((2 * w + 1) ^ (lane & 15)) << 3)) = (unsigned long long)pk2(v[4], v[5]) | ((unsigned long long)pk2(v[6], v[7]) << 32); }
__device__ __forceinline__ void gdn_pre_item(Frame& F, const bf16* P, const float* cw, const float* alog, const float* dtb, unsigned char* BL, int tbi, int h, int d) {
    int w = F.wave; asm volatile("" : "+s"(w));
    const TB tb = tb_of(tbi); const int lane = F.lane, L = tb.isx ? SEQ : CTXL;
    LAS float* Gs = (LAS float*)(F.lds + RING_OFF + PRE_ARR); LAS float* GM1 = Gs + 64; LAS float* BETA = Gs + 128; LAS float* LAa = Gs + 192;
    const int seq = (d * 4 + tb.b) * 4 + h; GAS unsigned char* item = item_ptr(BL, seq, chunk_of(tb, d));
    TSEC_BEGIN(1)
    constexpr int GSTR = 400;
    LAS unsigned char* STG = pimg(F, PI_M1);
    { const GAS bf16* Pg = (const GAS bf16*)P;
#pragma unroll
      for (int q = 0; q < 4; ++q) { const int e0 = F.tid + q * NTHR, e = e0 < 68 * 24 ? e0 : 68 * 24 - 1; const int row = e / 24, ch = e % 24, sg = ch >> 3, part = ch & 7; const int t = tb.t0 - 2 + row;
              const bool ok = t >= 0 && t < L; const int rowc = ok ? row : 2;
              v4u val = *(const GAS v4u*)(Pg + (size_t)(tb.m0 - 2 + rowc) * LDP + GDN_OFF + sg * 256 + h * 64 + part * 8);
              if (!ok) val = (v4u){0u, 0u, 0u, 0u};
              *(LAS v4u*)(STG + row * GSTR + ch * 16) = val; } }
    float qv[8], kv[8], vv[8];
    const float Aexp = __expf(alog[d * 4 + h]), dt = dtb[d * 4 + h];
    float Gall, GM1all, BEall;
    { const GAS bf16* Pg = (const GAS bf16*)P; const int tau = d ? 63 - lane : lane; const size_t mo = (size_t)(tb.m0 + tau) * LDP + GDN_OFF;
      const float ar = bf2f(Pg[mo + 768 + d * 4 + h]), br = bf2f(Pg[mo + 776 + d * 4 + h]);
      const float la = -Aexp * softplusf_(ar + dt); BEall = sigmoidf_(br); float gsum = la;
#pragma unroll
      for (int o = 1; o < 64; o <<= 1) { const float t = __shfl_up(gsum, o); if (lane >= o) gsum += t; }
      Gall = gsum; GM1all = gsum - la;
      if (w == 0) { Gs[lane] = Gall; GM1[lane] = GM1all; BETA[lane] = BEall; } }
    LDS_BARRIER();
    { float cwv[3][4];
#pragma unroll
      for (int c3 = 0; c3 < 3; ++c3)
#pragma unroll
          for (int j = 0; j < 4; ++j) cwv[c3][j] = cw[j * 768 + c3 * 256 + h * 64 + lane];
#pragma unroll
      for (int u = 0; u < 8; ++u) { const int s = 8 * w + u, tau = d ? 63 - s : s;
          float acc3[3] = {0.f, 0.f, 0.f};
#pragma unroll
          for (int j = 0; j < 4; ++j)
#pragma unroll
              for (int c3 = 0; c3 < 3; ++c3) acc3[c3] += bf2f(*(const LAS bf16*)(STG + (tau + j) * GSTR + (c3 * 64 + lane) * 2)) * cwv[c3][j];
          const float o0 = siluf_(acc3[0]), o1 = siluf_(acc3[1]), o2 = siluf_(acc3[2]);
          const float qs = wave_sum(o0 * o0), ks = wave_sum(o1 * o1);
          qv[u] = o0 * rsqrtf(qs + 1e-6f) * 0.125f; kv[u] = o1 * rsqrtf(ks + 1e-6f); vv[u] = o2;
          } }
    TSEC_END(1)
    TSEC_BEGIN(3)
    const float gc = __int_as_float(__builtin_amdgcn_readlane(__float_as_int(Gall), 63));
    { float kap[8], rho[8], kht[8], bh[8];
#pragma unroll
      for (int u = 0; u < 8; ++u) { const int s = 8 * w + u; const float gg = __int_as_float(__builtin_amdgcn_readlane(__float_as_int(Gall), s)), gm = __int_as_float(__builtin_amdgcn_readlane(__float_as_int(GM1all), s)), be = __int_as_float(__builtin_amdgcn_readlane(__float_as_int(BEall), s));
          *(LAS bf16*)(pimg(F, PI_A0) + s * LSTR + 2 * lane) = f2bf(kv[u]); *(LAS bf16*)(pimg(F, PI_A1) + s * LSTR + 2 * lane) = f2bf(qv[u]);
          kap[u] = kv[u] * __expf(gm); rho[u] = qv[u] * __expf(gg); kht[u] = be * kv[u] * __expf(gc - gg); bh[u] = be * kv[u] * __expf(gc - gm); }
      st_chn8(pimg(F, PI_KAPT), lane, w, kap); st_chn8(pimg(F, PI_RHOT), lane, w, rho); st_chn8(pimg(F, PI_VT), lane, w, vv); st_chn8(pimg(F, PI_KHT), lane, w, kht); st_bh8(item + IT_BH, lane, w, bh); }
    if (w == 0) ((GAS float*)(item + IT_GC))[lane] = __expf(gc);
    LDS_BARRIER();
    TSEC_END(3)
    dplr_core<true>(F, item);
}
__device__ __forceinline__ void ph_gdn_pre(Frame& F, const bf16* P, const float* cw, const float* alog, const float* dtb, unsigned char* BL) {
    for (int it = F.vcu; it < 272 * 8; it += F.G) { const int tbi = it >> 3, h = (it >> 1) & 3, d = it & 1; gdn_pre_item(F, P, cw, alog, dtb, BL, tbi, h, d); }
}

constexpr int SLOT_BYTES = 24576;
__device__ __forceinline__ void dplr_scan_seq(Frame& F, const unsigned char* BLgen, int seq, float* YSgen0, float* YSgen1) {
    const GAS unsigned char* BL = (const GAS unsigned char*)BLgen; GAS float* YS = (GAS float*)((seq >> 4) ? YSgen1 : YSgen0);
    const int w = F.wave, lane = F.lane, r = lane & 15, g = lane >> 4;
    const int d = seq >> 4, b = (seq >> 2) & 3, h = seq & 3;
    LAS unsigned char* ring = F.lds + RING_OFF;
    if (w >= 4) {
        const int lw = w - 4;
#define SCAN_ISSUE(n) do { const GAS unsigned char* src = BL + ((size_t)seq * 68 + (n)) * ITEM_BYTES + lw * 6144 + lane * 16; LAS unsigned char* dst = ring + ((n) % 5) * SLOT_BYTES + lw * 6144; \
        _Pragma("unroll") for (int q = 0; q < 6; ++q) __builtin_amdgcn_global_load_lds((const GAS unsigned*)(src + q * 1024), (LAS unsigned*)(dst + q * 1024), 16, 0, 0); } while (0)
        SCAN_ISSUE(0); SCAN_ISSUE(1); SCAN_ISSUE(2); SCAN_ISSUE(3);
        asm volatile("s_waitcnt vmcnt(18)" ::: "memory");
        __builtin_amdgcn_s_barrier(); asm volatile("" ::: "memory");
        for (int n = 0; n < 68; ++n) {
            if (n + 4 < 68) { SCAN_ISSUE(n + 4); asm volatile("s_waitcnt vmcnt(18)" ::: "memory"); }
            else asm volatile("s_waitcnt vmcnt(0)" ::: "memory");
            __builtin_amdgcn_s_barrier(); asm volatile("" ::: "memory");
        }
#undef SCAN_ISSUE
    } else {
        const int v = 16 * w + r;
        f32x4 z[4];
#pragma unroll
        for (int kb = 0; kb < 4; ++kb) z[kb] = zero4();
        struct Strip { unsigned long long ut[4], y0[4], d0[4]; f32x4 gc[4]; };
#define STRIP_LOAD(S, n) do { const GAS unsigned char* it_ = BL + ((size_t)seq * 68 + (n)) * ITEM_BYTES; const GAS bf16* UT_ = (const GAS bf16*)(it_ + IT_UT) + v * 64; const GAS bf16* Y0_ = (const GAS bf16*)(it_ + IT_Y0) + v * 64; \
        const GAS bf16* D0_ = (const GAS bf16*)(it_ + IT_D0) + v * 64; const GAS float* GC_ = (const GAS float*)(it_ + IT_GC); \
        _Pragma("unroll") for (int q = 0; q < 4; ++q) { S.ut[q] = *(const GAS unsigned long long*)(UT_ + 16 * q + 4 * g); S.y0[q] = *(const GAS unsigned long long*)(Y0_ + 16 * q + 4 * g); \
            S.d0[q] = *(const GAS unsigned long long*)(D0_ + 16 * q + 4 * g); S.gc[q] = *(const GAS f32x4*)(GC_ + 16 * q + 4 * g); } } while (0)
#define SCAN_BODY(S, n, SL) do { TSECN_BEGIN(8) const LAS unsigned char* slot = ring + (SL) * SLOT_BYTES; const LAS unsigned char* sx0 = slot + xo[0]; const LAS unsigned char* sx1 = slot + xo[1]; const LAS unsigned char* sx2 = slot + xo[2]; const LAS unsigned char* sx3 = slot + xo[3]; \
        bf16x4 zb[4]; _Pragma("unroll") for (int kb = 0; kb < 4; ++kb) zb[kb] = cvt4(z[kb]); \
        f32x4 sa[4], y[4]; \
        _Pragma("unroll") for (int tt = 0; tt < 4; ++tt) { sa[tt] = up4(S.ut[tt]); y[tt] = up4(S.y0[tt]); } \
        _Pragma("unroll") for (int kp = 0; kp < 2; ++kp) { const LAS unsigned char* sxa = kp == 0 ? sx0 : sx2; const LAS unsigned char* sxb = kp == 0 ? sx1 : sx3;     \
            _Pragma("unroll") for (int tt = 0; tt < 4; ++tt) { sa[tt] = MFMA32P(*(const LAS bf16x4*)(sxa + IT_KP + tt * 2048), *(const LAS bf16x4*)(sxb + IT_KP + tt * 2048), zb[2 * kp], zb[2 * kp + 1], sa[tt]); \
                y[tt] = MFMA32P(*(const LAS bf16x4*)(sxa + IT_RP + tt * 2048), *(const LAS bf16x4*)(sxb + IT_RP + tt * 2048), zb[2 * kp], zb[2 * kp + 1], y[tt]); } } \
        bf16x4 sb[4]; _Pragma("unroll") for (int tt = 0; tt < 4; ++tt) sb[tt] = cvt4(sa[tt]); \
        f32x4 zu[4]; _Pragma("unroll") for (int kb = 0; kb < 4; ++kb) zu[kb] = zero4(); \
        _Pragma("unroll") for (int tp = 0; tp < 2; ++tp) { const LAS unsigned char* sxa = tp == 0 ? sx0 : sx2; const LAS unsigned char* sxb = tp == 0 ? sx1 : sx3; \
            _Pragma("unroll") for (int kb = 0; kb < 4; ++kb) zu[kb] = MFMA32P(*(const LAS bf16x4*)(sxa + IT_BH + kb * 2048), *(const LAS bf16x4*)(sxb + IT_BH + kb * 2048), sb[2 * tp], sb[2 * tp + 1], zu[kb]); } \
        _Pragma("unroll") for (int kb = 0; kb < 4; ++kb) z[kb] = S.gc[kb] * z[kb] + up4(S.d0[kb]) - zu[kb]; \
        { int m0; if ((n) < 4) { const int j = d ? 3 - (n) : (n); m0 = NX + (b * 4 + j) * 64; } else { const int j = d ? 63 - ((n) - 4) : ((n) - 4); m0 = (b * 64 + j) * 64; } \
          GAS float* yb = YS + (size_t)m0 * 256 + h * 64 + v; \
          _Pragma("unroll") for (int tt = 0; tt < 4; ++tt) _Pragma("unroll") for (int i = 0; i < 4; ++i) { const int t = 16 * tt + 4 * g + i, tau = d ? 63 - t : t; yb[(size_t)tau * 256] = y[tt][i]; } } \
        if ((n) + 2 < 68) STRIP_LOAD(S, (n) + 2); \
        TSECN_END(8) TSECN_BEGIN(9) \
        asm volatile("" ::: "memory"); __builtin_amdgcn_s_barrier(); asm volatile("" ::: "memory"); TSECN_END(9) } while (0)
        int xo[4];
#pragma unroll
        for (int q = 0; q < 4; ++q) xo[q] = r * 128 + (((4 * q + g) ^ r) << 3);
        Strip S0, S1; STRIP_LOAD(S0, 0); STRIP_LOAD(S1, 1);
        __builtin_amdgcn_s_barrier(); asm volatile("" ::: "memory");
        for (int n = 0; n < 68; n += 2) { SCAN_BODY(S0, n, (n % 5)); SCAN_BODY(S1, n + 1, ((n + 1) % 5)); }
#undef STRIP_LOAD
#undef SCAN_BODY
    }
}
constexpr int RWT_A2 = 2 * 2 * 256 * 32, RWT_V2 = 2 * RWT_A2, RWT_G2 = RWT_V2 + 256 * 32, RWT_TOTAL = RWT_G2 + 2 * 256 * 64;
__device__ __forceinline__ void ph_convert_rwkv(Frame& F, const float* w2, const float* a2, const float* v2, const float* g2, bf16* RWTp) {
    for (int i = F.vcu * NTHR + F.tid; i < RWT_TOTAL; i += F.G * NTHR) {
        float x;
        if (i < RWT_V2) { const int which = i >= RWT_A2, r = i - which * RWT_A2, ld = r >> 13, c = (r >> 5) & 255, j = r & 31; x = (which ? a2 : w2)[((size_t)ld * 32 + j) * 256 + c]; }
        else if (i < RWT_G2) { const int r = i - RWT_V2, c = r >> 5, j = r & 31; x = v2[j * 256 + c]; }
        else { const int r = i - RWT_G2, l = r >> 14, c = (r >> 6) & 255, j = r & 63; x = g2[((size_t)l * 64 + j) * 256 + c]; }
        RWTp[i] = f2bf(x); }
}
constexpr int RW_RSTR = 720;
constexpr int RW_RAW = 0, RW_TW = 55296, RW_AD = RW_TW + 64 * 80, RW_VD = RW_AD + 64 * 80, RW_GD = RW_VD + 64 * 80, RW_ZZ = RW_GD + 64 * 144, RW_ZA = RW_ZZ + 16384, RW_ZV = RW_ZA + 16384, RW_ZG = RW_ZV + IMG;
static_assert(RW_ZG + IMG <= RING_BYTES && 66 * RW_RSTR <= RW_TW, "RWKV prep LDS map");
constexpr int RW_WT = LDSCTL_OFF + 4096;
__device__ __forceinline__ void rwkv_pre_item(Frame& F, const bf16* Pgen, const RwP& wp, const bf16* RWTg, int layer, float* VF, float* SV, float* GB, float* BSC, unsigned char* BL, int tbi, int h, int d) {
    int w = F.wave; asm volatile("" : "+s"(w));
    const GAS bf16* P = (const GAS bf16*)Pgen; const GAS bf16* RWTp = (const GAS bf16*)RWTg;
    const TB tb = tb_of(tbi); const int lane = F.lane, tid = F.tid, L = tb.isx ? SEQ : CTXL, c = h * 64 + lane, r = lane & 15, g = lane >> 4;
    LAS unsigned char* lds = F.lds + RING_OFF; LAS float* WT = (LAS float*)(F.lds + RW_WT);
    const int seq = (d * 4 + tb.b) * 4 + h; GAS unsigned char* item = item_ptr(BL, seq, chunk_of(tb, d));
#pragma unroll
    for (int q = 0; q < 6; ++q) { const int e0 = tid + q * NTHR, e = e0 < 66 * 44 ? e0 : 66 * 44 - 1; const int row = e / 44, ch = e % 44; const int t = tb.t0 - 1 + row; const bool ok = t >= 0 && t < L; const int rowc = ok ? row : 1;
        const int pcol = ch < 24 ? (ch >> 3) * 256 + h * 64 + (ch & 7) * 8 : ch < 28 ? 768 + d * 32 + (ch - 24) * 8 : ch < 32 ? 832 + d * 32 + (ch - 28) * 8 : ch < 40 ? 896 + (ch - 32) * 8 : VRES_OFF + (ch - 40) * 8;
        v4u val = *(const GAS v4u*)(P + (size_t)(tb.m0 - 1 + rowc) * LDP + pcol); if (!ok) val = (v4u){0u, 0u, 0u, 0u};
        *(LAS v4u*)(lds + RW_RAW + row * RW_RSTR + ch * 16) = val; }
    float svf[8];
#pragma unroll
    for (int u = 0; u < 8; ++u) { const int s = 8 * w + u, tau = d ? 63 - s : s; svf[u] = layer ? VF[(size_t)(tb.m0 + tau) * 256 + c] : 0.f; }
    LDS_BARRIER();
#define RAWV(row, col) bf2f(*(const LAS bf16*)(lds + RW_RAW + (row) * RW_RSTR + (col) * 2))
#define RSHF(tau_, col, mu_) ([&]() { const float p_ = RAWV((tau_) + 1, col); return p_ + (0.5f * (RAWV((tau_), col) + RAWV((tau_) + 2, col)) - p_) * (mu_); }())
    { const int tau = tid & 63, cg = tid >> 6;
#pragma unroll 4
      for (int q = 0; q < 20; ++q) { const int j = cg * 20 + q;
          if (j < 32) { const float x = RSHF(tau, 192 + j, wp.mu[768 + d * 32 + j]); *(LAS bf16*)(lds + RW_TW + tau * 80 + 2 * j) = f2bf(tanhf_(x)); }
          else if (j < 64) { const float x = RSHF(tau, 224 + (j - 32), wp.mu[832 + d * 32 + (j - 32)]); *(LAS bf16*)(lds + RW_AD + tau * 80 + 2 * (j - 32)) = f2bf(x); }
          else if (j < 128) { const float x = RSHF(tau, 256 + (j - 64), wp.mu[896 + (j - 64)]); *(LAS bf16*)(lds + RW_GD + tau * 144 + 2 * (j - 64)) = f2bf(sigmoidf_(x)); }
          else { *(LAS bf16*)(lds + RW_VD + tau * 80 + 2 * (j - 128)) = *(const LAS bf16*)(lds + RW_RAW + (tau + 1) * RW_RSTR + (320 + (j - 128)) * 2); } } }
    LDS_BARRIER();
    { const int p = w >> 1; const bool live = p < 2 || (p == 2 && layer) || (p == 3 && d == 0);
      if (live) { const int ksteps = p == 3 ? 4 : 2, astr = p == 3 ? 144 : 80; const LAS unsigned char* A = lds + (p == 0 ? RW_TW : p == 1 ? RW_AD : p == 2 ? RW_VD : RW_GD);
          const GAS bf16* Bw = p == 0 ? RWTp + ((size_t)(layer * 2 + d) * 256 + h * 64) * 32 : p == 1 ? RWTp + RWT_A2 + ((size_t)(layer * 2 + d) * 256 + h * 64) * 32 : p == 2 ? RWTp + RWT_V2 + (size_t)(h * 64) * 32 : RWTp + RWT_G2 + ((size_t)layer * 256 + h * 64) * 64;
          const int bstr = p == 3 ? 64 : 32;
#pragma unroll
          for (int sq = 0; sq < 2; ++sq) { const int st = 2 * (w & 1) + sq;
#pragma unroll
              for (int ct = 0; ct < 4; ++ct) { f32x4 acc = zero4();
                  for (int ks = 0; ks < ksteps; ++ks) { const bf16x4 af = *(const LAS bf16x4*)(A + (16 * st + r) * astr + (16 * ks + 4 * g) * 2); const bf16x4 bfr = *(const GAS bf16x4*)(Bw + (size_t)(16 * ct + r) * bstr + 16 * ks + 4 * g); acc = MFMA16(af, bfr, acc); }
#pragma unroll
                  for (int i = 0; i < 4; ++i) { const int tau = 16 * st + 4 * g + i, cc = 16 * ct + r;
                      if (p == 0) *(LAS float*)(lds + RW_ZZ + (tau * 64 + cc) * 4) = acc[i]; else if (p == 1) *(LAS float*)(lds + RW_ZA + (tau * 64 + cc) * 4) = acc[i];
                      else if (p == 2) *(LAS bf16*)(lds + RW_ZV + tau * LSTR + 2 * cc) = f2bf(acc[i]); else *(LAS bf16*)(lds + RW_ZG + tau * LSTR + 2 * cc) = f2bf(acc[i]); } } } } }
    LDS_BARRIER();
    float rv[8], kn[8], kd[8], bv[8], sv[8], lwv[8], gl[8]; float run = 0.f;
    { const float w0c = wp.w0[d * 256 + c], a0c = wp.a0[d * 256 + c], kkc = wp.kk[c], kac = wp.ka[c], rkc = wp.rk[c], v0c = layer ? wp.v0[c] : 0.f;
      const float mur = wp.mu[c], muk = wp.mu[256 + c], muv = wp.mu[512 + c];
#pragma unroll
      for (int u = 0; u < 8; ++u) { const int s = 8 * w + u, tau = d ? 63 - s : s, m = tb.m0 + tau;
          const float rr = RSHF(tau, lane, mur), kraw = RSHF(tau, 64 + lane, muk); float v = RSHF(tau, 128 + lane, muv);
          const float z = w0c + *(const LAS float*)(lds + RW_ZZ + (tau * 64 + lane) * 4), za = a0c + *(const LAS float*)(lds + RW_ZA + (tau * 64 + lane) * 4);
          const float lw = -0.6065306597f * sigmoidf_(z), a = sigmoidf_(za);
          const float kkr = kraw * kkc; const float kkn = kkr * rsqrtf(wave_sum(kkr * kkr) + 1e-6f);
          const float kdv = kraw * (1.f + (a - 1.f) * kac);
          const float bs = wave_sum(rr * kdv * rkc);
          if (lane == 0) BSC[((size_t)d * MT + m) * 4 + h] = bs;
          if (layer) { const float zv = v0c + bf2f(*(const LAS bf16*)(lds + RW_ZV + tau * LSTR + 2 * lane)); v = v + (svf[u] - v) * sigmoidf_(zv); }
          if (d == 0) { if (!layer) VF[(size_t)m * 256 + c] = v; SV[(size_t)m * 256 + c] = v; GB[(size_t)m * 256 + c] = bf2f(*(const LAS bf16*)(lds + RW_ZG + tau * LSTR + 2 * lane)); }
          run += lw; rv[u] = rr; kn[u] = kkn; kd[u] = kdv; bv[u] = kkn * a; sv[u] = v; lwv[u] = lw; gl[u] = run; } }
#undef RSHF
#undef RAWV
    WT[w * 64 + lane] = run;
    LDS_BARRIER();
    float off = 0.f, gc = 0.f;
#pragma unroll
    for (int q = 0; q < 8; ++q) { const float t = WT[q * 64 + lane]; gc += t; if (q < w) off += t; }
    { float kapv[8], rhov[8], kht[8], bh[8];
#pragma unroll
      for (int u = 0; u < 8; ++u) { const int s = 8 * w + u; const float G = off + gl[u]; const float eg = __expf(G), eng = __expf(-G), egc = __expf(gc - G);
          kapv[u] = kn[u] * __expf(G - lwv[u]); rhov[u] = rv[u] * eg; kht[u] = kd[u] * egc; bh[u] = bv[u] * egc;
          *(LAS bf16*)(pimg(F, PI_A0) + s * LSTR + 2 * lane) = f2bf(kapv[u]); *(LAS bf16*)(pimg(F, PI_A1) + s * LSTR + 2 * lane) = f2bf(bv[u] * eng);
          *(LAS bf16*)(pimg(F, PI_A2) + s * LSTR + 2 * lane) = f2bf(kd[u] * eng); *(LAS bf16*)(pimg(F, PI_A3) + s * LSTR + 2 * lane) = f2bf(rhov[u]); }
      st_chn8(pimg(F, PI_KAPT), lane, w, kapv); st_chn8(pimg(F, PI_RHOT), lane, w, rhov); st_chn8(pimg(F, PI_VT), lane, w, sv); st_chn8(pimg(F, PI_KHT), lane, w, kht); st_bh8(item + IT_BH, lane, w, bh); }
    if (w == 0) ((GAS float*)(item + IT_GC))[lane] = __expf(gc);
    LDS_BARRIER();
    dplr_core<false>(F, item);
}
__device__ __forceinline__ void ph_rwkv_pre(Frame& F, const bf16* P, const RwP& wp, const bf16* RWTg, int layer, float* VF, float* SV, float* GB, float* BSC, unsigned char* BL) {
    for (int it = F.vcu; it < 272 * 8; it += F.G) { const int tbi = it >> 3, h = (it >> 1) & 3, d = it & 1; rwkv_pre_item(F, P, wp, RWTg, layer, VF, SV, GB, BSC, BL, tbi, h, d); }
}

__device__ __forceinline__ void ph_rwkv_post(Frame& F, const float* YSg, const float* BSCg, const float* SVg, const float* Gg, const float* lnw, const float* lnb, bf16* MIXg) {
    const GAS float* YS = (const GAS float*)YSg; const GAS float* BSC = (const GAS float*)BSCg; const GAS float* SV = (const GAS float*)SVg; const GAS float* G = (const GAS float*)Gg; GAS bf16* MIX = (GAS bf16*)MIXg;
    const int gw = F.vcu * NWAVES + F.wave, NGW = F.G * NWAVES, lane = F.lane;
    for (int i0 = gw; i0 < MT * 4; i0 += 4 * NGW) {
        float y[4], bon[4], gg[4]; int mm[4], cc[4]; bool ok[4];
#pragma unroll
        for (int q = 0; q < 4; ++q) { const int it = i0 + q * NGW; ok[q] = it < MT * 4; const int itc = ok[q] ? it : i0; const int m = itc >> 2, h = itc & 3, c = h * 64 + lane; mm[q] = m; cc[q] = c;
            y[q] = YS[(size_t)m * 256 + c] + YS[((size_t)MT + m) * 256 + c]; bon[q] = (BSC[(size_t)m * 4 + h] + BSC[((size_t)MT + m) * 4 + h]) * SV[(size_t)m * 256 + c]; gg[q] = G[(size_t)m * 256 + c]; }
#pragma unroll
        for (int q = 0; q < 4; ++q) { const float mu = wave_sum(y[q]) * (1.f / 64.f); const float dlt = y[q] - mu; const float var = wave_sum(dlt * dlt) * (1.f / 64.f);
            const float yn = dlt * rsqrtf(var + 64e-5f); const float o = (yn * lnw[cc[q]] + lnb[cc[q]] + bon[q]) * gg[q];
            if (ok[q]) MIX[(size_t)mm[q] * D + cc[q]] = f2bf(o); }
    }
}
__device__ __forceinline__ void ph_hnorm_post(Frame& F, const float* YSag, const float* YSbg, const bf16* Pg, int gate_off, const float* nw, bf16* MIXg, int mix_off) {
    const GAS float* YSa = (const GAS float*)YSag; const GAS float* YSb = (const GAS float*)YSbg; const GAS bf16* P = (const GAS bf16*)Pg; GAS bf16* MIX = (GAS bf16*)MIXg;
    const int gw = F.vcu * NWAVES + F.wave, NGW = F.G * NWAVES, lane = F.lane; const float nwv = nw[lane];
    for (int i0 = gw; i0 < MT * 4; i0 += 4 * NGW) {
        float o[4], g[4]; int mm[4], cc[4]; bool ok[4];
#pragma unroll
        for (int q = 0; q < 4; ++q) { const int it = i0 + q * NGW; ok[q] = it < MT * 4; const int itc = ok[q] ? it : i0; const int m = itc >> 2, c = (itc & 3) * 64 + lane; mm[q] = m; cc[q] = c;
            o[q] = YSa[(size_t)m * 256 + c] + YSb[(size_t)m * 256 + c]; g[q] = bf2f(P[(size_t)m * LDP + gate_off + c]); }
#pragma unroll
        for (int q = 0; q < 4; ++q) { const float ms = wave_sum(o[q] * o[q]) * (1.f / 64.f); const float y = o[q] * rsqrtf(ms + 1e-6f) * siluf_(g[q]) * nwv;
            if (ok[q]) MIX[(size_t)mm[q] * D + mix_off + cc[q]] = f2bf(y); }
    }
}
__device__ __forceinline__ void ph_lru_pre(Frame& F, const bf16* Pgen, const LruP& wp, bf16* LLAg, bf16* LBg, float* LSUMg) {
    const GAS bf16* P = (const GAS bf16*)Pgen; GAS bf16* LLA = (GAS bf16*)LLAg; GAS bf16* LB = (GAS bf16*)LBg; GAS float* LSUM = (GAS float*)LSUMg;
    const int w = F.wave, lane = F.lane, r = lane & 15, g = lane >> 4, tid = F.tid;
    LAS unsigned char* XM = F.lds + RING_OFF;
    LAS unsigned char* WA = F.lds + RING_OFF + 1 * IMG;
    LAS unsigned char* WX = F.lds + RING_OFF + 2 * IMG;
    LAS float* LAs = (LAS float*)(F.lds + RING_OFF + 3 * IMG);
    LAS float* BBs = LAs + 4096;
    const int dh = F.vcu & 7, d = dh >> 2, h = dh & 3;
    { const float* wa = wp.wa + (size_t)dh * 4096; const float* wx = wp.wx + (size_t)dh * 4096;
#pragma unroll
      for (int q = 0; q < 8; ++q) { const int e = tid + q * NTHR, i = e >> 6, j = e & 63; *(LAS bf16*)(WA + j * LSTR + 2 * i) = f2bf(wa[e]); *(LAS bf16*)(WX + j * LSTR + 2 * i) = f2bf(wx[e]); } }
    const int cc = tid & 63, sg = tid >> 6, c = h * 64 + cc;
    const float cb = wp.cb[c]; float cwv[4];
#pragma unroll
    for (int j = 0; j < 4; ++j) cwv[j] = wp.cw[j * 256 + c];
    for (int it = F.vcu; it < 272 * 8; it += F.G) {
        const int tbi = it >> 3; const TB tb = tb_of(tbi); const int L = tb.isx ? SEQ : CTXL;
        { const GAS bf16* pc = P + (size_t)tb.m0 * LDP + LRU_OFF + c; float rowv[11];
#pragma unroll
          for (int q = 0; q < 11; ++q) { const int s = 8 * sg - 2 + q, t = tb.t0 + s; const bool ok = t >= 0 && t < L; const int sc = ok ? s : 8 * sg; const float v = bf2f(pc[(ptrdiff_t)sc * LDP]); rowv[q] = ok ? v : 0.f; }
#pragma unroll
          for (int u = 0; u < 8; ++u) { const float xm = cb + rowv[u] * cwv[0] + rowv[u + 1] * cwv[1] + rowv[u + 2] * cwv[2] + rowv[u + 3] * cwv[3];
              *(LAS bf16*)(XM + (8 * sg + u) * LSTR + 2 * cc) = f2bf(xm); } }
        LDS_BARRIER();
        { const int tt = w & 3, jh = w >> 2;
#pragma unroll
          for (int jq = 0; jq < 2; ++jq) { const int jt = 2 * jh + jq;
              const f32x4 ra = nt_tile64(XM, 16 * tt, WA, 16 * jt, lane, zero4()), rx = nt_tile64(XM, 16 * tt, WX, 16 * jt, lane, zero4());
              const int j = 16 * jt + r, cj = h * 64 + j; const float ba = wp.ba[d * 256 + cj], bx = wp.bx[d * 256 + cj], lam8 = -8.f * softplusf_(-wp.lam[d * 256 + cj]);
#pragma unroll
              for (int i = 0; i < 4; ++i) { const int s = 16 * tt + 4 * g + i; const float xm = bf2f(*(const LAS bf16*)(XM + s * LSTR + 2 * j));
                  const float la = lam8 * sigmoidf_(ra[i] + ba); const float bb = __builtin_amdgcn_sqrtf(fmaxf(1.f - __expf(2.f * la), 0.f)) * sigmoidf_(rx[i] + bx) * xm;
                  LAs[s * 64 + j] = la; BBs[s * 64 + j] = bb;
                  const size_t o = ((size_t)d * MT + tb.m0 + s) * 256 + cj; LLA[o] = f2bf(la); LB[o] = f2bf(bb); } } }
        LDS_BARRIER();
        if (w == 0) { float sl = 0.f, hh = 0.f;
#pragma unroll 8
            for (int s = 0; s < 64; ++s) { const int tau = d ? 63 - s : s; const float la = LAs[tau * 64 + lane], bb = BBs[tau * 64 + lane]; sl += la; hh = __expf(la) * hh + bb; }
            LSUM[(((size_t)d * 272 + tbi) * 2 + 0) * 256 + h * 64 + lane] = sl; LSUM[(((size_t)d * 272 + tbi) * 2 + 1) * 256 + h * 64 + lane] = hh; }
        LDS_BARRIER();
    }
}
__device__ __forceinline__ void ph_lru_carry(Frame& F, const float* LSUMg, float* LCINg) {
    if (blockIdx.x >= 4) return;
    const GAS float* LSUM = (const GAS float*)LSUMg; GAS float* LCIN = (GAS float*)LCINg;
    const int e = blockIdx.x * NTHR + F.tid, c = e & 255, bd = e >> 8, d = bd & 1, b = bd >> 1;
    float hh = 0.f;
#pragma unroll 1
    for (int n0 = 0; n0 < 68; n0 += 17) { float sl[17], he[17]; int tb_[17];
#pragma unroll
        for (int u = 0; u < 17; ++u) { const int n = n0 + u; tb_[u] = n < 4 ? 256 + b * 4 + (d ? 3 - n : n) : b * 64 + (d ? 63 - (n - 4) : (n - 4));
            sl[u] = LSUM[(((size_t)d * 272 + tb_[u]) * 2 + 0) * 256 + c]; he[u] = LSUM[(((size_t)d * 272 + tb_[u]) * 2 + 1) * 256 + c]; }
#pragma unroll
        for (int u = 0; u < 17; ++u) { LCIN[((size_t)d * 272 + tb_[u]) * 256 + c] = hh; hh = __expf(sl[u]) * hh + he[u]; } }
}
__device__ __forceinline__ void ph_lru_post(Frame& F, const bf16* P, const bf16* LLA, const bf16* LB, const float* LCIN, bf16* MIX) {
    const int half = F.tid >> 8, c = F.tid & 255;
    for (int it = F.vcu; it < 136; it += F.G) { const int tbi = it * 2 + half; const TB tb = tb_of(tbi);
        float hf[64]; float hh = LCIN[((size_t)0 * 272 + tbi) * 256 + c];
        const GAS bf16* pa = (const GAS bf16*)(LLA + (size_t)tb.m0 * 256 + c); const GAS bf16* pb = (const GAS bf16*)(LB + (size_t)tb.m0 * 256 + c);
#pragma unroll
        for (int s0 = 0; s0 < 64; s0 += 8) { float la[8], bb[8];
            asm volatile("" : "+v"(pa), "+v"(pb));
#pragma unroll
            for (int u = 0; u < 8; ++u) { la[u] = bf2f(pa[u * 256]); bb[u] = bf2f(pb[u * 256]); }
#pragma unroll
            for (int u = 0; u < 8; ++u) { hh = __expf(la[u]) * hh + bb[u]; hf[s0 + u] = hh; }
            pa += 8 * 256; pb += 8 * 256; }
        hh = LCIN[((size_t)1 * 272 + tbi) * 256 + c];
        pa = (const GAS bf16*)(LLA + ((size_t)MT + tb.m0 + 56) * 256 + c); pb = (const GAS bf16*)(LB + ((size_t)MT + tb.m0 + 56) * 256 + c);
        const GAS bf16* pg = (const GAS bf16*)(P + (size_t)(tb.m0 + 56) * LDP + LRU_OFF + 256 + c); GAS bf16* pm = (GAS bf16*)(MIX + (size_t)(tb.m0 + 56) * D + 768 + c);
#pragma unroll
        for (int s0 = 56; s0 >= 0; s0 -= 8) { float la[8], bb[8], gt[8];
            asm volatile("" : "+v"(pa), "+v"(pb), "+v"(pg), "+v"(pm));
#pragma unroll
            for (int u = 0; u < 8; ++u) { la[u] = bf2f(pa[(7 - u) * 256]); bb[u] = bf2f(pb[(7 - u) * 256]); gt[u] = bf2f(pg[(7 - u) * LDP]); }
#pragma unroll
            for (int u = 0; u < 8; ++u) { const int s = s0 + 7 - u; hh = __expf(la[u]) * hh + bb[u];
                const float ge = 0.5f * gt[u] * (1.f + tanhf_(0.7978845608f * (gt[u] + 0.044715f * gt[u] * gt[u] * gt[u])));
                pm[(7 - u) * D] = f2bf((hf[s] + hh) * ge); }
            pa -= 8 * 256; pb -= 8 * 256; pg -= 8 * LDP; pm -= 8 * D; }
    }
}

__device__ __forceinline__ void ph_final_norm(Frame& F, const float* XR, const float* gain, float* out) {
    const int gw = F.vcu * NWAVES + F.wave, NGW = F.G * NWAVES, lane = F.lane;
    for (int m = gw; m < NX; m += NGW) {
        const float* src = XR + (size_t)m * D; f32x4 v[4]; float ss = 0.f;
#pragma unroll
        for (int j = 0; j < 4; ++j) { v[j] = *(const f32x4*)(src + 4 * lane + 256 * j); ss += (v[j].x * v[j].x + v[j].y * v[j].y) + (v[j].z * v[j].z + v[j].w * v[j].w); }
        ss = wave_sum(ss); const float rs = rsqrtf(ss * (1.f / D) + 1e-6f);
#pragma unroll
        for (int j = 0; j < 4; ++j) { const int ci = 4 * lane + 256 * j; *(f32x4*)(out + (size_t)m * D + ci) = v[j] * rs * *(const f32x4*)(gain + ci); }
    }
}

#define INP(i) ([&]() { int ii_ = (i); asm volatile("" : "+s"(ii_)); return (const float*)(const GAS float*)a.in[ii_]; }())
#ifndef PH_MASK
#define PH_MASK 0xfffff
#endif
#define IN(k) ((PH_MASK >> (k)) & 1)
#define SEAM() do { xcd_barrier(bar); if (PROBE_SEC == 100 + F.curk) F.tacc += clock64() - F.tph0; } while (0)
#define MOD ((float*)(GAS float*)(wsb + WS_MOD))
#define XN ((bf16*)(GAS bf16*)(wsb + WS_XN))
#define XR ((float*)(GAS float*)(wsb + WS_XR))
#define P ((bf16*)(GAS bf16*)(wsb + WS_P))
#define WIN_T ((bf16*)(GAS bf16*)(wsb + WS_WIN))
#define WOUT_T ((bf16*)(GAS bf16*)(wsb + WS_WOUT))
#define VF ((float*)(GAS float*)(wsb + WS_VF))
#define BON ((float*)(GAS float*)(wsb + WS_BON))
#define GG ((float*)(GAS float*)(wsb + WS_G))
#define YS ((float*)(GAS float*)(wsb + WS_YS))
#define SV ((float*)(GAS float*)(wsb + WS_SV))
#define SI ((float*)(GAS float*)(wsb + WS_SI))
#define WGU_T ((bf16*)(GAS bf16*)(wsb + WS_WGU))
#define WD_T ((bf16*)(GAS bf16*)(wsb + WS_WD))
#define HACT ((bf16*)(GAS bf16*)(wsb + WS_HACT))
#define Y ((bf16*)(GAS bf16*)(wsb + WS_Y))
#define DZ ((bf16*)(GAS bf16*)(wsb + WS_DZ))
#define BSC ((float*)(GAS float*)(wsb + WS_BSC))
#define YS2A ((float*)(GAS float*)(wsb + WS_BON))
#define YS2B ((float*)(GAS float*)(wsb + WS_YS2B))
#define LLA ((bf16*)(GAS bf16*)(wsb + WS_LLA))
#define LBB ((bf16*)(GAS bf16*)(wsb + WS_LB))
#define LSUM ((float*)(GAS float*)(wsb + WS_LSUM))
#define LCIN ((float*)(GAS float*)(wsb + WS_LCIN))
#define LIST ((unsigned*)(GAS unsigned*)(wsb + WS_LIST))
#define SLOTPOS ((int*)(GAS int*)(wsb + WS_SLOT))
#define SLOTG ((float*)(GAS float*)(wsb + WS_SLOTG))
#define RTW_T ((bf16*)(GAS bf16*)(wsb + WS_RTW))
#define RWT ((bf16*)(GAS bf16*)(wsb + WS_RWT))
#define MIX XN
#define PH() do { wsb = (GAS unsigned char*)ws; asm volatile("" : "+s"(wsb)); int t_ = threadIdx.x; asm volatile("" : "+v"(t_)); F.tid = t_; F.lane = t_ & 63; F.wave = __builtin_amdgcn_readfirstlane(t_ >> 6); half = t_ >> 8; c256 = t_ & 255; \
        shh = (LAS float*)(F.lds + RING_OFF + half * 8192); } while (0)

template <int l>
__device__ __forceinline__ void layer_body(Frame& F, const MArgs& a, const XcdBarrier& bar, unsigned char* ws) {
    GAS unsigned char* wsb = (GAS unsigned char*)ws; int half = 0, c256 = 0; LAS float* shh = nullptr;
        const float* MODl = MOD + (size_t)l * 5 * 6144;
        const float* xs = l == 0 ? INP(I_X) : XR; const float* cs = l == 0 ? INP(I_CTX) : XR + (size_t)NX * D;
        const int ntok = l == 0 ? MT : NX;
        if (IN(1) && l == 0) for (int rp_ = 0; rp_ < REPS(1); ++rp_) { PH(); F.curk = 1; if (PROBE_SEC >= 100) F.tph0 = clock64(); ph_norm_mod(F, xs, cs, INP(I_NMIX) + l * D, MODl, 0, XN, MT); __syncthreads();
            ph_convert_small(F, INP(I_WIN), INP(I_WVRES), INP(I_WOUT), WIN_T, WOUT_T, 1, 2); ph_convert_router(F, INP(I_RTW), RTW_T); ph_convert_rwkv(F, INP(I_RWW2), INP(I_RWA2), INP(I_RWV2), INP(I_RWG2), RWT); SEAM(); }
        if (IN(2)) for (int rp_ = 0; rp_ < REPS(2); ++rp_) { PH(); F.curk = 2; if (PROBE_SEC >= 100) F.tph0 = clock64(); pg8::DenseOrder S; S.init(XN, WIN_T + (size_t)l * LDP * D, MT, LDP, D, F.G, (int)blockIdx.x); pg8::EpiStoreBf16 E{P, LDP};
            pg8::gemm_phase<pg8::EpiStoreBf16, pg8::DenseOrder, true>(F.lds + RING_OFF, D, S, E); SEAM(); }
        float* LA = SI; float* LB = SI + (size_t)2 * MT * 256;
        if (IN(3)) for (int rp_ = 0; rp_ < REPS(3); ++rp_) { PH(); F.curk = 3; if (PROBE_SEC >= 100) F.tph0 = clock64(); const RwP rwp{INP(I_RWMU) + l * 960, INP(I_RWW0) + l * 512, INP(I_RWW2) + l * 2 * 32 * 256, INP(I_RWA0) + l * 512, INP(I_RWA2) + l * 2 * 32 * 256, INP(I_RWG2) + l * 64 * 256, INP(I_RWKK) + l * 256, INP(I_RWKA) + l * 256,
                      INP(I_RWRK) + l * 256, INP(I_RWV0), INP(I_RWV2)};
            ph_rwkv_pre(F, P, rwp, RWT, l, VF, SV, GG, BSC, (unsigned char*)SI); SEAM(); }
        if (IN(4)) for (int rp_ = 0; rp_ < REPS(4); ++rp_) { PH(); F.curk = 4; if (PROBE_SEC >= 100) F.tph0 = clock64();
            if (blockIdx.x < 32) { TSECN_BEGIN(30) dplr_scan_seq(F, (const unsigned char*)SI, (int)blockIdx.x, YS, YS + (size_t)MT * 256); TSECN_END(30) }
            else { TSECN_BEGIN(31) const int vcu0 = F.vcu, G0 = F.G; F.vcu = (int)blockIdx.x - 32; F.G = G0 - 32;
                { const LruP lrp{INP(I_LCW) + l * 4 * 256, INP(I_LCB) + l * 256, INP(I_LWA) + (size_t)l * 2 * 4 * 64 * 64, INP(I_LBA) + l * 512, INP(I_LWX) + (size_t)l * 2 * 4 * 64 * 64, INP(I_LBX) + l * 512, INP(I_LLAM) + l * 512};
                  ph_lru_pre(F, P, lrp, LLA, LBB, LSUM); }
                __syncthreads(); build_rope(F); __syncthreads(); ph_ret_pre(F, P, INP(I_RETL) + l * 8, DZ);
                F.vcu = vcu0; F.G = G0; TSECN_END(31) }
            SEAM(); }
        if (IN(5)) for (int rp_ = 0; rp_ < REPS(5); ++rp_) { PH(); F.curk = 5; if (PROBE_SEC >= 100) F.tph0 = clock64();
            ph_gdn_pre(F, P, INP(I_GCW) + l * 4 * 768, INP(I_GALOG) + l * 8, INP(I_GDT) + l * 8, (unsigned char*)SI);
            ph_ret_prefix(F, INP(I_RETL) + l * 8, DZ); ph_lru_carry(F, LSUM, LCIN); SEAM(); }
        if (IN(8)) for (int rp_ = 0; rp_ < REPS(8); ++rp_) { PH(); F.curk = 8; if (PROBE_SEC >= 100) F.tph0 = clock64();
            if (blockIdx.x < 32) { TSECN_BEGIN(30) dplr_scan_seq(F, (const unsigned char*)SI, (int)blockIdx.x, YS2A, YS2B); TSECN_END(30) }
            else { TSECN_BEGIN(32) const int vcu0 = F.vcu, G0 = F.G; F.vcu = (int)blockIdx.x - 32; F.G = G0 - 32;
                ph_rwkv_post(F, YS, BSC, SV, GG, INP(I_RWLNW) + l * 256, INP(I_RWLNB) + l * 256, MIX);
                build_rope(F); __syncthreads(); ph_ret_post(F, P, INP(I_RETL) + l * 8, DZ, MIX); __syncthreads(); ph_lru_post(F, P, LLA, LBB, LCIN, MIX);
                F.vcu = vcu0; F.G = G0; TSECN_END(32) }
            SEAM(); }
        if (IN(9)) for (int rp_ = 0; rp_ < REPS(9); ++rp_) { PH(); F.curk = 9; if (PROBE_SEC >= 100) F.tph0 = clock64(); ph_hnorm_post(F, YS2A, YS2B, P, GDN_OFF + 784, INP(I_GNW) + l * 64, MIX, 512); SEAM(); }
        if (IN(12)) for (int rp_ = 0; rp_ < REPS(12); ++rp_) { PH(); F.curk = 12; if (PROBE_SEC >= 100) F.tph0 = clock64(); pg8::DenseOrder S; S.init(MIX, WOUT_T + (size_t)l * D * D, l == 0 ? MT : NX  , D, D, F.G, (int)blockIdx.x); pg8::EpiResidual E{xs, cs, MODl, XR};
            pg8::gemm_phase<pg8::EpiResidual, pg8::DenseOrder, true>(F.lds + RING_OFF, D, S, E); SEAM(); }
        if (IN(13)) for (int rp_ = 0; rp_ < REPS(13); ++rp_) { PH(); F.curk = 13; if (PROBE_SEC >= 100) F.tph0 = clock64(); ph_route(F, XR, INP(I_NFFN) + l * D, MODl, RTW_T + (size_t)l * 2 * 64 * 1024, INP(I_RTB) + l * NE, XN, l, LIST, SLOTPOS, SLOTG, ntok); __syncthreads();
            { ph_convert_experts(F, INP(I_EWG) + (size_t)l * NE * D * EFF, INP(I_EWU) + (size_t)l * NE * D * EFF, INP(I_EWD) + (size_t)l * NE * EFF * D,
                               INP(I_SWG) + (size_t)l * D * EFF, INP(I_SWU) + (size_t)l * D * EFF, INP(I_SWD) + (size_t)l * EFF * D, WGU_T, WD_T); }
            SEAM(); }
        if (IN(14)) for (int rp_ = 0; rp_ < REPS(14); ++rp_) { PH(); F.curk = 14; if (PROBE_SEC >= 100) F.tph0 = clock64(); moe_build_tab(F, l, ntok); MoeTab T = moe_tab(F);
            pg8::MoeOrder1 S{XN, WGU_T, LIST, T, F.G, F.vcu  , T.ups[65] * 2}; pg8::EpiSwiglu E{HACT};
            pg8::gemm_phase<pg8::EpiSwiglu, pg8::MoeOrder1, true>(F.lds + RING_OFF, D, S, E); SEAM(); }
        if (IN(15)) for (int rp_ = 0; rp_ < REPS(15); ++rp_) { PH(); F.curk = 15; if (PROBE_SEC >= 100) F.tph0 = clock64(); moe_build_tab(F, l, ntok); MoeTab T = moe_tab(F);
            pg8::MoeOrder2 S{HACT, WD_T, T, F.G, F.vcu, T.ups[65] * 4}; pg8::EpiDown E{Y, XR, MODl};
            int k2 = EFF; asm volatile("" : "+s"(k2));
            pg8::gemm_phase<pg8::EpiDown, pg8::MoeOrder2, true>(F.lds + RING_OFF, k2, S, E); SEAM(); }
        if (IN(16)) for (int rp_ = 0; rp_ < REPS(16); ++rp_) { PH(); F.curk = 16; if (PROBE_SEC >= 100) F.tph0 = clock64(); moe_build_tab(F, l, ntok);
            if (l == 0) ph_combine_norm<false>(F, Y, SLOTPOS, SLOTG, MODl, XR, ntok, INP(I_NMIX) + D, MOD + (size_t)5 * 6144, XN, nullptr);
            else ph_combine_norm<true>(F, Y, SLOTPOS, SLOTG, MODl, XR, ntok, INP(I_NFIN), nullptr, nullptr, a.out);
            if (l == 0) SEAM(); }
    }

__global__ void __launch_bounds__(NTHR, 2) mega(MArgs a) {
    extern __shared__ __attribute__((aligned(16))) unsigned char lds_raw[];
    Frame F; F.lds = (LAS unsigned char*)lds_raw; F.MISC = (volatile LAS unsigned*)(F.lds + MISC_OFF);
    F.tid = threadIdx.x; F.lane = F.tid & 63; F.wave = __builtin_amdgcn_readfirstlane(F.tid >> 6); F.tacc = 0ull;
    F.G = gridDim.x; { const int bx = blockIdx.x; F.vcu = (F.G % 8 == 0) ? (bx % 8) * (F.G / 8) + bx / 8 : bx; }
    unsigned char* ws = a.ws; F.ctl = (gu32*)ws;
    for (int u = F.tid; u < (LDS_BYTES - LDSCTL_OFF) / 4; u += NTHR) ((LAS unsigned*)(F.lds + LDSCTL_OFF))[u] = 0u;
    __syncthreads();
    XcdBarrier bar = xcd_barrier_post((unsigned*)(F.ctl + CW_BAR) + a.bar_region * XCD_BAR_WORDS, F.MISC + 8);
    GAS unsigned char* wsb = (GAS unsigned char*)ws;
    int half = 0, c256 = 0; LAS float* shh = nullptr;

    if (IN(0)) for (int rp_ = 0; rp_ < REPS(0); ++rp_) { PH(); F.curk = 0; if (PROBE_SEC >= 100) F.tph0 = clock64(); ph_mod(F, INP(I_C), INP(I_CCTX), INP(I_ADAW), INP(I_ADAB), MOD); ph_convert_small(F, INP(I_WIN), INP(I_WVRES), INP(I_WOUT), WIN_T, WOUT_T, 0, 1);     SEAM(); }
    layer_body<0>(F, a, bar, ws);
    layer_body<1>(F, a, bar, ws);
    if (PROBE_SEC >= 0) { const unsigned long long t0_ = clock64(); while (clock64() - t0_ < F.tacc) __builtin_amdgcn_s_sleep(4); }
#undef PH
#undef MOD
#undef XN
#undef XR
#undef P
#undef WIN_T
#undef WOUT_T
#undef VF
#undef BON
#undef GG
#undef YS
#undef SV
#undef SI
#undef WGU_T
#undef WD_T
#undef HACT
#undef Y
#undef DZ
#undef BSC
#undef YS2A
#undef YS2B
#undef LLA
#undef LBB
#undef LSUM
#undef LCIN
#undef LIST
#undef SLOTPOS
#undef SLOTG
#undef RTW_T
#undef RWT
#undef MIX
#undef IN
#undef SEAM
}

extern "C" void kernel_launch(void* const* d_in, const int* in_sizes, int n_in, void* d_out, int out_size, void* d_ws, size_t ws_size, hipStream_t stream) {
    static int grid = 0;
    if (grid == 0) {
        if (n_in != I_N || ws_size < WS_END) { fprintf(stderr, "kernel_launch: bad n_in %d or ws %zu\n", n_in, ws_size); grid = -1; return; }
        int dev = 0, cus = 0;
        if (hipGetDevice(&dev) != hipSuccess || hipDeviceGetAttribute(&cus, hipDeviceAttributeMultiprocessorCount, dev) != hipSuccess) { grid = -1; return; }
        if (hipFuncSetAttribute((const void*)mega, hipFuncAttributeMaxDynamicSharedMemorySize, LDS_BYTES) != hipSuccess) { grid = -1; return; }
        int per_cu = 0; (void)hipOccupancyMaxActiveBlocksPerMultiprocessor(&per_cu, (const void*)mega, NTHR, LDS_BYTES); (void)hipGetLastError();
        grid = cus;
    }
    if (grid < 0) return;
    unsigned char* ws = (unsigned char*)d_ws;
    (void)hipMemsetAsync(ws, 0, CTL_ZERO_BYTES, stream);
    MArgs ma{}; for (int i = 0; i < I_N; ++i) ma.in[i] = (const float*)d_in[i]; ma.out = (float*)d_out; ma.ws = ws;
    ma.ph_lo = 0; ma.ph_hi = 18; ma.l_lo = 0; ma.l_hi = 2; ma.bar_region = 0;
    hipLaunchKernelGGL(mega, dim3(grid), dim3(NTHR), LDS_BYTES, stream, ma);
}
```
